# Optimizing an MI355X kernel written in HIP

```python
import math
import jax, jax.numpy as jnp
from jax import lax
import numpy as np

D_MODEL = 1024
BATCH = 8
SEQ = 4096
DEPTH = 1

D_MIX = D_MODEL
M_HEADS = 4
M_HEAD_DIM = 128
M_WIDTH = M_HEADS * M_HEAD_DIM
M_CHUNK = 64
M_CONV = 4
M_INIT = -1e30
A_HEADS = 8
A_KV_HEADS = 2
A_HEAD_DIM = 64
A_WIDTH = A_HEADS * A_HEAD_DIM
A_GROUP = A_HEADS // A_KV_HEADS
WINDOW = 128
ROPE_THETA = 500000.0
ROT_DIM = A_HEAD_DIM // 4
D_FF = int(math.ceil(8 * D_MODEL / 3 / 256) * 256)
EPS = 1e-6

IN_SIZES = (M_WIDTH, M_WIDTH, M_WIDTH, M_WIDTH, M_HEADS, M_HEADS,
            A_WIDTH, A_KV_HEADS * A_HEAD_DIM, A_KV_HEADS * A_HEAD_DIM)
D_IN = sum(IN_SIZES)

kernel_name = "hybrid_mlstm_swa_sink_swiglu"


def _rmsnorm(x, g):
    xf = x.astype(jnp.float32)
    y = xf * lax.rsqrt(jnp.mean(xf * xf, axis=-1, keepdims=True) + EPS)
    return (y * g.astype(jnp.float32)).astype(x.dtype)


def _causal_conv_silu(x, w):
    k = w.shape[0]
    y = lax.conv_general_dilated(x, w[:, None, :].astype(x.dtype), window_strides=(1,),
                                 padding=((k - 1, 0),),
                                 dimension_numbers=("NWC", "WIO", "NWC"),
                                 feature_group_count=x.shape[-1])
    return jax.nn.silu(y)


def _rope_partial(x, cos, sin):
    xr, xp = x[..., :ROT_DIM], x[..., ROT_DIM:]
    xr = xr.astype(jnp.float32)
    x1, x2 = xr[..., :ROT_DIM // 2], xr[..., ROT_DIM // 2:]
    c = cos[None, :, None, :]
    s = sin[None, :, None, :]
    rot = jnp.concatenate([x1 * c - x2 * s, x2 * c + x1 * s], axis=-1)
    return jnp.concatenate([rot.astype(x.dtype), xp], axis=-1)


def _mlstm(q, k, v, i_pre, f_pre):
    f32 = jnp.float32
    B, S, NH, DH = q.shape
    L = M_CHUNK
    NC = S // L

    def chunk4(t):
        return t.astype(f32).reshape(B, NC, L, NH, DH).transpose(0, 3, 1, 2, 4)

    def chunk3(t):
        return t.astype(f32).reshape(B, NC, L, NH).transpose(0, 3, 1, 2)

    q = chunk4(q)
    k = chunk4(k) * (DH ** -0.5)
    v = chunk4(v)
    ig = chunk3(i_pre)
    lf = jax.nn.log_sigmoid(chunk3(f_pre))
    b = jnp.cumsum(lf, axis=-1)
    g = b[..., -1]

    a = g[..., None] - b + ig
    m_loc = jnp.max(a, axis=-1)
    w = jnp.exp(a - m_loc[..., None])
    dC = jnp.einsum('bhcl,bhcld,bhcle->bhcde', w, k, v)
    dn = jnp.einsum('bhcl,bhcld->bhcd', w, k)

    def step(carry, inp):
        C, n, m = carry
        dC_c, dn_c, g_c, ml_c = inp
        m_new = jnp.maximum(g_c + m, ml_c)
        s_old = jnp.exp(g_c + m - m_new)
        s_new = jnp.exp(ml_c - m_new)
        C_new = s_old[..., None, None] * C + s_new[..., None, None] * dC_c
        n_new = s_old[..., None] * n + s_new[..., None] * dn_c
        return (C_new, n_new, m_new), (C, n, m)

    init = (jnp.zeros((B, NH, DH, DH), f32), jnp.zeros((B, NH, DH), f32),
            jnp.full((B, NH), M_INIT, f32))
    xs = (jnp.moveaxis(dC, 2, 0), jnp.moveaxis(dn, 2, 0), jnp.moveaxis(g, 2, 0), jnp.moveaxis(m_loc, 2, 0))
    _, (Cs, ns, ms) = lax.scan(step, init, xs)
    Cs = jnp.moveaxis(Cs, 0, 2)
    ns = jnp.moveaxis(ns, 0, 2)
    ms = jnp.moveaxis(ms, 0, 2)

    causal = jnp.tril(jnp.ones((L, L), dtype=bool))
    D = jnp.where(causal, b[..., :, None] - b[..., None, :] + ig[..., None, :], -jnp.inf)
    inter = b + ms[..., None]
    m_t = jnp.maximum(jnp.max(D, axis=-1), inter)
    Sw = jnp.einsum('bhcld,bhcsd->bhcls', q, k) * jnp.exp(D - m_t[..., None])
    sc = jnp.exp(inter - m_t)
    num = jnp.einsum('bhcls,bhcse->bhcle', Sw, v) + sc[..., None] * jnp.einsum('bhcld,bhcde->bhcle', q, Cs)
    den = jnp.sum(Sw, axis=-1) + sc * jnp.einsum('bhcld,bhcd->bhcl', q, ns)
    h = num / jnp.maximum(jnp.abs(den), jnp.exp(-m_t))[..., None]
    return h.transpose(0, 2, 3, 1, 4).reshape(B, S, NH, DH)


def _swa_sinks(q, k, v, sinks):
    B, S, HQ, Dh = q.shape
    W = WINDOW
    NB = S // W
    qb = q.reshape(B, NB, W, A_KV_HEADS, A_GROUP, Dh)
    kb = k.reshape(B, NB, W, A_KV_HEADS, Dh)
    vb = v.reshape(B, NB, W, A_KV_HEADS, Dh)
    pad = jnp.zeros_like(kb[:, :1])
    k2 = jnp.concatenate([jnp.concatenate([pad, kb[:, :-1]], axis=1), kb], axis=2)
    v2 = jnp.concatenate([jnp.concatenate([pad, vb[:, :-1]], axis=1), vb], axis=2)
    s = jnp.einsum('bnqhgd,bnkhd->bnhgqk', qb, k2).astype(jnp.float32) * (Dh ** -0.5)
    qpos = jnp.arange(W)[:, None] + W
    kpos = jnp.arange(2 * W)[None, :]
    rel = qpos - kpos
    band = (rel >= 0) & (rel < W)
    valid = band[None] & ((jnp.arange(NB)[:, None, None] > 0) | (kpos >= W)[None])
    s = jnp.where(valid[None, :, None, None], s, -jnp.inf)
    sink = sinks.astype(jnp.float32).reshape(1, 1, A_KV_HEADS, A_GROUP, 1, 1)
    logits = jnp.concatenate([s, jnp.broadcast_to(sink, s.shape[:-1] + (1,))], axis=-1)
    p = jax.nn.softmax(logits, axis=-1)[..., :-1]
    o = jnp.einsum('bnhgqk,bnkhd->bnqhgd', p.astype(v.dtype), v2)
    return o.reshape(B, S, HQ, Dh)


def setup_inputs(seed: int = 0) -> dict:
    key = jax.random.key(seed)
    ks = jax.random.split(key, 16)
    f32 = jnp.float32
    nrm = lambda k_, shp, sc: (jax.random.normal(k_, shp, f32) * sc)
    return {
        "x": jax.random.normal(ks[0], (BATCH, SEQ, D_MODEL), f32),
        "norm1_g": 1.0 + nrm(ks[1], (DEPTH, D_MODEL), 0.02),
        "w_in": nrm(ks[2], (DEPTH, D_MODEL, D_IN), D_MODEL ** -0.5),
        "conv_w": nrm(ks[3], (DEPTH, M_CONV, 2 * M_WIDTH), M_CONV ** -0.5),
        "igate_b": nrm(ks[4], (DEPTH, M_HEADS), 0.1),
        "fgate_b": jax.random.uniform(ks[5], (DEPTH, M_HEADS), f32, 3.0, 6.0),
        "mlstm_norm_g": 1.0 + nrm(ks[6], (DEPTH, M_WIDTH), 0.02),
        "q_norm_g": 1.0 + nrm(ks[7], (DEPTH, A_HEAD_DIM), 0.02),
        "k_norm_g": 1.0 + nrm(ks[8], (DEPTH, A_HEAD_DIM), 0.02),
        "sinks": nrm(ks[9], (DEPTH, A_HEADS), 1.0),
        "w_out": nrm(ks[10], (DEPTH, D_MIX, D_MODEL), D_MIX ** -0.5),
        "norm2_g": 1.0 + nrm(ks[11], (DEPTH, D_MODEL), 0.02),
        "w_gate": nrm(ks[12], (DEPTH, D_MODEL, D_FF), D_MODEL ** -0.5),
        "w_up": nrm(ks[13], (DEPTH, D_MODEL, D_FF), D_MODEL ** -0.5),
        "w_down": nrm(ks[14], (DEPTH, D_FF, D_MODEL), D_FF ** -0.5),
    }


def reference(x, norm1_g, w_in, conv_w, igate_b, fgate_b, mlstm_norm_g, q_norm_g, k_norm_g,
              sinks, w_out, norm2_g, w_gate, w_up, w_down):
    B, S, _ = x.shape
    f32 = jnp.float32
    pos = jnp.arange(S, dtype=f32)
    inv_freq = ROPE_THETA ** (-jnp.arange(0, ROT_DIM, 2, dtype=f32) / ROT_DIM)
    ang = pos[:, None] * inv_freq[None, :]
    cos, sin = jnp.cos(ang), jnp.sin(ang)
    split_at = [int(i) for i in np.cumsum(IN_SIZES)[:-1]]

    h = x
    for l in range(DEPTH):
        u = _rmsnorm(h, norm1_g[l])
        proj = u @ w_in[l]
        mq, mk, mv, mo, mi, mf, aq, ak, av = jnp.split(proj, split_at, axis=-1)

        qk = _causal_conv_silu(jnp.concatenate([mq, mk], axis=-1), conv_w[l])
        mq_c, mk_c = qk[..., :M_WIDTH], qk[..., M_WIDTH:]
        hm = _mlstm(mq_c.reshape(B, S, M_HEADS, M_HEAD_DIM),
                    mk_c.reshape(B, S, M_HEADS, M_HEAD_DIM),
                    mv.reshape(B, S, M_HEADS, M_HEAD_DIM),
                    mi.astype(f32) + igate_b[l].astype(f32),
                    mf.astype(f32) + fgate_b[l].astype(f32))
        hm = _rmsnorm(hm, mlstm_norm_g[l].reshape(M_HEADS, M_HEAD_DIM))
        hm = (hm * jax.nn.sigmoid(mo.astype(f32)).reshape(B, S, M_HEADS, M_HEAD_DIM))
        hm = hm.reshape(B, S, M_WIDTH).astype(x.dtype)

        q = _rope_partial(_rmsnorm(aq.reshape(B, S, A_HEADS, A_HEAD_DIM), q_norm_g[l]), cos, sin)
        k = _rope_partial(_rmsnorm(ak.reshape(B, S, A_KV_HEADS, A_HEAD_DIM), k_norm_g[l]), cos, sin)
        v = av.reshape(B, S, A_KV_HEADS, A_HEAD_DIM)
        ha = _swa_sinks(q, k, v, sinks[l]).reshape(B, S, A_WIDTH).astype(x.dtype)

        h = h + jnp.concatenate([hm, ha], axis=-1) @ w_out[l]

        u2 = _rmsnorm(h, norm2_g[l])
        h = h + (jax.nn.silu(u2 @ w_gate[l]) * (u2 @ w_up[l])) @ w_down[l]
    return h
```

```cpp
#include <hip/hip_runtime.h>
#include <cstdio>
#include <cstdint>
namespace pg8 {
#define PG8_LAS __attribute__((address_space(3)))
typedef unsigned short bf16_t;
typedef short bf16x8 __attribute__((ext_vector_type(8)));
typedef float f32x4 __attribute__((ext_vector_type(4)));
typedef unsigned u32x4 __attribute__((ext_vector_type(4)));
constexpr int BM = 256, BK = 64, HALF = 128, HTB = HALF * BK * 2  , STAGE_BYTES = 8 * HTB, NXCD = 8, WGM = 8;

__host__ __device__ __forceinline__ int lds_byte(int r, int c) { const int st = (r >> 4) * 2 + (c >> 5), rr = r & 15, cc = c & 31, ob = rr * 64 + cc * 2; return st * 1024 + (ob ^ (((ob >> 9) & 1) << 5)); }
__host__ __device__ __forceinline__ void stage_rc(int b, int& R, int& C) { const int st = b / 1024, sb = b % 1024, swz = sb ^ (((sb >> 9) & 1) << 5); R = (st >> 1) * 16 + swz / 64; C = (st & 1) * 32 + (swz % 64) / 2; }
__host__ __device__ __forceinline__ int perm32(int rho) { const int n = rho >> 4, i = rho & 15; return 8 * (i >> 2) + 4 * n + (i & 3); }

struct Unit { int pm, pn; };
struct Gemm { const bf16_t* A; const bf16_t* Bt; int M, N, K; };

struct StaticOrder {
    int nM, nN, nwg, G, c;
    __host__ __device__ void init(int M, int N, int G_, int c_) { nM = M / BM; nN = N / BM; nwg = nM * nN; G = G_; c = c_; }
    __host__ __device__ bool next(int i, Unit& u) const {
        const long L = (long)i * G + c; if (L >= nwg) return false;
        int wgid = (int)L; { const int q = nwg / NXCD, r = nwg % NXCD, xcd = wgid % NXCD, off = wgid / NXCD; wgid = (xcd < r ? xcd * (q + 1) : r * (q + 1) + (xcd - r) * q) + off; }
        const int nig = WGM * nN, gid = wgid / nig, fm = gid * WGM, gsz = (nM - fm) < WGM ? (nM - fm) : WGM;
        u.pm = fm + ((wgid % nig) % gsz); u.pn = (wgid % nig) / gsz; return true;
    }
    __device__ __forceinline__ void a_ready(const Unit&) const {}
    __device__ __forceinline__ void done(const Unit&) const {}
};

__device__ __forceinline__ unsigned cvt_pk_bf16(float lo, float hi) { unsigned r; asm volatile("v_cvt_pk_bf16_f32 %0, %1, %2" : "=v"(r) : "v"(lo), "v"(hi)); return r; }
typedef float f32x2 __attribute__((ext_vector_type(2)));
__device__ __forceinline__ float fast_silu(float v) { return v * __builtin_amdgcn_rcpf(1.0f + __builtin_amdgcn_exp2f(v * -1.4426950408889634f)); }
struct EpiStoreBf16 {
    static constexpr bool PERM = true, AFTER_DRAIN = false;
    bf16_t* O; int ldc;
    __device__ __forceinline__ void operator()(const f32x4 (&acc)[2][2][4][2], const Unit& u, int wr, int wc, int fr, int fq) const {
        const int row0 = u.pm * BM + wr * 64 + fr, col0 = u.pn * BM + wc * 32 + 8 * fq;
#pragma unroll
        for (int ai = 0; ai < 2; ++ai)
#pragma unroll
            for (int m = 0; m < 4; ++m) { bf16_t* rowp = O + (size_t)(row0 + ai * HALF + m * 16) * ldc + col0;
#pragma unroll
                for (int bj = 0; bj < 2; ++bj) { const f32x4 v0 = acc[ai][bj][m][0], v1 = acc[ai][bj][m][1];
                    u32x4 w; w.x = cvt_pk_bf16(v0[0], v0[1]); w.y = cvt_pk_bf16(v0[2], v0[3]); w.z = cvt_pk_bf16(v1[0], v1[1]); w.w = cvt_pk_bf16(v1[2], v1[3]);
                    *(u32x4*)(rowp + bj * HALF) = w; } }
    }
};
struct EpiResidNorm {
    static constexpr bool PERM = true, AFTER_DRAIN = false;
    const float* X; float* H; bf16_t* HB; float* SSQ;
    __device__ __forceinline__ void operator()(const f32x4 (&acc)[2][2][4][2], const Unit& u, int wr, int wc, int fr, int fq) const {
        const int row0 = u.pm * BM + wr * 64 + fr, col0 = u.pn * BM + wc * 32 + 8 * fq;
#pragma unroll
        for (int ai = 0; ai < 2; ++ai)
#pragma unroll
            for (int m = 0; m < 4; ++m) { const int row = row0 + ai * HALF + m * 16; const size_t off = (size_t)row * 1024 + col0; float ss = 0.f;
#pragma unroll
                for (int bj = 0; bj < 2; ++bj) { const f32x4 x0 = *(const f32x4*)(X + off + bj * HALF), x1 = *(const f32x4*)(X + off + bj * HALF + 4);
                    const f32x4 v0 = x0 + acc[ai][bj][m][0], v1 = x1 + acc[ai][bj][m][1];
                    *(f32x4*)(H + off + bj * HALF) = v0; *(f32x4*)(H + off + bj * HALF + 4) = v1;
                    u32x4 w; w.x = cvt_pk_bf16(v0[0], v0[1]); w.y = cvt_pk_bf16(v0[2], v0[3]); w.z = cvt_pk_bf16(v1[0], v1[1]); w.w = cvt_pk_bf16(v1[2], v1[3]);
                    *(u32x4*)(HB + off + bj * HALF) = w;
                    ss += (v0[0] * v0[0] + v0[1] * v0[1]) + (v0[2] * v0[2] + v0[3] * v0[3]) + (v1[0] * v1[0] + v1[1] * v1[1]) + (v1[2] * v1[2] + v1[3] * v1[3]); }
                ss += __shfl_xor(ss, 16); ss += __shfl_xor(ss, 32);
                if (fq == 0) SSQ[(size_t)row * 16 + u.pn * 4 + wc] = ss; }
    }
};
struct EpiSwiGLU {
    static constexpr bool PERM = true, AFTER_DRAIN = false;
    bf16_t* O; int ldc; const float* SSQ; float eps;
    __device__ __forceinline__ void operator()(const f32x4 (&acc)[2][2][4][2], const Unit& u, int wr, int wc, int fr, int fq) const {
        const int row0 = u.pm * BM + wr * 64 + fr, col0 = u.pn * HALF + wc * 32 + 8 * fq;
#pragma unroll
        for (int ai = 0; ai < 2; ++ai)
#pragma unroll
            for (int m = 0; m < 4; ++m) { const int row = row0 + ai * HALF + m * 16;
                const f32x4* sp = (const f32x4*)(SSQ + (size_t)row * 16); const f32x4 s0 = sp[0], s1 = sp[1], s2 = sp[2], s3 = sp[3];
                const float ssum = ((s0[0] + s0[1]) + (s0[2] + s0[3])) + ((s1[0] + s1[1]) + (s1[2] + s1[3])) + ((s2[0] + s2[1]) + (s2[2] + s2[3])) + ((s3[0] + s3[1]) + (s3[2] + s3[3]));
                const float rs = __builtin_amdgcn_rsqf(ssum * (1.0f / 1024.0f) + eps);
                float h[8];
#pragma unroll
                for (int n = 0; n < 2; ++n)
#pragma unroll
                    for (int j = 0; j < 4; ++j) { const float g = acc[ai][0][m][n][j] * rs, up = acc[ai][1][m][n][j] * rs; h[n * 4 + j] = fast_silu(g) * up; }
                u32x4 w; w.x = cvt_pk_bf16(h[0], h[1]); w.y = cvt_pk_bf16(h[2], h[3]); w.z = cvt_pk_bf16(h[4], h[5]); w.w = cvt_pk_bf16(h[6], h[7]);
                *(u32x4*)(O + (size_t)row * ldc + col0) = w; }
    }
};
struct EpiResidOut {
    static constexpr bool PERM = true, AFTER_DRAIN = false;
    const float* R; float* OUT;
    __device__ __forceinline__ void operator()(const f32x4 (&acc)[2][2][4][2], const Unit& u, int wr, int wc, int fr, int fq) const {
        const int row0 = u.pm * BM + wr * 64 + fr, col0 = u.pn * BM + wc * 32 + 8 * fq;
#pragma unroll
        for (int ai = 0; ai < 2; ++ai)
#pragma unroll
            for (int m = 0; m < 4; ++m) { const size_t off = (size_t)(row0 + ai * HALF + m * 16) * 1024 + col0;
#pragma unroll
                for (int bj = 0; bj < 2; ++bj) { const f32x4 r0 = *(const f32x4*)(R + off + bj * HALF), r1 = *(const f32x4*)(R + off + bj * HALF + 4);
                    *(f32x4*)(OUT + off + bj * HALF) = r0 + acc[ai][bj][m][0]; *(f32x4*)(OUT + off + bj * HALF + 4) = r1 + acc[ai][bj][m][1]; } }
    }
};
template <class Epi, class Sched, bool ALIGN_EPI = false, bool SP2 = false>
__device__ __forceinline__ void gemm_phase(PG8_LAS unsigned char* lds, const Gemm g, const Sched& S, const Epi& E) {
    const int tid = threadIdx.x, wid = __builtin_amdgcn_readfirstlane(tid >> 6), lane = tid & 63, wr = wid >> 2, wc = wid & 3, fr = lane & 15, fq = lane >> 4;
    const int K = g.K, nt = K / BK;
    unsigned voffA[2], voffB[2];
#pragma unroll
    for (int i = 0; i < 2; ++i) { int R, C; stage_rc(tid * 16 + i * 8192, R, C); const int Rb = Epi::PERM ? ((R & ~31) + perm32(R & 31)) : R;
        voffA[i] = (unsigned)(R * K + C) * 2u; voffB[i] = (unsigned)(Rb * K + C) * 2u; }
    const size_t kstep = (size_t)(BK * 2);
    const size_t hstep = (size_t)HALF * K * 2;
    const size_t tstep = 2 * hstep;
    const unsigned ldsw = (unsigned)wid * 1024u;
    const int aoff = lds_byte(wr * 64 + fr, fq * 8), boff = lds_byte(wc * 32 + fr, fq * 8);
#define PG8_SA(b, h) (((b) * 2 + (h)) * HTB)
#define PG8_SB(b, h) ((4 + (b) * 2 + (h)) * HTB)
#define PG8_STAGE(bufoff, gbase, voff) do { _Pragma("unroll") for (int _i = 0; _i < 2; ++_i) \
        __builtin_amdgcn_global_load_lds((const unsigned*)((const char*)(gbase) + (voff)[_i]), (PG8_LAS unsigned*)(lds + (bufoff) + ldsw + _i * 8192), 16, 0, 0); } while (0)
#define PG8_LDA(dst, b, h) do { _Pragma("unroll") for (int m = 0; m < 4; ++m) _Pragma("unroll") for (int k = 0; k < 2; ++k) dst[m][k] = *(const PG8_LAS bf16x8*)(lds + PG8_SA(b, h) + aoff + m * 2048 + k * 1024); } while (0)
#define PG8_LDB(dst, b, h) do { _Pragma("unroll") for (int n = 0; n < 2; ++n) _Pragma("unroll") for (int k = 0; k < 2; ++k) dst[n][k] = *(const PG8_LAS bf16x8*)(lds + PG8_SB(b, h) + boff + n * 2048 + k * 1024); } while (0)
#define PG8_MMA(ai, bj, At, Bt) do { __builtin_amdgcn_s_setprio(1); _Pragma("unroll") for (int m = 0; m < 4; ++m) _Pragma("unroll") for (int n = 0; n < 2; ++n) _Pragma("unroll") for (int k = 0; k < 2; ++k) \
        acc[ai][bj][m][n] = __builtin_amdgcn_mfma_f32_16x16x32_bf16(Bt[n][k], At[m][k], acc[ai][bj][m][n], 0, 0, 0); __builtin_amdgcn_s_setprio(0); } while (0)
#define PG8_WAIT_V(n) asm volatile("s_waitcnt vmcnt(" #n ")" ::: "memory")
#define PG8_WAIT_L(n) asm volatile("s_waitcnt lgkmcnt(" #n ")" ::: "memory")
#define PG8_BAR __builtin_amdgcn_s_barrier()
#define PG8_SCHED __builtin_amdgcn_sched_barrier(0)
    Unit cur, nxt; int ui = 0;
    if (!S.next(0, cur)) return;
    f32x4 acc[2][2][4][2];
#pragma unroll
    for (int a = 0; a < 2; ++a)
#pragma unroll
        for (int b = 0; b < 2; ++b)
#pragma unroll
            for (int m = 0; m < 4; ++m)
#pragma unroll
                for (int n = 0; n < 2; ++n) acc[a][b][m][n] = (f32x4){0.f, 0.f, 0.f, 0.f};
    bf16x8 At[4][2], B0[2][2], B1[2][2];
    const char* cA = (const char*)g.A + (size_t)cur.pm * tstep; const char* cB = (const char*)g.Bt + (size_t)cur.pn * tstep;
    S.a_ready(cur);
    if constexpr (SP2) {
        PG8_STAGE(PG8_SB(0, 0), cB, voffB); PG8_STAGE(PG8_SB(0, 1), cB + hstep, voffB); PG8_STAGE(PG8_SA(0, 0), cA, voffA); PG8_STAGE(PG8_SA(0, 1), cA + hstep, voffA);
        if (wr == 1) PG8_BAR;
        PG8_WAIT_V(2); PG8_BAR;
        PG8_STAGE(PG8_SB(1, 0), cB + kstep, voffB); PG8_STAGE(PG8_SA(1, 0), cA + kstep, voffA); PG8_STAGE(PG8_SB(1, 1), cB + hstep + kstep, voffB);
        PG8_WAIT_V(6); PG8_BAR;
    } else {
        PG8_STAGE(PG8_SB(0, 0), cB, voffB); PG8_STAGE(PG8_SA(0, 0), cA, voffA); PG8_STAGE(PG8_SB(0, 1), cB + hstep, voffB); PG8_STAGE(PG8_SA(0, 1), cA + hstep, voffA);
        if (wr == 1) PG8_BAR;
        PG8_WAIT_V(4); PG8_BAR;
        PG8_STAGE(PG8_SB(1, 0), cB + kstep, voffB); PG8_STAGE(PG8_SA(1, 0), cA + kstep, voffA); PG8_STAGE(PG8_SB(1, 1), cB + hstep + kstep, voffB);
        PG8_WAIT_V(6); PG8_BAR;
    }
    for (;;) {
        const bool has_next = S.next(ui + 1, nxt);
        const char* nA = has_next ? (const char*)g.A + (size_t)nxt.pm * tstep : cA; const char* nB = has_next ? (const char*)g.Bt + (size_t)nxt.pn * tstep : cB;
        for (int t = 0; t < nt; t += 2) {
            const bool last = (t == nt - 2);
            const char* a1 = cA + (size_t)(t + 1) * kstep;
            const char* a2 = last ? nA : cA + (size_t)(t + 2) * kstep; const char* b2 = last ? nB : cB + (size_t)(t + 2) * kstep;
            const char* a3 = a2 + kstep; const char* b3 = b2 + kstep;
            if (last && has_next) S.a_ready(nxt);
            if constexpr (SP2) {
            PG8_LDB(B0, 0, 0); PG8_LDB(B1, 0, 1); PG8_SCHED; PG8_LDA(At, 0, 0); PG8_STAGE(PG8_SA(1, 1), a1 + hstep, voffA);
            PG8_WAIT_V(8); PG8_WAIT_L(0); PG8_BAR; PG8_MMA(0, 0, At, B0); PG8_MMA(0, 1, At, B1); PG8_BAR; PG8_SCHED;
            PG8_LDA(At, 0, 1); PG8_STAGE(PG8_SB(0, 0), b2, voffB); PG8_STAGE(PG8_SB(0, 1), b2 + hstep, voffB); PG8_STAGE(PG8_SA(0, 0), a2, voffA);
            PG8_WAIT_V(8); PG8_WAIT_L(0); PG8_BAR; PG8_MMA(1, 0, At, B0); PG8_MMA(1, 1, At, B1); PG8_BAR; PG8_SCHED;
            PG8_LDB(B0, 1, 0); PG8_LDB(B1, 1, 1); PG8_SCHED; PG8_LDA(At, 1, 0); PG8_STAGE(PG8_SA(0, 1), a2 + hstep, voffA);
            PG8_WAIT_V(8); PG8_WAIT_L(0); PG8_BAR; PG8_MMA(0, 0, At, B0); PG8_MMA(0, 1, At, B1); PG8_BAR; PG8_SCHED;
            PG8_LDA(At, 1, 1); PG8_STAGE(PG8_SB(1, 0), b3, voffB); PG8_STAGE(PG8_SB(1, 1), b3 + hstep, voffB); PG8_STAGE(PG8_SA(1, 0), a3, voffA);
            PG8_WAIT_V(8); PG8_WAIT_L(0); PG8_BAR; PG8_MMA(1, 0, At, B0); PG8_MMA(1, 1, At, B1); PG8_BAR; PG8_SCHED;
            } else {
            PG8_LDB(B0, 0, 0); PG8_SCHED; PG8_LDA(At, 0, 0); PG8_STAGE(PG8_SA(1, 1), a1 + hstep, voffA);
            PG8_WAIT_L(8); PG8_BAR; PG8_WAIT_L(0); PG8_MMA(0, 0, At, B0); PG8_BAR; PG8_SCHED;
            PG8_LDB(B1, 0, 1); PG8_STAGE(PG8_SB(0, 0), b2, voffB);
            PG8_BAR; PG8_WAIT_L(0); PG8_MMA(0, 1, At, B1); PG8_BAR;
            PG8_LDA(At, 0, 1); PG8_STAGE(PG8_SA(0, 0), a2, voffA);
            PG8_BAR; PG8_WAIT_L(0); PG8_MMA(1, 0, At, B0); PG8_BAR; PG8_SCHED;
            PG8_STAGE(PG8_SB(0, 1), b2 + hstep, voffB);
            PG8_WAIT_V(6); PG8_BAR; PG8_MMA(1, 1, At, B1); PG8_BAR;
            PG8_LDB(B0, 1, 0); PG8_SCHED; PG8_LDA(At, 1, 0); PG8_STAGE(PG8_SA(0, 1), a2 + hstep, voffA);
            PG8_WAIT_L(8); PG8_BAR; PG8_WAIT_L(0); PG8_MMA(0, 0, At, B0); PG8_BAR; PG8_SCHED;
            PG8_LDB(B1, 1, 1); PG8_STAGE(PG8_SB(1, 0), b3, voffB);
            PG8_BAR; PG8_WAIT_L(0); PG8_MMA(0, 1, At, B1); PG8_BAR;
            PG8_LDA(At, 1, 1); PG8_STAGE(PG8_SA(1, 0), a3, voffA);
            PG8_BAR; PG8_WAIT_L(0); PG8_MMA(1, 0, At, B0); PG8_BAR; PG8_SCHED;
            PG8_STAGE(PG8_SB(1, 1), b3 + hstep, voffB);
            PG8_WAIT_V(6); PG8_BAR; PG8_MMA(1, 1, At, B1); PG8_BAR;
            }
        }
        if constexpr (ALIGN_EPI) { if (wr == 0) PG8_BAR; }
        if constexpr (!Epi::AFTER_DRAIN) { E(acc, cur, wr, wc, fr, fq); S.done(cur); }
        if (!has_next) break;
#pragma unroll
        for (int a = 0; a < 2; ++a)
#pragma unroll
            for (int b = 0; b < 2; ++b)
#pragma unroll
                for (int m = 0; m < 4; ++m)
#pragma unroll
                    for (int n = 0; n < 2; ++n) acc[a][b][m][n] = (f32x4){0.f, 0.f, 0.f, 0.f};
        cur = nxt; cA = nA; cB = nB; ++ui;
        if constexpr (ALIGN_EPI) { if (wr == 1) PG8_BAR; }
    }
    PG8_WAIT_V(0);
    if constexpr (!ALIGN_EPI) { if (wr == 0) PG8_BAR; }
    PG8_BAR;
    if constexpr (Epi::AFTER_DRAIN) { E.fused(acc, cur, wr, wc, fr, fq, lds, wid, lane); S.done(cur); }
#undef PG8_SA
#undef PG8_SB
#undef PG8_STAGE
#undef PG8_LDA
#undef PG8_LDB
#undef PG8_MMA
#undef PG8_WAIT_V
#undef PG8_WAIT_L
#undef PG8_BAR
#undef PG8_SCHED
}
}
constexpr int NWAVES = 8;
constexpr int NB = 8, SEQ = 4096, T = NB * SEQ, DM = 1024, DIN = 2824, DFF = 2816, NPROJ = 2816;
constexpr int SRC_MI = 2048;
constexpr int PC_MQ = 0, PC_MK = 512, PC_MV = 1024, PC_MO = 1536, PC_AQ = 2048, PC_AK = 2560, PC_AV = 2688;
constexpr float EPS = 1e-6f;
constexpr size_t MiB = 1u << 20;
constexpr size_t WS_CTL = 0, CTL_ZERO_BYTES = 1 * MiB;
constexpr size_t WS_WIN = 1 * MiB;
constexpr size_t WS_WOUT = 7 * MiB;
constexpr size_t WS_WGU = 9 * MiB;
constexpr size_t WS_WDN = 20 * MiB;
constexpr size_t WS_ROPE = 26 * MiB;
constexpr size_t WS_GATES = 27 * MiB;
constexpr size_t WS_SSQ = 28 * MiB;
constexpr size_t WS_SEG = 30 * MiB;
constexpr size_t WS_XN = 48 * MiB;
constexpr size_t WS_MIX = 112 * MiB;
constexpr size_t WS_PROJ = 176 * MiB;
constexpr size_t WS_END = 352 * MiB;
constexpr int CW_BAR = 4096;
constexpr int RING_BYTES = 131072;
constexpr int LDSCTL_OFF = RING_BYTES, MISC_OFF = LDSCTL_OFF + 320;
constexpr int LDS_BYTES = 147456;

#define GAS __attribute__((address_space(1)))
#define LAS __attribute__((address_space(3)))
typedef unsigned short bf16;
typedef unsigned v4u __attribute__((ext_vector_type(4)));
typedef unsigned v2u __attribute__((ext_vector_type(2)));
typedef float f32x2v __attribute__((ext_vector_type(2)));
typedef float f32x4 __attribute__((ext_vector_type(4)));
typedef short bf16x8 __attribute__((ext_vector_type(8)));
typedef GAS unsigned gu32;
#define RLX_AGENT __ATOMIC_RELAXED, __HIP_MEMORY_SCOPE_AGENT
#define LDS_WAIT() asm volatile("s_waitcnt lgkmcnt(0)" ::: "memory")
#define VM_WAIT() asm volatile("s_waitcnt vmcnt(0)" ::: "memory")
__device__ __forceinline__ unsigned f2bf(float f) { unsigned u = __builtin_bit_cast(unsigned, f); return (u + 0x7fffu + ((u >> 16) & 1u)) >> 16; }
__device__ __forceinline__ unsigned pk2(float lo, float hi) { return f2bf(lo) | (f2bf(hi) << 16); }
__device__ __forceinline__ float bf2f(unsigned short b) { return __builtin_bit_cast(float, (unsigned)b << 16); }
__device__ __forceinline__ float bflo(unsigned w) { return __builtin_bit_cast(float, w << 16); }
__device__ __forceinline__ float bfhi(unsigned w) { return __builtin_bit_cast(float, w & 0xffff0000u); }
__device__ __forceinline__ float wave_sum(float v) {
#pragma unroll
    for (int o = 1; o < 64; o <<= 1) v += __shfl_xor(v, o);
    return v;
}
__device__ __forceinline__ float wave_max(float v) {
#pragma unroll
    for (int o = 1; o < 64; o <<= 1) v = fmaxf(v, __shfl_xor(v, o));
    return v;
}
#define XB_TMO      128
#define XB_XCNT(j)  (256  + 64 * (j))
#define XB_XSUB(j)  (1280 + 64 * (j))
#define XB_XGEN(j)  (2304 + 64 * (j))
#define XB_TOP      3328
#define XB_TOPGEN   3392
#define XCD_BAR_WORDS 3456
#define XB_SPIN_CAP (1u << 18)

__device__ __forceinline__ unsigned xb_ld(unsigned* p)              { return __hip_atomic_load(p, __ATOMIC_RELAXED, __HIP_MEMORY_SCOPE_AGENT); }
__device__ __forceinline__ unsigned xb_add(unsigned* p, unsigned v) { return __hip_atomic_fetch_add(p, v, __ATOMIC_RELAXED, __HIP_MEMORY_SCOPE_AGENT); }
__device__ __forceinline__ unsigned xb_xcc_id() { return (unsigned)__builtin_amdgcn_s_getreg((3 << 11) | 20) & 0xFu; }
#define XB_SPIN(cond, bar) do { unsigned _sp = 0; while (cond) { __builtin_amdgcn_s_sleep(1); \
    if ((++_sp & 255u) == 0u) { if (xb_ld(&(bar)[XB_TMO])) break; if (_sp > XB_SPIN_CAP) { atomicAdd(&(bar)[XB_TMO], 1u); break; } } } } while (0)

struct XcdBarrier {
    unsigned* bar; unsigned x;
    volatile LAS unsigned* st;
};

__device__ __forceinline__ XcdBarrier xcd_barrier_post(unsigned* bar, volatile LAS unsigned* st) {
    XcdBarrier b; b.bar = bar; b.x = xb_xcc_id(); b.st = st;
    if (threadIdx.x == 0) (void)xb_add(&bar[XB_XCNT(b.x)], 1u);
    return b;
}
__device__ __forceinline__ void xcd_barrier_complete(unsigned* bar, unsigned x, unsigned& nloc, unsigned& nx) {
    const unsigned G = gridDim.x * gridDim.y * gridDim.z;
    unsigned sum, cnt, mine, sp = 0u;
    for (;;) {
        sum = 0u; cnt = 0u; mine = 0u;
#pragma unroll
        for (unsigned j = 0; j < 16; ++j) { const unsigned c = xb_ld(&bar[XB_XCNT(j)]); sum += c; cnt += (c > 0u) ? 1u : 0u; mine = (j == x) ? c : mine; }
        if (sum == G) break;
        __builtin_amdgcn_s_sleep(1);
        if ((++sp & 255u) == 0u) { if (xb_ld(&bar[XB_TMO])) break; if (sp > XB_SPIN_CAP) { atomicAdd(&bar[XB_TMO], 1u); break; } }
    }
    nloc = mine > 0u ? mine : 1u; nx = cnt > 0u ? cnt : 1u;
}

__device__ __forceinline__ void xcd_barrier(const XcdBarrier& b) {
    asm volatile("s_waitcnt vmcnt(0)" ::: "memory");
    __syncthreads();
    if (threadIdx.x == 0) {
        unsigned* bar = b.bar;
        __builtin_amdgcn_s_waitcnt(0);
        unsigned nloc = b.st[0], nx = b.st[1];
        if (nloc == 0u) { xcd_barrier_complete(bar, b.x, nloc, nx); b.st[0] = nloc; b.st[1] = nx; }
        const unsigned old = xb_add(&bar[XB_XSUB(b.x)], 1u);
        const unsigned gen = old / nloc;
        if (old + 1u == (gen + 1u) * nloc) {
            __builtin_amdgcn_fence(__ATOMIC_RELEASE, "agent");
            asm volatile("s_waitcnt vmcnt(0)" ::: "memory");
            const unsigned og = xb_add(&bar[XB_TOP], 1u);
            const unsigned tg = og / nx;
            if (og + 1u == (tg + 1u) * nx) xb_add(&bar[XB_TOPGEN], 1u);
            else XB_SPIN(xb_ld(&bar[XB_TOPGEN]) == tg, bar);
            __builtin_amdgcn_fence(__ATOMIC_ACQUIRE, "agent");
            xb_add(&bar[XB_XGEN(b.x)], 1u);
            asm volatile("s_waitcnt vmcnt(0)" ::: "memory");
        } else {
            XB_SPIN(xb_ld(&bar[XB_XGEN(b.x)]) == gen, bar);
            __builtin_amdgcn_fence(__ATOMIC_ACQUIRE, "agent");
            asm volatile("s_waitcnt vmcnt(0)" ::: "memory");
        }
    }
    __syncthreads();
}
#define PHASE2_BODY do { mlstm_phase<1>(F); swa_phase(F); } while (0)
#define PHASE3_BODY mlstm_phase<2>(F)
#define LAUNCH_MK(lo_, hi_) do { a.ph_lo = (lo_); a.ph_hi = (hi_); a.li = (lo_); hipLaunchKernelGGL(mk_fwd, dim3(grid), dim3(NWAVES * 64), LDS_BYTES, stream, a); } while (0)
#define LAUNCH_PROGRAM { LAUNCH_MK(0, 7); }
struct Frame {
    LAS unsigned char* lds;
    volatile LAS unsigned* MISC;
    gu32* ctl;
    int tid, lane, wave, vcu, G;
    const float *x, *norm1_g, *w_in, *conv_w, *igate_b, *fgate_b, *mlstm_norm_g, *q_norm_g, *k_norm_g, *sinks, *w_out, *norm2_g, *w_gate, *w_up, *w_down;
    float* out;
    bf16 *Win_t, *Wout_t, *Wgu_t, *Wdn_t, *XN, *MIX, *PROJ;
    float2* ROPE; float* GATES; float* SSQ; float* SEG;
};

__device__ __forceinline__ void p0_transpose_item(const float* W, int ldw, int src_col0, const float* kscale, bf16* WT, int Kd, int dst_row0, int kb, LAS float* scr, int lane) {
    const int k0 = 64 * kb;
#pragma unroll 8
    for (int i = 0; i < 32; ++i) { const int kk = 2 * i + (lane >> 5); float v = W[(size_t)(k0 + kk) * ldw + src_col0 + (lane & 31)]; if (kscale) v *= kscale[k0 + kk]; scr[kk * 33 + (lane & 31)] = v; }
    LDS_WAIT(); asm volatile("" ::: "memory");
    const int c = lane & 7;
#pragma unroll
    for (int j = 0; j < 4; ++j) { const int n = (lane >> 3) + 8 * j; const LAS float* s = scr + (8 * c) * 33 + n;
        v4u o; o.x = pk2(s[0 * 33], s[1 * 33]); o.y = pk2(s[2 * 33], s[3 * 33]); o.z = pk2(s[4 * 33], s[5 * 33]); o.w = pk2(s[6 * 33], s[7 * 33]);
        *(GAS v4u*)(WT + (size_t)(dst_row0 + n) * Kd + k0 + 8 * c) = o; }
    LDS_WAIT(); asm volatile("" ::: "memory");
}
__device__ __forceinline__ void p0_prologue(Frame& F) {
    LAS float* scr = (LAS float*)(F.lds + F.wave * 8704);
    LAS float* WG = (LAS float*)(F.lds + 73728);
    for (int k = F.tid; k < DM; k += NWAVES * 64) { const f32x4* s = (const f32x4*)(F.w_in + (size_t)k * DIN + SRC_MI); *(LAS f32x4*)(WG + k * 8) = s[0]; *(LAS f32x4*)(WG + k * 8 + 4) = s[1]; }
    __syncthreads();
    const int gw = F.vcu * NWAVES + F.wave, NGW = F.G * NWAVES;
    constexpr int I_IN = 88 * 16, I_OUT = 32 * 16, I_GU = 176 * 16, I_DN = 32 * 44, NITEMS = I_IN + I_OUT + I_GU + I_DN;
    for (int it = gw; it < NITEMS; it += NGW) {
        int r = it;
        if (r < I_IN) { const int nb = r % 88, kb = r / 88; p0_transpose_item(F.w_in, DIN, nb < 64 ? 32 * nb : 32 * nb + 8, nullptr, F.Win_t, DM, 32 * nb, kb, scr, F.lane); continue; } r -= I_IN;
        if (r < I_OUT) { const int nb = r % 32, kb = r / 32; p0_transpose_item(F.w_out, DM, 32 * nb, nullptr, F.Wout_t, DM, 32 * nb, kb, scr, F.lane); continue; } r -= I_OUT;
        if (r < I_GU) { const int nb = r % 176, kb = r / 176, tile = nb >> 3, wi = nb & 7; const float* W = (wi < 4) ? F.w_gate : F.w_up;
            p0_transpose_item(W, DFF, 128 * tile + 32 * (wi & 3), F.norm2_g, F.Wgu_t, DM, 32 * nb, kb, scr, F.lane); continue; } r -= I_GU;
        { const int nb = r % 32, kb = r / 32; p0_transpose_item(F.w_down, DM, 32 * nb, nullptr, F.Wdn_t, DFF, 32 * nb, kb, scr, F.lane); }
    }
    { const int idx = (F.vcu * NWAVES * 64) + F.tid;
      if (idx < SEQ * 8) { const int pos = idx >> 3, i = idx & 7;
        double f = 1.0; f = (i == 1) ? 0.19392274474868576 : f; f = (i == 2) ? 0.03760603093086393 : f; f = (i == 3) ? 0.007292664737217109 : f; f = (i == 4) ? 0.001414213562373095 : f;
        f = (i == 5) ? 0.0002742481756762073 : f; f = (i == 6) ? 5.318295896944988e-05 : f; f = (i == 7) ? 1.031338537721246e-05 : f;
        const float angf = (float)pos * (float)f; const double rev = (double)angf * 0.15915494309189535; const double fr = rev - __builtin_floor(rev + 0.5);
        const float rr = (float)(fr * 6.283185307179586); F.ROPE[idx] = make_float2(__cosf(rr), __sinf(rr)); } }
    f32x4 g1[4];
#pragma unroll
    for (int j = 0; j < 4; ++j) g1[j] = ((const f32x4*)F.norm1_g)[F.lane + 64 * j];
    for (int m = gw; m < T; m += NGW) {
        const GAS f32x4* xr = (const GAS f32x4*)(F.x + (size_t)m * DM) + F.lane;
        f32x4 v[4]; float s = 0.f;
#pragma unroll
        for (int j = 0; j < 4; ++j) { v[j] = xr[64 * j]; s += (v[j].x * v[j].x + v[j].y * v[j].y) + (v[j].z * v[j].z + v[j].w * v[j].w); }
        const float rstd = __builtin_amdgcn_rsqf(wave_sum(s) * (1.f / DM) + EPS);
        GAS unsigned long long* o8 = (GAS unsigned long long*)(F.XN + (size_t)m * DM) + F.lane;
        float ga[8] = {0.f, 0.f, 0.f, 0.f, 0.f, 0.f, 0.f, 0.f};
#pragma unroll
        for (int j = 0; j < 4; ++j) { const f32x4 y = v[j] * rstd * g1[j];
            o8[64 * j] = (unsigned long long)pk2(y.x, y.y) | ((unsigned long long)pk2(y.z, y.w) << 32);
#pragma unroll
            for (int e = 0; e < 4; ++e) { const LAS f32x4* wp = (const LAS f32x4*)(WG + (4 * F.lane + 256 * j + e) * 8); const f32x4 w0 = wp[0], w1 = wp[1]; const float ye = y[e];
                ga[0] += ye * w0[0]; ga[1] += ye * w0[1]; ga[2] += ye * w0[2]; ga[3] += ye * w0[3]; ga[4] += ye * w1[0]; ga[5] += ye * w1[1]; ga[6] += ye * w1[2]; ga[7] += ye * w1[3]; } }
        float mine = 0.f;
#pragma unroll
        for (int c = 0; c < 8; ++c) { const float r = wave_sum(ga[c]); mine = (F.lane == c) ? r : mine; }
        if (F.lane < 8) F.GATES[(size_t)m * 8 + F.lane] = mine;
    }
}

constexpr int SWA_KS = 0, SWA_KSTR = 144, SWA_VT = 36864, SWA_VSTR = 528;
typedef short bf16x4 __attribute__((ext_vector_type(4)));
__device__ __forceinline__ void swa_unit(Frame& F, int b, int kvh, int blk) {
    const int tid = F.tid, lane = F.lane, wave = F.wave, l15 = lane & 15, g = lane >> 4;
    LAS unsigned char* KS = F.lds + SWA_KS; LAS unsigned char* VT = F.lds + SWA_VT;
    __syncthreads();
    {
        const int key = tid >> 1, half = tid & 1; const int kt = blk * 128 - 128 + key;
        float kf[32]; v4u vraw[4];
        if (kt >= 0) {
            const bf16* kp = F.PROJ + (size_t)(b * SEQ + kt) * NPROJ + PC_AK + kvh * 64 + 32 * half;
            const bf16* vp = F.PROJ + (size_t)(b * SEQ + kt) * NPROJ + PC_AV + kvh * 64 + 32 * half;
#pragma unroll
            for (int c = 0; c < 4; ++c) { const v4u w = *(const v4u*)(kp + 8 * c); vraw[c] = *(const v4u*)(vp + 8 * c);
                kf[8 * c + 0] = bflo(w.x); kf[8 * c + 1] = bfhi(w.x); kf[8 * c + 2] = bflo(w.y); kf[8 * c + 3] = bfhi(w.y); kf[8 * c + 4] = bflo(w.z); kf[8 * c + 5] = bfhi(w.z); kf[8 * c + 6] = bflo(w.w); kf[8 * c + 7] = bfhi(w.w); }
        } else {
#pragma unroll
            for (int c = 0; c < 32; ++c) kf[c] = 0.f;
#pragma unroll
            for (int c = 0; c < 4; ++c) vraw[c] = (v4u){0u, 0u, 0u, 0u};
        }
        float ss = 0.f;
#pragma unroll
        for (int c = 0; c < 32; ++c) ss += kf[c] * kf[c];
        ss += __shfl_xor(ss, 1);
        const float rstd = __builtin_amdgcn_rsqf(ss * (1.f / 64.f) + EPS);
#pragma unroll
        for (int c = 0; c < 32; ++c) kf[c] *= rstd * F.k_norm_g[32 * half + c];
        if (half == 0 && kt >= 0) {
#pragma unroll
            for (int i = 0; i < 8; ++i) { const float2 cs = F.ROPE[kt * 8 + i]; const float x1 = kf[i], x2 = kf[8 + i]; kf[i] = x1 * cs.x - x2 * cs.y; kf[8 + i] = x2 * cs.x + x1 * cs.y; }
        }
#pragma unroll
        for (int c = 0; c < 4; ++c) { v4u o; o.x = pk2(kf[8 * c], kf[8 * c + 1]); o.y = pk2(kf[8 * c + 2], kf[8 * c + 3]); o.z = pk2(kf[8 * c + 4], kf[8 * c + 5]); o.w = pk2(kf[8 * c + 6], kf[8 * c + 7]);
            *(LAS v4u*)(KS + key * SWA_KSTR + 64 * half + 16 * c) = o; }
#pragma unroll
        for (int c = 0; c < 4; ++c) { const unsigned ww[4] = {vraw[c].x, vraw[c].y, vraw[c].z, vraw[c].w};
#pragma unroll
            for (int e = 0; e < 4; ++e) { const int d = 32 * half + 8 * c + 2 * e;
                *(LAS unsigned short*)(VT + d * SWA_VSTR + key * 2) = (unsigned short)(ww[e] & 0xffffu);
                *(LAS unsigned short*)(VT + (d + 1) * SWA_VSTR + key * 2) = (unsigned short)(ww[e] >> 16); } }
    }
    __syncthreads();
    const int hq = kvh * 4 + (wave >> 1);
    const float sink2 = F.sinks[hq] * 1.4426950408889634f;
    const float SC = 0.125f * 1.4426950408889634f;
#pragma unroll 1
    for (int rb = 0; rb < 4; ++rb) {
        const int p0 = 64 * (wave & 1) + 16 * rb, j0 = p0 >> 4;
        const int tq = blk * 128 + p0 + l15;
        bf16x8 qf[2];
        {
            const bf16* qp = F.PROJ + (size_t)(b * SEQ + tq) * NPROJ + PC_AQ + hq * 64 + 8 * g;
            const v4u w0 = *(const v4u*)qp, w1 = *(const v4u*)(qp + 32);
            float q0[8] = {bflo(w0.x), bfhi(w0.x), bflo(w0.y), bfhi(w0.y), bflo(w0.z), bfhi(w0.z), bflo(w0.w), bfhi(w0.w)};
            float q1[8] = {bflo(w1.x), bfhi(w1.x), bflo(w1.y), bfhi(w1.y), bflo(w1.z), bfhi(w1.z), bflo(w1.w), bfhi(w1.w)};
            float ss = 0.f;
#pragma unroll
            for (int j = 0; j < 8; ++j) ss += q0[j] * q0[j] + q1[j] * q1[j];
            ss += __shfl_xor(ss, 16); ss += __shfl_xor(ss, 32);
            const float rstd = __builtin_amdgcn_rsqf(ss * (1.f / 64.f) + EPS);
#pragma unroll
            for (int j = 0; j < 8; ++j) { q0[j] *= rstd * F.q_norm_g[8 * g + j]; q1[j] *= rstd * F.q_norm_g[32 + 8 * g + j]; }
#pragma unroll
            for (int j = 0; j < 8; ++j) { const float other = __shfl_xor(q0[j], 16); const float2 cs = F.ROPE[tq * 8 + j];
                const float r0 = q0[j] * cs.x - other * cs.y, r1 = q0[j] * cs.x + other * cs.y; q0[j] = (g == 0) ? r0 : ((g == 1) ? r1 : q0[j]); }
            v4u a, c2; a.x = pk2(q0[0], q0[1]); a.y = pk2(q0[2], q0[3]); a.z = pk2(q0[4], q0[5]); a.w = pk2(q0[6], q0[7]);
            c2.x = pk2(q1[0], q1[1]); c2.y = pk2(q1[2], q1[3]); c2.z = pk2(q1[4], q1[5]); c2.w = pk2(q1[6], q1[7]);
            qf[0] = __builtin_bit_cast(bf16x8, a); qf[1] = __builtin_bit_cast(bf16x8, c2);
        }
        f32x4 s[10];
#pragma unroll
        for (int jj = 0; jj < 10; ++jj) { const int tile = (j0 + jj) > 15 ? 15 : (j0 + jj);
            f32x4 acc = (f32x4){0.f, 0.f, 0.f, 0.f};
#pragma unroll
            for (int ks = 0; ks < 2; ++ks) { const bf16x8 kfr = *(const LAS bf16x8*)(KS + (16 * tile + l15) * SWA_KSTR + 64 * ks + 16 * g);
                acc = __builtin_amdgcn_mfma_f32_16x16x32_bf16(kfr, qf[ks], acc, 0, 0, 0); }
            s[jj] = acc; }
        float mx = -INFINITY;
#pragma unroll
        for (int jj = 0; jj < 10; ++jj)
#pragma unroll
            for (int r = 0; r < 4; ++r) { const int kpos = 16 * (j0 + jj) + 4 * g + r;
                const bool valid = (kpos >= p0 + 1 + l15) && (kpos <= p0 + 128 + l15) && (blk > 0 || kpos >= 128);
                const float v = valid ? s[jj][r] * SC : -INFINITY; s[jj][r] = v; mx = fmaxf(mx, v); }
        mx = fmaxf(mx, __shfl_xor(mx, 16)); mx = fmaxf(mx, __shfl_xor(mx, 32)); mx = fmaxf(mx, sink2);
        float sum = 0.f;
#pragma unroll
        for (int jj = 0; jj < 10; ++jj)
#pragma unroll
            for (int r = 0; r < 4; ++r) { const float p = __builtin_amdgcn_exp2f(s[jj][r] - mx); s[jj][r] = p; sum += p; }
        sum += __shfl_xor(sum, 16); sum += __shfl_xor(sum, 32);
        const float inv = 1.0f / (sum + __builtin_amdgcn_exp2f(sink2 - mx));
        f32x4 o[4];
#pragma unroll
        for (int dt = 0; dt < 4; ++dt) o[dt] = (f32x4){0.f, 0.f, 0.f, 0.f};
#pragma unroll
        for (int kk = 0; kk < 5; ++kk) {
            const int t0 = (j0 + 2 * kk) > 15 ? 15 : (j0 + 2 * kk), t1 = (j0 + 2 * kk + 1) > 15 ? 15 : (j0 + 2 * kk + 1);
            v4u pw; pw.x = pk2(s[2 * kk][0], s[2 * kk][1]); pw.y = pk2(s[2 * kk][2], s[2 * kk][3]); pw.z = pk2(s[2 * kk + 1][0], s[2 * kk + 1][1]); pw.w = pk2(s[2 * kk + 1][2], s[2 * kk + 1][3]);
            const bf16x8 pf = __builtin_bit_cast(bf16x8, pw);
#pragma unroll
            for (int dt = 0; dt < 4; ++dt) {
                const v2u a0 = *(const LAS v2u*)(VT + (16 * dt + l15) * SWA_VSTR + (16 * t0 + 4 * g) * 2);
                const v2u a1 = *(const LAS v2u*)(VT + (16 * dt + l15) * SWA_VSTR + (16 * t1 + 4 * g) * 2);
                v4u av; av.x = a0.x; av.y = a0.y; av.z = a1.x; av.w = a1.y;
                o[dt] = __builtin_amdgcn_mfma_f32_16x16x32_bf16(__builtin_bit_cast(bf16x8, av), pf, o[dt], 0, 0, 0); }
        }
        bf16* op = F.MIX + (size_t)(b * SEQ + tq) * DM + 512 + hq * 64 + 4 * g;
#pragma unroll
        for (int dt = 0; dt < 4; ++dt) { v2u w; w.x = pk2(o[dt][0] * inv, o[dt][1] * inv); w.y = pk2(o[dt][2] * inv, o[dt][3] * inv); *(v2u*)(op + 16 * dt) = w; }
    }
}
__device__ __forceinline__ void swa_phase(Frame& F) {
    for (int u = F.vcu; u < NB * 2 * 32; u += F.G) { const int blk = u & 31, kvh = (u >> 5) & 1, b = u >> 6; swa_unit(F, b, kvh, blk); }
}
constexpr int ML_QS = 0, ML_KS = 17408, ML_KWT = 34816, ML_VT = 53248, ML_PS = 71680, ML_CT = 80896, ML_F = 115712;
constexpr int ML_QSTR = 272, ML_TSTR = 144, ML_HSTR = 528;
constexpr int FB = 0, FU = 64, FW = 128, FPM = 192, FDEN = 256, FN = 320, FSC = 448;
constexpr int SEG_STRIDE = 16640;
constexpr float LOG2E = 1.4426950408889634f;
__device__ __forceinline__ void unpack8(const v4u w, float* o) { o[0] = bflo(w.x); o[1] = bfhi(w.x); o[2] = bflo(w.y); o[3] = bfhi(w.y); o[4] = bflo(w.z); o[5] = bfhi(w.z); o[6] = bflo(w.w); o[7] = bfhi(w.w); }
__device__ __forceinline__ float silu_f(float v) { return v * __builtin_amdgcn_rcpf(1.0f + __builtin_amdgcn_exp2f(v * -LOG2E)); }
__device__ __forceinline__ float sigmoid_f(float v) { return __builtin_amdgcn_rcpf(1.0f + __builtin_amdgcn_exp2f(v * -LOG2E)); }
__device__ __forceinline__ float exp_f(float v) { return __builtin_amdgcn_exp2f(v * LOG2E); }

template <int PASS> __device__ __forceinline__ void mlstm_item(Frame& F, int b, int h, int sg) {
    const int wave = F.wave;
    int tid = F.tid; asm volatile("" : "+v"(tid));
    int lane = tid & 63, l15 = lane & 15, g4 = lane >> 4;
    LAS unsigned char* L = F.lds; LAS float* FL = (LAS float*)(L + ML_F);
    f32x4 C[8];
#pragma unroll
    for (int et = 0; et < 8; ++et) C[et] = (f32x4){0.f, 0.f, 0.f, 0.f};
    float m = -1e30f, Gsum = 0.f;
    __syncthreads();
    if (tid < 128) FL[FN + tid] = 0.f;
    if (PASS == 2) {
        for (int j = 0; j < sg; ++j) {
            const float* E = F.SEG + (size_t)((b * 4 + h) * 8 + j) * SEG_STRIDE;
            const float mE = E[16384 + 128], G = E[16384 + 129];
            const float mn = fmaxf(G + m, mE), so = exp_f(G + m - mn), sn = exp_f(mE - mn);
#pragma unroll
            for (int et = 0; et < 8; ++et)
#pragma unroll
                for (int r = 0; r < 4; ++r) C[et][r] = so * C[et][r] + sn * E[(16 * wave + 4 * g4 + r) * 128 + 16 * et + l15];
            if (tid < 128) FL[FN + tid] = so * FL[FN + tid] + sn * E[16384 + tid];
            m = mn;
        }
#pragma unroll
        for (int et = 0; et < 8; ++et) { v2u w; w.x = pk2(C[et][0], C[et][1]); w.y = pk2(C[et][2], C[et][3]); *(LAS v2u*)(L + ML_CT + (16 * et + l15) * ML_QSTR + (16 * wave + 4 * g4) * 2) = w; }
    }
    const float kscale = 0.08838834764831845f;
#pragma unroll 1
    for (int cc = 0; cc < 8; ++cc) {
        const int c = sg * 8 + cc; const size_t t0 = (size_t)b * SEQ + (size_t)c * 64;
        tid = F.tid; asm volatile("" : "+v"(tid));
        lane = tid & 63; l15 = lane & 15; g4 = lane >> 4;
        const int mat = tid >> 8, r8 = tid & 255, dg = r8 & 15, rg = r8 >> 4, l0 = 4 * rg;
        __syncthreads();
        v4u xr[7]; v4u vr[4];
        if (PASS == 2 || mat == 1) {
            const bf16* src = F.PROJ + (mat ? PC_MK : PC_MQ) + h * 128 + 8 * dg;
#pragma unroll
            for (int j = 0; j < 7; ++j) { const int lr = l0 + j - 3; xr[j] = (c == 0 && lr < 0) ? (v4u){0u, 0u, 0u, 0u} : *(const v4u*)(src + (t0 + lr) * NPROJ); }
        }
        if (mat == 0) {
#pragma unroll
            for (int lp = 0; lp < 4; ++lp) vr[lp] = *(const v4u*)(F.PROJ + (t0 + l0 + lp) * NPROJ + PC_MV + h * 128 + 8 * dg);
        }
        if (wave == 0) {
            const float* gr = F.GATES + (t0 + lane) * 8;
            const float ig = gr[h] + F.igate_b[h], fg = gr[4 + h] + F.fgate_b[h];
            const float lf = fminf(fg, 0.f) - log1pf(__expf(-fabsf(fg)));
            float bs = lf;
#pragma unroll
            for (int o = 1; o < 64; o <<= 1) { const float t = __shfl_up(bs, o); if (lane >= o) bs += t; }
            const float gtot = __shfl(bs, 63);
            const float u = ig - bs;
            float pm = u;
#pragma unroll
            for (int o = 1; o < 64; o <<= 1) { const float t = __shfl_up(pm, o); if (lane >= o) pm = fmaxf(pm, t); }
            const float a = gtot + u;
            const float mloc = wave_max(a);
            FL[FB + lane] = bs; FL[FU + lane] = u; FL[FW + lane] = exp_f(a - mloc); FL[FPM + lane] = pm;
            if (lane == 0) { FL[FSC] = gtot; FL[FSC + 1] = mloc; }
        }
        __syncthreads();
        const float gtot = FL[FSC], mloc = FL[FSC + 1];
        if (PASS == 2 || mat == 1) {
            const float w0 = FL[FW + l0], w1 = FL[FW + l0 + 1], w2 = FL[FW + l0 + 2], w3 = FL[FW + l0 + 3];
            unsigned ow[4][4];
            const float* cwp = F.conv_w + mat * 512 + h * 128 + 8 * dg;
#pragma unroll
            for (int ip = 0; ip < 4; ++ip) {
                float ya[4], yb[4];
                const float ca0 = cwp[2 * ip], ca1 = cwp[1024 + 2 * ip], ca2 = cwp[2048 + 2 * ip], ca3 = cwp[3072 + 2 * ip];
                const float cb0 = cwp[2 * ip + 1], cb1 = cwp[1024 + 2 * ip + 1], cb2 = cwp[2048 + 2 * ip + 1], cb3 = cwp[3072 + 2 * ip + 1];
                float xa[7], xb[7];
#pragma unroll
                for (int j = 0; j < 7; ++j) { const unsigned w = (ip == 0) ? xr[j].x : (ip == 1) ? xr[j].y : (ip == 2) ? xr[j].z : xr[j].w; xa[j] = bflo(w); xb[j] = bfhi(w); }
#pragma unroll
                for (int lp = 0; lp < 4; ++lp) {
                    ya[lp] = silu_f(ca0 * xa[lp] + ca1 * xa[lp + 1] + ca2 * xa[lp + 2] + ca3 * xa[lp + 3]) * (mat ? kscale : 1.0f);
                    yb[lp] = silu_f(cb0 * xb[lp] + cb1 * xb[lp + 1] + cb2 * xb[lp + 2] + cb3 * xb[lp + 3]) * (mat ? kscale : 1.0f);
                    ow[lp][ip] = pk2(ya[lp], yb[lp]); }
                if (mat == 1) {
                    v2u o; o.x = pk2(ya[0] * w0, ya[1] * w1); o.y = pk2(ya[2] * w2, ya[3] * w3); *(LAS v2u*)(L + ML_KWT + (8 * dg + 2 * ip) * ML_TSTR + l0 * 2) = o;
                    o.x = pk2(yb[0] * w0, yb[1] * w1); o.y = pk2(yb[2] * w2, yb[3] * w3); *(LAS v2u*)(L + ML_KWT + (8 * dg + 2 * ip + 1) * ML_TSTR + l0 * 2) = o; }
            }
            if (PASS == 2) {
                LAS unsigned char* dst = L + (mat ? ML_KS : ML_QS) + l0 * ML_QSTR + 16 * dg;
#pragma unroll
                for (int lp = 0; lp < 4; ++lp) { v4u o; o.x = ow[lp][0]; o.y = ow[lp][1]; o.z = ow[lp][2]; o.w = ow[lp][3]; *(LAS v4u*)(dst + lp * ML_QSTR) = o; }
            }
        }
        if (mat == 0) {
            const unsigned ww[4][4] = {{vr[0].x, vr[0].y, vr[0].z, vr[0].w}, {vr[1].x, vr[1].y, vr[1].z, vr[1].w}, {vr[2].x, vr[2].y, vr[2].z, vr[2].w}, {vr[3].x, vr[3].y, vr[3].z, vr[3].w}};
#pragma unroll
            for (int p = 0; p < 4; ++p) {
                v2u lo, hi;
                lo.x = (ww[0][p] & 0xffffu) | (ww[1][p] << 16); lo.y = (ww[2][p] & 0xffffu) | (ww[3][p] << 16);
                hi.x = (ww[0][p] >> 16) | (ww[1][p] & 0xffff0000u); hi.y = (ww[2][p] >> 16) | (ww[3][p] & 0xffff0000u);
                *(LAS v2u*)(L + ML_VT + (8 * dg + 2 * p) * ML_TSTR + l0 * 2) = lo;
                *(LAS v2u*)(L + ML_VT + (8 * dg + 2 * p + 1) * ML_TSTR + l0 * 2) = hi; }
        }
        __syncthreads();
        const float mn = fmaxf(gtot + m, mloc), so = exp_f(gtot + m - mn), sn = exp_f(mloc - mn);
        if (PASS == 2) {
            const int lt = wave >> 1;
#pragma unroll
            for (int si = 0; si < 2; ++si) { const int st = 2 * (wave & 1) + si;
                float p[4] = {0.f, 0.f, 0.f, 0.f};
                if (st <= lt) {
                    f32x4 acc = (f32x4){0.f, 0.f, 0.f, 0.f};
#pragma unroll
                    for (int ks = 0; ks < 4; ++ks) { const bf16x8 a = *(const LAS bf16x8*)(L + ML_QS + (16 * lt + l15) * ML_QSTR + 64 * ks + 16 * g4);
                        const bf16x8 bb = *(const LAS bf16x8*)(L + ML_KS + (16 * st + l15) * ML_QSTR + 64 * ks + 16 * g4);
                        acc = __builtin_amdgcn_mfma_f32_16x16x32_bf16(a, bb, acc, 0, 0, 0); }
                    const int s = 16 * st + l15; const float us = FL[FU + s];
#pragma unroll
                    for (int r = 0; r < 4; ++r) { const int l = 16 * lt + 4 * g4 + r; const float bl = FL[FB + l]; const float mrow = bl + fmaxf(FL[FPM + l], m);
                        const float e = __builtin_amdgcn_exp2f((bl - mrow + us) * LOG2E); p[r] = (s <= l) ? acc[r] * e : 0.f; }
                }
#pragma unroll
                for (int r = 0; r < 4; ++r) *(LAS unsigned short*)(L + ML_PS + (16 * lt + 4 * g4 + r) * ML_TSTR + (16 * st + l15) * 2) = (unsigned short)f2bf(p[r]);
            }
            __syncthreads();
            {
                const int row = 8 * wave + (lane >> 3), part = lane & 7;
                const v4u pw = *(const LAS v4u*)(L + ML_PS + row * ML_TSTR + 16 * part);
                float pf[8]; unpack8(pw, pf);
                float sp = ((pf[0] + pf[1]) + (pf[2] + pf[3])) + ((pf[4] + pf[5]) + (pf[6] + pf[7]));
                const v4u q0 = *(const LAS v4u*)(L + ML_QS + row * ML_QSTR + 32 * part), q1 = *(const LAS v4u*)(L + ML_QS + row * ML_QSTR + 32 * part + 16);
                float qf[16]; unpack8(q0, qf); unpack8(q1, qf + 8);
                float qn = 0.f;
#pragma unroll
                for (int i = 0; i < 16; ++i) qn += qf[i] * FL[FN + 16 * part + i];
                const float bl = FL[FB + row]; const float mrow = bl + fmaxf(FL[FPM + row], m); const float sc = exp_f(bl + m - mrow);
                float tot = sp + sc * qn;
                tot += __shfl_xor(tot, 1); tot += __shfl_xor(tot, 2); tot += __shfl_xor(tot, 4);
                if (part == 0) FL[FDEN + row] = fmaxf(fabsf(tot), exp_f(-mrow));
            }
            const int eh = wave & 1;
            f32x4 o1[4], o2[4];
#pragma unroll
            for (int ei = 0; ei < 4; ++ei) { const int et = 4 * eh + ei;
                f32x4 a1 = (f32x4){0.f, 0.f, 0.f, 0.f}, a2 = (f32x4){0.f, 0.f, 0.f, 0.f};
#pragma unroll
                for (int ks = 0; ks < 2; ++ks) { const bf16x8 a = *(const LAS bf16x8*)(L + ML_VT + (16 * et + l15) * ML_TSTR + 64 * ks + 16 * g4);
                    const bf16x8 bb = *(const LAS bf16x8*)(L + ML_PS + (16 * lt + l15) * ML_TSTR + 64 * ks + 16 * g4);
                    a1 = __builtin_amdgcn_mfma_f32_16x16x32_bf16(a, bb, a1, 0, 0, 0); }
#pragma unroll
                for (int ks = 0; ks < 4; ++ks) { const bf16x8 a = *(const LAS bf16x8*)(L + ML_CT + (16 * et + l15) * ML_QSTR + 64 * ks + 16 * g4);
                    const bf16x8 bb = *(const LAS bf16x8*)(L + ML_QS + (16 * lt + l15) * ML_QSTR + 64 * ks + 16 * g4);
                    a2 = __builtin_amdgcn_mfma_f32_16x16x32_bf16(a, bb, a2, 0, 0, 0); }
                o1[ei] = a1; o2[ei] = a2; }
            __syncthreads();
            {
                const int l = 16 * lt + l15; const float bl = FL[FB + l]; const float mrow = bl + fmaxf(FL[FPM + l], m); const float sc = exp_f(bl + m - mrow);
                const float inv = 1.0f / FL[FDEN + l];
#pragma unroll
                for (int ei = 0; ei < 4; ++ei) { const int et = 4 * eh + ei; const f32x4 hv = (o1[ei] + o2[ei] * sc) * inv;
                    *(LAS f32x4*)(L + l * ML_HSTR + (16 * et + 4 * g4) * 4) = hv; }
            }
        }
        {
            bf16x8 af[2];
#pragma unroll
            for (int ks = 0; ks < 2; ++ks) af[ks] = *(const LAS bf16x8*)(L + ML_KWT + (16 * wave + l15) * ML_TSTR + 64 * ks + 16 * g4);
#pragma unroll
            for (int et = 0; et < 8; ++et) { f32x4 d = (f32x4){0.f, 0.f, 0.f, 0.f};
#pragma unroll
                for (int ks = 0; ks < 2; ++ks) { const bf16x8 bb = *(const LAS bf16x8*)(L + ML_VT + (16 * et + l15) * ML_TSTR + 64 * ks + 16 * g4);
                    d = __builtin_amdgcn_mfma_f32_16x16x32_bf16(af[ks], bb, d, 0, 0, 0); }
                C[et] = C[et] * so + d * sn; }
            if (tid < 128) { float dn = 0.f;
#pragma unroll
                for (int q = 0; q < 8; ++q) { const v4u w = *(const LAS v4u*)(L + ML_KWT + tid * ML_TSTR + 16 * q); float f[8]; unpack8(w, f); dn += ((f[0] + f[1]) + (f[2] + f[3])) + ((f[4] + f[5]) + (f[6] + f[7])); }
                FL[FN + tid] = so * FL[FN + tid] + sn * dn; }
            m = mn; Gsum += gtot;
            if (PASS == 2) {
#pragma unroll
                for (int et = 0; et < 8; ++et) { v2u w; w.x = pk2(C[et][0], C[et][1]); w.y = pk2(C[et][2], C[et][3]); *(LAS v2u*)(L + ML_CT + (16 * et + l15) * ML_QSTR + (16 * wave + 4 * g4) * 2) = w; }
            }
        }
        if (PASS == 2) {
            __syncthreads();
#pragma unroll
            for (int rr = 0; rr < 8; ++rr) { const int l = 8 * wave + rr;
                const f32x2v hv = *(const LAS f32x2v*)(L + l * ML_HSTR + lane * 8);
                const float ss = wave_sum(hv.x * hv.x + hv.y * hv.y);
                const float rstd = __builtin_amdgcn_rsqf(ss * (1.f / 128.f) + EPS);
                const unsigned mo = *(const unsigned*)(F.PROJ + (t0 + l) * NPROJ + PC_MO + h * 128 + 2 * lane);
                const f32x2v gg = *(const f32x2v*)(F.mlstm_norm_g + h * 128 + 2 * lane);
                *(unsigned*)(F.MIX + (t0 + l) * DM + h * 128 + 2 * lane) = pk2(hv.x * rstd * gg.x * sigmoid_f(bflo(mo)), hv.y * rstd * gg.y * sigmoid_f(bfhi(mo))); }
        }
    }
    if (PASS == 1) {
        tid = F.tid; asm volatile("" : "+v"(tid)); lane = tid & 63; l15 = lane & 15; g4 = lane >> 4;
        float* E = F.SEG + (size_t)((b * 4 + h) * 8 + sg) * SEG_STRIDE;
#pragma unroll
        for (int et = 0; et < 8; ++et)
#pragma unroll
            for (int r = 0; r < 4; ++r) E[(16 * wave + 4 * g4 + r) * 128 + 16 * et + l15] = C[et][r];
        if (tid < 128) E[16384 + tid] = FL[FN + tid];
        if (tid == 0) { E[16384 + 128] = m; E[16384 + 129] = Gsum; }
    }
}
template <int PASS> __device__ __forceinline__ void mlstm_phase(Frame& F) {
    for (int it = F.vcu; it < NB * 4 * 8; it += F.G) { const int sg = it & 7, h = (it >> 3) & 3, b = it >> 5; if (PASS == 1 && sg == 7) continue; mlstm_item<PASS>(F, b, h, sg); }
}
struct Args { const float* in[15]; float* out; unsigned char* ws; int ph_lo, ph_hi, li, pad; };
__global__ void __launch_bounds__(NWAVES * 64, 2) mk_fwd(Args args) {
    extern __shared__ __attribute__((aligned(16))) unsigned char lds[];
    Frame F;
    F.lds = (LAS unsigned char*)lds;
    F.MISC = (volatile LAS unsigned*)(F.lds + MISC_OFF);
    F.tid = threadIdx.x; F.lane = F.tid & 63; F.wave = __builtin_amdgcn_readfirstlane(F.tid >> 6);
    F.G = gridDim.x; { const int bx = blockIdx.x; F.vcu = (F.G % 8 == 0) ? (bx % 8) * (F.G / 8) + bx / 8 : bx; }
    unsigned char* ws = args.ws;
    F.ctl = (gu32*)(ws + WS_CTL);
    F.x = args.in[0]; F.norm1_g = args.in[1]; F.w_in = args.in[2]; F.conv_w = args.in[3]; F.igate_b = args.in[4]; F.fgate_b = args.in[5]; F.mlstm_norm_g = args.in[6];
    F.q_norm_g = args.in[7]; F.k_norm_g = args.in[8]; F.sinks = args.in[9]; F.w_out = args.in[10]; F.norm2_g = args.in[11]; F.w_gate = args.in[12]; F.w_up = args.in[13]; F.w_down = args.in[14];
    F.out = args.out;
    F.Win_t = (bf16*)(ws + WS_WIN); F.Wout_t = (bf16*)(ws + WS_WOUT); F.Wgu_t = (bf16*)(ws + WS_WGU); F.Wdn_t = (bf16*)(ws + WS_WDN);
    F.XN = (bf16*)(ws + WS_XN); F.MIX = (bf16*)(ws + WS_MIX); F.PROJ = (bf16*)(ws + WS_PROJ);
    F.ROPE = (float2*)(ws + WS_ROPE); F.GATES = (float*)(ws + WS_GATES); F.SSQ = (float*)(ws + WS_SSQ); F.SEG = (float*)(ws + WS_SEG);
    for (int u = F.tid; u < (LDS_BYTES - LDSCTL_OFF) / 4; u += NWAVES * 64) ((LAS unsigned*)(F.lds + LDSCTL_OFF))[u] = 0u;
    __syncthreads();
    const int lo = args.ph_lo, hi = args.ph_hi;
    XcdBarrier bar; bar.bar = (unsigned*)(F.ctl + CW_BAR) + args.li * XCD_BAR_WORDS; bar.x = 0; bar.st = nullptr;
    if (hi - lo > 1) bar = xcd_barrier_post((unsigned*)(F.ctl + CW_BAR) + args.li * XCD_BAR_WORDS, F.MISC + 8);
#define IN(k) (lo <= (k) && (k) < hi)
#define BOTH(k) (IN(k) && IN((k) + 1))
#define GRID_BAR() xcd_barrier(bar)

    if (IN(0)) { p0_prologue(F); if (BOTH(0)) GRID_BAR(); }
    if (IN(1)) {
        pg8::Gemm g{F.XN, F.Win_t, T, NPROJ, DM}; pg8::StaticOrder S; S.init(T, NPROJ, F.G, (int)blockIdx.x);
        pg8::EpiStoreBf16 E{F.PROJ, NPROJ};
        pg8::gemm_phase<pg8::EpiStoreBf16, pg8::StaticOrder, true, true>(F.lds, g, S, E);
        if (BOTH(1)) GRID_BAR();
    }
    if (IN(2)) { PHASE2_BODY; if (BOTH(2)) GRID_BAR(); }
    if (IN(3)) { PHASE3_BODY; if (BOTH(3)) GRID_BAR(); }
    if (IN(4)) {
        pg8::Gemm g{F.MIX, F.Wout_t, T, DM, DM}; pg8::StaticOrder S; S.init(T, DM, F.G, (int)blockIdx.x);
        pg8::EpiResidNorm E{F.x, F.out, F.XN, F.SSQ};
        pg8::gemm_phase<pg8::EpiResidNorm, pg8::StaticOrder, true, true>(F.lds, g, S, E);
        if (BOTH(4)) GRID_BAR();
    }
    if (IN(5)) {
        pg8::Gemm g{F.XN, F.Wgu_t, T, 2 * DFF, DM}; pg8::StaticOrder S; S.init(T, 2 * DFF, F.G, (int)blockIdx.x);
        pg8::EpiSwiGLU E{F.PROJ, DFF, F.SSQ, EPS};
        pg8::gemm_phase<pg8::EpiSwiGLU, pg8::StaticOrder, true, true>(F.lds, g, S, E);
        if (BOTH(5)) GRID_BAR();
    }
    if (IN(6)) {
        pg8::Gemm g{F.PROJ, F.Wdn_t, T, DM, DFF}; pg8::StaticOrder S; S.init(T, DM, F.G, (int)blockIdx.x);
        pg8::EpiResidOut E{F.out, F.out};
        pg8::gemm_phase<pg8::EpiResidOut, pg8::StaticOrder, true, true>(F.lds, g, S, E);
    }
#undef IN
#undef BOTH
}
namespace nv {
__device__ __forceinline__ float sigmoidf_(float x) { return 1.f / (1.f + __expf(-x)); }
__device__ __forceinline__ float siluf_(float x) { return x / (1.f + __expf(-x)); }
__global__ __launch_bounds__(128) void k_mlstm_rec(const bf16* __restrict__ proj, const float* __restrict__ gates, const float* __restrict__ conv_w, const float* __restrict__ igb, const float* __restrict__ fgb,
                                                   float* __restrict__ hm) {
    __shared__ float red[2][12];
    const int d = threadIdx.x, lane = d & 63, w = d >> 6;
    const int es = blockIdx.x & 15, h = (blockIdx.x >> 4) & 3, b = blockIdx.x >> 6;
    const int e0 = es * 8;
    const int cq = h * 128 + d, ck = 512 + h * 128 + d;
    float wq[4], wk[4];
#pragma unroll
    for (int j = 0; j < 4; ++j) { wq[j] = conv_w[j * 1024 + cq]; wk[j] = conv_w[j * 1024 + ck]; }
    const float ib = igb[h], fb = fgb[h];
    float C[8] = {}, n = 0.f, m = -1e30f;
    float q1 = 0.f, q2 = 0.f, q3 = 0.f, k1 = 0.f, k2 = 0.f, k3 = 0.f;
    const float kscale = 0.08838834764831845f;
    for (int t = 0; t < SEQ; ++t) {
        const bf16* row = proj + (size_t)(b * SEQ + t) * NPROJ;
        const float* gr = gates + (size_t)(b * SEQ + t) * 8;
        const float q0 = bf2f(row[PC_MQ + h * 128 + d]), k0 = bf2f(row[PC_MK + h * 128 + d]);
        const float qt = siluf_(wq[0] * q3 + wq[1] * q2 + wq[2] * q1 + wq[3] * q0);
        const float kt = siluf_(wk[0] * k3 + wk[1] * k2 + wk[2] * k1 + wk[3] * k0) * kscale;
        q3 = q2; q2 = q1; q1 = q0; k3 = k2; k2 = k1; k1 = k0;
        const float ig = gr[h] + ib, fg = gr[4 + h] + fb;
        const float lf = fminf(fg, 0.f) - log1pf(__expf(-fabsf(fg)));
        const float mn = fmaxf(lf + m, ig);
        const float so = __expf(lf + m - mn), sn = __expf(ig - mn);
        m = mn;
        float part[9];
#pragma unroll
        for (int e = 0; e < 8; ++e) { const float v = bf2f(row[PC_MV + h * 128 + e0 + e]); C[e] = so * C[e] + sn * kt * v; part[e] = qt * C[e]; }
        n = so * n + sn * kt; part[8] = qt * n;
#pragma unroll
        for (int e = 0; e < 9; ++e) part[e] = wave_sum(part[e]);
        __syncthreads();
        if (lane == 0) {
#pragma unroll
            for (int e = 0; e < 9; ++e) red[w][e] = part[e];
        }
        __syncthreads();
        if (d < 8) {
            const float num = red[0][d] + red[1][d], den = red[0][8] + red[1][8];
            hm[(size_t)(b * SEQ + t) * 512 + h * 128 + e0 + d] = num / fmaxf(fabsf(den), __expf(-mn));
        }
    }
}
__global__ __launch_bounds__(256) void k_mlstm_post(const float* __restrict__ hm, const bf16* __restrict__ proj, const float* __restrict__ g, bf16* __restrict__ mix) {
    const int gw = blockIdx.x * 4 + (threadIdx.x >> 6), lane = threadIdx.x & 63;
    const int t = gw >> 2, h = gw & 3;
    const float a0 = hm[(size_t)t * 512 + h * 128 + lane], a1 = hm[(size_t)t * 512 + h * 128 + 64 + lane];
    const float ss = wave_sum(a0 * a0 + a1 * a1);
    const float r = rsqrtf(ss * (1.f / 128.f) + EPS);
    const float o0 = bf2f(proj[(size_t)t * NPROJ + PC_MO + h * 128 + lane]), o1 = bf2f(proj[(size_t)t * NPROJ + PC_MO + h * 128 + 64 + lane]);
    mix[(size_t)t * DM + h * 128 + lane] = (bf16)f2bf(a0 * r * g[h * 128 + lane] * sigmoidf_(o0));
    mix[(size_t)t * DM + h * 128 + 64 + lane] = (bf16)f2bf(a1 * r * g[h * 128 + 64 + lane] * sigmoidf_(o1));
}
__global__ __launch_bounds__(256) void k_qknorm_rope(const bf16* __restrict__ proj, const float* __restrict__ qg, const float* __restrict__ kg, const float2* __restrict__ cs, float* __restrict__ qk) {
    const int gw = blockIdx.x * 4 + (threadIdx.x >> 6), lane = threadIdx.x & 63;
    const int t = gw / 10, j = gw % 10;
    const int pos = t & (SEQ - 1);
    const bf16* p = proj + (size_t)t * NPROJ + (j < 8 ? PC_AQ + j * 64 : PC_AK + (j - 8) * 64);
    const float x = bf2f(p[lane]);
    const float ss = wave_sum(x * x);
    float y = x * rsqrtf(ss * (1.f / 64.f) + EPS) * (j < 8 ? qg[lane] : kg[lane]);
    const float yp = __shfl_xor(y, 8);
    if (lane < 16) {
        const float2 c = cs[pos * 8 + (lane & 7)];
        y = (lane < 8) ? (y * c.x - yp * c.y) : (y * c.x + yp * c.y);
    }
    qk[(size_t)t * 640 + j * 64 + lane] = y;
}
__global__ __launch_bounds__(256) void k_swa(const float* __restrict__ qk, const bf16* __restrict__ proj, const float* __restrict__ sinks, bf16* __restrict__ mix) {
    __shared__ float sq[4][64];
    const int wv = threadIdx.x >> 6, lane = threadIdx.x & 63;
    const int gw = blockIdx.x * 4 + wv;
    const int t = gw >> 3, hq = gw & 7, hk = hq >> 2;
    const int pos = t & (SEQ - 1);
    sq[wv][lane] = qk[(size_t)t * 640 + hq * 64 + lane];
    __syncthreads();
    float sc[2];
#pragma unroll
    for (int r = 0; r < 2; ++r) {
        const int rel = lane + 64 * r;
        float s = -INFINITY;
        if (rel <= pos) {
            const float* kp = qk + (size_t)(t - rel) * 640 + 512 + hk * 64;
            float a = 0.f;
            for (int dd = 0; dd < 64; ++dd) a += sq[wv][dd] * kp[dd];
            s = a * 0.125f;
        }
        sc[r] = s;
    }
    const float snk = sinks[hq];
    const float mx = fmaxf(wave_max(fmaxf(sc[0], sc[1])), snk);
    const float p0 = __expf(sc[0] - mx), p1 = __expf(sc[1] - mx);
    const float den = wave_sum(p0 + p1) + __expf(snk - mx);
    float o = 0.f;
    for (int rel = 0; rel < 128; ++rel) {
        const float p = __shfl((rel < 64) ? p0 : p1, rel & 63);
        if (rel <= pos) o += p * bf2f(proj[(size_t)(t - rel) * NPROJ + PC_AV + hk * 64 + lane]);
    }
    mix[(size_t)t * DM + 512 + hq * 64 + lane] = (bf16)f2bf(o / den);
}
}
extern "C" void kernel_launch(void* const* d_in, const int* in_sizes, int n_in, void* d_out, int out_size, void* d_ws, size_t ws_size, hipStream_t stream) {
    static int grid = 0;
    if (grid == 0) {
        if (n_in != 15 || in_sizes[0] != T * DM || out_size != T * DM || ws_size < WS_END) { fprintf(stderr, "kernel_launch: unexpected shapes / workspace (n_in %d, ws %zu)\n", n_in, ws_size); grid = -1; return; }
        int dev = 0, cus = 0, per_cu = 0;
        if (hipGetDevice(&dev) != hipSuccess || hipDeviceGetAttribute(&cus, hipDeviceAttributeMultiprocessorCount, dev) != hipSuccess) { grid = -1; return; }
        if (hipFuncSetAttribute((const void*)mk_fwd, hipFuncAttributeMaxDynamicSharedMemorySize, LDS_BYTES) != hipSuccess) { fprintf(stderr, "kernel_launch: hipFuncSetAttribute failed\n"); grid = -1; return; }
        if (hipOccupancyMaxActiveBlocksPerMultiprocessor(&per_cu, (const void*)mk_fwd, NWAVES * 64, LDS_BYTES) != hipSuccess || per_cu < 1) { fprintf(stderr, "kernel_launch: occupancy query says %d blocks per CU\n", per_cu); grid = -1; (void)hipGetLastError(); return; }
        grid = cus;
    }
    if (grid < 0) return;
    (void)hipMemsetAsync((char*)d_ws + WS_CTL, 0, CTL_ZERO_BYTES, stream);
    Args a{};
    for (int i = 0; i < 15; ++i) a.in[i] = (const float*)d_in[i];
    a.out = (float*)d_out; a.ws = (unsigned char*)d_ws;
    LAUNCH_PROGRAM
}
```

```cpp
#include <hip/hip_runtime.h>
#include <cstdio>
#include <cstdint>
namespace pg8 {
#define PG8_LAS __attribute__((address_space(3)))
typedef unsigned short bf16_t;
typedef short bf16x8 __attribute__((ext_vector_type(8)));
typedef float f32x4 __attribute__((ext_vector_type(4)));
typedef unsigned u32x4 __attribute__((ext_vector_type(4)));
constexpr int BM = 256, BK = 64, HALF = 128, HTB = HALF * BK * 2  , STAGE_BYTES = 8 * HTB, NXCD = 8, WGM = 8;

__host__ __device__ __forceinline__ int lds_byte(int r, int c) { const int st = (r >> 4) * 2 + (c >> 5), rr = r & 15, cc = c & 31, ob = rr * 64 + cc * 2; return st * 1024 + (ob ^ (((ob >> 9) & 1) << 5)); }
__host__ __device__ __forceinline__ void stage_rc(int b, int& R, int& C) { const int st = b / 1024, sb = b % 1024, swz = sb ^ (((sb >> 9) & 1) << 5); R = (st >> 1) * 16 + swz / 64; C = (st & 1) * 32 + (swz % 64) / 2; }
__host__ __device__ __forceinline__ int perm32(int rho) { const int n = rho >> 4, i = rho & 15; return 8 * (i >> 2) + 4 * n + (i & 3); }

struct Unit { int pm, pn; };
struct Gemm { const bf16_t* A; const bf16_t* Bt; int M, N, K; };

struct StaticOrder {
    int nM, nN, nwg, G, c;
    __host__ __device__ void init(int M, int N, int G_, int c_) { nM = M / BM; nN = N / BM; nwg = nM * nN; G = G_; c = c_; }
    __host__ __device__ bool next(int i, Unit& u) const {
        const long L = (long)i * G + c; if (L >= nwg) return false;
        int wgid = (int)L; { const int q = nwg / NXCD, r = nwg % NXCD, xcd = wgid % NXCD, off = wgid / NXCD; wgid = (xcd < r ? xcd * (q + 1) : r * (q + 1) + (xcd - r) * q) + off; }
        const int nig = WGM * nN, gid = wgid / nig, fm = gid * WGM, gsz = (nM - fm) < WGM ? (nM - fm) : WGM;
        u.pm = fm + ((wgid % nig) % gsz); u.pn = (wgid % nig) / gsz; return true;
    }
    __device__ __forceinline__ void a_ready(const Unit&) const {}
    __device__ __forceinline__ void done(const Unit&) const {}
};

__device__ __forceinline__ unsigned cvt_pk_bf16(float lo, float hi) { unsigned r; asm volatile("v_cvt_pk_bf16_f32 %0, %1, %2" : "=v"(r) : "v"(lo), "v"(hi)); return r; }
typedef float f32x2 __attribute__((ext_vector_type(2)));
__device__ __forceinline__ float fast_silu(float v) { return v * __builtin_amdgcn_rcpf(1.0f + __builtin_amdgcn_exp2f(v * -1.4426950408889634f)); }
struct EpiStoreBf16 {
    static constexpr bool PERM = true, AFTER_DRAIN = false;
    bf16_t* O; int ldc;
    __device__ __forceinline__ void operator()(const f32x4 (&acc)[2][2][4][2], const Unit& u, int wr, int wc, int fr, int fq) const {
        const int row0 = u.pm * BM + wr * 64 + fr, col0 = u.pn * BM + wc * 32 + 8 * fq;
#pragma unroll
        for (int ai = 0; ai < 2; ++ai)
#pragma unroll
            for (int m = 0; m < 4; ++m) { bf16_t* rowp = O + (size_t)(row0 + ai * HALF + m * 16) * ldc + col0;
#pragma unroll
                for (int bj = 0; bj < 2; ++bj) { const f32x4 v0 = acc[ai][bj][m][0], v1 = acc[ai][bj][m][1];
                    u32x4 w; w.x = cvt_pk_bf16(v0[0], v0[1]); w.y = cvt_pk_bf16(v0[2], v0[3]); w.z = cvt_pk_bf16(v1[0], v1[1]); w.w = cvt_pk_bf16(v1[2], v1[3]);
                    *(u32x4*)(rowp + bj * HALF) = w; } }
    }
};
struct EpiResidNorm {
    static constexpr bool PERM = true, AFTER_DRAIN = false;
    const float* X; float* H; bf16_t* HB; float* SSQ;
    __device__ __forceinline__ void operator()(const f32x4 (&acc)[2][2][4][2], const Unit& u, int wr, int wc, int fr, int fq) const {
        const int row0 = u.pm * BM + wr * 64 + fr, col0 = u.pn * BM + wc * 32 + 8 * fq;
#pragma unroll
        for (int ai = 0; ai < 2; ++ai)
#pragma unroll
            for (int m = 0; m < 4; ++m) { const int row = row0 + ai * HALF + m * 16; const size_t off = (size_t)row * 1024 + col0; float ss = 0.f;
#pragma unroll
                for (int bj = 0; bj < 2; ++bj) { const f32x4 x0 = *(const f32x4*)(X + off + bj * HALF), x1 = *(const f32x4*)(X + off + bj * HALF + 4);
                    const f32x4 v0 = x0 + acc[ai][bj][m][0], v1 = x1 + acc[ai][bj][m][1];
                    *(f32x4*)(H + off + bj * HALF) = v0; *(f32x4*)(H + off + bj * HALF + 4) = v1;
                    u32x4 w; w.x = cvt_pk_bf16(v0[0], v0[1]); w.y = cvt_pk_bf16(v0[2], v0[3]); w.z = cvt_pk_bf16(v1[0], v1[1]); w.w = cvt_pk_bf16(v1[2], v1[3]);
                    *(u32x4*)(HB + off + bj * HALF) = w;
                    ss += (v0[0] * v0[0] + v0[1] * v0[1]) + (v0[2] * v0[2] + v0[3] * v0[3]) + (v1[0] * v1[0] + v1[1] * v1[1]) + (v1[2] * v1[2] + v1[3] * v1[3]); }
                ss += __shfl_xor(ss, 16); ss += __shfl_xor(ss, 32);
                if (fq == 0) SSQ[(size_t)row * 16 + u.pn * 4 + wc] = ss; }
    }
};
struct EpiSwiGLU {
    static constexpr bool PERM = true, AFTER_DRAIN = false;
    bf16_t* O; int ldc; const float* SSQ; float eps;
    __device__ __forceinline__ void operator()(const f32x4 (&acc)[2][2][4][2], const Unit& u, int wr, int wc, int fr, int fq) const {
        const int row0 = u.pm * BM + wr * 64 + fr, col0 = u.pn * HALF + wc * 32 + 8 * fq;
#pragma unroll
        for (int ai = 0; ai < 2; ++ai)
#pragma unroll
            for (int m = 0; m < 4; ++m) { const int row = row0 + ai * HALF + m * 16;
                const f32x4* sp = (const f32x4*)(SSQ + (size_t)row * 16); const f32x4 s0 = sp[0], s1 = sp[1], s2 = sp[2], s3 = sp[3];
                const float ssum = ((s0[0] + s0[1]) + (s0[2] + s0[3])) + ((s1[0] + s1[1]) + (s1[2] + s1[3])) + ((s2[0] + s2[1]) + (s2[2] + s2[3])) + ((s3[0] + s3[1]) + (s3[2] + s3[3]));
                const float rs = __builtin_amdgcn_rsqf(ssum * (1.0f / 1024.0f) + eps);
                float h[8];
#pragma unroll
                for (int n = 0; n < 2; ++n)
#pragma unroll
                    for (int j = 0; j < 4; ++j) { const float g = acc[ai][0][m][n][j] * rs, up = acc[ai][1][m][n][j] * rs; h[n * 4 + j] = fast_silu(g) * up; }
                u32x4 w; w.x = cvt_pk_bf16(h[0], h[1]); w.y = cvt_pk_bf16(h[2], h[3]); w.z = cvt_pk_bf16(h[4], h[5]); w.w = cvt_pk_bf16(h[6], h[7]);
                *(u32x4*)(O + (size_t)row * ldc + col0) = w; }
    }
};
struct EpiResidOut {
    static constexpr bool PERM = true, AFTER_DRAIN = false;
    const float* R; float* OUT;
    __device__ __forceinline__ void operator()(const f32x4 (&acc)[2][2][4][2], const Unit& u, int wr, int wc, int fr, int fq) const {
        const int row0 = u.pm * BM + wr * 64 + fr, col0 = u.pn * BM + wc * 32 + 8 * fq;
#pragma unroll
        for (int ai = 0; ai < 2; ++ai)
#pragma unroll
            for (int m = 0; m < 4; ++m) { const size_t off = (size_t)(row0 + ai * HALF + m * 16) * 1024 + col0;
#pragma unroll
                for (int bj = 0; bj < 2; ++bj) { const f32x4 r0 = *(const f32x4*)(R + off + bj * HALF), r1 = *(const f32x4*)(R + off + bj * HALF + 4);
                    *(f32x4*)(OUT + off + bj * HALF) = r0 + acc[ai][bj][m][0]; *(f32x4*)(OUT + off + bj * HALF + 4) = r1 + acc[ai][bj][m][1]; } }
    }
};
template <class Epi, class Sched, bool ALIGN_EPI = false, bool SP2 = false>
__device__ __forceinline__ void gemm_phase(PG8_LAS unsigned char* lds, const Gemm g, const Sched& S, const Epi& E) {
    const int tid = threadIdx.x, wid = __builtin_amdgcn_readfirstlane(tid >> 6), lane = tid & 63, wr = wid >> 2, wc = wid & 3, fr = lane & 15, fq = lane >> 4;
    const int K = g.K, nt = K / BK;
    unsigned voffA[2], voffB[2];
#pragma unroll
    for (int i = 0; i < 2; ++i) { int R, C; stage_rc(tid * 16 + i * 8192, R, C); const int Rb = Epi::PERM ? ((R & ~31) + perm32(R & 31)) : R;
        voffA[i] = (unsigned)(R * K + C) * 2u; voffB[i] = (unsigned)(Rb * K + C) * 2u; }
    const size_t kstep = (size_t)(BK * 2);
    const size_t hstep = (size_t)HALF * K * 2;
    const size_t tstep = 2 * hstep;
    const unsigned ldsw = (unsigned)wid * 1024u;
    const int aoff = lds_byte(wr * 64 + fr, fq * 8), boff = lds_byte(wc * 32 + fr, fq * 8);
#define PG8_SA(b, h) (((b) * 2 + (h)) * HTB)
#define PG8_SB(b, h) ((4 + (b) * 2 + (h)) * HTB)
#define PG8_STAGE(bufoff, gbase, voff) do { _Pragma("unroll") for (int _i = 0; _i < 2; ++_i) \
        __builtin_amdgcn_global_load_lds((const unsigned*)((const char*)(gbase) + (voff)[_i]), (PG8_LAS unsigned*)(lds + (bufoff) + ldsw + _i * 8192), 16, 0, 0); } while (0)
#define PG8_LDA(dst, b, h) do { _Pragma("unroll") for (int m = 0; m < 4; ++m) _Pragma("unroll") for (int k = 0; k < 2; ++k) dst[m][k] = *(const PG8_LAS bf16x8*)(lds + PG8_SA(b, h) + aoff + m * 2048 + k * 1024); } while (0)
#define PG8_LDB(dst, b, h) do { _Pragma("unroll") for (int n = 0; n < 2; ++n) _Pragma("unroll") for (int k = 0; k < 2; ++k) dst[n][k] = *(const PG8_LAS bf16x8*)(lds + PG8_SB(b, h) + boff + n * 2048 + k * 1024); } while (0)
#define PG8_MMA(ai, bj, At, Bt) do { __builtin_amdgcn_s_setprio(1); _Pragma("unroll") for (int m = 0; m < 4; ++m) _Pragma("unroll") for (int n = 0; n < 2; ++n) _Pragma("unroll") for (int k = 0; k < 2; ++k) \
        acc[ai][bj][m][n] = __builtin_amdgcn_mfma_f32_16x16x32_bf16(Bt[n][k], At[m][k], acc[ai][bj][m][n], 0, 0, 0); __builtin_amdgcn_s_setprio(0); } while (0)
#define PG8_WAIT_V(n) asm volatile("s_waitcnt vmcnt(" #n ")" ::: "memory")
#define PG8_WAIT_L(n) asm volatile("s_waitcnt lgkmcnt(" #n ")" ::: "memory")
#define PG8_BAR __builtin_amdgcn_s_barrier()
#define PG8_SCHED __builtin_amdgcn_sched_barrier(0)
    Unit cur, nxt; int ui = 0;
    if (!S.next(0, cur)) return;
    f32x4 acc[2][2][4][2];
#pragma unroll
    for (int a = 0; a < 2; ++a)
#pragma unroll
        for (int b = 0; b < 2; ++b)
#pragma unroll
            for (int m = 0; m < 4; ++m)
#pragma unroll
                for (int n = 0; n < 2; ++n) acc[a][b][m][n] = (f32x4){0.f, 0.f, 0.f, 0.f};
    bf16x8 At[4][2], B0[2][2], B1[2][2];
    const char* cA = (const char*)g.A + (size_t)cur.pm * tstep; const char* cB = (const char*)g.Bt + (size_t)cur.pn * tstep;
    S.a_ready(cur);
    if constexpr (SP2) {
        PG8_STAGE(PG8_SB(0, 0), cB, voffB); PG8_STAGE(PG8_SB(0, 1), cB + hstep, voffB); PG8_STAGE(PG8_SA(0, 0), cA, voffA); PG8_STAGE(PG8_SA(0, 1), cA + hstep, voffA);
        if (wr == 1) PG8_BAR;
        PG8_WAIT_V(2); PG8_BAR;
        PG8_STAGE(PG8_SB(1, 0), cB + kstep, voffB); PG8_STAGE(PG8_SA(1, 0), cA + kstep, voffA); PG8_STAGE(PG8_SB(1, 1), cB + hstep + kstep, voffB);
        PG8_WAIT_V(6); PG8_BAR;
    } else {
        PG8_STAGE(PG8_SB(0, 0), cB, voffB); PG8_STAGE(PG8_SA(0, 0), cA, voffA); PG8_STAGE(PG8_SB(0, 1), cB + hstep, voffB); PG8_STAGE(PG8_SA(0, 1), cA + hstep, voffA);
        if (wr == 1) PG8_BAR;
        PG8_WAIT_V(4); PG8_BAR;
        PG8_STAGE(PG8_SB(1, 0), cB + kstep, voffB); PG8_STAGE(PG8_SA(1, 0), cA + kstep, voffA); PG8_STAGE(PG8_SB(1, 1), cB + hstep + kstep, voffB);
        PG8_WAIT_V(6); PG8_BAR;
    }
    for (;;) {
        const bool has_next = S.next(ui + 1, nxt);
        const char* nA = has_next ? (const char*)g.A + (size_t)nxt.pm * tstep : cA; const char* nB = has_next ? (const char*)g.Bt + (size_t)nxt.pn * tstep : cB;
        for (int t = 0; t < nt; t += 2) {
            const bool last = (t == nt - 2);
            const char* a1 = cA + (size_t)(t + 1) * kstep;
            const char* a2 = last ? nA : cA + (size_t)(t + 2) * kstep; const char* b2 = last ? nB : cB + (size_t)(t + 2) * kstep;
            const char* a3 = a2 + kstep; const char* b3 = b2 + kstep;
            if (last && has_next) S.a_ready(nxt);
            if constexpr (SP2) {
            PG8_LDB(B0, 0, 0); PG8_LDB(B1, 0, 1); PG8_SCHED; PG8_LDA(At, 0, 0); PG8_STAGE(PG8_SA(1, 1), a1 + hstep, voffA);
            PG8_WAIT_V(8); PG8_WAIT_L(0); PG8_BAR; PG8_MMA(0, 0, At, B0); PG8_MMA(0, 1, At, B1); PG8_BAR; PG8_SCHED;
            PG8_LDA(At, 0, 1); PG8_STAGE(PG8_SB(0, 0), b2, voffB); PG8_STAGE(PG8_SB(0, 1), b2 + hstep, voffB); PG8_STAGE(PG8_SA(0, 0), a2, voffA);
            PG8_WAIT_V(8); PG8_WAIT_L(0); PG8_BAR; PG8_MMA(1, 0, At, B0); PG8_MMA(1, 1, At, B1); PG8_BAR; PG8_SCHED;
            PG8_LDB(B0, 1, 0); PG8_LDB(B1, 1, 1); PG8_SCHED; PG8_LDA(At, 1, 0); PG8_STAGE(PG8_SA(0, 1), a2 + hstep, voffA);
            PG8_WAIT_V(8); PG8_WAIT_L(0); PG8_BAR; PG8_MMA(0, 0, At, B0); PG8_MMA(0, 1, At, B1); PG8_BAR; PG8_SCHED;
            PG8_LDA(At, 1, 1); PG8_STAGE(PG8_SB(1, 0), b3, voffB); PG8_STAGE(PG8_SB(1, 1), b3 + hstep, voffB); PG8_STAGE(PG8_SA(1, 0), a3, voffA);
            PG8_WAIT_V(8); PG8_WAIT_L(0); PG8_BAR; PG8_MMA(1, 0, At, B0); PG8_MMA(1, 1, At, B1); PG8_BAR; PG8_SCHED;
            } else {
            PG8_LDB(B0, 0, 0); PG8_SCHED; PG8_LDA(At, 0, 0); PG8_STAGE(PG8_SA(1, 1), a1 + hstep, voffA);
            PG8_WAIT_L(8); PG8_BAR; PG8_WAIT_L(0); PG8_MMA(0, 0, At, B0); PG8_BAR; PG8_SCHED;
            PG8_LDB(B1, 0, 1); PG8_STAGE(PG8_SB(0, 0), b2, voffB);
            PG8_BAR; PG8_WAIT_L(0); PG8_MMA(0, 1, At, B1); PG8_BAR;
            PG8_LDA(At, 0, 1); PG8_STAGE(PG8_SA(0, 0), a2, voffA);
            PG8_BAR; PG8_WAIT_L(0); PG8_MMA(1, 0, At, B0); PG8_BAR; PG8_SCHED;
            PG8_STAGE(PG8_SB(0, 1), b2 + hstep, voffB);
            PG8_WAIT_V(6); PG8_BAR; PG8_MMA(1, 1, At, B1); PG8_BAR;
            PG8_LDB(B0, 1, 0); PG8_SCHED; PG8_LDA(At, 1, 0); PG8_STAGE(PG8_SA(0, 1), a2 + hstep, voffA);
            PG8_WAIT_L(8); PG8_BAR; PG8_WAIT_L(0); PG8_MMA(0, 0, At, B0); PG8_BAR; PG8_SCHED;
            PG8_LDB(B1, 1, 1); PG8_STAGE(PG8_SB(1, 0), b3, voffB);
            PG8_BAR; PG8_WAIT_L(0); PG8_MMA(0, 1, At, B1); PG8_BAR;
            PG8_LDA(At, 1, 1); PG8_STAGE(PG8_SA(1, 0), a3, voffA);
            PG8_BAR; PG8_WAIT_L(0); PG8_MMA(1, 0, At, B0); PG8_BAR; PG8_SCHED;
            PG8_STAGE(PG8_SB(1, 1), b3 + hstep, voffB);
            PG8_WAIT_V(6); PG8_BAR; PG8_MMA(1, 1, At, B1); PG8_BAR;
            }
        }
        if constexpr (ALIGN_EPI) { if (wr == 0) PG8_BAR; }
        if constexpr (!Epi::AFTER_DRAIN) { E(acc, cur, wr, wc, fr, fq); S.done(cur); }
        if (!has_next) break;
#pragma unroll
        for (int a = 0; a < 2; ++a)
#pragma unroll
            for (int b = 0; b < 2; ++b)
#pragma unroll
                for (int m = 0; m < 4; ++m)
#pragma unroll
                    for (int n = 0; n < 2; ++n) acc[a][b][m][n] = (f32x4){0.f, 0.f, 0.f, 0.f};
        cur = nxt; cA = nA; cB = nB; ++ui;
        if constexpr (ALIGN_EPI) { if (wr == 1) PG8_BAR; }
    }
    PG8_WAIT_V(0);
    if constexpr (!ALIGN_EPI) { if (wr == 0) PG8_BAR; }
    PG8_BAR;
    if constexpr (Epi::AFTER_DRAIN) { E.fused(acc, cur, wr, wc, fr, fq, lds, wid, lane); S.done(cur); }
#undef PG8_SA
#undef PG8_SB
#undef PG8_STAGE
#undef PG8_LDA
#undef PG8_LDB
#undef PG8_MMA
#undef PG8_WAIT_V
#undef PG8_WAIT_L
#undef PG8_BAR
#undef PG8_SCHED
}
}
constexpr int NWAVES = 8;
constexpr int NB = 8, SEQ = 4096, T = NB * SEQ, DM = 1024, DIN = 2824, DFF = 2816, NPROJ = 2816;
constexpr int SRC_MI = 2048;
constexpr int PC_MQ = 0, PC_MK = 512, PC_MV = 1024, PC_MO = 1536, PC_AQ = 2048, PC_AK = 2560, PC_AV = 2688;
constexpr float EPS = 1e-6f;
constexpr size_t MiB = 1u << 20;
constexpr size_t WS_CTL = 0, CTL_ZERO_BYTES = 1 * MiB;
constexpr size_t WS_WIN = 1 * MiB;
constexpr size_t WS_WOUT = 7 * MiB;
constexpr size_t WS_WGU = 9 * MiB;
constexpr size_t WS_WDN = 20 * MiB;
constexpr size_t WS_ROPE = 26 * MiB;
constexpr size_t WS_RSTD1 = 26 * MiB + 512 * 1024;
constexpr size_t WS_GATES = 27 * MiB;
constexpr size_t WS_SSQ = 28 * MiB;
constexpr size_t WS_SEG = 30 * MiB;
constexpr size_t WS_XN = 48 * MiB;
constexpr size_t WS_MIX = 112 * MiB;
constexpr size_t WS_PROJ = 176 * MiB;
constexpr size_t WS_END = 352 * MiB;
constexpr int CW_BAR = 4096;
constexpr int RING_BYTES = 131072;
constexpr int LDSCTL_OFF = RING_BYTES, MISC_OFF = LDSCTL_OFF + 320;
constexpr int LDS_BYTES = 147456;

#define GAS __attribute__((address_space(1)))
#define LAS __attribute__((address_space(3)))
typedef unsigned short bf16;
typedef unsigned v4u __attribute__((ext_vector_type(4)));
typedef unsigned v2u __attribute__((ext_vector_type(2)));
typedef float f32x2v __attribute__((ext_vector_type(2)));
typedef float f32x4 __attribute__((ext_vector_type(4)));
typedef short bf16x8 __attribute__((ext_vector_type(8)));
typedef GAS unsigned gu32;
#define RLX_AGENT __ATOMIC_RELAXED, __HIP_MEMORY_SCOPE_AGENT
#define LDS_WAIT() asm volatile("s_waitcnt lgkmcnt(0)" ::: "memory")
#define VM_WAIT() asm volatile("s_waitcnt vmcnt(0)" ::: "memory")
__device__ __forceinline__ unsigned f2bf(float f) { unsigned u = __builtin_bit_cast(unsigned, f); return (u + 0x7fffu + ((u >> 16) & 1u)) >> 16; }
__device__ __forceinline__ unsigned pk2(float lo, float hi) { return f2bf(lo) | (f2bf(hi) << 16); }
__device__ __forceinline__ float bf2f(unsigned short b) { return __builtin_bit_cast(float, (unsigned)b << 16); }
__device__ __forceinline__ float bflo(unsigned w) { return __builtin_bit_cast(float, w << 16); }
__device__ __forceinline__ float bfhi(unsigned w) { return __builtin_bit_cast(float, w & 0xffff0000u); }
__device__ __forceinline__ float wave_sum(float v) {
#pragma unroll
    for (int o = 1; o < 64; o <<= 1) v += __shfl_xor(v, o);
    return v;
}
__device__ __forceinline__ float wave_max(float v) {
#pragma unroll
    for (int o = 1; o < 64; o <<= 1) v = fmaxf(v, __shfl_xor(v, o));
    return v;
}
__device__ __forceinline__ void unpack8(const v4u w, float* o) { o[0] = bflo(w.x); o[1] = bfhi(w.x); o[2] = bflo(w.y); o[3] = bfhi(w.y); o[4] = bflo(w.z); o[5] = bfhi(w.z); o[6] = bflo(w.w); o[7] = bfhi(w.w); }
#define XB_TMO      128
#define XB_XCNT(j)  (256  + 64 * (j))
#define XB_XSUB(j)  (1280 + 64 * (j))
#define XB_XGEN(j)  (2304 + 64 * (j))
#define XB_TOP      3328
#define XB_TOPGEN   3392
#define XCD_BAR_WORDS 3456
#define XB_SPIN_CAP (1u << 18)

__device__ __forceinline__ unsigned xb_ld(unsigned* p)              { return __hip_atomic_load(p, __ATOMIC_RELAXED, __HIP_MEMORY_SCOPE_AGENT); }
__device__ __forceinline__ unsigned xb_add(unsigned* p, unsigned v) { return __hip_atomic_fetch_add(p, v, __ATOMIC_RELAXED, __HIP_MEMORY_SCOPE_AGENT); }
__device__ __forceinline__ unsigned xb_xcc_id() { return (unsigned)__builtin_amdgcn_s_getreg((3 << 11) | 20) & 0xFu; }
#define XB_SPIN(cond, bar) do { unsigned _sp = 0; while (cond) { __builtin_amdgcn_s_sleep(1); \
    if ((++_sp & 255u) == 0u) { if (xb_ld(&(bar)[XB_TMO])) break; if (_sp > XB_SPIN_CAP) { atomicAdd(&(bar)[XB_TMO], 1u); break; } } } } while (0)

struct XcdBarrier {
    unsigned* bar; unsigned x;
    volatile LAS unsigned* st;
};

__device__ __forceinline__ XcdBarrier xcd_barrier_post(unsigned* bar, volatile LAS unsigned* st) {
    XcdBarrier b; b.bar = bar; b.x = xb_xcc_id(); b.st = st;
    if (threadIdx.x == 0) (void)xb_add(&bar[XB_XCNT(b.x)], 1u);
    return b;
}
__device__ __forceinline__ void xcd_barrier_complete(unsigned* bar, unsigned x, unsigned& nloc, unsigned& nx) {
    const unsigned G = gridDim.x * gridDim.y * gridDim.z;
    unsigned sum, cnt, mine, sp = 0u;
    for (;;) {
        sum = 0u; cnt = 0u; mine = 0u;
#pragma unroll
        for (unsigned j = 0; j < 16; ++j) { const unsigned c = xb_ld(&bar[XB_XCNT(j)]); sum += c; cnt += (c > 0u) ? 1u : 0u; mine = (j == x) ? c : mine; }
        if (sum == G) break;
        __builtin_amdgcn_s_sleep(1);
        if ((++sp & 255u) == 0u) { if (xb_ld(&bar[XB_TMO])) break; if (sp > XB_SPIN_CAP) { atomicAdd(&bar[XB_TMO], 1u); break; } }
    }
    nloc = mine > 0u ? mine : 1u; nx = cnt > 0u ? cnt : 1u;
}

__device__ __forceinline__ void xcd_barrier(const XcdBarrier& b) {
    asm volatile("s_waitcnt vmcnt(0)" ::: "memory");
    __syncthreads();
    if (threadIdx.x == 0) {
        unsigned* bar = b.bar;
        __builtin_amdgcn_s_waitcnt(0);
        unsigned nloc = b.st[0], nx = b.st[1];
        if (nloc == 0u) { xcd_barrier_complete(bar, b.x, nloc, nx); b.st[0] = nloc; b.st[1] = nx; }
        const unsigned old = xb_add(&bar[XB_XSUB(b.x)], 1u);
        const unsigned gen = old / nloc;
        if (old + 1u == (gen + 1u) * nloc) {
            __builtin_amdgcn_fence(__ATOMIC_RELEASE, "agent");
            asm volatile("s_waitcnt vmcnt(0)" ::: "memory");
            const unsigned og = xb_add(&bar[XB_TOP], 1u);
            const unsigned tg = og / nx;
            if (og + 1u == (tg + 1u) * nx) xb_add(&bar[XB_TOPGEN], 1u);
            else XB_SPIN(xb_ld(&bar[XB_TOPGEN]) == tg, bar);
            __builtin_amdgcn_fence(__ATOMIC_ACQUIRE, "agent");
            xb_add(&bar[XB_XGEN(b.x)], 1u);
            asm volatile("s_waitcnt vmcnt(0)" ::: "memory");
        } else {
            XB_SPIN(xb_ld(&bar[XB_XGEN(b.x)]) == gen, bar);
            __builtin_amdgcn_fence(__ATOMIC_ACQUIRE, "agent");
            asm volatile("s_waitcnt vmcnt(0)" ::: "memory");
        }
    }
    __syncthreads();
}
#define PHASE2_BODY do { mlstm_phase<1>(F); swa_phase(F); } while (0)
#define PHASE3_BODY mlstm_phase<2>(F)
#define LAUNCH_MK(lo_, hi_) do { a.ph_lo = (lo_); a.ph_hi = (hi_); a.li = (lo_); hipLaunchKernelGGL(mk_fwd, dim3(grid), dim3(NWAVES * 64), LDS_BYTES, stream, a); } while (0)
#define LAUNCH_PROGRAM { LAUNCH_MK(0, 7); }
struct Frame {
    LAS unsigned char* lds;
    volatile LAS unsigned* MISC;
    gu32* ctl;
    int tid, lane, wave, vcu, G;
    const float *x, *norm1_g, *w_in, *conv_w, *igate_b, *fgate_b, *mlstm_norm_g, *q_norm_g, *k_norm_g, *sinks, *w_out, *norm2_g, *w_gate, *w_up, *w_down;
    float* out;
    bf16 *Win_t, *Wout_t, *Wgu_t, *Wdn_t, *XN, *MIX, *PROJ;
    float2* ROPE; float* GATES; float* SSQ; float* SEG;
};

struct P0Item { const float* W; int ldw, src_col0; const float* kscale; bf16* WT; int Kd, dst_row0, kb; };
template <bool SCALE> __device__ __forceinline__ void p0_item_load(const P0Item& I, float (&v)[32], int lane) {
    const int k0 = 64 * I.kb;
#pragma unroll
    for (int i = 0; i < 32; ++i) { const int kk = 2 * i + (lane >> 5); v[i] = I.W[(size_t)(k0 + kk) * I.ldw + I.src_col0 + (lane & 31)]; }
    if (SCALE) {
        float sc[32];
#pragma unroll
        for (int i = 0; i < 32; ++i) sc[i] = I.kscale[k0 + 2 * i + (lane >> 5)];
#pragma unroll
        for (int i = 0; i < 32; ++i) v[i] *= sc[i];
    }
}
__device__ __forceinline__ void p0_item_finish(const P0Item& I, const float (&v)[32], LAS float* scr, int lane) {
    const int k0 = 64 * I.kb;
#pragma unroll
    for (int i = 0; i < 32; ++i) { const int kk = 2 * i + (lane >> 5); scr[kk * 33 + (lane & 31)] = v[i]; }
    LDS_WAIT(); asm volatile("" ::: "memory");
    const int c = lane & 7;
#pragma unroll
    for (int j = 0; j < 4; ++j) { const int n = (lane >> 3) + 8 * j; const LAS float* s = scr + (8 * c) * 33 + n;
        v4u o; o.x = pk2(s[0 * 33], s[1 * 33]); o.y = pk2(s[2 * 33], s[3 * 33]); o.z = pk2(s[4 * 33], s[5 * 33]); o.w = pk2(s[6 * 33], s[7 * 33]);
        *(GAS v4u*)(I.WT + (size_t)(I.dst_row0 + n) * I.Kd + k0 + 8 * c) = o; }
    LDS_WAIT(); asm volatile("" ::: "memory");
}
constexpr int I_IN = 88 * 16, I_OUT = 32 * 16, I_GU = 176 * 16, I_DN = 32 * 44;
__device__ __forceinline__ P0Item p0_item_in(Frame& F, int r) { const int nb = r % 88, kb = r / 88; return P0Item{F.w_in, DIN, nb < 64 ? 32 * nb : 32 * nb + 8, nullptr, F.Win_t, DM, 32 * nb, kb}; }
__device__ __forceinline__ P0Item p0_item_gu(Frame& F, int r) { const int nb = r % 176, kb = r / 176, tile = nb >> 3, wi = nb & 7; const float* W = (wi < 4) ? F.w_gate : F.w_up;
    return P0Item{W, DFF, 128 * tile + 32 * (wi & 3), F.norm2_g, F.Wgu_t, DM, 32 * nb, kb}; }
__device__ __forceinline__ P0Item p0_item_od(Frame& F, int r) {
    if (r < I_OUT) { const int nb = r % 32, kb = r / 32; return P0Item{F.w_out, DM, 32 * nb, nullptr, F.Wout_t, DM, 32 * nb, kb}; } r -= I_OUT;
    { const int nb = r % 32, kb = r / 32; return P0Item{F.w_down, DM, 32 * nb, nullptr, F.Wdn_t, DFF, 32 * nb, kb}; }
}
__device__ __forceinline__ void p0_prologue(Frame& F) {
    LAS float* scr = (LAS float*)(F.lds + F.wave * 8704);
    const int gw = F.vcu * NWAVES + F.wave, NGW = F.G * NWAVES;
    for (int it = gw; it < I_IN; it += NGW) { const P0Item I = p0_item_in(F, it); float v[32]; p0_item_load<false>(I, v, F.lane); p0_item_finish(I, v, scr, F.lane); }
    { const int idx = (F.vcu * NWAVES * 64) + F.tid;
      if (idx < SEQ * 8) { const int pos = idx >> 3, i = idx & 7;
        double f = 1.0; f = (i == 1) ? 0.19392274474868576 : f; f = (i == 2) ? 0.03760603093086393 : f; f = (i == 3) ? 0.007292664737217109 : f; f = (i == 4) ? 0.001414213562373095 : f;
        f = (i == 5) ? 0.0002742481756762073 : f; f = (i == 6) ? 5.318295896944988e-05 : f; f = (i == 7) ? 1.031338537721246e-05 : f;
        const float angf = (float)pos * (float)f; const double rev = (double)angf * 0.15915494309189535; const double fr = rev - __builtin_floor(rev + 0.5);
        const float rr = (float)(fr * 6.283185307179586); F.ROPE[idx] = make_float2(__cosf(rr), __sinf(rr)); } }
    f32x4 g1[4];
#pragma unroll
    for (int j = 0; j < 4; ++j) g1[j] = ((const f32x4*)F.norm1_g)[F.lane + 64 * j];
    for (int m = gw; m < T; m += NGW) {
        const GAS f32x4* xr = (const GAS f32x4*)(F.x + (size_t)m * DM) + F.lane;
        f32x4 v[4]; float s = 0.f;
#pragma unroll
        for (int j = 0; j < 4; ++j) { v[j] = xr[64 * j]; s += (v[j].x * v[j].x + v[j].y * v[j].y) + (v[j].z * v[j].z + v[j].w * v[j].w); }
        const float rstd = __builtin_amdgcn_rsqf(wave_sum(s) * (1.f / DM) + EPS);
        GAS v2u* o8 = (GAS v2u*)(F.XN + (size_t)m * DM) + F.lane;
#pragma unroll
        for (int j = 0; j < 4; ++j) { const f32x4 y = v[j] * rstd * g1[j]; v2u w; w.x = pg8::cvt_pk_bf16(y.x, y.y); w.y = pg8::cvt_pk_bf16(y.z, y.w); o8[64 * j] = w; }
    }
}
__device__ __forceinline__ void p1_side_work(Frame& F, int ii, int ni) {
    LAS float* scr = (LAS float*)(F.lds + F.wave * 8704);
    LAS unsigned char* WB = F.lds + 73728;
    for (int idx = F.tid; idx < 2048; idx += NWAVES * 64) { const int ks = idx >> 6, ln = idx & 63, col = ln & 15, gq = ln >> 4;
        v4u o = (v4u){0u, 0u, 0u, 0u};
        if (col < 8) { const float* wp = F.w_in + (size_t)(32 * ks + 8 * gq) * DIN + SRC_MI + col;
            o.x = pk2(wp[0], wp[DIN]); o.y = pk2(wp[2 * DIN], wp[3 * DIN]); o.z = pk2(wp[4 * DIN], wp[5 * DIN]); o.w = pk2(wp[6 * DIN], wp[7 * DIN]); }
        *(LAS v4u*)(WB + idx * 16) = o; }
    __syncthreads();
    const int igw = ii * NWAVES + F.wave, NIW = ni * NWAVES;
#pragma unroll 1
    for (int it = igw; it < I_GU; it += 2 * NIW) {
        const P0Item Ia = p0_item_gu(F, it); const bool two = it + NIW < I_GU; const P0Item Ib = p0_item_gu(F, two ? it + NIW : it);
        float va[32], vb[32]; p0_item_load<true>(Ia, va, F.lane); p0_item_load<true>(Ib, vb, F.lane);
        p0_item_finish(Ia, va, scr, F.lane); if (two) p0_item_finish(Ib, vb, scr, F.lane);
    }
#pragma unroll 1
    for (int it = igw; it < I_OUT + I_DN; it += 2 * NIW) {
        const P0Item Ia = p0_item_od(F, it); const bool two = it + NIW < I_OUT + I_DN; const P0Item Ib = p0_item_od(F, two ? it + NIW : it);
        float va[32], vb[32]; p0_item_load<false>(Ia, va, F.lane); p0_item_load<false>(Ib, vb, F.lane);
        p0_item_finish(Ia, va, scr, F.lane); if (two) p0_item_finish(Ib, vb, scr, F.lane);
    }
    const int l15 = F.lane & 15, g = F.lane >> 4;
    for (int blk = igw; blk < T / 16; blk += NIW) {
        const bf16* xp = F.XN + ((size_t)blk * 16 + l15) * DM + 8 * g;
        f32x4 acc = (f32x4){0.f, 0.f, 0.f, 0.f};
        bf16x8 a[32];
#pragma unroll
        for (int q = 0; q < 32; ++q) a[q] = *(const bf16x8*)(xp + 32 * q);
#pragma unroll
        for (int q = 0; q < 32; ++q) acc = __builtin_amdgcn_mfma_f32_16x16x32_bf16(a[q], *(const LAS bf16x8*)(WB + (q * 64 + F.lane) * 16), acc, 0, 0, 0);
        if (l15 < 8) {
#pragma unroll
            for (int r = 0; r < 4; ++r) F.GATES[((size_t)blk * 16 + 4 * g + r) * 8 + l15] = acc[r];
        }
    }
}

constexpr int SWA_KS = 0, SWA_KSTR = 144, SWA_VT = 36864, SWA_VSTR = 528;
typedef short bf16x4 __attribute__((ext_vector_type(4)));
constexpr int SWA_TAB = 70656;
struct SwaKV { v4u k[4], v[4]; float2 cs[8]; };
struct SwaQ { v4u w0, w1; float2 cs[8]; };
__device__ __forceinline__ void swa_load_kv(Frame& F, int tid, int u, SwaKV& R) {
    const int blk = u & 31, kvh = (u >> 5) & 1, b = u >> 6; const int key = tid >> 1, half = tid & 1; const int kt = blk * 128 - 128 + key;
    if (kt >= 0) {
        const bf16* kp = F.PROJ + (size_t)(b * SEQ + kt) * NPROJ + PC_AK + kvh * 64 + 32 * half;
        const bf16* vp = F.PROJ + (size_t)(b * SEQ + kt) * NPROJ + PC_AV + kvh * 64 + 32 * half;
#pragma unroll
        for (int c = 0; c < 4; ++c) { R.k[c] = *(const v4u*)(kp + 8 * c); R.v[c] = *(const v4u*)(vp + 8 * c); }
#pragma unroll
        for (int i = 0; i < 8; ++i) R.cs[i] = F.ROPE[kt * 8 + i];
    } else {
#pragma unroll
        for (int c = 0; c < 4; ++c) { R.k[c] = (v4u){0u, 0u, 0u, 0u}; R.v[c] = (v4u){0u, 0u, 0u, 0u}; }
#pragma unroll
        for (int i = 0; i < 8; ++i) R.cs[i] = make_float2(1.f, 0.f);
    }
}
__device__ __forceinline__ void swa_load_q(Frame& F, int lane, int wave, int u, int rb, SwaQ& R) {
    const int blk = u & 31, kvh = (u >> 5) & 1, b = u >> 6; const int l15 = lane & 15, g = lane >> 4;
    const int hq = kvh * 4 + (wave >> 1), p0 = 64 * (wave & 1) + 16 * rb, tq = blk * 128 + p0 + l15;
    const bf16* qp = F.PROJ + (size_t)(b * SEQ + tq) * NPROJ + PC_AQ + hq * 64 + 8 * g;
    R.w0 = *(const v4u*)qp; R.w1 = *(const v4u*)(qp + 32);
#pragma unroll
    for (int j = 0; j < 8; ++j) R.cs[j] = F.ROPE[tq * 8 + j];
}
__device__ __forceinline__ void swa_phase(Frame& F) {
    LAS unsigned char* KS = F.lds + SWA_KS; LAS unsigned char* VT = F.lds + SWA_VT; LAS float* TAB = (LAS float*)(F.lds + SWA_TAB);
    const int wave = F.wave;
    int u = F.vcu;
    if (u >= NB * 2 * 32) return;
    __syncthreads();
    if (F.tid < 64) TAB[F.tid] = F.q_norm_g[F.tid]; else if (F.tid < 128) TAB[F.tid] = F.k_norm_g[F.tid - 64];
    SwaKV kv; SwaQ qr;
    swa_load_kv(F, F.tid, u, kv);
    swa_load_q(F, F.lane, wave, u, 0, qr);
#pragma unroll 1
    for (; u < NB * 2 * 32; u += F.G) {
        int tid = F.tid; asm volatile("" : "+v"(tid));
        const int lane = tid & 63, l15 = lane & 15, g = lane >> 4;
        const int blk = u & 31, kvh = (u >> 5) & 1, b = u >> 6;
        const int un = u + F.G; const bool has_next = un < NB * 2 * 32;
        __syncthreads();
        {
            const int key = tid >> 1, half = tid & 1;
            float kf[32];
#pragma unroll
            for (int c = 0; c < 4; ++c) unpack8(kv.k[c], kf + 8 * c);
            float ss = 0.f;
#pragma unroll
            for (int c = 0; c < 32; ++c) ss += kf[c] * kf[c];
            ss += __shfl_xor(ss, 1);
            const float rstd = __builtin_amdgcn_rsqf(ss * (1.f / 64.f) + EPS);
#pragma unroll
            for (int c = 0; c < 8; ++c) { const f32x4 gg = *(const LAS f32x4*)(TAB + 64 + 32 * half + 4 * c); kf[4 * c] *= rstd * gg[0]; kf[4 * c + 1] *= rstd * gg[1]; kf[4 * c + 2] *= rstd * gg[2]; kf[4 * c + 3] *= rstd * gg[3]; }
            if (half == 0) {
#pragma unroll
                for (int i = 0; i < 8; ++i) { const float2 cs = kv.cs[i]; const float x1 = kf[i], x2 = kf[8 + i]; kf[i] = x1 * cs.x - x2 * cs.y; kf[8 + i] = x2 * cs.x + x1 * cs.y; }
            }
#pragma unroll
            for (int c = 0; c < 4; ++c) { v4u o; o.x = pg8::cvt_pk_bf16(kf[8 * c], kf[8 * c + 1]); o.y = pg8::cvt_pk_bf16(kf[8 * c + 2], kf[8 * c + 3]); o.z = pg8::cvt_pk_bf16(kf[8 * c + 4], kf[8 * c + 5]); o.w = pg8::cvt_pk_bf16(kf[8 * c + 6], kf[8 * c + 7]);
                *(LAS v4u*)(KS + key * SWA_KSTR + 64 * half + 16 * c) = o; }
#pragma unroll
            for (int c = 0; c < 4; ++c) { const unsigned ww[4] = {kv.v[c].x, kv.v[c].y, kv.v[c].z, kv.v[c].w};
#pragma unroll
                for (int e = 0; e < 4; ++e) { const int d = 32 * half + 8 * c + 2 * e;
                    *(LAS unsigned short*)(VT + d * SWA_VSTR + key * 2) = (unsigned short)(ww[e] & 0xffffu);
                    *(LAS unsigned short*)(VT + (d + 1) * SWA_VSTR + key * 2) = (unsigned short)(ww[e] >> 16); } }
        }
        __syncthreads();
        if (has_next) swa_load_kv(F, tid, un, kv);
        const int hq = kvh * 4 + (wave >> 1);
        const float sink2 = F.sinks[hq] * 1.4426950408889634f;
        const float SC = 0.125f * 1.4426950408889634f;
#pragma unroll 1
        for (int rb = 0; rb < 4; ++rb) {
            const int p0 = 64 * (wave & 1) + 16 * rb, j0 = p0 >> 4;
            const int tq = blk * 128 + p0 + l15;
            bf16x8 qf[2];
            {
                float q0[8], q1[8]; unpack8(qr.w0, q0); unpack8(qr.w1, q1);
                float ss = 0.f;
#pragma unroll
                for (int j = 0; j < 8; ++j) ss += q0[j] * q0[j] + q1[j] * q1[j];
                ss += __shfl_xor(ss, 16); ss += __shfl_xor(ss, 32);
                const float rstd = __builtin_amdgcn_rsqf(ss * (1.f / 64.f) + EPS);
#pragma unroll
                for (int c = 0; c < 2; ++c) { const f32x4 ga = *(const LAS f32x4*)(TAB + 8 * g + 4 * c), gb = *(const LAS f32x4*)(TAB + 32 + 8 * g + 4 * c);
#pragma unroll
                    for (int e = 0; e < 4; ++e) { q0[4 * c + e] *= rstd * ga[e]; q1[4 * c + e] *= rstd * gb[e]; } }
#pragma unroll
                for (int j = 0; j < 8; ++j) { const float other = __shfl_xor(q0[j], 16); const float2 cs = qr.cs[j];
                    const float r0 = q0[j] * cs.x - other * cs.y, r1 = q0[j] * cs.x + other * cs.y; q0[j] = (g == 0) ? r0 : ((g == 1) ? r1 : q0[j]); }
                v4u a, c2; a.x = pg8::cvt_pk_bf16(q0[0], q0[1]); a.y = pg8::cvt_pk_bf16(q0[2], q0[3]); a.z = pg8::cvt_pk_bf16(q0[4], q0[5]); a.w = pg8::cvt_pk_bf16(q0[6], q0[7]);
                c2.x = pg8::cvt_pk_bf16(q1[0], q1[1]); c2.y = pg8::cvt_pk_bf16(q1[2], q1[3]); c2.z = pg8::cvt_pk_bf16(q1[4], q1[5]); c2.w = pg8::cvt_pk_bf16(q1[6], q1[7]);
                qf[0] = __builtin_bit_cast(bf16x8, a); qf[1] = __builtin_bit_cast(bf16x8, c2);
            }
            if (rb < 3) swa_load_q(F, lane, wave, u, rb + 1, qr); else if (has_next) swa_load_q(F, lane, wave, un, 0, qr);
            f32x4 s[10];
    #pragma unroll
            for (int jj = 0; jj < 9; ++jj) { const int tile = j0 + jj;
                f32x4 acc = (f32x4){0.f, 0.f, 0.f, 0.f};
    #pragma unroll
                for (int ks = 0; ks < 2; ++ks) { const bf16x8 kfr = *(const LAS bf16x8*)(KS + (16 * tile + l15) * SWA_KSTR + 64 * ks + 16 * g);
                    acc = __builtin_amdgcn_mfma_f32_16x16x32_bf16(kfr, qf[ks], acc, 0, 0, 0); }
                s[jj] = acc; }
            s[9] = (f32x4){0.f, 0.f, 0.f, 0.f};
    #pragma unroll
            for (int r = 0; r < 4; ++r) { if (4 * g + r < 1 + l15) s[0][r] = -INFINITY; if (4 * g + r > l15) s[8][r] = -INFINITY; }
            if (blk == 0) {
    #pragma unroll
                for (int jj = 0; jj < 9; ++jj)
    #pragma unroll
                    for (int r = 0; r < 4; ++r) { if (16 * (j0 + jj) + 4 * g + r < 128) s[jj][r] = -INFINITY; }
            }
            float mx = -INFINITY;
    #pragma unroll
            for (int jj = 0; jj < 9; ++jj)
    #pragma unroll
                for (int r = 0; r < 4; ++r) mx = fmaxf(mx, s[jj][r]);
            mx = fmaxf(mx, __shfl_xor(mx, 16)); mx = fmaxf(mx, __shfl_xor(mx, 32)); mx = fmaxf(mx * SC, sink2);
            float sum = 0.f;
    #pragma unroll
            for (int jj = 0; jj < 9; ++jj)
    #pragma unroll
                for (int r = 0; r < 4; ++r) { const float p = __builtin_amdgcn_exp2f(__builtin_fmaf(s[jj][r], SC, -mx)); s[jj][r] = p; sum += p; }
            sum += __shfl_xor(sum, 16); sum += __shfl_xor(sum, 32);
            const float inv = 1.0f / (sum + __builtin_amdgcn_exp2f(sink2 - mx));
            f32x4 o[4];
    #pragma unroll
            for (int dt = 0; dt < 4; ++dt) o[dt] = (f32x4){0.f, 0.f, 0.f, 0.f};
    #pragma unroll
            for (int kk = 0; kk < 5; ++kk) {
                const int t0 = (j0 + 2 * kk) > 15 ? 15 : (j0 + 2 * kk), t1 = (j0 + 2 * kk + 1) > 15 ? 15 : (j0 + 2 * kk + 1);
                v4u pw; pw.x = pg8::cvt_pk_bf16(s[2 * kk][0], s[2 * kk][1]); pw.y = pg8::cvt_pk_bf16(s[2 * kk][2], s[2 * kk][3]); pw.z = pg8::cvt_pk_bf16(s[2 * kk + 1][0], s[2 * kk + 1][1]); pw.w = pg8::cvt_pk_bf16(s[2 * kk + 1][2], s[2 * kk + 1][3]);
                const bf16x8 pf = __builtin_bit_cast(bf16x8, pw);
    #pragma unroll
                for (int dt = 0; dt < 4; ++dt) {
                    const v2u a0 = *(const LAS v2u*)(VT + (16 * dt + l15) * SWA_VSTR + (16 * t0 + 4 * g) * 2);
                    const v2u a1 = *(const LAS v2u*)(VT + (16 * dt + l15) * SWA_VSTR + (16 * t1 + 4 * g) * 2);
                    v4u av; av.x = a0.x; av.y = a0.y; av.z = a1.x; av.w = a1.y;
                    o[dt] = __builtin_amdgcn_mfma_f32_16x16x32_bf16(__builtin_bit_cast(bf16x8, av), pf, o[dt], 0, 0, 0); }
            }
            bf16* op = F.MIX + (size_t)(b * SEQ + tq) * DM + 512 + hq * 64 + 4 * g;
    #pragma unroll
            for (int dt = 0; dt < 4; ++dt) { v2u w; w.x = pg8::cvt_pk_bf16(o[dt][0] * inv, o[dt][1] * inv); w.y = pg8::cvt_pk_bf16(o[dt][2] * inv, o[dt][3] * inv); *(v2u*)(op + 16 * dt) = w; }
        }
    }
}
constexpr int ML_QS = 0, ML_KS = 17408, ML_KWT = 34816, ML_VT = 53248, ML_PS = 71680, ML_CT = 80896, ML_F = 115712;
constexpr int ML_QSTR = 272, ML_TSTR = 144, ML_HSTR = 528;
constexpr int FDEN = 256, FN = 320;
constexpr int ML_GV = 132096, ML_GS = ML_GV + 8192, ML_CW = ML_GS + 256;
constexpr int SEG_STRIDE = 16640;
constexpr float LOG2E = 1.4426950408889634f;
__device__ __forceinline__ float silu_f(float v) { return v * __builtin_amdgcn_rcpf(1.0f + __builtin_amdgcn_exp2f(v * -LOG2E)); }
__device__ __forceinline__ float sigmoid_f(float v) { return __builtin_amdgcn_rcpf(1.0f + __builtin_amdgcn_exp2f(v * -LOG2E)); }
__device__ __forceinline__ float exp_f(float v) { return __builtin_amdgcn_exp2f(v * LOG2E); }

template <int PASS> __device__ __forceinline__ void mlstm_item(Frame& F, int b, int h, int sg) {
    const int wave = F.wave;
    int tid = F.tid; asm volatile("" : "+v"(tid));
    int lane = tid & 63, l15 = lane & 15, g4 = lane >> 4;
    LAS unsigned char* L = F.lds; LAS float* FL = (LAS float*)(L + ML_F);
    f32x4 C[8];
#pragma unroll
    for (int et = 0; et < 8; ++et) C[et] = (f32x4){0.f, 0.f, 0.f, 0.f};
    float m = -1e30f, Gsum = 0.f;
    LAS float* GV = (LAS float*)(L + ML_GV); LAS float* GS = (LAS float*)(L + ML_GS); LAS float* CW = (LAS float*)(L + ML_CW);
    __syncthreads();
    if (tid < 128) FL[FN + tid] = 0.f;
    for (int i = tid; i < 1024; i += NWAVES * 64) { const int j = i >> 8, ch = i & 255; CW[i] = F.conv_w[j * 1024 + (ch >> 7) * 512 + h * 128 + (ch & 127)]; }
    {
        const size_t tg = (size_t)b * SEQ + (size_t)(sg * 8 + wave) * 64 + lane;
        const float* gr = F.GATES + tg * 8;
        const float ig = gr[h] + F.igate_b[h], fg = gr[4 + h] + F.fgate_b[h];
        const float lf = fminf(fg, 0.f) - log1pf(__expf(-fabsf(fg)));
        float bs = lf;
#pragma unroll
        for (int o = 1; o < 64; o <<= 1) { const float t = __shfl_up(bs, o); if (lane >= o) bs += t; }
        const float gtot = __shfl(bs, 63);
        const float u = ig - bs;
        float pm = u;
#pragma unroll
        for (int o = 1; o < 64; o <<= 1) { const float t = __shfl_up(pm, o); if (lane >= o) pm = fmaxf(pm, t); }
        const float a = gtot + u;
        const float mloc = wave_max(a);
        GV[wave * 256 + lane] = bs; GV[wave * 256 + 64 + lane] = u; GV[wave * 256 + 128 + lane] = exp_f(a - mloc); GV[wave * 256 + 192 + lane] = pm;
        if (lane == 0) { GS[wave * 2] = gtot; GS[wave * 2 + 1] = mloc; }
    }
    if (PASS == 2 && sg > 0) {
        const float* E0 = F.SEG + (size_t)((b * 4 + h) * 8) * SEG_STRIDE;
        float lw[7]; float sfx = 0.f, mfin = -1e30f;
#pragma unroll
        for (int j = 6; j >= 0; --j) { const int jc = (j < sg) ? j : 0; const float mE = E0[(size_t)jc * SEG_STRIDE + 16384 + 128], G = E0[(size_t)jc * SEG_STRIDE + 16384 + 129];
            lw[j] = (j < sg) ? (mE + sfx) : -1e30f; sfx += (j < sg) ? G : 0.f; mfin = fmaxf(mfin, lw[j]); }
        float coef[7];
#pragma unroll
        for (int j = 0; j < 7; ++j) coef[j] = (j < sg) ? exp_f(lw[j] - mfin) : 0.f;
#pragma unroll 1
        for (int j = 0; j < sg; ++j) { const float* Ej = E0 + (size_t)j * SEG_STRIDE; float cj = coef[0];
#pragma unroll
            for (int q = 1; q < 7; ++q) cj = (j == q) ? coef[q] : cj;
#pragma unroll
            for (int et = 0; et < 8; ++et)
#pragma unroll
                for (int r = 0; r < 4; ++r) C[et][r] += cj * Ej[(unsigned)((16 * wave + 4 * g4 + r) * 128 + 16 * et + l15)];
            if (tid < 128) FL[FN + tid] += cj * Ej[16384 + tid]; }
        m = mfin;
    }
    if (PASS == 2) {
#pragma unroll
        for (int et = 0; et < 8; ++et) { v2u w; w.x = pk2(C[et][0], C[et][1]); w.y = pk2(C[et][2], C[et][3]); *(LAS v2u*)(L + ML_CT + (16 * et + l15) * ML_QSTR + (16 * wave + 4 * g4) * 2) = w; }
    }
    const float kscale = 0.08838834764831845f;
    v4u xr[7]; v4u vr[4];
#define ML_LOAD(cidx) do { const int c_ = (cidx); const size_t t0_ = (size_t)b * SEQ + (size_t)c_ * 64; \
        const int mat_ = tid >> 8, r8_ = tid & 255, dg_ = r8_ & 15, l0_ = 4 * (r8_ >> 4); \
        if (PASS == 2 || mat_ == 1) { const bf16* src_ = F.PROJ + (mat_ ? PC_MK : PC_MQ) + h * 128 + 8 * dg_; \
            _Pragma("unroll") for (int j = 0; j < 7; ++j) { const int lr = l0_ + j - 3; xr[j] = (c_ == 0 && lr < 0) ? (v4u){0u, 0u, 0u, 0u} : *(const v4u*)(src_ + (t0_ + lr) * NPROJ); } } \
        if (mat_ == 0) { _Pragma("unroll") for (int lp = 0; lp < 4; ++lp) vr[lp] = *(const v4u*)(F.PROJ + (t0_ + l0_ + lp) * NPROJ + PC_MV + h * 128 + 8 * dg_); } } while (0)
    ML_LOAD(sg * 8);
#pragma unroll 1
    for (int cc = 0; cc < 8; ++cc) {
        const int c = sg * 8 + cc; const size_t t0 = (size_t)b * SEQ + (size_t)c * 64;
        tid = F.tid; asm volatile("" : "+v"(tid));
        lane = tid & 63; l15 = lane & 15; g4 = lane >> 4;
        const int mat = tid >> 8, r8 = tid & 255, dg = r8 & 15, rg = r8 >> 4, l0 = 4 * rg;
        LAS float* GB = GV + cc * 256;
        __syncthreads();
        const float gtot = GS[cc * 2], mloc = GS[cc * 2 + 1];
        if (PASS == 2 || mat == 1) {
            const float w0 = GB[128 + l0], w1 = GB[128 + l0 + 1], w2 = GB[128 + l0 + 2], w3 = GB[128 + l0 + 3];
            unsigned ow[4][4];
            const LAS float* cwp = CW + mat * 128 + 8 * dg;
#pragma unroll
            for (int ip = 0; ip < 4; ++ip) {
                float ya[4], yb[4];
                const float ca0 = cwp[2 * ip], ca1 = cwp[256 + 2 * ip], ca2 = cwp[512 + 2 * ip], ca3 = cwp[768 + 2 * ip];
                const float cb0 = cwp[2 * ip + 1], cb1 = cwp[256 + 2 * ip + 1], cb2 = cwp[512 + 2 * ip + 1], cb3 = cwp[768 + 2 * ip + 1];
                float xa[7], xb[7];
#pragma unroll
                for (int j = 0; j < 7; ++j) { const unsigned w = (ip == 0) ? xr[j].x : (ip == 1) ? xr[j].y : (ip == 2) ? xr[j].z : xr[j].w; xa[j] = bflo(w); xb[j] = bfhi(w); }
#pragma unroll
                for (int lp = 0; lp < 4; ++lp) {
                    ya[lp] = silu_f(ca0 * xa[lp] + ca1 * xa[lp + 1] + ca2 * xa[lp + 2] + ca3 * xa[lp + 3]) * (mat ? kscale : 1.0f);
                    yb[lp] = silu_f(cb0 * xb[lp] + cb1 * xb[lp + 1] + cb2 * xb[lp + 2] + cb3 * xb[lp + 3]) * (mat ? kscale : 1.0f);
                    ow[lp][ip] = pk2(ya[lp], yb[lp]); }
                if (mat == 1) {
                    v2u o; o.x = pk2(ya[0] * w0, ya[1] * w1); o.y = pk2(ya[2] * w2, ya[3] * w3); *(LAS v2u*)(L + ML_KWT + (8 * dg + 2 * ip) * ML_TSTR + l0 * 2) = o;
                    o.x = pk2(yb[0] * w0, yb[1] * w1); o.y = pk2(yb[2] * w2, yb[3] * w3); *(LAS v2u*)(L + ML_KWT + (8 * dg + 2 * ip + 1) * ML_TSTR + l0 * 2) = o; }
            }
            if (PASS == 2) {
                LAS unsigned char* dst = L + (mat ? ML_KS : ML_QS) + l0 * ML_QSTR + 16 * dg;
#pragma unroll
                for (int lp = 0; lp < 4; ++lp) { v4u o; o.x = ow[lp][0]; o.y = ow[lp][1]; o.z = ow[lp][2]; o.w = ow[lp][3]; *(LAS v4u*)(dst + lp * ML_QSTR) = o; }
            }
        }
        if (mat == 0) {
            const unsigned ww[4][4] = {{vr[0].x, vr[0].y, vr[0].z, vr[0].w}, {vr[1].x, vr[1].y, vr[1].z, vr[1].w}, {vr[2].x, vr[2].y, vr[2].z, vr[2].w}, {vr[3].x, vr[3].y, vr[3].z, vr[3].w}};
#pragma unroll
            for (int p = 0; p < 4; ++p) {
                v2u lo, hi;
                lo.x = (ww[0][p] & 0xffffu) | (ww[1][p] << 16); lo.y = (ww[2][p] & 0xffffu) | (ww[3][p] << 16);
                hi.x = (ww[0][p] >> 16) | (ww[1][p] & 0xffff0000u); hi.y = (ww[2][p] >> 16) | (ww[3][p] & 0xffff0000u);
                *(LAS v2u*)(L + ML_VT + (8 * dg + 2 * p) * ML_TSTR + l0 * 2) = lo;
                *(LAS v2u*)(L + ML_VT + (8 * dg + 2 * p + 1) * ML_TSTR + l0 * 2) = hi; }
        }
        __syncthreads();
        if (cc < 7) ML_LOAD(c + 1);
        unsigned mo8[8];
        if (PASS == 2) {
#pragma unroll
            for (int rr = 0; rr < 8; ++rr) mo8[rr] = *(const unsigned*)(F.PROJ + (t0 + 8 * wave + rr) * NPROJ + PC_MO + h * 128 + 2 * lane);
        }
        const float mn = fmaxf(gtot + m, mloc), so = exp_f(gtot + m - mn), sn = exp_f(mloc - mn);
        if (PASS == 2) {
            const int lt = wave >> 1;
#pragma unroll
            for (int si = 0; si < 2; ++si) { const int st = 2 * (wave & 1) + si;
                float p[4] = {0.f, 0.f, 0.f, 0.f};
                if (st <= lt) {
                    f32x4 acc = (f32x4){0.f, 0.f, 0.f, 0.f};
#pragma unroll
                    for (int ks = 0; ks < 4; ++ks) { const bf16x8 a = *(const LAS bf16x8*)(L + ML_QS + (16 * lt + l15) * ML_QSTR + 64 * ks + 16 * g4);
                        const bf16x8 bb = *(const LAS bf16x8*)(L + ML_KS + (16 * st + l15) * ML_QSTR + 64 * ks + 16 * g4);
                        acc = __builtin_amdgcn_mfma_f32_16x16x32_bf16(a, bb, acc, 0, 0, 0); }
                    const int s = 16 * st + l15; const float us = GB[64 + s];
#pragma unroll
                    for (int r = 0; r < 4; ++r) { const int l = 16 * lt + 4 * g4 + r; const float bl = GB[l]; const float mrow = bl + fmaxf(GB[192 + l], m);
                        const float e = __builtin_amdgcn_exp2f((bl - mrow + us) * LOG2E); p[r] = (s <= l) ? acc[r] * e : 0.f; }
                }
#pragma unroll
                for (int r = 0; r < 4; ++r) *(LAS unsigned short*)(L + ML_PS + (16 * lt + 4 * g4 + r) * ML_TSTR + (16 * st + l15) * 2) = (unsigned short)f2bf(p[r]);
            }
            __syncthreads();
            {
                const int row = 8 * wave + (lane >> 3), part = lane & 7;
                const v4u pw = *(const LAS v4u*)(L + ML_PS + row * ML_TSTR + 16 * part);
                float pf[8]; unpack8(pw, pf);
                float sp = ((pf[0] + pf[1]) + (pf[2] + pf[3])) + ((pf[4] + pf[5]) + (pf[6] + pf[7]));
                const v4u q0 = *(const LAS v4u*)(L + ML_QS + row * ML_QSTR + 32 * part), q1 = *(const LAS v4u*)(L + ML_QS + row * ML_QSTR + 32 * part + 16);
                float qf[16]; unpack8(q0, qf); unpack8(q1, qf + 8);
                float qn = 0.f;
#pragma unroll
                for (int i = 0; i < 16; ++i) qn += qf[i] * FL[FN + 16 * part + i];
                const float bl = GB[row]; const float mrow = bl + fmaxf(GB[192 + row], m); const float sc = exp_f(bl + m - mrow);
                float tot = sp + sc * qn;
                tot += __shfl_xor(tot, 1); tot += __shfl_xor(tot, 2); tot += __shfl_xor(tot, 4);
                if (part == 0) FL[FDEN + row] = fmaxf(fabsf(tot), exp_f(-mrow));
            }
            const int eh = wave & 1;
            f32x4 o1[4], o2[4];
#pragma unroll
            for (int ei = 0; ei < 4; ++ei) { const int et = 4 * eh + ei;
                f32x4 a1 = (f32x4){0.f, 0.f, 0.f, 0.f}, a2 = (f32x4){0.f, 0.f, 0.f, 0.f};
#pragma unroll
                for (int ks = 0; ks < 2; ++ks) { const bf16x8 a = *(const LAS bf16x8*)(L + ML_VT + (16 * et + l15) * ML_TSTR + 64 * ks + 16 * g4);
                    const bf16x8 bb = *(const LAS bf16x8*)(L + ML_PS + (16 * lt + l15) * ML_TSTR + 64 * ks + 16 * g4);
                    a1 = __builtin_amdgcn_mfma_f32_16x16x32_bf16(a, bb, a1, 0, 0, 0); }
#pragma unroll
                for (int ks = 0; ks < 4; ++ks) { const bf16x8 a = *(const LAS bf16x8*)(L + ML_CT + (16 * et + l15) * ML_QSTR + 64 * ks + 16 * g4);
                    const bf16x8 bb = *(const LAS bf16x8*)(L + ML_QS + (16 * lt + l15) * ML_QSTR + 64 * ks + 16 * g4);
                    a2 = __builtin_amdgcn_mfma_f32_16x16x32_bf16(a, bb, a2, 0, 0, 0); }
                o1[ei] = a1; o2[ei] = a2; }
            __syncthreads();
            {
                const int l = 16 * lt + l15; const float bl = GB[l]; const float mrow = bl + fmaxf(GB[192 + l], m); const float sc = exp_f(bl + m - mrow);
                const float inv = 1.0f / FL[FDEN + l];
#pragma unroll
                for (int ei = 0; ei < 4; ++ei) { const int et = 4 * eh + ei; const f32x4 hv = (o1[ei] + o2[ei] * sc) * inv;
                    *(LAS f32x4*)(L + l * ML_HSTR + (16 * et + 4 * g4) * 4) = hv; }
            }
        }
        {
            bf16x8 af[2];
#pragma unroll
            for (int ks = 0; ks < 2; ++ks) af[ks] = *(const LAS bf16x8*)(L + ML_KWT + (16 * wave + l15) * ML_TSTR + 64 * ks + 16 * g4);
#pragma unroll
            for (int et = 0; et < 8; ++et) { f32x4 d = (f32x4){0.f, 0.f, 0.f, 0.f};
#pragma unroll
                for (int ks = 0; ks < 2; ++ks) { const bf16x8 bb = *(const LAS bf16x8*)(L + ML_VT + (16 * et + l15) * ML_TSTR + 64 * ks + 16 * g4);
                    d = __builtin_amdgcn_mfma_f32_16x16x32_bf16(af[ks], bb, d, 0, 0, 0); }
                C[et] = C[et] * so + d * sn; }
            if (tid < 128) { float dn = 0.f;
#pragma unroll
                for (int q = 0; q < 8; ++q) { const v4u w = *(const LAS v4u*)(L + ML_KWT + tid * ML_TSTR + 16 * q); float f[8]; unpack8(w, f); dn += ((f[0] + f[1]) + (f[2] + f[3])) + ((f[4] + f[5]) + (f[6] + f[7])); }
                FL[FN + tid] = so * FL[FN + tid] + sn * dn; }
            m = mn; Gsum += gtot;
            if (PASS == 2) {
#pragma unroll
                for (int et = 0; et < 8; ++et) { v2u w; w.x = pk2(C[et][0], C[et][1]); w.y = pk2(C[et][2], C[et][3]); *(LAS v2u*)(L + ML_CT + (16 * et + l15) * ML_QSTR + (16 * wave + 4 * g4) * 2) = w; }
            }
        }
        if (PASS == 2) {
            __syncthreads();
#pragma unroll
            for (int rr = 0; rr < 8; ++rr) { const int l = 8 * wave + rr;
                const f32x2v hv = *(const LAS f32x2v*)(L + l * ML_HSTR + lane * 8);
                const float ss = wave_sum(hv.x * hv.x + hv.y * hv.y);
                const float rstd = __builtin_amdgcn_rsqf(ss * (1.f / 128.f) + EPS);
                const unsigned mo = mo8[rr];
                const f32x2v gg = *(const f32x2v*)(F.mlstm_norm_g + h * 128 + 2 * lane);
                *(unsigned*)(F.MIX + (t0 + l) * DM + h * 128 + 2 * lane) = pk2(hv.x * rstd * gg.x * sigmoid_f(bflo(mo)), hv.y * rstd * gg.y * sigmoid_f(bfhi(mo))); }
        }
    }
    if (PASS == 1) {
        tid = F.tid; asm volatile("" : "+v"(tid)); lane = tid & 63; l15 = lane & 15; g4 = lane >> 4;
        float* E = F.SEG + (size_t)((b * 4 + h) * 8 + sg) * SEG_STRIDE;
#pragma unroll
        for (int et = 0; et < 8; ++et)
#pragma unroll
            for (int r = 0; r < 4; ++r) E[(16 * wave + 4 * g4 + r) * 128 + 16 * et + l15] = C[et][r];
        if (tid < 128) E[16384 + tid] = FL[FN + tid];
        if (tid == 0) { E[16384 + 128] = m; E[16384 + 129] = Gsum; }
    }
}
template <int PASS> __device__ __forceinline__ void mlstm_phase(Frame& F) {
    for (int it = F.vcu; it < NB * 4 * 8; it += F.G) { const int sg = it & 7, h = (it >> 3) & 3, b = it >> 5; if (PASS == 1 && sg == 7) continue; mlstm_item<PASS>(F, b, h, sg); }
}
struct Args { const float* in[15]; float* out; unsigned char* ws; int ph_lo, ph_hi, li, pad; };
__global__ void __launch_bounds__(NWAVES * 64, 2) mk_fwd(Args args) {
    extern __shared__ __attribute__((aligned(16))) unsigned char lds[];
    Frame F;
    F.lds = (LAS unsigned char*)lds;
    F.MISC = (volatile LAS unsigned*)(F.lds + MISC_OFF);
    F.tid = threadIdx.x; F.lane = F.tid & 63; F.wave = __builtin_amdgcn_readfirstlane(F.tid >> 6);
    F.G = gridDim.x; { const int bx = blockIdx.x; F.vcu = (F.G % 8 == 0) ? (bx % 8) * (F.G / 8) + bx / 8 : bx; }
    unsigned char* ws = args.ws;
    F.ctl = (gu32*)(ws + WS_CTL);
    F.x = args.in[0]; F.norm1_g = args.in[1]; F.w_in = args.in[2]; F.conv_w = args.in[3]; F.igate_b = args.in[4]; F.fgate_b = args.in[5]; F.mlstm_norm_g = args.in[6];
    F.q_norm_g = args.in[7]; F.k_norm_g = args.in[8]; F.sinks = args.in[9]; F.w_out = args.in[10]; F.norm2_g = args.in[11]; F.w_gate = args.in[12]; F.w_up = args.in[13]; F.w_down = args.in[14];
    F.out = args.out;
    F.Win_t = (bf16*)(ws + WS_WIN); F.Wout_t = (bf16*)(ws + WS_WOUT); F.Wgu_t = (bf16*)(ws + WS_WGU); F.Wdn_t = (bf16*)(ws + WS_WDN);
    F.XN = (bf16*)(ws + WS_XN); F.MIX = (bf16*)(ws + WS_MIX); F.PROJ = (bf16*)(ws + WS_PROJ);
    F.ROPE = (float2*)(ws + WS_ROPE); F.GATES = (float*)(ws + WS_GATES); F.SSQ = (float*)(ws + WS_SSQ); F.SEG = (float*)(ws + WS_SEG);
    for (int u = F.tid; u < (LDS_BYTES - LDSCTL_OFF) / 4; u += NWAVES * 64) ((LAS unsigned*)(F.lds + LDSCTL_OFF))[u] = 0u;
    __syncthreads();
    const int lo = args.ph_lo, hi = args.ph_hi;
    XcdBarrier bar; bar.bar = (unsigned*)(F.ctl + CW_BAR) + args.li * XCD_BAR_WORDS; bar.x = 0; bar.st = nullptr;
    if (hi - lo > 1) bar = xcd_barrier_post((unsigned*)(F.ctl + CW_BAR) + args.li * XCD_BAR_WORDS, F.MISC + 8);
#define IN(k) (lo <= (k) && (k) < hi)
#define BOTH(k) (IN(k) && IN((k) + 1))
#define GRID_BAR() xcd_barrier(bar)

#ifndef DOUBLE_PHASE
#define DOUBLE_PHASE -1
#endif
#define RUN_PHASE(k, BODY) if (IN(k)) { BODY; if (DOUBLE_PHASE == (k)) { GRID_BAR(); BODY; } if (BOTH(k)) GRID_BAR(); }
#define PH0 p0_prologue(F)
#define PH1 do { pg8::Gemm g{F.XN, F.Win_t, T, NPROJ, DM}; pg8::StaticOrder S; S.init(T, NPROJ, F.G, (int)blockIdx.x); pg8::EpiStoreBf16 E{F.PROJ, NPROJ}; \
        pg8::gemm_phase<pg8::EpiStoreBf16, pg8::StaticOrder, true, true>(F.lds, g, S, E); \
        { const int nwg_ = (T / 256) * (NPROJ / 256), rem_ = nwg_ % F.G;               \
          if (rem_ == 0) p1_side_work(F, (int)blockIdx.x, F.G); else if ((int)blockIdx.x >= rem_) p1_side_work(F, (int)blockIdx.x - rem_, F.G - rem_); } } while (0)
#define PH4 do { pg8::Gemm g{F.MIX, F.Wout_t, T, DM, DM}; pg8::StaticOrder S; S.init(T, DM, F.G, (int)blockIdx.x); pg8::EpiResidNorm E{F.x, F.out, F.XN, F.SSQ}; \
        pg8::gemm_phase<pg8::EpiResidNorm, pg8::StaticOrder, true, true>(F.lds, g, S, E); } while (0)
#define PH5 do { pg8::Gemm g{F.XN, F.Wgu_t, T, 2 * DFF, DM}; pg8::StaticOrder S; S.init(T, 2 * DFF, F.G, (int)blockIdx.x); pg8::EpiSwiGLU E{F.PROJ, DFF, F.SSQ, EPS}; \
        pg8::gemm_phase<pg8::EpiSwiGLU, pg8::StaticOrder, true, true>(F.lds, g, S, E); } while (0)
#define PH6 do { pg8::Gemm g{F.PROJ, F.Wdn_t, T, DM, DFF}; pg8::StaticOrder S; S.init(T, DM, F.G, (int)blockIdx.x); pg8::EpiResidOut E{F.out, F.out}; \
        pg8::gemm_phase<pg8::EpiResidOut, pg8::StaticOrder, true, true>(F.lds, g, S, E); } while (0)
    RUN_PHASE(0, PH0)
    RUN_PHASE(1, PH1)
    RUN_PHASE(2, PHASE2_BODY)
    RUN_PHASE(3, PHASE3_BODY)
    RUN_PHASE(4, PH4)
    RUN_PHASE(5, PH5)
    RUN_PHASE(6, PH6)
#undef IN
#undef BOTH
}
namespace nv {
__device__ __forceinline__ float sigmoidf_(float x) { return 1.f / (1.f + __expf(-x)); }
__device__ __forceinline__ float siluf_(float x) { return x / (1.f + __expf(-x)); }
__global__ __launch_bounds__(128) void k_mlstm_rec(const bf16* __restrict__ proj, const float* __restrict__ gates, const float* __restrict__ conv_w, const float* __restrict__ igb, const float* __restrict__ fgb,
                                                   float* __restrict__ hm) {
    __shared__ float red[2][12];
    const int d = threadIdx.x, lane = d & 63, w = d >> 6;
    const int es = blockIdx.x & 15, h = (blockIdx.x >> 4) & 3, b = blockIdx.x >> 6;
    const int e0 = es * 8;
    const int cq = h * 128 + d, ck = 512 + h * 128 + d;
    float wq[4], wk[4];
#pragma unroll
    for (int j = 0; j < 4; ++j) { wq[j] = conv_w[j * 1024 + cq]; wk[j] = conv_w[j * 1024 + ck]; }
    const float ib = igb[h], fb = fgb[h];
    float C[8] = {}, n = 0.f, m = -1e30f;
    float q1 = 0.f, q2 = 0.f, q3 = 0.f, k1 = 0.f, k2 = 0.f, k3 = 0.f;
    const float kscale = 0.08838834764831845f;
    for (int t = 0; t < SEQ; ++t) {
        const bf16* row = proj + (size_t)(b * SEQ + t) * NPROJ;
        const float* gr = gates + (size_t)(b * SEQ + t) * 8;
        const float q0 = bf2f(row[PC_MQ + h * 128 + d]), k0 = bf2f(row[PC_MK + h * 128 + d]);
        const float qt = siluf_(wq[0] * q3 + wq[1] * q2 + wq[2] * q1 + wq[3] * q0);
        const float kt = siluf_(wk[0] * k3 + wk[1] * k2 + wk[2] * k1 + wk[3] * k0) * kscale;
        q3 = q2; q2 = q1; q1 = q0; k3 = k2; k2 = k1; k1 = k0;
        const float ig = gr[h] + ib, fg = gr[4 + h] + fb;
        const float lf = fminf(fg, 0.f) - log1pf(__expf(-fabsf(fg)));
        const float mn = fmaxf(lf + m, ig);
        const float so = __expf(lf + m - mn), sn = __expf(ig - mn);
        m = mn;
        float part[9];
#pragma unroll
        for (int e = 0; e < 8; ++e) { const float v = bf2f(row[PC_MV + h * 128 + e0 + e]); C[e] = so * C[e] + sn * kt * v; part[e] = qt * C[e]; }
        n = so * n + sn * kt; part[8] = qt * n;
#pragma unroll
        for (int e = 0; e < 9; ++e) part[e] = wave_sum(part[e]);
        __syncthreads();
        if (lane == 0) {
#pragma unroll
            for (int e = 0; e < 9; ++e) red[w][e] = part[e];
        }
        __syncthreads();
        if (d < 8) {
            const float num = red[0][d] + red[1][d], den = red[0][8] + red[1][8];
            hm[(size_t)(b * SEQ + t) * 512 + h * 128 + e0 + d] = num / fmaxf(fabsf(den), __expf(-mn));
        }
    }
}
__global__ __launch_bounds__(256) void k_mlstm_post(const float* __restrict__ hm, const bf16* __restrict__ proj, const float* __restrict__ g, bf16* __restrict__ mix) {
    const int gw = blockIdx.x * 4 + (threadIdx.x >> 6), lane = threadIdx.x & 63;
    const int t = gw >> 2, h = gw & 3;
    const float a0 = hm[(size_t)t * 512 + h * 128 + lane], a1 = hm[(size_t)t * 512 + h * 128 + 64 + lane];
    const float ss = wave_sum(a0 * a0 + a1 * a1);
    const float r = rsqrtf(ss * (1.f / 128.f) + EPS);
    const float o0 = bf2f(proj[(size_t)t * NPROJ + PC_MO + h * 128 + lane]), o1 = bf2f(proj[(size_t)t * NPROJ + PC_MO + h * 128 + 64 + lane]);
    mix[(size_t)t * DM + h * 128 + lane] = (bf16)f2bf(a0 * r * g[h * 128 + lane] * sigmoidf_(o0));
    mix[(size_t)t * DM + h * 128 + 64 + lane] = (bf16)f2bf(a1 * r * g[h * 128 + 64 + lane] * sigmoidf_(o1));
}
__global__ __launch_bounds__(256) void k_qknorm_rope(const bf16* __restrict__ proj, const float* __restrict__ qg, const float* __restrict__ kg, const float2* __restrict__ cs, float* __restrict__ qk) {
    const int gw = blockIdx.x * 4 + (threadIdx.x >> 6), lane = threadIdx.x & 63;
    const int t = gw / 10, j = gw % 10;
    const int pos = t & (SEQ - 1);
    const bf16* p = proj + (size_t)t * NPROJ + (j < 8 ? PC_AQ + j * 64 : PC_AK + (j - 8) * 64);
    const float x = bf2f(p[lane]);
    const float ss = wave_sum(x * x);
    float y = x * rsqrtf(ss * (1.f / 64.f) + EPS) * (j < 8 ? qg[lane] : kg[lane]);
    const float yp = __shfl_xor(y, 8);
    if (lane < 16) {
        const float2 c = cs[pos * 8 + (lane & 7)];
        y = (lane < 8) ? (y * c.x - yp * c.y) : (y * c.x + yp * c.y);
    }
    qk[(size_t)t * 640 + j * 64 + lane] = y;
}
__global__ __launch_bounds__(256) void k_swa(const float* __restrict__ qk, const bf16* __restrict__ proj, const float* __restrict__ sinks, bf16* __restrict__ mix) {
    __shared__ float sq[4][64];
    const int wv = threadIdx.x >> 6, lane = threadIdx.x & 63;
    const int gw = blockIdx.x * 4 + wv;
    const int t = gw >> 3, hq = gw & 7, hk = hq >> 2;
    const int pos = t & (SEQ - 1);
    sq[wv][lane] = qk[(size_t)t * 640 + hq * 64 + lane];
    __syncthreads();
    float sc[2];
#pragma unroll
    for (int r = 0; r < 2; ++r) {
        const int rel = lane + 64 * r;
        float s = -INFINITY;
        if (rel <= pos) {
            const float* kp = qk + (size_t)(t - rel) * 640 + 512 + hk * 64;
            float a = 0.f;
            for (int dd = 0; dd < 64; ++dd) a += sq[wv][dd] * kp[dd];
            s = a * 0.125f;
        }
        sc[r] = s;
    }
    const float snk = sinks[hq];
    const float mx = fmaxf(wave_max(fmaxf(sc[0], sc[1])), snk);
    const float p0 = __expf(sc[0] - mx), p1 = __expf(sc[1] - mx);
    const float den = wave_sum(p0 + p1) + __expf(snk - mx);
    float o = 0.f;
    for (int rel = 0; rel < 128; ++rel) {
        const float p = __shfl((rel < 64) ? p0 : p1, rel & 63);
        if (rel <= pos) o += p * bf2f(proj[(size_t)(t - rel) * NPROJ + PC_AV + hk * 64 + lane]);
    }
    mix[(size_t)t * DM + 512 + hq * 64 + lane] = (bf16)f2bf(o / den);
}
}
extern "C" void kernel_launch(void* const* d_in, const int* in_sizes, int n_in, void* d_out, int out_size, void* d_ws, size_t ws_size, hipStream_t stream) {
    static int grid = 0;
    if (grid == 0) {
        if (n_in != 15 || in_sizes[0] != T * DM || out_size != T * DM || ws_size < WS_END) { fprintf(stderr, "kernel_launch: unexpected shapes / workspace (n_in %d, ws %zu)\n", n_in, ws_size); grid = -1; return; }
        int dev = 0, cus = 0, per_cu = 0;
        if (hipGetDevice(&dev) != hipSuccess || hipDeviceGetAttribute(&cus, hipDeviceAttributeMultiprocessorCount, dev) != hipSuccess) { grid = -1; return; }
        if (hipFuncSetAttribute((const void*)mk_fwd, hipFuncAttributeMaxDynamicSharedMemorySize, LDS_BYTES) != hipSuccess) { fprintf(stderr, "kernel_launch: hipFuncSetAttribute failed\n"); grid = -1; return; }
        if (hipOccupancyMaxActiveBlocksPerMultiprocessor(&per_cu, (const void*)mk_fwd, NWAVES * 64, LDS_BYTES) != hipSuccess || per_cu < 1) { fprintf(stderr, "kernel_launch: occupancy query says %d blocks per CU\n", per_cu); grid = -1; (void)hipGetLastError(); return; }
        grid = cus;
    }
    if (grid < 0) return;
    (void)hipMemsetAsync((char*)d_ws + WS_CTL, 0, CTL_ZERO_BYTES, stream);
    Args a{};
    for (int i = 0; i < 15; ++i) a.in[i] = (const float*)d_in[i];
    a.out = (float*)d_out; a.ws = (unsigned char*)d_ws;
    LAUNCH_PROGRAM
}
```

```cpp
#include <hip/hip_runtime.h>
#include <cstdio>
#include <cstdint>
namespace pg8 {
#define PG8_LAS __attribute__((address_space(3)))
typedef unsigned short bf16_t;
typedef short bf16x8 __attribute__((ext_vector_type(8)));
typedef float f32x4 __attribute__((ext_vector_type(4)));
typedef unsigned u32x4 __attribute__((ext_vector_type(4)));
constexpr int BM = 256, BK = 64, HALF = 128, HTB = HALF * BK * 2  , STAGE_BYTES = 8 * HTB, NXCD = 8, WGM = 8;

__host__ __device__ __forceinline__ int lds_byte(int r, int c) { const int st = (r >> 4) * 2 + (c >> 5), rr = r & 15, cc = c & 31, ob = rr * 64 + cc * 2; return st * 1024 + (ob ^ (((ob >> 9) & 1) << 5)); }
__host__ __device__ __forceinline__ void stage_rc(int b, int& R, int& C) { const int st = b / 1024, sb = b % 1024, swz = sb ^ (((sb >> 9) & 1) << 5); R = (st >> 1) * 16 + swz / 64; C = (st & 1) * 32 + (swz % 64) / 2; }
__host__ __device__ __forceinline__ int perm32(int rho) { const int n = rho >> 4, i = rho & 15; return 8 * (i >> 2) + 4 * n + (i & 3); }

struct Unit { int pm, pn; };
struct Gemm { const bf16_t* A; const bf16_t* Bt; int M, N, K; };

struct StaticOrder {
    int nM, nN, nwg, G, c;
    __host__ __device__ void init(int M, int N, int G_, int c_) { nM = M / BM; nN = N / BM; nwg = nM * nN; G = G_; c = c_; }
    __host__ __device__ bool next(int i, Unit& u) const {
        const long L = (long)i * G + c; if (L >= nwg) return false;
        int wgid = (int)L; { const int q = nwg / NXCD, r = nwg % NXCD, xcd = wgid % NXCD, off = wgid / NXCD; wgid = (xcd < r ? xcd * (q + 1) : r * (q + 1) + (xcd - r) * q) + off; }
        const int nig = WGM * nN, gid = wgid / nig, fm = gid * WGM, gsz = (nM - fm) < WGM ? (nM - fm) : WGM;
        u.pm = fm + ((wgid % nig) % gsz); u.pn = (wgid % nig) / gsz; return true;
    }
    __device__ __forceinline__ void a_ready(const Unit&) const {}
    __device__ __forceinline__ void done(const Unit&) const {}
};

__device__ __forceinline__ unsigned cvt_pk_bf16(float lo, float hi) { unsigned r; asm volatile("v_cvt_pk_bf16_f32 %0, %1, %2" : "=v"(r) : "v"(lo), "v"(hi)); return r; }
typedef float f32x2 __attribute__((ext_vector_type(2)));
__device__ __forceinline__ float fast_silu(float v) { return v * __builtin_amdgcn_rcpf(1.0f + __builtin_amdgcn_exp2f(v * -1.4426950408889634f)); }
struct EpiStoreBf16 {
    static constexpr bool PERM = true, AFTER_DRAIN = false;
    bf16_t* O; int ldc;
    __device__ __forceinline__ void operator()(const f32x4 (&acc)[2][2][4][2], const Unit& u, int wr, int wc, int fr, int fq) const {
        const int row0 = u.pm * BM + wr * 64 + fr, col0 = u.pn * BM + wc * 32 + 8 * fq;
#pragma unroll
        for (int ai = 0; ai < 2; ++ai)
#pragma unroll
            for (int m = 0; m < 4; ++m) { bf16_t* rowp = O + (size_t)(row0 + ai * HALF + m * 16) * ldc + col0;
#pragma unroll
                for (int bj = 0; bj < 2; ++bj) { const f32x4 v0 = acc[ai][bj][m][0], v1 = acc[ai][bj][m][1];
                    u32x4 w; w.x = cvt_pk_bf16(v0[0], v0[1]); w.y = cvt_pk_bf16(v0[2], v0[3]); w.z = cvt_pk_bf16(v1[0], v1[1]); w.w = cvt_pk_bf16(v1[2], v1[3]);
                    *(u32x4*)(rowp + bj * HALF) = w; } }
    }
};
struct EpiResidNorm {
    static constexpr bool PERM = true, AFTER_DRAIN = false;
    const float* X; float* H; bf16_t* HB; float* SSQ;
    __device__ __forceinline__ void operator()(const f32x4 (&acc)[2][2][4][2], const Unit& u, int wr, int wc, int fr, int fq) const {
        const int row0 = u.pm * BM + wr * 64 + fr, col0 = u.pn * BM + wc * 32 + 8 * fq;
#pragma unroll
        for (int ai = 0; ai < 2; ++ai)
#pragma unroll
            for (int m = 0; m < 4; ++m) { const int row = row0 + ai * HALF + m * 16; const size_t off = (size_t)row * 1024 + col0; float ss = 0.f;
#pragma unroll
                for (int bj = 0; bj < 2; ++bj) { const f32x4 x0 = *(const f32x4*)(X + off + bj * HALF), x1 = *(const f32x4*)(X + off + bj * HALF + 4);
                    const f32x4 v0 = x0 + acc[ai][bj][m][0], v1 = x1 + acc[ai][bj][m][1];
                    *(f32x4*)(H + off + bj * HALF) = v0; *(f32x4*)(H + off + bj * HALF + 4) = v1;
                    u32x4 w; w.x = cvt_pk_bf16(v0[0], v0[1]); w.y = cvt_pk_bf16(v0[2], v0[3]); w.z = cvt_pk_bf16(v1[0], v1[1]); w.w = cvt_pk_bf16(v1[2], v1[3]);
                    *(u32x4*)(HB + off + bj * HALF) = w;
                    ss += (v0[0] * v0[0] + v0[1] * v0[1]) + (v0[2] * v0[2] + v0[3] * v0[3]) + (v1[0] * v1[0] + v1[1] * v1[1]) + (v1[2] * v1[2] + v1[3] * v1[3]); }
                ss += __shfl_xor(ss, 16); ss += __shfl_xor(ss, 32);
                if (fq == 0) SSQ[(size_t)row * 16 + u.pn * 4 + wc] = ss; }
    }
};
struct EpiSwiGLU {
    static constexpr bool PERM = true, AFTER_DRAIN = false;
    bf16_t* O; int ldc; const float* SSQ; float eps;
    __device__ __forceinline__ void operator()(const f32x4 (&acc)[2][2][4][2], const Unit& u, int wr, int wc, int fr, int fq) const {
        const int row0 = u.pm * BM + wr * 64 + fr, col0 = u.pn * HALF + wc * 32 + 8 * fq;
#pragma unroll
        for (int ai = 0; ai < 2; ++ai)
#pragma unroll
            for (int m = 0; m < 4; ++m) { const int row = row0 + ai * HALF + m * 16;
                const f32x4* sp = (const f32x4*)(SSQ + (size_t)row * 16); const f32x4 s0 = sp[0], s1 = sp[1], s2 = sp[2], s3 = sp[3];
                const float ssum = ((s0[0] + s0[1]) + (s0[2] + s0[3])) + ((s1[0] + s1[1]) + (s1[2] + s1[3])) + ((s2[0] + s2[1]) + (s2[2] + s2[3])) + ((s3[0] + s3[1]) + (s3[2] + s3[3]));
                const float rs = __builtin_amdgcn_rsqf(ssum * (1.0f / 1024.0f) + eps);
                float h[8];
#pragma unroll
                for (int n = 0; n < 2; ++n)
#pragma unroll
                    for (int j = 0; j < 4; ++j) { const float g = acc[ai][0][m][n][j] * rs, up = acc[ai][1][m][n][j] * rs; h[n * 4 + j] = fast_silu(g) * up; }
                u32x4 w; w.x = cvt_pk_bf16(h[0], h[1]); w.y = cvt_pk_bf16(h[2], h[3]); w.z = cvt_pk_bf16(h[4], h[5]); w.w = cvt_pk_bf16(h[6], h[7]);
                *(u32x4*)(O + (size_t)row * ldc + col0) = w; }
    }
};
struct EpiResidOut {
    static constexpr bool PERM = true, AFTER_DRAIN = false;
    const float* R; float* OUT;
    __device__ __forceinline__ void operator()(const f32x4 (&acc)[2][2][4][2], const Unit& u, int wr, int wc, int fr, int fq) const {
        const int row0 = u.pm * BM + wr * 64 + fr, col0 = u.pn * BM + wc * 32 + 8 * fq;
#pragma unroll
        for (int ai = 0; ai < 2; ++ai)
#pragma unroll
            for (int m = 0; m < 4; ++m) { const size_t off = (size_t)(row0 + ai * HALF + m * 16) * 1024 + col0;
#pragma unroll
                for (int bj = 0; bj < 2; ++bj) { const f32x4 r0 = *(const f32x4*)(R + off + bj * HALF), r1 = *(const f32x4*)(R + off + bj * HALF + 4);
                    *(f32x4*)(OUT + off + bj * HALF) = r0 + acc[ai][bj][m][0]; *(f32x4*)(OUT + off + bj * HALF + 4) = r1 + acc[ai][bj][m][1]; } }
    }
};
struct EpiResidNormB {
    static constexpr bool PERM = true, AFTER_DRAIN = false;
    const float* X; bf16_t* HB; float* SSQ;
    __device__ __forceinline__ void operator()(const f32x4 (&acc)[2][2][4][2], const Unit& u, int wr, int wc, int fr, int fq) const {
        const int row0 = u.pm * BM + wr * 64 + fr, col0 = u.pn * BM + wc * 32 + 8 * fq;
#pragma unroll
        for (int ai = 0; ai < 2; ++ai)
#pragma unroll
            for (int m = 0; m < 4; ++m) { const int row = row0 + ai * HALF + m * 16; const size_t off = (size_t)row * 1024 + col0; float ss = 0.f;
#pragma unroll
                for (int bj = 0; bj < 2; ++bj) { const f32x4 x0 = *(const f32x4*)(X + off + bj * HALF), x1 = *(const f32x4*)(X + off + bj * HALF + 4);
                    const f32x4 v0 = x0 + acc[ai][bj][m][0], v1 = x1 + acc[ai][bj][m][1];
                    u32x4 w; w.x = cvt_pk_bf16(v0[0], v0[1]); w.y = cvt_pk_bf16(v0[2], v0[3]); w.z = cvt_pk_bf16(v1[0], v1[1]); w.w = cvt_pk_bf16(v1[2], v1[3]);
                    *(u32x4*)(HB + off + bj * HALF) = w;
                    ss += (v0[0] * v0[0] + v0[1] * v0[1]) + (v0[2] * v0[2] + v0[3] * v0[3]) + (v1[0] * v1[0] + v1[1] * v1[1]) + (v1[2] * v1[2] + v1[3] * v1[3]); }
                ss += __shfl_xor(ss, 16); ss += __shfl_xor(ss, 32);
                if (fq == 0) SSQ[(size_t)row * 16 + u.pn * 4 + wc] = ss; }
    }
};
struct EpiResidOutB {
    static constexpr bool PERM = true, AFTER_DRAIN = false;
    const bf16_t* RB; float* OUT;
    __device__ __forceinline__ void operator()(const f32x4 (&acc)[2][2][4][2], const Unit& u, int wr, int wc, int fr, int fq) const {
        const int row0 = u.pm * BM + wr * 64 + fr, col0 = u.pn * BM + wc * 32 + 8 * fq;
#pragma unroll
        for (int ai = 0; ai < 2; ++ai)
#pragma unroll
            for (int m = 0; m < 4; ++m) { const size_t off = (size_t)(row0 + ai * HALF + m * 16) * 1024 + col0;
#pragma unroll
                for (int bj = 0; bj < 2; ++bj) { const u32x4 w = *(const u32x4*)(RB + off + bj * HALF);
                    const f32x4 r0 = (f32x4){__builtin_bit_cast(float, w.x << 16), __builtin_bit_cast(float, w.x & 0xffff0000u), __builtin_bit_cast(float, w.y << 16), __builtin_bit_cast(float, w.y & 0xffff0000u)};
                    const f32x4 r1 = (f32x4){__builtin_bit_cast(float, w.z << 16), __builtin_bit_cast(float, w.z & 0xffff0000u), __builtin_bit_cast(float, w.w << 16), __builtin_bit_cast(float, w.w & 0xffff0000u)};
                    *(f32x4*)(OUT + off + bj * HALF) = r0 + acc[ai][bj][m][0]; *(f32x4*)(OUT + off + bj * HALF + 4) = r1 + acc[ai][bj][m][1]; } }
    }
};
template <class Epi, class Sched, bool ALIGN_EPI = false, bool SP2 = false>
__device__ __forceinline__ void gemm_phase(PG8_LAS unsigned char* lds, const Gemm g, const Sched& S, const Epi& E) {
    const int tid = threadIdx.x, wid = __builtin_amdgcn_readfirstlane(tid >> 6), lane = tid & 63, wr = wid >> 2, wc = wid & 3, fr = lane & 15, fq = lane >> 4;
    const int K = g.K, nt = K / BK;
    unsigned voffA[2], voffB[2];
#pragma unroll
    for (int i = 0; i < 2; ++i) { int R, C; stage_rc(tid * 16 + i * 8192, R, C); const int Rb = Epi::PERM ? ((R & ~31) + perm32(R & 31)) : R;
        voffA[i] = (unsigned)(R * K + C) * 2u; voffB[i] = (unsigned)(Rb * K + C) * 2u; }
    const size_t kstep = (size_t)(BK * 2);
    const size_t hstep = (size_t)HALF * K * 2;
    const size_t tstep = 2 * hstep;
    const unsigned ldsw = (unsigned)wid * 1024u;
    const int aoff = lds_byte(wr * 64 + fr, fq * 8), boff = lds_byte(wc * 32 + fr, fq * 8);
#define PG8_SA(b, h) (((b) * 2 + (h)) * HTB)
#define PG8_SB(b, h) ((4 + (b) * 2 + (h)) * HTB)
#define PG8_STAGE(bufoff, gbase, voff) do { _Pragma("unroll") for (int _i = 0; _i < 2; ++_i) \
        __builtin_amdgcn_global_load_lds((const unsigned*)((const char*)(gbase) + (voff)[_i]), (PG8_LAS unsigned*)(lds + (bufoff) + ldsw + _i * 8192), 16, 0, 0); } while (0)
#define PG8_LDA(dst, b, h) do { _Pragma("unroll") for (int m = 0; m < 4; ++m) _Pragma("unroll") for (int k = 0; k < 2; ++k) dst[m][k] = *(const PG8_LAS bf16x8*)(lds + PG8_SA(b, h) + aoff + m * 2048 + k * 1024); } while (0)
#define PG8_LDB(dst, b, h) do { _Pragma("unroll") for (int n = 0; n < 2; ++n) _Pragma("unroll") for (int k = 0; k < 2; ++k) dst[n][k] = *(const PG8_LAS bf16x8*)(lds + PG8_SB(b, h) + boff + n * 2048 + k * 1024); } while (0)
#define PG8_MMA(ai, bj, At, Bt) do { __builtin_amdgcn_s_setprio(1); _Pragma("unroll") for (int m = 0; m < 4; ++m) _Pragma("unroll") for (int n = 0; n < 2; ++n) _Pragma("unroll") for (int k = 0; k < 2; ++k) \
        acc[ai][bj][m][n] = __builtin_amdgcn_mfma_f32_16x16x32_bf16(Bt[n][k], At[m][k], acc[ai][bj][m][n], 0, 0, 0); __builtin_amdgcn_s_setprio(0); } while (0)
#define PG8_WAIT_V(n) asm volatile("s_waitcnt vmcnt(" #n ")" ::: "memory")
#define PG8_WAIT_L(n) asm volatile("s_waitcnt lgkmcnt(" #n ")" ::: "memory")
#define PG8_BAR __builtin_amdgcn_s_barrier()
#define PG8_SCHED __builtin_amdgcn_sched_barrier(0)
    Unit cur, nxt; int ui = 0;
    if (!S.next(0, cur)) return;
    f32x4 acc[2][2][4][2];
#pragma unroll
    for (int a = 0; a < 2; ++a)
#pragma unroll
        for (int b = 0; b < 2; ++b)
#pragma unroll
            for (int m = 0; m < 4; ++m)
#pragma unroll
                for (int n = 0; n < 2; ++n) acc[a][b][m][n] = (f32x4){0.f, 0.f, 0.f, 0.f};
    bf16x8 At[4][2], B0[2][2], B1[2][2];
    const char* cA = (const char*)g.A + (size_t)cur.pm * tstep; const char* cB = (const char*)g.Bt + (size_t)cur.pn * tstep;
    S.a_ready(cur);
    if constexpr (SP2) {
        PG8_STAGE(PG8_SB(0, 0), cB, voffB); PG8_STAGE(PG8_SB(0, 1), cB + hstep, voffB); PG8_STAGE(PG8_SA(0, 0), cA, voffA); PG8_STAGE(PG8_SA(0, 1), cA + hstep, voffA);
        if (wr == 1) PG8_BAR;
        PG8_WAIT_V(2); PG8_BAR;
        PG8_STAGE(PG8_SB(1, 0), cB + kstep, voffB); PG8_STAGE(PG8_SA(1, 0), cA + kstep, voffA); PG8_STAGE(PG8_SB(1, 1), cB + hstep + kstep, voffB);
        PG8_WAIT_V(6); PG8_BAR;
    } else {
        PG8_STAGE(PG8_SB(0, 0), cB, voffB); PG8_STAGE(PG8_SA(0, 0), cA, voffA); PG8_STAGE(PG8_SB(0, 1), cB + hstep, voffB); PG8_STAGE(PG8_SA(0, 1), cA + hstep, voffA);
        if (wr == 1) PG8_BAR;
        PG8_WAIT_V(4); PG8_BAR;
        PG8_STAGE(PG8_SB(1, 0), cB + kstep, voffB); PG8_STAGE(PG8_SA(1, 0), cA + kstep, voffA); PG8_STAGE(PG8_SB(1, 1), cB + hstep + kstep, voffB);
        PG8_WAIT_V(6); PG8_BAR;
    }
    for (;;) {
        const bool has_next = S.next(ui + 1, nxt);
        const char* nA = has_next ? (const char*)g.A + (size_t)nxt.pm * tstep : cA; const char* nB = has_next ? (const char*)g.Bt + (size_t)nxt.pn * tstep : cB;
        for (int t = 0; t < nt; t += 2) {
            const bool last = (t == nt - 2);
            const char* a1 = cA + (size_t)(t + 1) * kstep;
            const char* a2 = last ? nA : cA + (size_t)(t + 2) * kstep; const char* b2 = last ? nB : cB + (size_t)(t + 2) * kstep;
            const char* a3 = a2 + kstep; const char* b3 = b2 + kstep;
            if (last && has_next) S.a_ready(nxt);
            if constexpr (SP2) {
            PG8_LDB(B0, 0, 0); PG8_LDB(B1, 0, 1); PG8_SCHED; PG8_LDA(At, 0, 0); PG8_STAGE(PG8_SA(1, 1), a1 + hstep, voffA);
            PG8_WAIT_V(8); PG8_WAIT_L(0); PG8_BAR; PG8_MMA(0, 0, At, B0); PG8_MMA(0, 1, At, B1); PG8_BAR; PG8_SCHED;
            PG8_LDA(At, 0, 1); PG8_STAGE(PG8_SB(0, 0), b2, voffB); PG8_STAGE(PG8_SB(0, 1), b2 + hstep, voffB); PG8_STAGE(PG8_SA(0, 0), a2, voffA);
            PG8_WAIT_V(8); PG8_WAIT_L(0); PG8_BAR; PG8_MMA(1, 0, At, B0); PG8_MMA(1, 1, At, B1); PG8_BAR; PG8_SCHED;
            PG8_LDB(B0, 1, 0); PG8_LDB(B1, 1, 1); PG8_SCHED; PG8_LDA(At, 1, 0); PG8_STAGE(PG8_SA(0, 1), a2 + hstep, voffA);
            PG8_WAIT_V(8); PG8_WAIT_L(0); PG8_BAR; PG8_MMA(0, 0, At, B0); PG8_MMA(0, 1, At, B1); PG8_BAR; PG8_SCHED;
            PG8_LDA(At, 1, 1); PG8_STAGE(PG8_SB(1, 0), b3, voffB); PG8_STAGE(PG8_SB(1, 1), b3 + hstep, voffB); PG8_STAGE(PG8_SA(1, 0), a3, voffA);
            PG8_WAIT_V(8); PG8_WAIT_L(0); PG8_BAR; PG8_MMA(1, 0, At, B0); PG8_MMA(1, 1, At, B1); PG8_BAR; PG8_SCHED;
            } else {
            PG8_LDB(B0, 0, 0); PG8_SCHED; PG8_LDA(At, 0, 0); PG8_STAGE(PG8_SA(1, 1), a1 + hstep, voffA);
            PG8_WAIT_L(8); PG8_BAR; PG8_WAIT_L(0); PG8_MMA(0, 0, At, B0); PG8_BAR; PG8_SCHED;
            PG8_LDB(B1, 0, 1); PG8_STAGE(PG8_SB(0, 0), b2, voffB);
            PG8_BAR; PG8_WAIT_L(0); PG8_MMA(0, 1, At, B1); PG8_BAR;
            PG8_LDA(At, 0, 1); PG8_STAGE(PG8_SA(0, 0), a2, voffA);
            PG8_BAR; PG8_WAIT_L(0); PG8_MMA(1, 0, At, B0); PG8_BAR; PG8_SCHED;
            PG8_STAGE(PG8_SB(0, 1), b2 + hstep, voffB);
            PG8_WAIT_V(6); PG8_BAR; PG8_MMA(1, 1, At, B1); PG8_BAR;
            PG8_LDB(B0, 1, 0); PG8_SCHED; PG8_LDA(At, 1, 0); PG8_STAGE(PG8_SA(0, 1), a2 + hstep, voffA);
            PG8_WAIT_L(8); PG8_BAR; PG8_WAIT_L(0); PG8_MMA(0, 0, At, B0); PG8_BAR; PG8_SCHED;
            PG8_LDB(B1, 1, 1); PG8_STAGE(PG8_SB(1, 0), b3, voffB);
            PG8_BAR; PG8_WAIT_L(0); PG8_MMA(0, 1, At, B1); PG8_BAR;
            PG8_LDA(At, 1, 1); PG8_STAGE(PG8_SA(1, 0), a3, voffA);
            PG8_BAR; PG8_WAIT_L(0); PG8_MMA(1, 0, At, B0); PG8_BAR; PG8_SCHED;
            PG8_STAGE(PG8_SB(1, 1), b3 + hstep, voffB);
            PG8_WAIT_V(6); PG8_BAR; PG8_MMA(1, 1, At, B1); PG8_BAR;
            }
        }
        if constexpr (ALIGN_EPI) { if (wr == 0) PG8_BAR; }
        if constexpr (!Epi::AFTER_DRAIN) { E(acc, cur, wr, wc, fr, fq); S.done(cur); }
        if (!has_next) break;
#pragma unroll
        for (int a = 0; a < 2; ++a)
#pragma unroll
            for (int b = 0; b < 2; ++b)
#pragma unroll
                for (int m = 0; m < 4; ++m)
#pragma unroll
                    for (int n = 0; n < 2; ++n) acc[a][b][m][n] = (f32x4){0.f, 0.f, 0.f, 0.f};
        cur = nxt; cA = nA; cB = nB; ++ui;
        if constexpr (ALIGN_EPI) { if (wr == 1) PG8_BAR; }
    }
    PG8_WAIT_V(0);
    if constexpr (!ALIGN_EPI) { if (wr == 0) PG8_BAR; }
    PG8_BAR;
    if constexpr (Epi::AFTER_DRAIN) { E.fused(acc, cur, wr, wc, fr, fq, lds, wid, lane); S.done(cur); }
#undef PG8_SA
#undef PG8_SB
#undef PG8_STAGE
#undef PG8_LDA
#undef PG8_LDB
#undef PG8_MMA
#undef PG8_WAIT_V
#undef PG8_WAIT_L
#undef PG8_BAR
#undef PG8_SCHED
}
}
constexpr int NWAVES = 8;
constexpr int NB = 8, SEQ = 4096, T = NB * SEQ, DM = 1024, DIN = 2824, DFF = 2816, NPROJ = 2816;
constexpr int SRC_MI = 2048;
constexpr int PC_MQ = 0, PC_MK = 512, PC_MV = 1024, PC_MO = 1536, PC_AQ = 2048, PC_AK = 2560, PC_AV = 2688;
constexpr float EPS = 1e-6f;
constexpr size_t MiB = 1u << 20;
constexpr size_t WS_CTL = 0, CTL_ZERO_BYTES = 1 * MiB;
constexpr size_t WS_WIN = 1 * MiB;
constexpr size_t WS_WOUT = 7 * MiB;
constexpr size_t WS_WGU = 9 * MiB;
constexpr size_t WS_WDN = 20 * MiB;
constexpr size_t WS_ROPE = 26 * MiB;
constexpr size_t WS_WBG = 26 * MiB + 512 * 1024;
constexpr size_t WS_GATES = 27 * MiB;
constexpr size_t WS_SSQ = 28 * MiB;
constexpr size_t WS_SEG = 30 * MiB;
constexpr size_t WS_XN = 48 * MiB;
constexpr size_t WS_MIX = 112 * MiB;
constexpr size_t WS_PROJ = 176 * MiB;
constexpr size_t WS_END = 352 * MiB;
constexpr int CW_BAR = 4096;
constexpr int RING_BYTES = 131072;
constexpr int LDSCTL_OFF = RING_BYTES, MISC_OFF = LDSCTL_OFF + 320;
constexpr int LDS_BYTES = 147456;

#define GAS __attribute__((address_space(1)))
#define LAS __attribute__((address_space(3)))
typedef unsigned short bf16;
typedef unsigned v4u __attribute__((ext_vector_type(4)));
typedef unsigned v2u __attribute__((ext_vector_type(2)));
typedef float f32x2v __attribute__((ext_vector_type(2)));
typedef float f32x4 __attribute__((ext_vector_type(4)));
typedef short bf16x8 __attribute__((ext_vector_type(8)));
typedef GAS unsigned gu32;
#define RLX_AGENT __ATOMIC_RELAXED, __HIP_MEMORY_SCOPE_AGENT
#define LDS_WAIT() asm volatile("s_waitcnt lgkmcnt(0)" ::: "memory")
#define VM_WAIT() asm volatile("s_waitcnt vmcnt(0)" ::: "memory")
__device__ __forceinline__ unsigned f2bf(float f) { unsigned u = __builtin_bit_cast(unsigned, f); return (u + 0x7fffu + ((u >> 16) & 1u)) >> 16; }
__device__ __forceinline__ unsigned pk2(float lo, float hi) { return f2bf(lo) | (f2bf(hi) << 16); }
__device__ __forceinline__ float bf2f(unsigned short b) { return __builtin_bit_cast(float, (unsigned)b << 16); }
__device__ __forceinline__ float bflo(unsigned w) { return __builtin_bit_cast(float, w << 16); }
__device__ __forceinline__ float bfhi(unsigned w) { return __builtin_bit_cast(float, w & 0xffff0000u); }
__device__ __forceinline__ float wave_sum(float v) {
#pragma unroll
    for (int o = 1; o < 64; o <<= 1) v += __shfl_xor(v, o);
    return v;
}
__device__ __forceinline__ float wave_max(float v) {
#pragma unroll
    for (int o = 1; o < 64; o <<= 1) v = fmaxf(v, __shfl_xor(v, o));
    return v;
}
__device__ __forceinline__ void unpack8(const v4u w, float* o) { o[0] = bflo(w.x); o[1] = bfhi(w.x); o[2] = bflo(w.y); o[3] = bfhi(w.y); o[4] = bflo(w.z); o[5] = bfhi(w.z); o[6] = bflo(w.w); o[7] = bfhi(w.w); }
#define XB_TMO      128
#define XB_XCNT(j)  (256  + 64 * (j))
#define XB_XSUB(j)  (1280 + 64 * (j))
#define XB_XGEN(j)  (2304 + 64 * (j))
#define XB_TOP      3328
#define XB_TOPGEN   3392
#define XCD_BAR_WORDS 3456
#define XB_SPIN_CAP (1u << 18)

__device__ __forceinline__ unsigned xb_ld(unsigned* p)              { return __hip_atomic_load(p, __ATOMIC_RELAXED, __HIP_MEMORY_SCOPE_AGENT); }
__device__ __forceinline__ unsigned xb_add(unsigned* p, unsigned v) { return __hip_atomic_fetch_add(p, v, __ATOMIC_RELAXED, __HIP_MEMORY_SCOPE_AGENT); }
__device__ __forceinline__ unsigned xb_xcc_id() { return (unsigned)__builtin_amdgcn_s_getreg((3 << 11) | 20) & 0xFu; }
#define XB_SPIN(cond, bar) do { unsigned _sp = 0; while (cond) { __builtin_amdgcn_s_sleep(1); \
    if ((++_sp & 255u) == 0u) { if (xb_ld(&(bar)[XB_TMO])) break; if (_sp > XB_SPIN_CAP) { atomicAdd(&(bar)[XB_TMO], 1u); break; } } } } while (0)

struct XcdBarrier {
    unsigned* bar; unsigned x;
    volatile LAS unsigned* st;
};

__device__ __forceinline__ XcdBarrier xcd_barrier_post(unsigned* bar, volatile LAS unsigned* st) {
    XcdBarrier b; b.bar = bar; b.x = xb_xcc_id(); b.st = st;
    if (threadIdx.x == 0) (void)xb_add(&bar[XB_XCNT(b.x)], 1u);
    return b;
}
__device__ __forceinline__ void xcd_barrier_complete(unsigned* bar, unsigned x, unsigned& nloc, unsigned& nx) {
    const unsigned G = gridDim.x * gridDim.y * gridDim.z;
    unsigned sum, cnt, mine, sp = 0u;
    for (;;) {
        sum = 0u; cnt = 0u; mine = 0u;
#pragma unroll
        for (unsigned j = 0; j < 16; ++j) { const unsigned c = xb_ld(&bar[XB_XCNT(j)]); sum += c; cnt += (c > 0u) ? 1u : 0u; mine = (j == x) ? c : mine; }
        if (sum == G) break;
        __builtin_amdgcn_s_sleep(1);
        if ((++sp & 255u) == 0u) { if (xb_ld(&bar[XB_TMO])) break; if (sp > XB_SPIN_CAP) { atomicAdd(&bar[XB_TMO], 1u); break; } }
    }
    nloc = mine > 0u ? mine : 1u; nx = cnt > 0u ? cnt : 1u;
}

__device__ __forceinline__ void xcd_barrier(const XcdBarrier& b) {
    asm volatile("s_waitcnt vmcnt(0)" ::: "memory");
    __syncthreads();
    if (threadIdx.x == 0) {
        unsigned* bar = b.bar;
        __builtin_amdgcn_s_waitcnt(0);
        unsigned nloc = b.st[0], nx = b.st[1];
        if (nloc == 0u) { xcd_barrier_complete(bar, b.x, nloc, nx); b.st[0] = nloc; b.st[1] = nx; }
        const unsigned old = xb_add(&bar[XB_XSUB(b.x)], 1u);
        const unsigned gen = old / nloc;
        if (old + 1u == (gen + 1u) * nloc) {
            __builtin_amdgcn_fence(__ATOMIC_RELEASE, "agent");
            asm volatile("s_waitcnt vmcnt(0)" ::: "memory");
            const unsigned og = xb_add(&bar[XB_TOP], 1u);
            const unsigned tg = og / nx;
            if (og + 1u == (tg + 1u) * nx) xb_add(&bar[XB_TOPGEN], 1u);
            else XB_SPIN(xb_ld(&bar[XB_TOPGEN]) == tg, bar);
            __builtin_amdgcn_fence(__ATOMIC_ACQUIRE, "agent");
            xb_add(&bar[XB_XGEN(b.x)], 1u);
            asm volatile("s_waitcnt vmcnt(0)" ::: "memory");
        } else {
            XB_SPIN(xb_ld(&bar[XB_XGEN(b.x)]) == gen, bar);
            __builtin_amdgcn_fence(__ATOMIC_ACQUIRE, "agent");
            asm volatile("s_waitcnt vmcnt(0)" ::: "memory");
        }
    }
    __syncthreads();
}
#define H1_BF16 1
#define PHASE2_BODY do { mlstm_phase<1>(F); swa_phase(F); } while (0)
#define PHASE3_BODY mlstm_phase<2>(F)
#define LAUNCH_MK(lo_, hi_) do { a.ph_lo = (lo_); a.ph_hi = (hi_); a.li = (lo_); hipLaunchKernelGGL(mk_fwd, dim3(grid), dim3(NWAVES * 64), LDS_BYTES, stream, a); } while (0)
#define LAUNCH_PROGRAM { LAUNCH_MK(0, 7); }
struct Frame {
    LAS unsigned char* lds;
    volatile LAS unsigned* MISC;
    gu32* ctl;
    int tid, lane, wave, vcu, G;
    const float *x, *norm1_g, *w_in, *conv_w, *igate_b, *fgate_b, *mlstm_norm_g, *q_norm_g, *k_norm_g, *sinks, *w_out, *norm2_g, *w_gate, *w_up, *w_down;
    float* out;
    bf16 *Win_t, *Wout_t, *Wgu_t, *Wdn_t, *XN, *MIX, *PROJ;
    float2* ROPE; float* GATES; float* SSQ; float* SEG; unsigned char* WBG;
};

struct P0Item { const float* W; int ldw, src_col0; const float* kscale; bf16* WT; int Kd, dst_row0, kb; };
template <bool SCALE> __device__ __forceinline__ void p0_item_load(const P0Item& I, float (&v)[32], int lane) {
    const int k0 = 64 * I.kb;
#pragma unroll
    for (int i = 0; i < 32; ++i) { const int kk = 2 * i + (lane >> 5); v[i] = I.W[(size_t)(k0 + kk) * I.ldw + I.src_col0 + (lane & 31)]; }
    if (SCALE) {
        float sc[32];
#pragma unroll
        for (int i = 0; i < 32; ++i) sc[i] = I.kscale[k0 + 2 * i + (lane >> 5)];
#pragma unroll
        for (int i = 0; i < 32; ++i) v[i] *= sc[i];
    }
}
__device__ __forceinline__ void p0_item_finish(const P0Item& I, const float (&v)[32], LAS float* scr, int lane) {
    const int k0 = 64 * I.kb;
#pragma unroll
    for (int i = 0; i < 32; ++i) { const int kk = 2 * i + (lane >> 5); scr[kk * 33 + (lane & 31)] = v[i]; }
    LDS_WAIT(); asm volatile("" ::: "memory");
    const int c = lane & 7;
#pragma unroll
    for (int j = 0; j < 4; ++j) { const int n = (lane >> 3) + 8 * j; const LAS float* s = scr + (8 * c) * 33 + n;
        v4u o; o.x = pk2(s[0 * 33], s[1 * 33]); o.y = pk2(s[2 * 33], s[3 * 33]); o.z = pk2(s[4 * 33], s[5 * 33]); o.w = pk2(s[6 * 33], s[7 * 33]);
        *(GAS v4u*)(I.WT + (size_t)(I.dst_row0 + n) * I.Kd + k0 + 8 * c) = o; }
    LDS_WAIT(); asm volatile("" ::: "memory");
}
constexpr int I_IN = 88 * 16, I_OUT = 32 * 16, I_GU = 176 * 16, I_DN = 32 * 44;
__device__ __forceinline__ P0Item p0_item_in(Frame& F, int r) { const int nb = r % 88, kb = r / 88; return P0Item{F.w_in, DIN, nb < 64 ? 32 * nb : 32 * nb + 8, nullptr, F.Win_t, DM, 32 * nb, kb}; }
__device__ __forceinline__ P0Item p0_item_gu(Frame& F, int r) { const int nb = r % 176, kb = r / 176, tile = nb >> 3, wi = nb & 7; const float* W = (wi < 4) ? F.w_gate : F.w_up;
    return P0Item{W, DFF, 128 * tile + 32 * (wi & 3), F.norm2_g, F.Wgu_t, DM, 32 * nb, kb}; }
__device__ __forceinline__ P0Item p0_item_od(Frame& F, int r) {
    if (r < I_OUT) { const int nb = r % 32, kb = r / 32; return P0Item{F.w_out, DM, 32 * nb, nullptr, F.Wout_t, DM, 32 * nb, kb}; } r -= I_OUT;
    { const int nb = r % 32, kb = r / 32; return P0Item{F.w_down, DM, 32 * nb, nullptr, F.Wdn_t, DFF, 32 * nb, kb}; }
}
__device__ __forceinline__ void p0_prologue(Frame& F) {
    LAS float* scr = (LAS float*)(F.lds + F.wave * 8704);
    const int gw = F.vcu * NWAVES + F.wave, NGW = F.G * NWAVES;
    for (int it = gw; it < I_IN; it += NGW) { const P0Item I = p0_item_in(F, it); float v[32]; p0_item_load<false>(I, v, F.lane); p0_item_finish(I, v, scr, F.lane); }
    if (F.vcu < 4) { const int idx = F.vcu * 512 + F.tid; const int ks = idx >> 6, ln = idx & 63, col = ln & 15, gq = ln >> 4;
        v4u o = (v4u){0u, 0u, 0u, 0u};
        if (col < 8) { const float* wp = F.w_in + (size_t)(32 * ks + 8 * gq) * DIN + SRC_MI + col;
            const float w0 = wp[0], w1 = wp[DIN], w2 = wp[2 * DIN], w3 = wp[3 * DIN], w4 = wp[4 * DIN], w5 = wp[5 * DIN], w6 = wp[6 * DIN], w7 = wp[7 * DIN];
            o.x = pk2(w0, w1); o.y = pk2(w2, w3); o.z = pk2(w4, w5); o.w = pk2(w6, w7); }
        ((v4u*)F.WBG)[idx] = o; }
    { const int idx = (F.vcu * NWAVES * 64) + F.tid;
      if (idx < SEQ * 8) { const int pos = idx >> 3, i = idx & 7;
        double f = 1.0; f = (i == 1) ? 0.19392274474868576 : f; f = (i == 2) ? 0.03760603093086393 : f; f = (i == 3) ? 0.007292664737217109 : f; f = (i == 4) ? 0.001414213562373095 : f;
        f = (i == 5) ? 0.0002742481756762073 : f; f = (i == 6) ? 5.318295896944988e-05 : f; f = (i == 7) ? 1.031338537721246e-05 : f;
        const float angf = (float)pos * (float)f; const double rev = (double)angf * 0.15915494309189535; const double fr = rev - __builtin_floor(rev + 0.5);
        const float rr = (float)(fr * 6.283185307179586); F.ROPE[idx] = make_float2(__cosf(rr), __sinf(rr)); } }
    f32x4 g1[4];
#pragma unroll
    for (int j = 0; j < 4; ++j) g1[j] = ((const f32x4*)F.norm1_g)[F.lane + 64 * j];
    for (int m = gw; m < T; m += NGW) {
        const GAS f32x4* xr = (const GAS f32x4*)(F.x + (size_t)m * DM) + F.lane;
        f32x4 v[4]; float s = 0.f;
#pragma unroll
        for (int j = 0; j < 4; ++j) { v[j] = xr[64 * j]; s += (v[j].x * v[j].x + v[j].y * v[j].y) + (v[j].z * v[j].z + v[j].w * v[j].w); }
        const float rstd = __builtin_amdgcn_rsqf(wave_sum(s) * (1.f / DM) + EPS);
        GAS v2u* o8 = (GAS v2u*)(F.XN + (size_t)m * DM) + F.lane;
#pragma unroll
        for (int j = 0; j < 4; ++j) { const f32x4 y = v[j] * rstd * g1[j]; v2u w; w.x = pg8::cvt_pk_bf16(y.x, y.y); w.y = pg8::cvt_pk_bf16(y.z, y.w); o8[64 * j] = w; }
    }
}
__device__ __forceinline__ void p1_side_work(Frame& F, int ii, int ni) {
    LAS float* scr = (LAS float*)(F.lds + F.wave * 8704);
    LAS unsigned char* WB = F.lds + 73728;
    for (int idx = F.tid; idx < 2048; idx += NWAVES * 64) *(LAS v4u*)(WB + idx * 16) = ((const v4u*)F.WBG)[idx];
    __syncthreads();
    const int igw = ii * NWAVES + F.wave, NIW = ni * NWAVES;
#pragma unroll 1
    for (int it = igw; it < I_GU; it += 2 * NIW) {
        const P0Item Ia = p0_item_gu(F, it); const bool two = it + NIW < I_GU; const P0Item Ib = p0_item_gu(F, two ? it + NIW : it);
        float va[32], vb[32]; p0_item_load<true>(Ia, va, F.lane); p0_item_load<true>(Ib, vb, F.lane);
        p0_item_finish(Ia, va, scr, F.lane); if (two) p0_item_finish(Ib, vb, scr, F.lane);
    }
#pragma unroll 1
    for (int it = igw; it < I_OUT + I_DN; it += 2 * NIW) {
        const P0Item Ia = p0_item_od(F, it); const bool two = it + NIW < I_OUT + I_DN; const P0Item Ib = p0_item_od(F, two ? it + NIW : it);
        float va[32], vb[32]; p0_item_load<false>(Ia, va, F.lane); p0_item_load<false>(Ib, vb, F.lane);
        p0_item_finish(Ia, va, scr, F.lane); if (two) p0_item_finish(Ib, vb, scr, F.lane);
    }
    const int l15 = F.lane & 15, g = F.lane >> 4;
    for (int blk = igw; blk < T / 16; blk += NIW) {
        const bf16* xp = F.XN + ((size_t)blk * 16 + l15) * DM + 8 * g;
        f32x4 acc = (f32x4){0.f, 0.f, 0.f, 0.f};
        bf16x8 a[32];
#pragma unroll
        for (int q = 0; q < 32; ++q) a[q] = *(const bf16x8*)(xp + 32 * q);
#pragma unroll
        for (int q = 0; q < 32; ++q) acc = __builtin_amdgcn_mfma_f32_16x16x32_bf16(a[q], *(const LAS bf16x8*)(WB + (q * 64 + F.lane) * 16), acc, 0, 0, 0);
        if (l15 < 8) {
#pragma unroll
            for (int r = 0; r < 4; ++r) F.GATES[((size_t)blk * 16 + 4 * g + r) * 8 + l15] = acc[r];
        }
    }
}

constexpr int SWA_KS = 0, SWA_KSTR = 144, SWA_VT = 36864, SWA_VSTR = 528;
typedef short bf16x4 __attribute__((ext_vector_type(4)));
constexpr int SWA_TAB = 70656;
struct SwaKV { v4u k[4], v[4]; float2 cs[8]; };
struct SwaQ { v4u w0, w1; float2 cs[8]; };
__device__ __forceinline__ void swa_load_kv(Frame& F, int tid, int u, SwaKV& R) {
    const int blk = u & 31, kvh = (u >> 5) & 1, b = u >> 6; const int key = tid >> 1, half = tid & 1; const int kt = blk * 128 - 128 + key;
    if (kt >= 0) {
        const bf16* kp = F.PROJ + (size_t)(b * SEQ + kt) * NPROJ + PC_AK + kvh * 64 + 32 * half;
        const bf16* vp = F.PROJ + (size_t)(b * SEQ + kt) * NPROJ + PC_AV + kvh * 64 + 32 * half;
#pragma unroll
        for (int c = 0; c < 4; ++c) { R.k[c] = *(const v4u*)(kp + 8 * c); R.v[c] = *(const v4u*)(vp + 8 * c); }
#pragma unroll
        for (int i = 0; i < 8; ++i) R.cs[i] = F.ROPE[kt * 8 + i];
    } else {
#pragma unroll
        for (int c = 0; c < 4; ++c) { R.k[c] = (v4u){0u, 0u, 0u, 0u}; R.v[c] = (v4u){0u, 0u, 0u, 0u}; }
#pragma unroll
        for (int i = 0; i < 8; ++i) R.cs[i] = make_float2(1.f, 0.f);
    }
}
__device__ __forceinline__ void swa_load_q(Frame& F, int lane, int wave, int u, int rb, SwaQ& R) {
    const int blk = u & 31, kvh = (u >> 5) & 1, b = u >> 6; const int l15 = lane & 15, g = lane >> 4;
    const int hq = kvh * 4 + (wave >> 1), p0 = 64 * (wave & 1) + 16 * rb, tq = blk * 128 + p0 + l15;
    const bf16* qp = F.PROJ + (size_t)(b * SEQ + tq) * NPROJ + PC_AQ + hq * 64 + 8 * g;
    R.w0 = *(const v4u*)qp; R.w1 = *(const v4u*)(qp + 32);
#pragma unroll
    for (int j = 0; j < 8; ++j) R.cs[j] = F.ROPE[tq * 8 + j];
}
__device__ __forceinline__ void swa_phase(Frame& F) {
    LAS unsigned char* KS = F.lds + SWA_KS; LAS unsigned char* VT = F.lds + SWA_VT; LAS float* TAB = (LAS float*)(F.lds + SWA_TAB);
    const int wave = F.wave;
    int u = F.vcu;
    if (u >= NB * 2 * 32) return;
    __syncthreads();
    if (F.tid < 64) TAB[F.tid] = F.q_norm_g[F.tid]; else if (F.tid < 128) TAB[F.tid] = F.k_norm_g[F.tid - 64];
    SwaKV kv; SwaQ qr;
    swa_load_kv(F, F.tid, u, kv);
    swa_load_q(F, F.lane, wave, u, 0, qr);
#pragma unroll 1
    for (; u < NB * 2 * 32; u += F.G) {
        int tid = F.tid; asm volatile("" : "+v"(tid));
        const int lane = tid & 63, l15 = lane & 15, g = lane >> 4;
        const int blk = u & 31, kvh = (u >> 5) & 1, b = u >> 6;
        const int un = u + F.G; const bool has_next = un < NB * 2 * 32;
        __syncthreads();
        {
            const int key = tid >> 1, half = tid & 1;
            float kf[32];
#pragma unroll
            for (int c = 0; c < 4; ++c) unpack8(kv.k[c], kf + 8 * c);
            float ss = 0.f;
#pragma unroll
            for (int c = 0; c < 32; ++c) ss += kf[c] * kf[c];
            ss += __shfl_xor(ss, 1);
            const float rstd = __builtin_amdgcn_rsqf(ss * (1.f / 64.f) + EPS);
#pragma unroll
            for (int c = 0; c < 8; ++c) { const f32x4 gg = *(const LAS f32x4*)(TAB + 64 + 32 * half + 4 * c); kf[4 * c] *= rstd * gg[0]; kf[4 * c + 1] *= rstd * gg[1]; kf[4 * c + 2] *= rstd * gg[2]; kf[4 * c + 3] *= rstd * gg[3]; }
            if (half == 0) {
#pragma unroll
                for (int i = 0; i < 8; ++i) { const float2 cs = kv.cs[i]; const float x1 = kf[i], x2 = kf[8 + i]; kf[i] = x1 * cs.x - x2 * cs.y; kf[8 + i] = x2 * cs.x + x1 * cs.y; }
            }
#pragma unroll
            for (int c = 0; c < 4; ++c) { v4u o; o.x = pg8::cvt_pk_bf16(kf[8 * c], kf[8 * c + 1]); o.y = pg8::cvt_pk_bf16(kf[8 * c + 2], kf[8 * c + 3]); o.z = pg8::cvt_pk_bf16(kf[8 * c + 4], kf[8 * c + 5]); o.w = pg8::cvt_pk_bf16(kf[8 * c + 6], kf[8 * c + 7]);
                *(LAS v4u*)(KS + key * SWA_KSTR + 64 * half + 16 * c) = o; }
#pragma unroll
            for (int c = 0; c < 4; ++c) { const unsigned ww[4] = {kv.v[c].x, kv.v[c].y, kv.v[c].z, kv.v[c].w};
#pragma unroll
                for (int e = 0; e < 4; ++e) { const int d = 32 * half + 8 * c + 2 * e;
                    *(LAS unsigned short*)(VT + d * SWA_VSTR + key * 2) = (unsigned short)(ww[e] & 0xffffu);
                    *(LAS unsigned short*)(VT + (d + 1) * SWA_VSTR + key * 2) = (unsigned short)(ww[e] >> 16); } }
        }
        __syncthreads();
        if (has_next) swa_load_kv(F, tid, un, kv);
        const int hq = kvh * 4 + (wave >> 1);
        const float sink2 = F.sinks[hq] * 1.4426950408889634f;
        const float SC = 0.125f * 1.4426950408889634f;
#pragma unroll 1
        for (int rb = 0; rb < 4; ++rb) {
            const int p0 = 64 * (wave & 1) + 16 * rb, j0 = p0 >> 4;
            const int tq = blk * 128 + p0 + l15;
            bf16x8 qf[2];
            {
                float q0[8], q1[8]; unpack8(qr.w0, q0); unpack8(qr.w1, q1);
                float ss = 0.f;
#pragma unroll
                for (int j = 0; j < 8; ++j) ss += q0[j] * q0[j] + q1[j] * q1[j];
                ss += __shfl_xor(ss, 16); ss += __shfl_xor(ss, 32);
                const float rstd = __builtin_amdgcn_rsqf(ss * (1.f / 64.f) + EPS);
#pragma unroll
                for (int c = 0; c < 2; ++c) { const f32x4 ga = *(const LAS f32x4*)(TAB + 8 * g + 4 * c), gb = *(const LAS f32x4*)(TAB + 32 + 8 * g + 4 * c);
#pragma unroll
                    for (int e = 0; e < 4; ++e) { q0[4 * c + e] *= rstd * ga[e]; q1[4 * c + e] *= rstd * gb[e]; } }
#pragma unroll
                for (int j = 0; j < 8; ++j) { const float other = __shfl_xor(q0[j], 16); const float2 cs = qr.cs[j];
                    const float r0 = q0[j] * cs.x - other * cs.y, r1 = q0[j] * cs.x + other * cs.y; q0[j] = (g == 0) ? r0 : ((g == 1) ? r1 : q0[j]); }
                v4u a, c2; a.x = pg8::cvt_pk_bf16(q0[0], q0[1]); a.y = pg8::cvt_pk_bf16(q0[2], q0[3]); a.z = pg8::cvt_pk_bf16(q0[4], q0[5]); a.w = pg8::cvt_pk_bf16(q0[6], q0[7]);
                c2.x = pg8::cvt_pk_bf16(q1[0], q1[1]); c2.y = pg8::cvt_pk_bf16(q1[2], q1[3]); c2.z = pg8::cvt_pk_bf16(q1[4], q1[5]); c2.w = pg8::cvt_pk_bf16(q1[6], q1[7]);
                qf[0] = __builtin_bit_cast(bf16x8, a); qf[1] = __builtin_bit_cast(bf16x8, c2);
            }
            if (rb < 3) swa_load_q(F, lane, wave, u, rb + 1, qr); else if (has_next) swa_load_q(F, lane, wave, un, 0, qr);
            f32x4 s[10];
    #pragma unroll
            for (int jj = 0; jj < 9; ++jj) { const int tile = j0 + jj;
                f32x4 acc = (f32x4){0.f, 0.f, 0.f, 0.f};
    #pragma unroll
                for (int ks = 0; ks < 2; ++ks) { const bf16x8 kfr = *(const LAS bf16x8*)(KS + (16 * tile + l15) * SWA_KSTR + 64 * ks + 16 * g);
                    acc = __builtin_amdgcn_mfma_f32_16x16x32_bf16(kfr, qf[ks], acc, 0, 0, 0); }
                s[jj] = acc; }
            s[9] = (f32x4){0.f, 0.f, 0.f, 0.f};
    #pragma unroll
            for (int r = 0; r < 4; ++r) { if (4 * g + r < 1 + l15) s[0][r] = -INFINITY; if (4 * g + r > l15) s[8][r] = -INFINITY; }
            if (blk == 0) {
    #pragma unroll
                for (int jj = 0; jj < 9; ++jj)
    #pragma unroll
                    for (int r = 0; r < 4; ++r) { if (16 * (j0 + jj) + 4 * g + r < 128) s[jj][r] = -INFINITY; }
            }
            float mx = -INFINITY;
    #pragma unroll
            for (int jj = 0; jj < 9; ++jj)
    #pragma unroll
                for (int r = 0; r < 4; ++r) mx = fmaxf(mx, s[jj][r]);
            mx = fmaxf(mx, __shfl_xor(mx, 16)); mx = fmaxf(mx, __shfl_xor(mx, 32)); mx = fmaxf(mx * SC, sink2);
            float sum = 0.f;
    #pragma unroll
            for (int jj = 0; jj < 9; ++jj)
    #pragma unroll
                for (int r = 0; r < 4; ++r) { const float p = __builtin_amdgcn_exp2f(__builtin_fmaf(s[jj][r], SC, -mx)); s[jj][r] = p; sum += p; }
            sum += __shfl_xor(sum, 16); sum += __shfl_xor(sum, 32);
            const float inv = 1.0f / (sum + __builtin_amdgcn_exp2f(sink2 - mx));
            f32x4 o[4];
    #pragma unroll
            for (int dt = 0; dt < 4; ++dt) o[dt] = (f32x4){0.f, 0.f, 0.f, 0.f};
    #pragma unroll
            for (int kk = 0; kk < 5; ++kk) {
                const int t0 = (j0 + 2 * kk) > 15 ? 15 : (j0 + 2 * kk), t1 = (j0 + 2 * kk + 1) > 15 ? 15 : (j0 + 2 * kk + 1);
                v4u pw; pw.x = pg8::cvt_pk_bf16(s[2 * kk][0], s[2 * kk][1]); pw.y = pg8::cvt_pk_bf16(s[2 * kk][2], s[2 * kk][3]); pw.z = pg8::cvt_pk_bf16(s[2 * kk + 1][0], s[2 * kk + 1][1]); pw.w = pg8::cvt_pk_bf16(s[2 * kk + 1][2], s[2 * kk + 1][3]);
                const bf16x8 pf = __builtin_bit_cast(bf16x8, pw);
    #pragma unroll
                for (int dt = 0; dt < 4; ++dt) {
                    const v2u a0 = *(const LAS v2u*)(VT + (16 * dt + l15) * SWA_VSTR + (16 * t0 + 4 * g) * 2);
                    const v2u a1 = *(const LAS v2u*)(VT + (16 * dt + l15) * SWA_VSTR + (16 * t1 + 4 * g) * 2);
                    v4u av; av.x = a0.x; av.y = a0.y; av.z = a1.x; av.w = a1.y;
                    o[dt] = __builtin_amdgcn_mfma_f32_16x16x32_bf16(__builtin_bit_cast(bf16x8, av), pf, o[dt], 0, 0, 0); }
            }
            bf16* op = F.MIX + (size_t)(b * SEQ + tq) * DM + 512 + hq * 64 + 4 * g;
    #pragma unroll
            for (int dt = 0; dt < 4; ++dt) { v2u w; w.x = pg8::cvt_pk_bf16(o[dt][0] * inv, o[dt][1] * inv); w.y = pg8::cvt_pk_bf16(o[dt][2] * inv, o[dt][3] * inv); *(v2u*)(op + 16 * dt) = w; }
        }
    }
}
constexpr int ML_QS = 0, ML_KS = 17408, ML_KWT = 34816, ML_VT = 53248, ML_PS = 71680, ML_CT = 80896, ML_F = 115712;
constexpr int ML_QSTR = 272, ML_TSTR = 144, ML_HSTR = 528;
constexpr int FDEN = 256, FN = 320;
constexpr int ML_GV = 132096, ML_GS = ML_GV + 8192, ML_CW = ML_GS + 256;
constexpr int SEG_STRIDE = 16640;
constexpr float LOG2E = 1.4426950408889634f;
__device__ __forceinline__ float silu_f(float v) { return v * __builtin_amdgcn_rcpf(1.0f + __builtin_amdgcn_exp2f(v * -LOG2E)); }
__device__ __forceinline__ float sigmoid_f(float v) { return __builtin_amdgcn_rcpf(1.0f + __builtin_amdgcn_exp2f(v * -LOG2E)); }
__device__ __forceinline__ float exp_f(float v) { return __builtin_amdgcn_exp2f(v * LOG2E); }

template <int PASS> __device__ __forceinline__ void mlstm_item(Frame& F, int b, int h, int sg) {
    const int wave = F.wave;
    int tid = F.tid; asm volatile("" : "+v"(tid));
    int lane = tid & 63, l15 = lane & 15, g4 = lane >> 4;
    LAS unsigned char* L = F.lds; LAS float* FL = (LAS float*)(L + ML_F);
    f32x4 C[8];
#pragma unroll
    for (int et = 0; et < 8; ++et) C[et] = (f32x4){0.f, 0.f, 0.f, 0.f};
    float m = -1e30f, Gsum = 0.f;
    LAS float* GV = (LAS float*)(L + ML_GV); LAS float* GS = (LAS float*)(L + ML_GS); LAS float* CW = (LAS float*)(L + ML_CW);
    __syncthreads();
    if (tid < 128) FL[FN + tid] = 0.f;
    for (int i = tid; i < 1024; i += NWAVES * 64) { const int j = i >> 8, ch = i & 255; CW[i] = F.conv_w[j * 1024 + (ch >> 7) * 512 + h * 128 + (ch & 127)]; }
    {
        const size_t tg = (size_t)b * SEQ + (size_t)(sg * 8 + wave) * 64 + lane;
        const float* gr = F.GATES + tg * 8;
        const float ig = gr[h] + F.igate_b[h], fg = gr[4 + h] + F.fgate_b[h];
        const float lf = fminf(fg, 0.f) - log1pf(__expf(-fabsf(fg)));
        float bs = lf;
#pragma unroll
        for (int o = 1; o < 64; o <<= 1) { const float t = __shfl_up(bs, o); if (lane >= o) bs += t; }
        const float gtot = __shfl(bs, 63);
        const float u = ig - bs;
        float pm = u;
#pragma unroll
        for (int o = 1; o < 64; o <<= 1) { const float t = __shfl_up(pm, o); if (lane >= o) pm = fmaxf(pm, t); }
        const float a = gtot + u;
        const float mloc = wave_max(a);
        GV[wave * 256 + lane] = bs; GV[wave * 256 + 64 + lane] = u; GV[wave * 256 + 128 + lane] = exp_f(a - mloc); GV[wave * 256 + 192 + lane] = pm;
        if (lane == 0) { GS[wave * 2] = gtot; GS[wave * 2 + 1] = mloc; }
    }
    if (PASS == 2 && sg > 0) {
        const float* E0 = F.SEG + (size_t)((b * 4 + h) * 8) * SEG_STRIDE;
        float lw[7]; float sfx = 0.f, mfin = -1e30f;
#pragma unroll
        for (int j = 6; j >= 0; --j) { const int jc = (j < sg) ? j : 0; const float mE = E0[(size_t)jc * SEG_STRIDE + 16384 + 128], G = E0[(size_t)jc * SEG_STRIDE + 16384 + 129];
            lw[j] = (j < sg) ? (mE + sfx) : -1e30f; sfx += (j < sg) ? G : 0.f; mfin = fmaxf(mfin, lw[j]); }
        float coef[7];
#pragma unroll
        for (int j = 0; j < 7; ++j) coef[j] = (j < sg) ? exp_f(lw[j] - mfin) : 0.f;
#pragma unroll 1
        for (int j = 0; j < sg; ++j) { const float* Ej = E0 + (size_t)j * SEG_STRIDE; float cj = coef[0];
#pragma unroll
            for (int q = 1; q < 7; ++q) cj = (j == q) ? coef[q] : cj;
#pragma unroll
            for (int et = 0; et < 8; ++et)
#pragma unroll
                for (int r = 0; r < 4; ++r) C[et][r] += cj * Ej[(unsigned)((16 * wave + 4 * g4 + r) * 128 + 16 * et + l15)];
            if (tid < 128) FL[FN + tid] += cj * Ej[16384 + tid]; }
        m = mfin;
    }
    if (PASS == 2) {
#pragma unroll
        for (int et = 0; et < 8; ++et) { v2u w; w.x = pk2(C[et][0], C[et][1]); w.y = pk2(C[et][2], C[et][3]); *(LAS v2u*)(L + ML_CT + (16 * et + l15) * ML_QSTR + (16 * wave + 4 * g4) * 2) = w; }
    }
    const float kscale = 0.08838834764831845f;
    v4u xr[7]; v4u vr[4];
#define ML_LOAD(cidx) do { const int c_ = (cidx); const size_t t0_ = (size_t)b * SEQ + (size_t)c_ * 64; \
        const int mat_ = tid >> 8, r8_ = tid & 255, dg_ = r8_ & 15, l0_ = 4 * (r8_ >> 4); \
        if (PASS == 2 || mat_ == 1) { const bf16* src_ = F.PROJ + (mat_ ? PC_MK : PC_MQ) + h * 128 + 8 * dg_; \
            _Pragma("unroll") for (int j = 0; j < 7; ++j) { const int lr = l0_ + j - 3; xr[j] = (c_ == 0 && lr < 0) ? (v4u){0u, 0u, 0u, 0u} : *(const v4u*)(src_ + (t0_ + lr) * NPROJ); } } \
        if (mat_ == 0) { _Pragma("unroll") for (int lp = 0; lp < 4; ++lp) vr[lp] = *(const v4u*)(F.PROJ + (t0_ + l0_ + lp) * NPROJ + PC_MV + h * 128 + 8 * dg_); } } while (0)
    ML_LOAD(sg * 8);
#pragma unroll 1
    for (int cc = 0; cc < 8; ++cc) {
        const int c = sg * 8 + cc; const size_t t0 = (size_t)b * SEQ + (size_t)c * 64;
        tid = F.tid; asm volatile("" : "+v"(tid));
        lane = tid & 63; l15 = lane & 15; g4 = lane >> 4;
        const int mat = tid >> 8, r8 = tid & 255, dg = r8 & 15, rg = r8 >> 4, l0 = 4 * rg;
        LAS float* GB = GV + cc * 256;
        __syncthreads();
        const float gtot = GS[cc * 2], mloc = GS[cc * 2 + 1];
        if (PASS == 2 || mat == 1) {
            const float w0 = GB[128 + l0], w1 = GB[128 + l0 + 1], w2 = GB[128 + l0 + 2], w3 = GB[128 + l0 + 3];
            unsigned ow[4][4];
            const LAS float* cwp = CW + mat * 128 + 8 * dg;
#pragma unroll
            for (int ip = 0; ip < 4; ++ip) {
                float ya[4], yb[4];
                const float ca0 = cwp[2 * ip], ca1 = cwp[256 + 2 * ip], ca2 = cwp[512 + 2 * ip], ca3 = cwp[768 + 2 * ip];
                const float cb0 = cwp[2 * ip + 1], cb1 = cwp[256 + 2 * ip + 1], cb2 = cwp[512 + 2 * ip + 1], cb3 = cwp[768 + 2 * ip + 1];
                float xa[7], xb[7];
#pragma unroll
                for (int j = 0; j < 7; ++j) { const unsigned w = (ip == 0) ? xr[j].x : (ip == 1) ? xr[j].y : (ip == 2) ? xr[j].z : xr[j].w; xa[j] = bflo(w); xb[j] = bfhi(w); }
#pragma unroll
                for (int lp = 0; lp < 4; ++lp) {
                    ya[lp] = silu_f(ca0 * xa[lp] + ca1 * xa[lp + 1] + ca2 * xa[lp + 2] + ca3 * xa[lp + 3]) * (mat ? kscale : 1.0f);
                    yb[lp] = silu_f(cb0 * xb[lp] + cb1 * xb[lp + 1] + cb2 * xb[lp + 2] + cb3 * xb[lp + 3]) * (mat ? kscale : 1.0f);
                    ow[lp][ip] = pk2(ya[lp], yb[lp]); }
                if (mat == 1) {
                    v2u o; o.x = pk2(ya[0] * w0, ya[1] * w1); o.y = pk2(ya[2] * w2, ya[3] * w3); *(LAS v2u*)(L + ML_KWT + (8 * dg + 2 * ip) * ML_TSTR + l0 * 2) = o;
                    o.x = pk2(yb[0] * w0, yb[1] * w1); o.y = pk2(yb[2] * w2, yb[3] * w3); *(LAS v2u*)(L + ML_KWT + (8 * dg + 2 * ip + 1) * ML_TSTR + l0 * 2) = o; }
            }
            if (PASS == 2) {
                LAS unsigned char* dst = L + (mat ? ML_KS : ML_QS) + l0 * ML_QSTR + 16 * dg;
#pragma unroll
                for (int lp = 0; lp < 4; ++lp) { v4u o; o.x = ow[lp][0]; o.y = ow[lp][1]; o.z = ow[lp][2]; o.w = ow[lp][3]; *(LAS v4u*)(dst + lp * ML_QSTR) = o; }
            }
        }
        if (mat == 0) {
            const unsigned ww[4][4] = {{vr[0].x, vr[0].y, vr[0].z, vr[0].w}, {vr[1].x, vr[1].y, vr[1].z, vr[1].w}, {vr[2].x, vr[2].y, vr[2].z, vr[2].w}, {vr[3].x, vr[3].y, vr[3].z, vr[3].w}};
#pragma unroll
            for (int p = 0; p < 4; ++p) {
                v2u lo, hi;
                lo.x = (ww[0][p] & 0xffffu) | (ww[1][p] << 16); lo.y = (ww[2][p] & 0xffffu) | (ww[3][p] << 16);
                hi.x = (ww[0][p] >> 16) | (ww[1][p] & 0xffff0000u); hi.y = (ww[2][p] >> 16) | (ww[3][p] & 0xffff0000u);
                *(LAS v2u*)(L + ML_VT + (8 * dg + 2 * p) * ML_TSTR + l0 * 2) = lo;
                *(LAS v2u*)(L + ML_VT + (8 * dg + 2 * p + 1) * ML_TSTR + l0 * 2) = hi; }
        }
        __syncthreads();
        if (cc < 7) ML_LOAD(c + 1);
        unsigned mo8[8];
        if (PASS == 2) {
#pragma unroll
            for (int rr = 0; rr < 8; ++rr) mo8[rr] = *(const unsigned*)(F.PROJ + (t0 + 8 * wave + rr) * NPROJ + PC_MO + h * 128 + 2 * lane);
        }
        const float mn = fmaxf(gtot + m, mloc), so = exp_f(gtot + m - mn), sn = exp_f(mloc - mn);
        if (PASS == 2) {
            const int lt = wave >> 1;
#pragma unroll
            for (int si = 0; si < 2; ++si) { const int st = 2 * (wave & 1) + si;
                float p[4] = {0.f, 0.f, 0.f, 0.f};
                if (st <= lt) {
                    f32x4 acc = (f32x4){0.f, 0.f, 0.f, 0.f};
#pragma unroll
                    for (int ks = 0; ks < 4; ++ks) { const bf16x8 a = *(const LAS bf16x8*)(L + ML_QS + (16 * lt + l15) * ML_QSTR + 64 * ks + 16 * g4);
                        const bf16x8 bb = *(const LAS bf16x8*)(L + ML_KS + (16 * st + l15) * ML_QSTR + 64 * ks + 16 * g4);
                        acc = __builtin_amdgcn_mfma_f32_16x16x32_bf16(a, bb, acc, 0, 0, 0); }
                    const int s = 16 * st + l15; const float us = GB[64 + s];
#pragma unroll
                    for (int r = 0; r < 4; ++r) { const int l = 16 * lt + 4 * g4 + r; const float bl = GB[l]; const float mrow = bl + fmaxf(GB[192 + l], m);
                        const float e = __builtin_amdgcn_exp2f((bl - mrow + us) * LOG2E); p[r] = (s <= l) ? acc[r] * e : 0.f; }
                }
#pragma unroll
                for (int r = 0; r < 4; ++r) *(LAS unsigned short*)(L + ML_PS + (16 * lt + 4 * g4 + r) * ML_TSTR + (16 * st + l15) * 2) = (unsigned short)f2bf(p[r]);
            }
            __syncthreads();
            {
                const int row = 8 * wave + (lane >> 3), part = lane & 7;
                const v4u pw = *(const LAS v4u*)(L + ML_PS + row * ML_TSTR + 16 * part);
                float pf[8]; unpack8(pw, pf);
                float sp = ((pf[0] + pf[1]) + (pf[2] + pf[3])) + ((pf[4] + pf[5]) + (pf[6] + pf[7]));
                const v4u q0 = *(const LAS v4u*)(L + ML_QS + row * ML_QSTR + 32 * part), q1 = *(const LAS v4u*)(L + ML_QS + row * ML_QSTR + 32 * part + 16);
                float qf[16]; unpack8(q0, qf); unpack8(q1, qf + 8);
                float qn = 0.f;
#pragma unroll
                for (int i = 0; i < 16; ++i) qn += qf[i] * FL[FN + 16 * part + i];
                const float bl = GB[row]; const float mrow = bl + fmaxf(GB[192 + row], m); const float sc = exp_f(bl + m - mrow);
                float tot = sp + sc * qn;
                tot += __shfl_xor(tot, 1); tot += __shfl_xor(tot, 2); tot += __shfl_xor(tot, 4);
                if (part == 0) FL[FDEN + row] = fmaxf(fabsf(tot), exp_f(-mrow));
            }
            const int eh = wave & 1;
            f32x4 o1[4], o2[4];
#pragma unroll
            for (int ei = 0; ei < 4; ++ei) { const int et = 4 * eh + ei;
                f32x4 a1 = (f32x4){0.f, 0.f, 0.f, 0.f}, a2 = (f32x4){0.f, 0.f, 0.f, 0.f};
#pragma unroll
                for (int ks = 0; ks < 2; ++ks) { const bf16x8 a = *(const LAS bf16x8*)(L + ML_VT + (16 * et + l15) * ML_TSTR + 64 * ks + 16 * g4);
                    const bf16x8 bb = *(const LAS bf16x8*)(L + ML_PS + (16 * lt + l15) * ML_TSTR + 64 * ks + 16 * g4);
                    a1 = __builtin_amdgcn_mfma_f32_16x16x32_bf16(a, bb, a1, 0, 0, 0); }
#pragma unroll
                for (int ks = 0; ks < 4; ++ks) { const bf16x8 a = *(const LAS bf16x8*)(L + ML_CT + (16 * et + l15) * ML_QSTR + 64 * ks + 16 * g4);
                    const bf16x8 bb = *(const LAS bf16x8*)(L + ML_QS + (16 * lt + l15) * ML_QSTR + 64 * ks + 16 * g4);
                    a2 = __builtin_amdgcn_mfma_f32_16x16x32_bf16(a, bb, a2, 0, 0, 0); }
                o1[ei] = a1; o2[ei] = a2; }
            __syncthreads();
            {
                const int l = 16 * lt + l15; const float bl = GB[l]; const float mrow = bl + fmaxf(GB[192 + l], m); const float sc = exp_f(bl + m - mrow);
                const float inv = 1.0f / FL[FDEN + l];
#pragma unroll
                for (int ei = 0; ei < 4; ++ei) { const int et = 4 * eh + ei; const f32x4 hv = (o1[ei] + o2[ei] * sc) * inv;
                    *(LAS f32x4*)(L + l * ML_HSTR + (16 * et + 4 * g4) * 4) = hv; }
            }
        }
        {
            bf16x8 af[2];
#pragma unroll
            for (int ks = 0; ks < 2; ++ks) af[ks] = *(const LAS bf16x8*)(L + ML_KWT + (16 * wave + l15) * ML_TSTR + 64 * ks + 16 * g4);
#pragma unroll
            for (int et = 0; et < 8; ++et) { f32x4 d = (f32x4){0.f, 0.f, 0.f, 0.f};
#pragma unroll
                for (int ks = 0; ks < 2; ++ks) { const bf16x8 bb = *(const LAS bf16x8*)(L + ML_VT + (16 * et + l15) * ML_TSTR + 64 * ks + 16 * g4);
                    d = __builtin_amdgcn_mfma_f32_16x16x32_bf16(af[ks], bb, d, 0, 0, 0); }
                C[et] = C[et] * so + d * sn; }
            if (tid < 128) { float dn = 0.f;
#pragma unroll
                for (int q = 0; q < 8; ++q) { const v4u w = *(const LAS v4u*)(L + ML_KWT + tid * ML_TSTR + 16 * q); float f[8]; unpack8(w, f); dn += ((f[0] + f[1]) + (f[2] + f[3])) + ((f[4] + f[5]) + (f[6] + f[7])); }
                FL[FN + tid] = so * FL[FN + tid] + sn * dn; }
            m = mn; Gsum += gtot;
            if (PASS == 2) {
#pragma unroll
                for (int et = 0; et < 8; ++et) { v2u w; w.x = pk2(C[et][0], C[et][1]); w.y = pk2(C[et][2], C[et][3]); *(LAS v2u*)(L + ML_CT + (16 * et + l15) * ML_QSTR + (16 * wave + 4 * g4) * 2) = w; }
            }
        }
        if (PASS == 2) {
            __syncthreads();
#pragma unroll
            for (int rr = 0; rr < 8; ++rr) { const int l = 8 * wave + rr;
                const f32x2v hv = *(const LAS f32x2v*)(L + l * ML_HSTR + lane * 8);
                const float ss = wave_sum(hv.x * hv.x + hv.y * hv.y);
                const float rstd = __builtin_amdgcn_rsqf(ss * (1.f / 128.f) + EPS);
                const unsigned mo = mo8[rr];
                const f32x2v gg = *(const f32x2v*)(F.mlstm_norm_g + h * 128 + 2 * lane);
                *(unsigned*)(F.MIX + (t0 + l) * DM + h * 128 + 2 * lane) = pk2(hv.x * rstd * gg.x * sigmoid_f(bflo(mo)), hv.y * rstd * gg.y * sigmoid_f(bfhi(mo))); }
        }
    }
    if (PASS == 1) {
        tid = F.tid; asm volatile("" : "+v"(tid)); lane = tid & 63; l15 = lane & 15; g4 = lane >> 4;
        float* E = F.SEG + (size_t)((b * 4 + h) * 8 + sg) * SEG_STRIDE;
#pragma unroll
        for (int et = 0; et < 8; ++et)
#pragma unroll
            for (int r = 0; r < 4; ++r) E[(16 * wave + 4 * g4 + r) * 128 + 16 * et + l15] = C[et][r];
        if (tid < 128) E[16384 + tid] = FL[FN + tid];
        if (tid == 0) { E[16384 + 128] = m; E[16384 + 129] = Gsum; }
    }
}
template <int PASS> __device__ __forceinline__ void mlstm_phase(Frame& F) {
    for (int it = F.vcu; it < NB * 4 * 8; it += F.G) { const int sg = it & 7, h = (it >> 3) & 3, b = it >> 5; if (PASS == 1 && sg == 7) continue; mlstm_item<PASS>(F, b, h, sg); }
}
struct Args { const float* in[15]; float* out; unsigned char* ws; int ph_lo, ph_hi, li, pad; };
__global__ void __launch_bounds__(NWAVES * 64, 2) mk_fwd(Args args) {
    extern __shared__ __attribute__((aligned(16))) unsigned char lds[];
    Frame F;
    F.lds = (LAS unsigned char*)lds;
    F.MISC = (volatile LAS unsigned*)(F.lds + MISC_OFF);
    F.tid = threadIdx.x; F.lane = F.tid & 63; F.wave = __builtin_amdgcn_readfirstlane(F.tid >> 6);
    F.G = gridDim.x; { const int bx = blockIdx.x; F.vcu = (F.G % 8 == 0) ? (bx % 8) * (F.G / 8) + bx / 8 : bx; }
    unsigned char* ws = args.ws;
    F.ctl = (gu32*)(ws + WS_CTL);
    F.x = args.in[0]; F.norm1_g = args.in[1]; F.w_in = args.in[2]; F.conv_w = args.in[3]; F.igate_b = args.in[4]; F.fgate_b = args.in[5]; F.mlstm_norm_g = args.in[6];
    F.q_norm_g = args.in[7]; F.k_norm_g = args.in[8]; F.sinks = args.in[9]; F.w_out = args.in[10]; F.norm2_g = args.in[11]; F.w_gate = args.in[12]; F.w_up = args.in[13]; F.w_down = args.in[14];
    F.out = args.out;
    F.Win_t = (bf16*)(ws + WS_WIN); F.Wout_t = (bf16*)(ws + WS_WOUT); F.Wgu_t = (bf16*)(ws + WS_WGU); F.Wdn_t = (bf16*)(ws + WS_WDN);
    F.XN = (bf16*)(ws + WS_XN); F.MIX = (bf16*)(ws + WS_MIX); F.PROJ = (bf16*)(ws + WS_PROJ);
    F.ROPE = (float2*)(ws + WS_ROPE); F.GATES = (float*)(ws + WS_GATES); F.SSQ = (float*)(ws + WS_SSQ); F.SEG = (float*)(ws + WS_SEG); F.WBG = ws + WS_WBG;
    for (int u = F.tid; u < (LDS_BYTES - LDSCTL_OFF) / 4; u += NWAVES * 64) ((LAS unsigned*)(F.lds + LDSCTL_OFF))[u] = 0u;
    __syncthreads();
    const int lo = args.ph_lo, hi = args.ph_hi;
    XcdBarrier bar; bar.bar = (unsigned*)(F.ctl + CW_BAR) + args.li * XCD_BAR_WORDS; bar.x = 0; bar.st = nullptr;
    if (hi - lo > 1) bar = xcd_barrier_post((unsigned*)(F.ctl + CW_BAR) + args.li * XCD_BAR_WORDS, F.MISC + 8);
#define IN(k) (lo <= (k) && (k) < hi)
#define BOTH(k) (IN(k) && IN((k) + 1))
#define GRID_BAR() xcd_barrier(bar)

#ifndef DOUBLE_PHASE
#define DOUBLE_PHASE -1
#endif
#define RUN_PHASE(k, BODY) if (IN(k)) { BODY; if (DOUBLE_PHASE == (k)) { GRID_BAR(); BODY; } if (BOTH(k)) GRID_BAR(); }
#define PH0 p0_prologue(F)
#define PH1 do { pg8::Gemm g{F.XN, F.Win_t, T, NPROJ, DM}; pg8::StaticOrder S; S.init(T, NPROJ, F.G, (int)blockIdx.x); pg8::EpiStoreBf16 E{F.PROJ, NPROJ}; \
        pg8::gemm_phase<pg8::EpiStoreBf16, pg8::StaticOrder, true, true>(F.lds, g, S, E); \
        { const int nwg_ = (T / 256) * (NPROJ / 256), rem_ = nwg_ % F.G;               \
          if (rem_ == 0) p1_side_work(F, (int)blockIdx.x, F.G); else if ((int)blockIdx.x >= rem_) p1_side_work(F, (int)blockIdx.x - rem_, F.G - rem_); } } while (0)
#ifdef H1_BF16
#define PH4 do { pg8::Gemm g{F.MIX, F.Wout_t, T, DM, DM}; pg8::StaticOrder S; S.init(T, DM, F.G, (int)blockIdx.x); pg8::EpiResidNormB E{F.x, F.XN, F.SSQ}; \
        pg8::gemm_phase<pg8::EpiResidNormB, pg8::StaticOrder, true, true>(F.lds, g, S, E); } while (0)
#define PH6 do { pg8::Gemm g{F.PROJ, F.Wdn_t, T, DM, DFF}; pg8::StaticOrder S; S.init(T, DM, F.G, (int)blockIdx.x); pg8::EpiResidOutB E{F.XN, F.out}; \
        pg8::gemm_phase<pg8::EpiResidOutB, pg8::StaticOrder, true, true>(F.lds, g, S, E); } while (0)
#else
#define PH4 do { pg8::Gemm g{F.MIX, F.Wout_t, T, DM, DM}; pg8::StaticOrder S; S.init(T, DM, F.G, (int)blockIdx.x); pg8::EpiResidNorm E{F.x, F.out, F.XN, F.SSQ}; \
        pg8::gemm_phase<pg8::EpiResidNorm, pg8::StaticOrder, true, true>(F.lds, g, S, E); } while (0)
#define PH6 do { pg8::Gemm g{F.PROJ, F.Wdn_t, T, DM, DFF}; pg8::StaticOrder S; S.init(T, DM, F.G, (int)blockIdx.x); pg8::EpiResidOut E{F.out, F.out}; \
        pg8::gemm_phase<pg8::EpiResidOut, pg8::StaticOrder, true, true>(F.lds, g, S, E); } while (0)
#endif
#define PH5 do { pg8::Gemm g{F.XN, F.Wgu_t, T, 2 * DFF, DM}; pg8::StaticOrder S; S.init(T, 2 * DFF, F.G, (int)blockIdx.x); pg8::EpiSwiGLU E{F.PROJ, DFF, F.SSQ, EPS}; \
        pg8::gemm_phase<pg8::EpiSwiGLU, pg8::StaticOrder, true, true>(F.lds, g, S, E); } while (0)
    RUN_PHASE(0, PH0)
    RUN_PHASE(1, PH1)
    RUN_PHASE(2, PHASE2_BODY)
    RUN_PHASE(3, PHASE3_BODY)
    RUN_PHASE(4, PH4)
    RUN_PHASE(5, PH5)
#if defined(PROBE_P6)
    if (IN(6)) { { pg8::Gemm g{F.PROJ, F.Wdn_t, T, DM, DFF}; pg8::StaticOrder S; S.init(T, DM, F.G, (int)blockIdx.x); pg8::EpiResidOut E{F.out, (float*)(ws + WS_XN)};
        pg8::gemm_phase<pg8::EpiResidOut, pg8::StaticOrder, true, true>(F.lds, g, S, E); } GRID_BAR(); }
#endif
    RUN_PHASE(6, PH6)
#undef IN
#undef BOTH
}
namespace nv {
__device__ __forceinline__ float sigmoidf_(float x) { return 1.f / (1.f + __expf(-x)); }
__device__ __forceinline__ float siluf_(float x) { return x / (1.f + __expf(-x)); }
__global__ __launch_bounds__(128) void k_mlstm_rec(const bf16* __restrict__ proj, const float* __restrict__ gates, const float* __restrict__ conv_w, const float* __restrict__ igb, const float* __restrict__ fgb,
                                                   float* __restrict__ hm) {
    __shared__ float red[2][12];
    const int d = threadIdx.x, lane = d & 63, w = d >> 6;
    const int es = blockIdx.x & 15, h = (blockIdx.x >> 4) & 3, b = blockIdx.x >> 6;
    const int e0 = es * 8;
    const int cq = h * 128 + d, ck = 512 + h * 128 + d;
    float wq[4], wk[4];
#pragma unroll
    for (int j = 0; j < 4; ++j) { wq[j] = conv_w[j * 1024 + cq]; wk[j] = conv_w[j * 1024 + ck]; }
    const float ib = igb[h], fb = fgb[h];
    float C[8] = {}, n = 0.f, m = -1e30f;
    float q1 = 0.f, q2 = 0.f, q3 = 0.f, k1 = 0.f, k2 = 0.f, k3 = 0.f;
    const float kscale = 0.08838834764831845f;
    for (int t = 0; t < SEQ; ++t) {
        const bf16* row = proj + (size_t)(b * SEQ + t) * NPROJ;
        const float* gr = gates + (size_t)(b * SEQ + t) * 8;
        const float q0 = bf2f(row[PC_MQ + h * 128 + d]), k0 = bf2f(row[PC_MK + h * 128 + d]);
        const float qt = siluf_(wq[0] * q3 + wq[1] * q2 + wq[2] * q1 + wq[3] * q0);
        const float kt = siluf_(wk[0] * k3 + wk[1] * k2 + wk[2] * k1 + wk[3] * k0) * kscale;
        q3 = q2; q2 = q1; q1 = q0; k3 = k2; k2 = k1; k1 = k0;
        const float ig = gr[h] + ib, fg = gr[4 + h] + fb;
        const float lf = fminf(fg, 0.f) - log1pf(__expf(-fabsf(fg)));
        const float mn = fmaxf(lf + m, ig);
        const float so = __expf(lf + m - mn), sn = __expf(ig - mn);
        m = mn;
        float part[9];
#pragma unroll
        for (int e = 0; e < 8; ++e) { const float v = bf2f(row[PC_MV + h * 128 + e0 + e]); C[e] = so * C[e] + sn * kt * v; part[e] = qt * C[e]; }
        n = so * n + sn * kt; part[8] = qt * n;
#pragma unroll
        for (int e = 0; e < 9; ++e) part[e] = wave_sum(part[e]);
        __syncthreads();
        if (lane == 0) {
#pragma unroll
            for (int e = 0; e < 9; ++e) red[w][e] = part[e];
        }
        __syncthreads();
        if (d < 8) {
            const float num = red[0][d] + red[1][d], den = red[0][8] + red[1][8];
            hm[(size_t)(b * SEQ + t) * 512 + h * 128 + e0 + d] = num / fmaxf(fabsf(den), __expf(-mn));
        }
    }
}
__global__ __launch_bounds__(256) void k_mlstm_post(const float* __restrict__ hm, const bf16* __restrict__ proj, const float* __restrict__ g, bf16* __restrict__ mix) {
    const int gw = blockIdx.x * 4 + (threadIdx.x >> 6), lane = threadIdx.x & 63;
    const int t = gw >> 2, h = gw & 3;
    const float a0 = hm[(size_t)t * 512 + h * 128 + lane], a1 = hm[(size_t)t * 512 + h * 128 + 64 + lane];
    const float ss = wave_sum(a0 * a0 + a1 * a1);
    const float r = rsqrtf(ss * (1.f / 128.f) + EPS);
    const float o0 = bf2f(proj[(size_t)t * NPROJ + PC_MO + h * 128 + lane]), o1 = bf2f(proj[(size_t)t * NPROJ + PC_MO + h * 128 + 64 + lane]);
    mix[(size_t)t * DM + h * 128 + lane] = (bf16)f2bf(a0 * r * g[h * 128 + lane] * sigmoidf_(o0));
    mix[(size_t)t * DM + h * 128 + 64 + lane] = (bf16)f2bf(a1 * r * g[h * 128 + 64 + lane] * sigmoidf_(o1));
}
__global__ __launch_bounds__(256) void k_qknorm_rope(const bf16* __restrict__ proj, const float* __restrict__ qg, const float* __restrict__ kg, const float2* __restrict__ cs, float* __restrict__ qk) {
    const int gw = blockIdx.x * 4 + (threadIdx.x >> 6), lane = threadIdx.x & 63;
    const int t = gw / 10, j = gw % 10;
    const int pos = t & (SEQ - 1);
    const bf16* p = proj + (size_t)t * NPROJ + (j < 8 ? PC_AQ + j * 64 : PC_AK + (j - 8) * 64);
    const float x = bf2f(p[lane]);
    const float ss = wave_sum(x * x);
    float y = x * rsqrtf(ss * (1.f / 64.f) + EPS) * (j < 8 ? qg[lane] : kg[lane]);
    const float yp = __shfl_xor(y, 8);
    if (lane < 16) {
        const float2 c = cs[pos * 8 + (lane & 7)];
        y = (lane < 8) ? (y * c.x - yp * c.y) : (y * c.x + yp * c.y);
    }
    qk[(size_t)t * 640 + j * 64 + lane] = y;
}
__global__ __launch_bounds__(256) void k_swa(const float* __restrict__ qk, const bf16* __restrict__ proj, const float* __restrict__ sinks, bf16* __restrict__ mix) {
    __shared__ float sq[4][64];
    const int wv = threadIdx.x >> 6, lane = threadIdx.x & 63;
    const int gw = blockIdx.x * 4 + wv;
    const int t = gw >> 3, hq = gw & 7, hk = hq >> 2;
    const int pos = t & (SEQ - 1);
    sq[wv][lane] = qk[(size_t)t * 640 + hq * 64 + lane];
    __syncthreads();
    float sc[2];
#pragma unroll
    for (int r = 0; r < 2; ++r) {
        const int rel = lane + 64 * r;
        float s = -INFINITY;
        if (rel <= pos) {
            const float* kp = qk + (size_t)(t - rel) * 640 + 512 + hk * 64;
            float a = 0.f;
            for (int dd = 0; dd < 64; ++dd) a += sq[wv][dd] * kp[dd];
            s = a * 0.125f;
        }
        sc[r] = s;
    }
    const float snk = sinks[hq];
    const float mx = fmaxf(wave_max(fmaxf(sc[0], sc[1])), snk);
    const float p0 = __expf(sc[0] - mx), p1 = __expf(sc[1] - mx);
    const float den = wave_sum(p0 + p1) + __expf(snk - mx);
    float o = 0.f;
    for (int rel = 0; rel < 128; ++rel) {
        const float p = __shfl((rel < 64) ? p0 : p1, rel & 63);
        if (rel <= pos) o += p * bf2f(proj[(size_t)(t - rel) * NPROJ + PC_AV + hk * 64 + lane]);
    }
    mix[(size_t)t * DM + 512 + hq * 64 + lane] = (bf16)f2bf(o / den);
}
}
extern "C" void kernel_launch(void* const* d_in, const int* in_sizes, int n_in, void* d_out, int out_size, void* d_ws, size_t ws_size, hipStream_t stream) {
    static int grid = 0;
    if (grid == 0) {
        if (n_in != 15 || in_sizes[0] != T * DM || out_size != T * DM || ws_size < WS_END) { fprintf(stderr, "kernel_launch: unexpected shapes / workspace (n_in %d, ws %zu)\n", n_in, ws_size); grid = -1; return; }
        int dev = 0, cus = 0, per_cu = 0;
        if (hipGetDevice(&dev) != hipSuccess || hipDeviceGetAttribute(&cus, hipDeviceAttributeMultiprocessorCount, dev) != hipSuccess) { grid = -1; return; }
        if (hipFuncSetAttribute((const void*)mk_fwd, hipFuncAttributeMaxDynamicSharedMemorySize, LDS_BYTES) != hipSuccess) { fprintf(stderr, "kernel_launch: hipFuncSetAttribute failed\n"); grid = -1; return; }
        if (hipOccupancyMaxActiveBlocksPerMultiprocessor(&per_cu, (const void*)mk_fwd, NWAVES * 64, LDS_BYTES) != hipSuccess || per_cu < 1) { fprintf(stderr, "kernel_launch: occupancy query says %d blocks per CU\n", per_cu); grid = -1; (void)hipGetLastError(); return; }
        grid = cus;
    }
    if (grid < 0) return;
    (void)hipMemsetAsync((char*)d_ws + WS_CTL, 0, CTL_ZERO_BYTES, stream);
    Args a{};
    for (int i = 0; i < 15; ++i) a.in[i] = (const float*)d_in[i];
    a.out = (float*)d_out; a.ws = (unsigned char*)d_ws;
    LAUNCH_PROGRAM
}
```

```cpp
#include <hip/hip_runtime.h>
#include <cstdio>
#include <cstdint>
namespace pg8 {
#define PG8_LAS __attribute__((address_space(3)))
typedef unsigned short bf16_t;
typedef short bf16x8 __attribute__((ext_vector_type(8)));
typedef float f32x4 __attribute__((ext_vector_type(4)));
typedef unsigned u32x4 __attribute__((ext_vector_type(4)));
constexpr int BM = 256, BK = 64, HALF = 128, HTB = HALF * BK * 2  , STAGE_BYTES = 8 * HTB, NXCD = 8, WGM = 8;

__host__ __device__ __forceinline__ int lds_byte(int r, int c) { const int st = (r >> 4) * 2 + (c >> 5), rr = r & 15, cc = c & 31, ob = rr * 64 + cc * 2; return st * 1024 + (ob ^ (((ob >> 9) & 1) << 5)); }
__host__ __device__ __forceinline__ void stage_rc(int b, int& R, int& C) { const int st = b / 1024, sb = b % 1024, swz = sb ^ (((sb >> 9) & 1) << 5); R = (st >> 1) * 16 + swz / 64; C = (st & 1) * 32 + (swz % 64) / 2; }
__host__ __device__ __forceinline__ int perm32(int rho) { const int n = rho >> 4, i = rho & 15; return 8 * (i >> 2) + 4 * n + (i & 3); }

struct Unit { int pm, pn; };
struct Gemm { const bf16_t* A; const bf16_t* Bt; int M, N, K; };

struct StaticOrder {
    int nM, nN, nwg, G, c;
    __host__ __device__ void init(int M, int N, int G_, int c_) { nM = M / BM; nN = N / BM; nwg = nM * nN; G = G_; c = c_; }
    __host__ __device__ bool next(int i, Unit& u) const {
        const long L = (long)i * G + c; if (L >= nwg) return false;
        int wgid = (int)L; { const int q = nwg / NXCD, r = nwg % NXCD, xcd = wgid % NXCD, off = wgid / NXCD; wgid = (xcd < r ? xcd * (q + 1) : r * (q + 1) + (xcd - r) * q) + off; }
        const int nig = WGM * nN, gid = wgid / nig, fm = gid * WGM, gsz = (nM - fm) < WGM ? (nM - fm) : WGM;
        u.pm = fm + ((wgid % nig) % gsz); u.pn = (wgid % nig) / gsz; return true;
    }
    __device__ __forceinline__ void a_ready(const Unit&) const {}
    __device__ __forceinline__ void done(const Unit&) const {}
};

__device__ __forceinline__ unsigned cvt_pk_bf16(float lo, float hi) { unsigned r; asm volatile("v_cvt_pk_bf16_f32 %0, %1, %2" : "=v"(r) : "v"(lo), "v"(hi)); return r; }
typedef float f32x2 __attribute__((ext_vector_type(2)));
#ifdef WT_STORES
__device__ __forceinline__ void st16(void* p, u32x4 v) { asm volatile("global_store_dwordx4 %0, %1, off sc1\n\ts_nop 1" :: "v"(p), "v"(v) : "memory"); }
#else
__device__ __forceinline__ void st16(void* p, u32x4 v) { *(u32x4*)p = v; }
#endif
__device__ __forceinline__ float fast_silu(float v) { return v * __builtin_amdgcn_rcpf(1.0f + __builtin_amdgcn_exp2f(v * -1.4426950408889634f)); }
struct EpiStoreBf16 {
    static constexpr bool PERM = true, AFTER_DRAIN = false, STREAM_R = false, STREAM_BF16 = false;
    bf16_t* O; int ldc;
    __device__ __forceinline__ void operator()(const f32x4 (&acc)[2][2][4][2], const Unit& u, int wr, int wc, int fr, int fq) const {
        const int row0 = u.pm * BM + wr * 64 + fr, col0 = u.pn * BM + wc * 32 + 8 * fq;
#pragma unroll
        for (int ai = 0; ai < 2; ++ai)
#pragma unroll
            for (int m = 0; m < 4; ++m) { bf16_t* rowp = O + (size_t)(row0 + ai * HALF + m * 16) * ldc + col0;
#pragma unroll
                for (int bj = 0; bj < 2; ++bj) { const f32x4 v0 = acc[ai][bj][m][0], v1 = acc[ai][bj][m][1];
                    u32x4 w; w.x = cvt_pk_bf16(v0[0], v0[1]); w.y = cvt_pk_bf16(v0[2], v0[3]); w.z = cvt_pk_bf16(v1[0], v1[1]); w.w = cvt_pk_bf16(v1[2], v1[3]);
                    st16(rowp + bj * HALF, w); } }
    }
};
struct EpiResidNorm {
    static constexpr bool PERM = true, AFTER_DRAIN = false, STREAM_R = false, STREAM_BF16 = false;
    const float* X; float* H; bf16_t* HB; float* SSQ;
    __device__ __forceinline__ void operator()(const f32x4 (&acc)[2][2][4][2], const Unit& u, int wr, int wc, int fr, int fq) const {
        const int row0 = u.pm * BM + wr * 64 + fr, col0 = u.pn * BM + wc * 32 + 8 * fq;
#pragma unroll
        for (int ai = 0; ai < 2; ++ai)
#pragma unroll
            for (int m = 0; m < 4; ++m) { const int row = row0 + ai * HALF + m * 16; const size_t off = (size_t)row * 1024 + col0; float ss = 0.f;
#pragma unroll
                for (int bj = 0; bj < 2; ++bj) { const f32x4 x0 = *(const f32x4*)(X + off + bj * HALF), x1 = *(const f32x4*)(X + off + bj * HALF + 4);
                    const f32x4 v0 = x0 + acc[ai][bj][m][0], v1 = x1 + acc[ai][bj][m][1];
                    *(f32x4*)(H + off + bj * HALF) = v0; *(f32x4*)(H + off + bj * HALF + 4) = v1;
                    u32x4 w; w.x = cvt_pk_bf16(v0[0], v0[1]); w.y = cvt_pk_bf16(v0[2], v0[3]); w.z = cvt_pk_bf16(v1[0], v1[1]); w.w = cvt_pk_bf16(v1[2], v1[3]);
                    *(u32x4*)(HB + off + bj * HALF) = w;
                    ss += (v0[0] * v0[0] + v0[1] * v0[1]) + (v0[2] * v0[2] + v0[3] * v0[3]) + (v1[0] * v1[0] + v1[1] * v1[1]) + (v1[2] * v1[2] + v1[3] * v1[3]); }
                ss += __shfl_xor(ss, 16); ss += __shfl_xor(ss, 32);
                if (fq == 0) SSQ[(size_t)row * 16 + u.pn * 4 + wc] = ss; }
    }
};
struct EpiSwiGLU {
    static constexpr bool PERM = true, AFTER_DRAIN = false, STREAM_R = false, STREAM_BF16 = false;
    bf16_t* O; int ldc; const float* SSQ; float eps;
    __device__ __forceinline__ void operator()(const f32x4 (&acc)[2][2][4][2], const Unit& u, int wr, int wc, int fr, int fq) const {
        const int row0 = u.pm * BM + wr * 64 + fr, col0 = u.pn * HALF + wc * 32 + 8 * fq;
        f32x4 sv[4];
        { const f32x4* sp = (const f32x4*)(SSQ + (size_t)row0 * 16); sv[0] = sp[0]; sv[1] = sp[1]; sv[2] = sp[2]; sv[3] = sp[3]; }
#pragma unroll
        for (int grp = 0; grp < 8; ++grp) { const int ai = grp >> 2, m = grp & 3; const int row = row0 + ai * HALF + m * 16;
            const f32x4 t = (sv[0] + sv[1]) + (sv[2] + sv[3]);
            const float rs = __builtin_amdgcn_rsqf(((t[0] + t[1]) + (t[2] + t[3])) * (1.0f / 1024.0f) + eps);
            if (grp < 7) { const int rown = row0 + ((grp + 1) >> 2) * HALF + ((grp + 1) & 3) * 16; const f32x4* sp = (const f32x4*)(SSQ + (size_t)rown * 16); sv[0] = sp[0]; sv[1] = sp[1]; sv[2] = sp[2]; sv[3] = sp[3]; }
            float h[8];
#pragma unroll
            for (int n = 0; n < 2; ++n)
#pragma unroll
                for (int j = 0; j < 4; ++j) { const float g = acc[ai][0][m][n][j] * rs, up = acc[ai][1][m][n][j] * rs; h[n * 4 + j] = fast_silu(g) * up; }
            u32x4 w; w.x = cvt_pk_bf16(h[0], h[1]); w.y = cvt_pk_bf16(h[2], h[3]); w.z = cvt_pk_bf16(h[4], h[5]); w.w = cvt_pk_bf16(h[6], h[7]);
            st16(O + (size_t)row * ldc + col0, w); }
    }
};
struct EpiResidOut {
    static constexpr bool PERM = true, AFTER_DRAIN = false, STREAM_R = false, STREAM_BF16 = false;
    const float* R; float* OUT;
    __device__ __forceinline__ void operator()(const f32x4 (&acc)[2][2][4][2], const Unit& u, int wr, int wc, int fr, int fq) const {
        const int row0 = u.pm * BM + wr * 64 + fr, col0 = u.pn * BM + wc * 32 + 8 * fq;
#pragma unroll
        for (int ai = 0; ai < 2; ++ai)
#pragma unroll
            for (int m = 0; m < 4; ++m) { const size_t off = (size_t)(row0 + ai * HALF + m * 16) * 1024 + col0;
#pragma unroll
                for (int bj = 0; bj < 2; ++bj) { const f32x4 r0 = *(const f32x4*)(R + off + bj * HALF), r1 = *(const f32x4*)(R + off + bj * HALF + 4);
                    *(f32x4*)(OUT + off + bj * HALF) = r0 + acc[ai][bj][m][0]; *(f32x4*)(OUT + off + bj * HALF + 4) = r1 + acc[ai][bj][m][1]; } }
    }
};
struct EpiResidNormB {
    static constexpr bool PERM = true, AFTER_DRAIN = false, STREAM_R = false, STREAM_BF16 = false;
    const float* X; bf16_t* HB; float* SSQ;
    __device__ __forceinline__ void operator()(const f32x4 (&acc)[2][2][4][2], const Unit& u, int wr, int wc, int fr, int fq) const {
        const int row0 = u.pm * BM + wr * 64 + fr, col0 = u.pn * BM + wc * 32 + 8 * fq;
#pragma unroll
        for (int ai = 0; ai < 2; ++ai)
#pragma unroll
            for (int m = 0; m < 4; ++m) { const int row = row0 + ai * HALF + m * 16; const size_t off = (size_t)row * 1024 + col0; float ss = 0.f;
#pragma unroll
                for (int bj = 0; bj < 2; ++bj) { const f32x4 x0 = *(const f32x4*)(X + off + bj * HALF), x1 = *(const f32x4*)(X + off + bj * HALF + 4);
                    const f32x4 v0 = x0 + acc[ai][bj][m][0], v1 = x1 + acc[ai][bj][m][1];
                    u32x4 w; w.x = cvt_pk_bf16(v0[0], v0[1]); w.y = cvt_pk_bf16(v0[2], v0[3]); w.z = cvt_pk_bf16(v1[0], v1[1]); w.w = cvt_pk_bf16(v1[2], v1[3]);
                    *(u32x4*)(HB + off + bj * HALF) = w;
                    ss += (v0[0] * v0[0] + v0[1] * v0[1]) + (v0[2] * v0[2] + v0[3] * v0[3]) + (v1[0] * v1[0] + v1[1] * v1[1]) + (v1[2] * v1[2] + v1[3] * v1[3]); }
                ss += __shfl_xor(ss, 16); ss += __shfl_xor(ss, 32);
                if (fq == 0) SSQ[(size_t)row * 16 + u.pn * 4 + wc] = ss; }
    }
};
struct EpiResidOutB {
    static constexpr bool PERM = true, AFTER_DRAIN = false, STREAM_R = false, STREAM_BF16 = false;
    const bf16_t* RB; float* OUT;
    __device__ __forceinline__ void operator()(const f32x4 (&acc)[2][2][4][2], const Unit& u, int wr, int wc, int fr, int fq) const {
        const int row0 = u.pm * BM + wr * 64 + fr, col0 = u.pn * BM + wc * 32 + 8 * fq;
#pragma unroll
        for (int ai = 0; ai < 2; ++ai) {
            u32x4 rw[4][2];
#pragma unroll
            for (int m = 0; m < 4; ++m) { const size_t off = (size_t)(row0 + ai * HALF + m * 16) * 1024 + col0;
#pragma unroll
                for (int bj = 0; bj < 2; ++bj) rw[m][bj] = *(const u32x4*)(RB + off + bj * HALF); }
#pragma unroll
            for (int m = 0; m < 4; ++m) { const size_t off = (size_t)(row0 + ai * HALF + m * 16) * 1024 + col0;
#pragma unroll
                for (int bj = 0; bj < 2; ++bj) { const u32x4 w = rw[m][bj];
                    const f32x4 r0 = (f32x4){__builtin_bit_cast(float, w.x << 16), __builtin_bit_cast(float, w.x & 0xffff0000u), __builtin_bit_cast(float, w.y << 16), __builtin_bit_cast(float, w.y & 0xffff0000u)};
                    const f32x4 r1 = (f32x4){__builtin_bit_cast(float, w.z << 16), __builtin_bit_cast(float, w.z & 0xffff0000u), __builtin_bit_cast(float, w.w << 16), __builtin_bit_cast(float, w.w & 0xffff0000u)};
                    *(f32x4*)(OUT + off + bj * HALF) = r0 + acc[ai][bj][m][0]; *(f32x4*)(OUT + off + bj * HALF + 4) = r1 + acc[ai][bj][m][1]; } }
            asm volatile("" ::: "memory");
        }
    }
};
struct EpiResidNormBS {
    static constexpr bool PERM = true, AFTER_DRAIN = false, STREAM_R = true, STREAM_BF16 = false;
    const float* RS; bf16_t* HB; float* SSQ;
    __device__ __forceinline__ void operator()(const f32x4 (&acc)[2][2][4][2], const Unit& u, int wr, int wc, int fr, int fq) const {
        { int t_ = threadIdx.x; asm volatile("" : "+v"(t_)); fr = t_ & 15; fq = (t_ >> 4) & 3; }
        const int row0 = u.pm * BM + wr * 64 + fr, col0 = u.pn * BM + wc * 32 + 8 * fq;
#pragma unroll
        for (int ai = 0; ai < 2; ++ai)
#pragma unroll
            for (int m = 0; m < 4; ++m) { const int row = row0 + ai * HALF + m * 16; const size_t off = (size_t)row * 1024 + col0; float ss = 0.f;
#pragma unroll
                for (int bj = 0; bj < 2; ++bj) { const f32x4 v0 = acc[ai][bj][m][0], v1 = acc[ai][bj][m][1];
                    u32x4 w; w.x = cvt_pk_bf16(v0[0], v0[1]); w.y = cvt_pk_bf16(v0[2], v0[3]); w.z = cvt_pk_bf16(v1[0], v1[1]); w.w = cvt_pk_bf16(v1[2], v1[3]);
                    st16(HB + off + bj * HALF, w);
                    ss += (v0[0] * v0[0] + v0[1] * v0[1]) + (v0[2] * v0[2] + v0[3] * v0[3]) + (v1[0] * v1[0] + v1[1] * v1[1]) + (v1[2] * v1[2] + v1[3] * v1[3]); }
                ss += __shfl_xor(ss, 16); ss += __shfl_xor(ss, 32);
                if (fq == 0) SSQ[(size_t)row * 16 + u.pn * 4 + wc] = ss; }
    }
};
struct EpiResidOutBS {
    static constexpr bool PERM = true, AFTER_DRAIN = false, STREAM_R = true, STREAM_BF16 = true;
    const bf16_t* RS; float* OUT;
    __device__ __forceinline__ void operator()(const f32x4 (&acc)[2][2][4][2], const Unit& u, int wr, int wc, int fr, int fq) const {
        { int t_ = threadIdx.x; asm volatile("" : "+v"(t_)); fr = t_ & 15; fq = (t_ >> 4) & 3; }
        const int row0 = u.pm * BM + wr * 64 + fr, col0 = u.pn * BM + wc * 32 + 8 * fq;
#pragma unroll
        for (int ai = 0; ai < 2; ++ai)
#pragma unroll
            for (int m = 0; m < 4; ++m) { const size_t off = (size_t)(row0 + ai * HALF + m * 16) * 1024 + col0;
#pragma unroll
                for (int bj = 0; bj < 2; ++bj) { *(f32x4*)(OUT + off + bj * HALF) = acc[ai][bj][m][0]; *(f32x4*)(OUT + off + bj * HALF + 4) = acc[ai][bj][m][1]; } }
    }
};
template <class Epi, class Sched, bool ALIGN_EPI = false, bool SP2 = false>
__device__ __forceinline__ void gemm_phase(PG8_LAS unsigned char* lds, const Gemm g, const Sched& S, const Epi& E) {
    const int tid = threadIdx.x, wid = __builtin_amdgcn_readfirstlane(tid >> 6), lane = tid & 63, wr = wid >> 2, wc = wid & 3, fr = lane & 15, fq = lane >> 4;
    const int K = g.K, nt = K / BK;
    unsigned voffA[2], voffB[2];
#pragma unroll
    for (int i = 0; i < 2; ++i) { int R, C; stage_rc(tid * 16 + i * 8192, R, C); const int Rb = Epi::PERM ? ((R & ~31) + perm32(R & 31)) : R;
        voffA[i] = (unsigned)(R * K + C) * 2u; voffB[i] = (unsigned)(Rb * K + C) * 2u; }
    const size_t kstep = (size_t)(BK * 2);
    const size_t hstep = (size_t)HALF * K * 2;
    const size_t tstep = 2 * hstep;
    const unsigned ldsw = (unsigned)wid * 1024u;
    const int aoff = lds_byte(wr * 64 + fr, fq * 8), boff = lds_byte(wc * 32 + fr, fq * 8);
#define PG8_SA(b, h) (((b) * 2 + (h)) * HTB)
#define PG8_SB(b, h) ((4 + (b) * 2 + (h)) * HTB)
#define PG8_STAGE(bufoff, gbase, voff) do { _Pragma("unroll") for (int _i = 0; _i < 2; ++_i) \
        __builtin_amdgcn_global_load_lds((const unsigned*)((const char*)(gbase) + (voff)[_i]), (PG8_LAS unsigned*)(lds + (bufoff) + ldsw + _i * 8192), 16, 0, 0); } while (0)
#define PG8_LDA(dst, b, h) do { _Pragma("unroll") for (int m = 0; m < 4; ++m) _Pragma("unroll") for (int k = 0; k < 2; ++k) dst[m][k] = *(const PG8_LAS bf16x8*)(lds + PG8_SA(b, h) + aoff + m * 2048 + k * 1024); } while (0)
#define PG8_LDB(dst, b, h) do { _Pragma("unroll") for (int n = 0; n < 2; ++n) _Pragma("unroll") for (int k = 0; k < 2; ++k) dst[n][k] = *(const PG8_LAS bf16x8*)(lds + PG8_SB(b, h) + boff + n * 2048 + k * 1024); } while (0)
#define PG8_MMA(ai, bj, At, Bt) do { __builtin_amdgcn_s_setprio(1); _Pragma("unroll") for (int m = 0; m < 4; ++m) _Pragma("unroll") for (int n = 0; n < 2; ++n) _Pragma("unroll") for (int k = 0; k < 2; ++k) \
        acc[ai][bj][m][n] = __builtin_amdgcn_mfma_f32_16x16x32_bf16(Bt[n][k], At[m][k], acc[ai][bj][m][n], 0, 0, 0); __builtin_amdgcn_s_setprio(0); } while (0)
#define PG8_WAIT_V(n) asm volatile("s_waitcnt vmcnt(" #n ")" ::: "memory")
#define PG8_WAIT_L(n) asm volatile("s_waitcnt lgkmcnt(" #n ")" ::: "memory")
#define PG8_BAR __builtin_amdgcn_s_barrier()
#define PG8_SCHED __builtin_amdgcn_sched_barrier(0)
#define PG8_PIECE_OFF 147456
#define PG8_RLOAD_P(p) do { if constexpr (Epi::STREAM_BF16) { const char* pa_ = rcur + (size_t)((((((p) >> 3) & 1) * HALF + (((p) >> 1) & 3) * 16) * 1024 + ((p) & 1) * HALF) * 2) + (rvoff >> 1); \
            __builtin_amdgcn_global_load_lds((const unsigned*)pa_, (PG8_LAS unsigned*)(lds + PG8_PIECE_OFF + wid * 2048), 16, 0, 0); \
        } else { const char* pa_ = rcur + (size_t)((((((p) >> 3) & 1) * HALF + (((p) >> 1) & 3) * 16) * 1024 + ((p) & 1) * HALF) * 4) + rvoff; \
            __builtin_amdgcn_global_load_lds((const unsigned*)pa_, (PG8_LAS unsigned*)(lds + PG8_PIECE_OFF + wid * 2048), 16, 0, 0); \
            __builtin_amdgcn_global_load_lds((const unsigned*)(pa_ + 16), (PG8_LAS unsigned*)(lds + PG8_PIECE_OFF + wid * 2048 + 1024), 16, 0, 0); } } while (0)
#define PG8_RADD_P(p) do { if constexpr (Epi::STREAM_BF16) { typedef unsigned u32x2_ __attribute__((ext_vector_type(2))); \
            { const u32x2_ w_ = *(const PG8_LAS u32x2_*)(lds + PG8_PIECE_OFF + wid * 2048 + lane * 16); \
              acc[((p) >> 3) & 1][(p) & 1][((p) >> 1) & 3][0] += (f32x4){__builtin_bit_cast(float, w_.x << 16), __builtin_bit_cast(float, w_.x & 0xffff0000u), __builtin_bit_cast(float, w_.y << 16), __builtin_bit_cast(float, w_.y & 0xffff0000u)}; } \
            asm volatile("" ::: "memory"); \
            { const u32x2_ w_ = *(const PG8_LAS u32x2_*)(lds + PG8_PIECE_OFF + wid * 2048 + lane * 16 + 8); \
              acc[((p) >> 3) & 1][(p) & 1][((p) >> 1) & 3][1] += (f32x4){__builtin_bit_cast(float, w_.x << 16), __builtin_bit_cast(float, w_.x & 0xffff0000u), __builtin_bit_cast(float, w_.y << 16), __builtin_bit_cast(float, w_.y & 0xffff0000u)}; } \
        } else { { const f32x4 q0_ = *(const PG8_LAS f32x4*)(lds + PG8_PIECE_OFF + wid * 2048 + lane * 16); acc[((p) >> 3) & 1][(p) & 1][((p) >> 1) & 3][0] += q0_; } asm volatile("" ::: "memory"); \
        { const f32x4 q1_ = *(const PG8_LAS f32x4*)(lds + PG8_PIECE_OFF + wid * 2048 + 1024 + lane * 16); acc[((p) >> 3) & 1][(p) & 1][((p) >> 1) & 3][1] += q1_; } } } while (0)
#define PG8_WAIT_V1P() do { if constexpr (Epi::STREAM_BF16) PG8_WAIT_V(9); else PG8_WAIT_V(10); } while (0)
#define PG8_KPAIR(t, P0_, P1_) do { \
            const bool last = ((t) == nt - 2); \
            const char* a1 = cA + (size_t)((t) + 1) * kstep; \
            const char* a2 = last ? nA : cA + (size_t)((t) + 2) * kstep; const char* b2 = last ? nB : cB + (size_t)((t) + 2) * kstep; \
            const char* a3 = a2 + kstep; const char* b3 = b2 + kstep; \
            if (last && has_next) S.a_ready(nxt); \
            if constexpr ((P0_) >= 0) PG8_RLOAD_P(P0_); \
            PG8_LDB(B0, 0, 0); PG8_LDB(B1, 0, 1); PG8_SCHED; PG8_LDA(At, 0, 0); PG8_STAGE(PG8_SA(1, 1), a1 + hstep, voffA); \
            if constexpr ((P0_) >= 0) PG8_WAIT_V1P(); else PG8_WAIT_V(8); \
            PG8_WAIT_L(0); PG8_BAR; PG8_MMA(0, 0, At, B0); PG8_MMA(0, 1, At, B1); PG8_BAR; PG8_SCHED; \
            PG8_LDA(At, 0, 1); PG8_STAGE(PG8_SB(0, 0), b2, voffB); PG8_STAGE(PG8_SB(0, 1), b2 + hstep, voffB); PG8_STAGE(PG8_SA(0, 0), a2, voffA); \
            PG8_WAIT_V(8); PG8_WAIT_L(0); PG8_BAR; if constexpr ((P0_) >= 0) PG8_RADD_P(P0_); PG8_MMA(1, 0, At, B0); PG8_MMA(1, 1, At, B1); PG8_BAR; PG8_SCHED; \
            if constexpr ((P1_) >= 0) PG8_RLOAD_P(P1_); \
            PG8_LDB(B0, 1, 0); PG8_LDB(B1, 1, 1); PG8_SCHED; PG8_LDA(At, 1, 0); PG8_STAGE(PG8_SA(0, 1), a2 + hstep, voffA); \
            if constexpr ((P1_) >= 0) PG8_WAIT_V1P(); else PG8_WAIT_V(8); \
            PG8_WAIT_L(0); PG8_BAR; PG8_MMA(0, 0, At, B0); PG8_MMA(0, 1, At, B1); PG8_BAR; PG8_SCHED; \
            PG8_LDA(At, 1, 1); PG8_STAGE(PG8_SB(1, 0), b3, voffB); PG8_STAGE(PG8_SB(1, 1), b3 + hstep, voffB); PG8_STAGE(PG8_SA(1, 0), a3, voffA); \
            PG8_WAIT_V(8); PG8_WAIT_L(0); PG8_BAR; if constexpr ((P1_) >= 0) PG8_RADD_P(P1_); PG8_MMA(1, 0, At, B0); PG8_MMA(1, 1, At, B1); PG8_BAR; PG8_SCHED; \
        } while (0)
    Unit cur, nxt; int ui = 0;
    if (!S.next(0, cur)) return;
    f32x4 acc[2][2][4][2];
#pragma unroll
    for (int a = 0; a < 2; ++a)
#pragma unroll
        for (int b = 0; b < 2; ++b)
#pragma unroll
            for (int m = 0; m < 4; ++m)
#pragma unroll
                for (int n = 0; n < 2; ++n) acc[a][b][m][n] = (f32x4){0.f, 0.f, 0.f, 0.f};
    bf16x8 At[4][2], B0[2][2], B1[2][2];
    const char* rcur = nullptr;
    const unsigned rvoff = (unsigned)(((wr * 64 + fr) * 1024 + wc * 32 + 8 * fq) * 4);
#define PG8_RCUR(u_) do { if constexpr (Epi::STREAM_R) rcur = (const char*)E.RS + ((size_t)((u_).pm * BM) * 1024 + (u_).pn * BM) * (Epi::STREAM_BF16 ? 2 : 4); } while (0)
    PG8_RCUR(cur);
    const char* cA = (const char*)g.A + (size_t)cur.pm * tstep; const char* cB = (const char*)g.Bt + (size_t)cur.pn * tstep;
    S.a_ready(cur);
    if constexpr (SP2) {
        PG8_STAGE(PG8_SB(0, 0), cB, voffB); PG8_STAGE(PG8_SB(0, 1), cB + hstep, voffB); PG8_STAGE(PG8_SA(0, 0), cA, voffA); PG8_STAGE(PG8_SA(0, 1), cA + hstep, voffA);
        if (wr == 1) PG8_BAR;
        PG8_WAIT_V(2); PG8_BAR;
        PG8_STAGE(PG8_SB(1, 0), cB + kstep, voffB); PG8_STAGE(PG8_SA(1, 0), cA + kstep, voffA); PG8_STAGE(PG8_SB(1, 1), cB + hstep + kstep, voffB);
        PG8_WAIT_V(6); PG8_BAR;
    } else {
        PG8_STAGE(PG8_SB(0, 0), cB, voffB); PG8_STAGE(PG8_SA(0, 0), cA, voffA); PG8_STAGE(PG8_SB(0, 1), cB + hstep, voffB); PG8_STAGE(PG8_SA(0, 1), cA + hstep, voffA);
        if (wr == 1) PG8_BAR;
        PG8_WAIT_V(4); PG8_BAR;
        PG8_STAGE(PG8_SB(1, 0), cB + kstep, voffB); PG8_STAGE(PG8_SA(1, 0), cA + kstep, voffA); PG8_STAGE(PG8_SB(1, 1), cB + hstep + kstep, voffB);
        PG8_WAIT_V(6); PG8_BAR;
    }
    for (;;) {
        const bool has_next = S.next(ui + 1, nxt);
        const char* nA = has_next ? (const char*)g.A + (size_t)nxt.pm * tstep : cA; const char* nB = has_next ? (const char*)g.Bt + (size_t)nxt.pn * tstep : cB;
        if constexpr (SP2 && Epi::STREAM_R) {
            PG8_KPAIR(0, 0, 1); PG8_KPAIR(2, 2, 3); PG8_KPAIR(4, 4, 5); PG8_KPAIR(6, 6, 7); PG8_KPAIR(8, 8, 9); PG8_KPAIR(10, 10, 11); PG8_KPAIR(12, 12, 13); PG8_KPAIR(14, 14, 15);
#pragma unroll 1
            for (int t = 16; t < nt; t += 2) PG8_KPAIR(t, -1, -1);
        } else
        for (int t = 0; t < nt; t += 2) {
            const bool last = (t == nt - 2);
            const char* a1 = cA + (size_t)(t + 1) * kstep;
            const char* a2 = last ? nA : cA + (size_t)(t + 2) * kstep; const char* b2 = last ? nB : cB + (size_t)(t + 2) * kstep;
            const char* a3 = a2 + kstep; const char* b3 = b2 + kstep;
            if (last && has_next) S.a_ready(nxt);
            if constexpr (SP2) {
            PG8_LDB(B0, 0, 0); PG8_LDB(B1, 0, 1); PG8_SCHED; PG8_LDA(At, 0, 0); PG8_STAGE(PG8_SA(1, 1), a1 + hstep, voffA);
            PG8_WAIT_V(8); PG8_WAIT_L(0); PG8_BAR; PG8_MMA(0, 0, At, B0); PG8_MMA(0, 1, At, B1); PG8_BAR; PG8_SCHED;
            PG8_LDA(At, 0, 1); PG8_STAGE(PG8_SB(0, 0), b2, voffB); PG8_STAGE(PG8_SB(0, 1), b2 + hstep, voffB); PG8_STAGE(PG8_SA(0, 0), a2, voffA);
            PG8_WAIT_V(8); PG8_WAIT_L(0); PG8_BAR; PG8_MMA(1, 0, At, B0); PG8_MMA(1, 1, At, B1); PG8_BAR; PG8_SCHED;
            PG8_LDB(B0, 1, 0); PG8_LDB(B1, 1, 1); PG8_SCHED; PG8_LDA(At, 1, 0); PG8_STAGE(PG8_SA(0, 1), a2 + hstep, voffA);
            PG8_WAIT_V(8); PG8_WAIT_L(0); PG8_BAR; PG8_MMA(0, 0, At, B0); PG8_MMA(0, 1, At, B1); PG8_BAR; PG8_SCHED;
            PG8_LDA(At, 1, 1); PG8_STAGE(PG8_SB(1, 0), b3, voffB); PG8_STAGE(PG8_SB(1, 1), b3 + hstep, voffB); PG8_STAGE(PG8_SA(1, 0), a3, voffA);
            PG8_WAIT_V(8); PG8_WAIT_L(0); PG8_BAR; PG8_MMA(1, 0, At, B0); PG8_MMA(1, 1, At, B1); PG8_BAR; PG8_SCHED;
            } else {
            PG8_LDB(B0, 0, 0); PG8_SCHED; PG8_LDA(At, 0, 0); PG8_STAGE(PG8_SA(1, 1), a1 + hstep, voffA);
            PG8_WAIT_L(8); PG8_BAR; PG8_WAIT_L(0); PG8_MMA(0, 0, At, B0); PG8_BAR; PG8_SCHED;
            PG8_LDB(B1, 0, 1); PG8_STAGE(PG8_SB(0, 0), b2, voffB);
            PG8_BAR; PG8_WAIT_L(0); PG8_MMA(0, 1, At, B1); PG8_BAR;
            PG8_LDA(At, 0, 1); PG8_STAGE(PG8_SA(0, 0), a2, voffA);
            PG8_BAR; PG8_WAIT_L(0); PG8_MMA(1, 0, At, B0); PG8_BAR; PG8_SCHED;
            PG8_STAGE(PG8_SB(0, 1), b2 + hstep, voffB);
            PG8_WAIT_V(6); PG8_BAR; PG8_MMA(1, 1, At, B1); PG8_BAR;
            PG8_LDB(B0, 1, 0); PG8_SCHED; PG8_LDA(At, 1, 0); PG8_STAGE(PG8_SA(0, 1), a2 + hstep, voffA);
            PG8_WAIT_L(8); PG8_BAR; PG8_WAIT_L(0); PG8_MMA(0, 0, At, B0); PG8_BAR; PG8_SCHED;
            PG8_LDB(B1, 1, 1); PG8_STAGE(PG8_SB(1, 0), b3, voffB);
            PG8_BAR; PG8_WAIT_L(0); PG8_MMA(0, 1, At, B1); PG8_BAR;
            PG8_LDA(At, 1, 1); PG8_STAGE(PG8_SA(1, 0), a3, voffA);
            PG8_BAR; PG8_WAIT_L(0); PG8_MMA(1, 0, At, B0); PG8_BAR; PG8_SCHED;
            PG8_STAGE(PG8_SB(1, 1), b3 + hstep, voffB);
            PG8_WAIT_V(6); PG8_BAR; PG8_MMA(1, 1, At, B1); PG8_BAR;
            }
        }
        if constexpr (ALIGN_EPI) { if (wr == 0) PG8_BAR; }
        if constexpr (!Epi::AFTER_DRAIN) { E(acc, cur, wr, wc, fr, fq); S.done(cur); }
        if (!has_next) break;
#pragma unroll
        for (int a = 0; a < 2; ++a)
#pragma unroll
            for (int b = 0; b < 2; ++b)
#pragma unroll
                for (int m = 0; m < 4; ++m)
#pragma unroll
                    for (int n = 0; n < 2; ++n) acc[a][b][m][n] = (f32x4){0.f, 0.f, 0.f, 0.f};
        cur = nxt; cA = nA; cB = nB; ++ui; PG8_RCUR(cur);
        if constexpr (ALIGN_EPI) { if (wr == 1) PG8_BAR; }
    }
    PG8_WAIT_V(0);
    if constexpr (!ALIGN_EPI) { if (wr == 0) PG8_BAR; }
    PG8_BAR;
    if constexpr (Epi::AFTER_DRAIN) { E.fused(acc, cur, wr, wc, fr, fq, lds, wid, lane); S.done(cur); }
#undef PG8_SA
#undef PG8_SB
#undef PG8_STAGE
#undef PG8_LDA
#undef PG8_LDB
#undef PG8_MMA
#undef PG8_WAIT_V
#undef PG8_WAIT_L
#undef PG8_BAR
#undef PG8_SCHED
#undef PG8_PIECE_OFF
#undef PG8_RLOAD_P
#undef PG8_WAIT_V1P
#undef PG8_RADD_P
#undef PG8_KPAIR
#undef PG8_RCUR
}
}
constexpr int NWAVES = 8;
constexpr int NB = 8, SEQ = 4096, T = NB * SEQ, DM = 1024, DIN = 2824, DFF = 2816, NPROJ = 2816;
constexpr int SRC_MI = 2048;
constexpr int PC_MQ = 0, PC_MK = 512, PC_MV = 1024, PC_MO = 1536, PC_AQ = 2048, PC_AK = 2560, PC_AV = 2688;
constexpr float EPS = 1e-6f;
constexpr size_t MiB = 1u << 20;
constexpr size_t WS_CTL = 0, CTL_ZERO_BYTES = 1 * MiB;
constexpr size_t WS_WIN = 1 * MiB;
constexpr size_t WS_WOUT = 7 * MiB;
constexpr size_t WS_WGU = 9 * MiB;
constexpr size_t WS_WDN = 20 * MiB;
constexpr size_t WS_ROPE = 26 * MiB;
constexpr size_t WS_WBG = 26 * MiB + 512 * 1024;
constexpr size_t WS_GATES = 27 * MiB;
constexpr size_t WS_SSQ = 28 * MiB;
constexpr size_t WS_SEG = 30 * MiB;
constexpr size_t WS_XN = 48 * MiB;
constexpr size_t WS_MIX = 112 * MiB;
constexpr size_t WS_PROJ = 176 * MiB;
constexpr size_t WS_END = 352 * MiB;
constexpr int CW_BAR = 4096;
constexpr int RING_BYTES = 131072;
constexpr int LDSCTL_OFF = RING_BYTES, MISC_OFF = LDSCTL_OFF + 320;
constexpr int LDS_BYTES = 163840;

#define GAS __attribute__((address_space(1)))
#define LAS __attribute__((address_space(3)))
typedef unsigned short bf16;
typedef unsigned v4u __attribute__((ext_vector_type(4)));
typedef unsigned v2u __attribute__((ext_vector_type(2)));
typedef float f32x2v __attribute__((ext_vector_type(2)));
typedef float f32x4 __attribute__((ext_vector_type(4)));
typedef short bf16x8 __attribute__((ext_vector_type(8)));
typedef GAS unsigned gu32;
#define RLX_AGENT __ATOMIC_RELAXED, __HIP_MEMORY_SCOPE_AGENT
#define LDS_WAIT() asm volatile("s_waitcnt lgkmcnt(0)" ::: "memory")
#define VM_WAIT() asm volatile("s_waitcnt vmcnt(0)" ::: "memory")
__device__ __forceinline__ unsigned f2bf(float f) { unsigned u = __builtin_bit_cast(unsigned, f); return (u + 0x7fffu + ((u >> 16) & 1u)) >> 16; }
__device__ __forceinline__ unsigned pk2(float lo, float hi) { return f2bf(lo) | (f2bf(hi) << 16); }
__device__ __forceinline__ float bf2f(unsigned short b) { return __builtin_bit_cast(float, (unsigned)b << 16); }
__device__ __forceinline__ float bflo(unsigned w) { return __builtin_bit_cast(float, w << 16); }
__device__ __forceinline__ float bfhi(unsigned w) { return __builtin_bit_cast(float, w & 0xffff0000u); }
__device__ __forceinline__ float wave_sum(float v) {
#pragma unroll
    for (int o = 1; o < 64; o <<= 1) v += __shfl_xor(v, o);
    return v;
}
__device__ __forceinline__ float wave_max(float v) {
#pragma unroll
    for (int o = 1; o < 64; o <<= 1) v = fmaxf(v, __shfl_xor(v, o));
    return v;
}
__device__ __forceinline__ void unpack8(const v4u w, float* o) { o[0] = bflo(w.x); o[1] = bfhi(w.x); o[2] = bflo(w.y); o[3] = bfhi(w.y); o[4] = bflo(w.z); o[5] = bfhi(w.z); o[6] = bflo(w.w); o[7] = bfhi(w.w); }
#define XB_TMO      128
#define XB_XCNT(j)  (256  + 64 * (j))
#define XB_XSUB(j)  (1280 + 64 * (j))
#define XB_XGEN(j)  (2304 + 64 * (j))
#define XB_TOP      3328
#define XB_TOPGEN   3392
#define XCD_BAR_WORDS 3456
#define XB_SPIN_CAP (1u << 18)

__device__ __forceinline__ unsigned xb_ld(unsigned* p)              { return __hip_atomic_load(p, __ATOMIC_RELAXED, __HIP_MEMORY_SCOPE_AGENT); }
__device__ __forceinline__ unsigned xb_add(unsigned* p, unsigned v) { return __hip_atomic_fetch_add(p, v, __ATOMIC_RELAXED, __HIP_MEMORY_SCOPE_AGENT); }
__device__ __forceinline__ unsigned xb_xcc_id() { return (unsigned)__builtin_amdgcn_s_getreg((3 << 11) | 20) & 0xFu; }
#define XB_SPIN(cond, bar) do { unsigned _sp = 0; while (cond) { __builtin_amdgcn_s_sleep(1); \
    if ((++_sp & 255u) == 0u) { if (xb_ld(&(bar)[XB_TMO])) break; if (_sp > XB_SPIN_CAP) { atomicAdd(&(bar)[XB_TMO], 1u); break; } } } } while (0)

struct XcdBarrier {
    unsigned* bar; unsigned x;
    volatile LAS unsigned* st;
};

__device__ __forceinline__ XcdBarrier xcd_barrier_post(unsigned* bar, volatile LAS unsigned* st) {
    XcdBarrier b; b.bar = bar; b.x = xb_xcc_id(); b.st = st;
    if (threadIdx.x == 0) (void)xb_add(&bar[XB_XCNT(b.x)], 1u);
    return b;
}
__device__ __forceinline__ void xcd_barrier_complete(unsigned* bar, unsigned x, unsigned& nloc, unsigned& nx) {
    const unsigned G = gridDim.x * gridDim.y * gridDim.z;
    unsigned sum, cnt, mine, sp = 0u;
    for (;;) {
        sum = 0u; cnt = 0u; mine = 0u;
#pragma unroll
        for (unsigned j = 0; j < 16; ++j) { const unsigned c = xb_ld(&bar[XB_XCNT(j)]); sum += c; cnt += (c > 0u) ? 1u : 0u; mine = (j == x) ? c : mine; }
        if (sum == G) break;
        __builtin_amdgcn_s_sleep(1);
        if ((++sp & 255u) == 0u) { if (xb_ld(&bar[XB_TMO])) break; if (sp > XB_SPIN_CAP) { atomicAdd(&bar[XB_TMO], 1u); break; } }
    }
    nloc = mine > 0u ? mine : 1u; nx = cnt > 0u ? cnt : 1u;
}

__device__ __forceinline__ void xcd_barrier(const XcdBarrier& b) {
    asm volatile("s_waitcnt vmcnt(0)" ::: "memory");
    __syncthreads();
    if (threadIdx.x == 0) {
        unsigned* bar = b.bar;
        __builtin_amdgcn_s_waitcnt(0);
        unsigned nloc = b.st[0], nx = b.st[1];
        if (nloc == 0u) { xcd_barrier_complete(bar, b.x, nloc, nx); b.st[0] = nloc; b.st[1] = nx; }
        const unsigned old = xb_add(&bar[XB_XSUB(b.x)], 1u);
        const unsigned gen = old / nloc;
        if (old + 1u == (gen + 1u) * nloc) {
            __builtin_amdgcn_fence(__ATOMIC_RELEASE, "agent");
            asm volatile("s_waitcnt vmcnt(0)" ::: "memory");
            const unsigned og = xb_add(&bar[XB_TOP], 1u);
            const unsigned tg = og / nx;
            if (og + 1u == (tg + 1u) * nx) xb_add(&bar[XB_TOPGEN], 1u);
            else XB_SPIN(xb_ld(&bar[XB_TOPGEN]) == tg, bar);
            __builtin_amdgcn_fence(__ATOMIC_ACQUIRE, "agent");
            xb_add(&bar[XB_XGEN(b.x)], 1u);
            asm volatile("s_waitcnt vmcnt(0)" ::: "memory");
        } else {
            XB_SPIN(xb_ld(&bar[XB_XGEN(b.x)]) == gen, bar);
            __builtin_amdgcn_fence(__ATOMIC_ACQUIRE, "agent");
            asm volatile("s_waitcnt vmcnt(0)" ::: "memory");
        }
    }
    __syncthreads();
}
#define H1_BF16 1
#ifndef P5_ALIGN
#define P5_ALIGN true
#endif
#define PHASE2_BODY do { mlstm_phase<1>(F); swa_phase(F); } while (0)
#define PHASE3_BODY mlstm_phase<2>(F)
#define LAUNCH_MK(lo_, hi_) do { a.ph_lo = (lo_); a.ph_hi = (hi_); a.li = (lo_); hipLaunchKernelGGL(mk_fwd, dim3(grid), dim3(NWAVES * 64), LDS_BYTES, stream, a); } while (0)
#define LAUNCH_PROGRAM { LAUNCH_MK(0, 7); }
struct Frame {
    LAS unsigned char* lds;
    volatile LAS unsigned* MISC;
    gu32* ctl;
    int tid, lane, wave, vcu, G;
    const float *x, *norm1_g, *w_in, *conv_w, *igate_b, *fgate_b, *mlstm_norm_g, *q_norm_g, *k_norm_g, *sinks, *w_out, *norm2_g, *w_gate, *w_up, *w_down;
    float* out;
    bf16 *Win_t, *Wout_t, *Wgu_t, *Wdn_t, *XN, *MIX, *PROJ;
    float2* ROPE; float* GATES; float* SSQ; float* SEG; unsigned char* WBG;
};

struct P0Item { const float* W; int ldw, src_col0; const float* kscale; bf16* WT; int Kd, dst_row0, kb; };
template <bool SCALE> __device__ __forceinline__ void p0_item_load(const P0Item& I, float (&v)[32], int lane) {
    const int k0 = 64 * I.kb;
#pragma unroll
    for (int i = 0; i < 32; ++i) { const int kk = 2 * i + (lane >> 5); v[i] = I.W[(size_t)(k0 + kk) * I.ldw + I.src_col0 + (lane & 31)]; }
    if (SCALE) {
        float sc[32];
#pragma unroll
        for (int i = 0; i < 32; ++i) sc[i] = I.kscale[k0 + 2 * i + (lane >> 5)];
#pragma unroll
        for (int i = 0; i < 32; ++i) v[i] *= sc[i];
    }
}
__device__ __forceinline__ void p0_item_finish(const P0Item& I, const float (&v)[32], LAS float* scr, int lane) {
    const int k0 = 64 * I.kb;
#pragma unroll
    for (int i = 0; i < 32; ++i) { const int kk = 2 * i + (lane >> 5); scr[kk * 33 + (lane & 31)] = v[i]; }
    LDS_WAIT(); asm volatile("" ::: "memory");
    const int c = lane & 7;
#pragma unroll
    for (int j = 0; j < 4; ++j) { const int n = (lane >> 3) + 8 * j; const LAS float* s = scr + (8 * c) * 33 + n;
        v4u o; o.x = pk2(s[0 * 33], s[1 * 33]); o.y = pk2(s[2 * 33], s[3 * 33]); o.z = pk2(s[4 * 33], s[5 * 33]); o.w = pk2(s[6 * 33], s[7 * 33]);
        *(GAS v4u*)(I.WT + (size_t)(I.dst_row0 + n) * I.Kd + k0 + 8 * c) = o; }
    LDS_WAIT(); asm volatile("" ::: "memory");
}
constexpr int I_IN = 88 * 16, I_OUT = 32 * 16, I_GU = 176 * 16, I_DN = 32 * 44;
__device__ __forceinline__ P0Item p0_item_in(Frame& F, int r) { const int nb = r % 88, kb = r / 88; return P0Item{F.w_in, DIN, nb < 64 ? 32 * nb : 32 * nb + 8, nullptr, F.Win_t, DM, 32 * nb, kb}; }
__device__ __forceinline__ P0Item p0_item_gu(Frame& F, int r) { const int nb = r % 176, kb = r / 176, tile = nb >> 3, wi = nb & 7; const float* W = (wi < 4) ? F.w_gate : F.w_up;
    return P0Item{W, DFF, 128 * tile + 32 * (wi & 3), F.norm2_g, F.Wgu_t, DM, 32 * nb, kb}; }
__device__ __forceinline__ P0Item p0_item_od(Frame& F, int r) {
    if (r < I_OUT) { const int nb = r % 32, kb = r / 32; return P0Item{F.w_out, DM, 32 * nb, nullptr, F.Wout_t, DM, 32 * nb, kb}; } r -= I_OUT;
    { const int nb = r % 32, kb = r / 32; return P0Item{F.w_down, DM, 32 * nb, nullptr, F.Wdn_t, DFF, 32 * nb, kb}; }
}
__device__ __forceinline__ void p0_prologue(Frame& F) {
    LAS float* scr = (LAS float*)(F.lds + F.wave * 8704);
    const int gw = F.vcu * NWAVES + F.wave, NGW = F.G * NWAVES;
    for (int it = gw; it < I_IN; it += NGW) { const P0Item I = p0_item_in(F, it); float v[32]; p0_item_load<false>(I, v, F.lane); p0_item_finish(I, v, scr, F.lane); }
    if (F.vcu < 4) { const int idx = F.vcu * 512 + F.tid; const int ks = idx >> 6, ln = idx & 63, col = ln & 15, gq = ln >> 4;
        v4u o = (v4u){0u, 0u, 0u, 0u};
        if (col < 8) { const float* wp = F.w_in + (size_t)(32 * ks + 8 * gq) * DIN + SRC_MI + col;
            const float w0 = wp[0], w1 = wp[DIN], w2 = wp[2 * DIN], w3 = wp[3 * DIN], w4 = wp[4 * DIN], w5 = wp[5 * DIN], w6 = wp[6 * DIN], w7 = wp[7 * DIN];
            o.x = pk2(w0, w1); o.y = pk2(w2, w3); o.z = pk2(w4, w5); o.w = pk2(w6, w7); }
        ((v4u*)F.WBG)[idx] = o; }
    { const int idx = (F.vcu * NWAVES * 64) + F.tid;
      if (idx < SEQ * 8) { const int pos = idx >> 3, i = idx & 7;
        double f = 1.0; f = (i == 1) ? 0.19392274474868576 : f; f = (i == 2) ? 0.03760603093086393 : f; f = (i == 3) ? 0.007292664737217109 : f; f = (i == 4) ? 0.001414213562373095 : f;
        f = (i == 5) ? 0.0002742481756762073 : f; f = (i == 6) ? 5.318295896944988e-05 : f; f = (i == 7) ? 1.031338537721246e-05 : f;
        const float angf = (float)pos * (float)f; const double rev = (double)angf * 0.15915494309189535; const double fr = rev - __builtin_floor(rev + 0.5);
        const float rr = (float)(fr * 6.283185307179586); F.ROPE[idx] = make_float2(__cosf(rr), __sinf(rr)); } }
    f32x4 g1[4];
#pragma unroll
    for (int j = 0; j < 4; ++j) g1[j] = ((const f32x4*)F.norm1_g)[F.lane + 64 * j];
    f32x4 v[4];
    if (gw < T) {
#pragma unroll
        for (int j = 0; j < 4; ++j) v[j] = ((const GAS f32x4*)(F.x + (size_t)gw * DM))[F.lane + 64 * j];
    }
#pragma unroll 1
    for (int m = gw; m < T; m += NGW) {
        f32x4 c[4]; float s = 0.f;
#pragma unroll
        for (int j = 0; j < 4; ++j) { c[j] = v[j]; s += (c[j].x * c[j].x + c[j].y * c[j].y) + (c[j].z * c[j].z + c[j].w * c[j].w); }
        if (m + NGW < T) {
#pragma unroll
            for (int j = 0; j < 4; ++j) v[j] = ((const GAS f32x4*)(F.x + (size_t)(m + NGW) * DM))[F.lane + 64 * j];
        }
        const float rstd = __builtin_amdgcn_rsqf(wave_sum(s) * (1.f / DM) + EPS);
        GAS v2u* o8 = (GAS v2u*)(F.XN + (size_t)m * DM) + F.lane;
#pragma unroll
        for (int j = 0; j < 4; ++j) { const f32x4 y = c[j] * rstd * g1[j]; v2u w; w.x = pg8::cvt_pk_bf16(y.x, y.y); w.y = pg8::cvt_pk_bf16(y.z, y.w); o8[64 * j] = w; }
    }
}
__device__ __forceinline__ void convert_gu(Frame& F, int ii, int ni) {
    LAS float* scr = (LAS float*)(F.lds + F.wave * 8704);
    __syncthreads();
    const int igw = ii * NWAVES + F.wave, NIW = ni * NWAVES;
#pragma unroll 1
    for (int it = igw; it < I_GU; it += 2 * NIW) {
        const P0Item Ia = p0_item_gu(F, it); const bool two = it + NIW < I_GU; const P0Item Ib = p0_item_gu(F, two ? it + NIW : it);
        float va[32], vb[32]; p0_item_load<true>(Ia, va, F.lane); p0_item_load<true>(Ib, vb, F.lane);
        p0_item_finish(Ia, va, scr, F.lane); if (two) p0_item_finish(Ib, vb, scr, F.lane);
    }
}
__device__ __forceinline__ void convert_od(Frame& F, int ii, int ni) {
    LAS float* scr = (LAS float*)(F.lds + F.wave * 8704);
    const int igw = ii * NWAVES + F.wave, NIW = ni * NWAVES;
#pragma unroll 1
    for (int it = igw; it < I_OUT + I_DN; it += 2 * NIW) {
        const P0Item Ia = p0_item_od(F, it); const bool two = it + NIW < I_OUT + I_DN; const P0Item Ib = p0_item_od(F, two ? it + NIW : it);
        float va[32], vb[32]; p0_item_load<false>(Ia, va, F.lane); p0_item_load<false>(Ib, vb, F.lane);
        p0_item_finish(Ia, va, scr, F.lane); if (two) p0_item_finish(Ib, vb, scr, F.lane);
    }
}
__device__ __forceinline__ void p1_side_work(Frame& F, int ii, int ni) {
    LAS unsigned char* WB = F.lds + 73728;
    for (int idx = F.tid; idx < 2048; idx += NWAVES * 64) *(LAS v4u*)(WB + idx * 16) = ((const v4u*)F.WBG)[idx];
    __syncthreads();
    convert_od(F, ii, ni);
    const int igw = ii * NWAVES + F.wave, NIW = ni * NWAVES;
    const int l15 = F.lane & 15, g = F.lane >> 4;
    for (int blk = igw; blk < T / 16; blk += NIW) {
        const bf16* xp = F.XN + ((size_t)blk * 16 + l15) * DM + 8 * g;
        f32x4 acc = (f32x4){0.f, 0.f, 0.f, 0.f};
        bf16x8 a[32];
#pragma unroll
        for (int q = 0; q < 32; ++q) a[q] = *(const bf16x8*)(xp + 32 * q);
#pragma unroll
        for (int q = 0; q < 32; ++q) acc = __builtin_amdgcn_mfma_f32_16x16x32_bf16(a[q], *(const LAS bf16x8*)(WB + (q * 64 + F.lane) * 16), acc, 0, 0, 0);
        if (l15 < 8) {
#pragma unroll
            for (int r = 0; r < 4; ++r) F.GATES[((size_t)blk * 16 + 4 * g + r) * 8 + l15] = acc[r];
        }
    }
}

constexpr int SWA_KS = 0, SWA_KSTR = 144, SWA_VT = 36864, SWA_VSTR = 528;
typedef short bf16x4 __attribute__((ext_vector_type(4)));
#ifndef SWA_UNROLL
#define SWA_UNROLL 1
#endif
constexpr int SWA_TAB = 70656;
struct SwaKV { v4u k[4], v[4]; float2 cs[8]; };
struct SwaQ { v4u w0, w1; float2 cs[8]; };
__device__ __forceinline__ void swa_load_kv(Frame& F, int tid, int u, SwaKV& R) {
    const int blk = u & 31, kvh = (u >> 5) & 1, b = u >> 6; const int key = tid >> 1, half = tid & 1; const int kt = blk * 128 - 128 + key;
    if (kt >= 0) {
        const bf16* kp = F.PROJ + (size_t)(b * SEQ + kt) * NPROJ + PC_AK + kvh * 64 + 32 * half;
        const bf16* vp = F.PROJ + (size_t)(b * SEQ + kt) * NPROJ + PC_AV + kvh * 64 + 32 * half;
#pragma unroll
        for (int c = 0; c < 4; ++c) { R.k[c] = *(const v4u*)(kp + 8 * c); R.v[c] = *(const v4u*)(vp + 8 * c); }
#pragma unroll
        for (int i = 0; i < 8; ++i) R.cs[i] = F.ROPE[kt * 8 + i];
    } else {
#pragma unroll
        for (int c = 0; c < 4; ++c) { R.k[c] = (v4u){0u, 0u, 0u, 0u}; R.v[c] = (v4u){0u, 0u, 0u, 0u}; }
#pragma unroll
        for (int i = 0; i < 8; ++i) R.cs[i] = make_float2(1.f, 0.f);
    }
}
__device__ __forceinline__ void swa_load_q(Frame& F, int lane, int wave, int u, int rb, SwaQ& R) {
    const int blk = u & 31, kvh = (u >> 5) & 1, b = u >> 6; const int l15 = lane & 15, g = lane >> 4;
    const int hq = kvh * 4 + (wave >> 1), p0 = 64 * (wave & 1) + 16 * rb, tq = blk * 128 + p0 + l15;
    const bf16* qp = F.PROJ + (size_t)(b * SEQ + tq) * NPROJ + PC_AQ + hq * 64 + 8 * g;
    R.w0 = *(const v4u*)qp; R.w1 = *(const v4u*)(qp + 32);
#pragma unroll
    for (int j = 0; j < 8; ++j) R.cs[j] = F.ROPE[tq * 8 + j];
}
__device__ __forceinline__ void swa_phase(Frame& F) {
    LAS unsigned char* KS = F.lds + SWA_KS; LAS unsigned char* VT = F.lds + SWA_VT; LAS float* TAB = (LAS float*)(F.lds + SWA_TAB);
    const int wave = F.wave;
    int u = F.vcu;
    if (u >= NB * 2 * 32) return;
    __syncthreads();
    if (F.tid < 64) TAB[F.tid] = F.q_norm_g[F.tid]; else if (F.tid < 128) TAB[F.tid] = F.k_norm_g[F.tid - 64];
    SwaKV kv; SwaQ qr;
    swa_load_kv(F, F.tid, u, kv);
    swa_load_q(F, F.lane, wave, u, 0, qr);
#pragma unroll 1
    for (; u < NB * 2 * 32; u += F.G) {
        int tid = F.tid; asm volatile("" : "+v"(tid));
        const int lane = tid & 63, l15 = lane & 15, g = lane >> 4;
        const int blk = u & 31, kvh = (u >> 5) & 1, b = u >> 6;
        const int un = u + F.G; const bool has_next = un < NB * 2 * 32;
        __syncthreads();
        {
            const int key = tid >> 1, half = tid & 1;
            float kf[32];
#pragma unroll
            for (int c = 0; c < 4; ++c) unpack8(kv.k[c], kf + 8 * c);
            float ss = 0.f;
#pragma unroll
            for (int c = 0; c < 32; ++c) ss += kf[c] * kf[c];
            ss += __shfl_xor(ss, 1);
            const float rstd = __builtin_amdgcn_rsqf(ss * (1.f / 64.f) + EPS);
#pragma unroll
            for (int c = 0; c < 8; ++c) { const f32x4 gg = *(const LAS f32x4*)(TAB + 64 + 32 * half + 4 * c); kf[4 * c] *= rstd * gg[0]; kf[4 * c + 1] *= rstd * gg[1]; kf[4 * c + 2] *= rstd * gg[2]; kf[4 * c + 3] *= rstd * gg[3]; }
            if (half == 0) {
#pragma unroll
                for (int i = 0; i < 8; ++i) { const float2 cs = kv.cs[i]; const float x1 = kf[i], x2 = kf[8 + i]; kf[i] = x1 * cs.x - x2 * cs.y; kf[8 + i] = x2 * cs.x + x1 * cs.y; }
            }
#pragma unroll
            for (int c = 0; c < 4; ++c) { v4u o; o.x = pg8::cvt_pk_bf16(kf[8 * c], kf[8 * c + 1]); o.y = pg8::cvt_pk_bf16(kf[8 * c + 2], kf[8 * c + 3]); o.z = pg8::cvt_pk_bf16(kf[8 * c + 4], kf[8 * c + 5]); o.w = pg8::cvt_pk_bf16(kf[8 * c + 6], kf[8 * c + 7]);
                *(LAS v4u*)(KS + key * SWA_KSTR + 64 * half + 16 * c) = o; }
#pragma unroll
            for (int c = 0; c < 4; ++c) { const unsigned ww[4] = {kv.v[c].x, kv.v[c].y, kv.v[c].z, kv.v[c].w};
#pragma unroll
                for (int e = 0; e < 4; ++e) { const int d = 32 * half + 8 * c + 2 * e;
                    *(LAS unsigned short*)(VT + d * SWA_VSTR + key * 2) = (unsigned short)(ww[e] & 0xffffu);
                    *(LAS unsigned short*)(VT + (d + 1) * SWA_VSTR + key * 2) = (unsigned short)(ww[e] >> 16); } }
        }
        __syncthreads();
        if (has_next) swa_load_kv(F, tid, un, kv);
        const int hq = kvh * 4 + (wave >> 1);
        const float sink2 = F.sinks[hq] * 1.4426950408889634f;
        const float SC = 0.125f * 1.4426950408889634f;
#pragma unroll SWA_UNROLL
        for (int rb = 0; rb < 4; ++rb) {
            const int p0 = 64 * (wave & 1) + 16 * rb, j0 = p0 >> 4;
            const int tq = blk * 128 + p0 + l15;
            bf16x8 qf[2];
            {
                float q0[8], q1[8]; unpack8(qr.w0, q0); unpack8(qr.w1, q1);
                float ss = 0.f;
#pragma unroll
                for (int j = 0; j < 8; ++j) ss += q0[j] * q0[j] + q1[j] * q1[j];
                ss += __shfl_xor(ss, 16); ss += __shfl_xor(ss, 32);
                const float rstd = __builtin_amdgcn_rsqf(ss * (1.f / 64.f) + EPS);
#pragma unroll
                for (int c = 0; c < 2; ++c) { const f32x4 ga = *(const LAS f32x4*)(TAB + 8 * g + 4 * c), gb = *(const LAS f32x4*)(TAB + 32 + 8 * g + 4 * c);
#pragma unroll
                    for (int e = 0; e < 4; ++e) { q0[4 * c + e] *= rstd * ga[e]; q1[4 * c + e] *= rstd * gb[e]; } }
#pragma unroll
                for (int j = 0; j < 8; ++j) { const float other = __shfl_xor(q0[j], 16); const float2 cs = qr.cs[j];
                    const float r0 = q0[j] * cs.x - other * cs.y, r1 = q0[j] * cs.x + other * cs.y; q0[j] = (g == 0) ? r0 : ((g == 1) ? r1 : q0[j]); }
                v4u a, c2; a.x = pg8::cvt_pk_bf16(q0[0], q0[1]); a.y = pg8::cvt_pk_bf16(q0[2], q0[3]); a.z = pg8::cvt_pk_bf16(q0[4], q0[5]); a.w = pg8::cvt_pk_bf16(q0[6], q0[7]);
                c2.x = pg8::cvt_pk_bf16(q1[0], q1[1]); c2.y = pg8::cvt_pk_bf16(q1[2], q1[3]); c2.z = pg8::cvt_pk_bf16(q1[4], q1[5]); c2.w = pg8::cvt_pk_bf16(q1[6], q1[7]);
                qf[0] = __builtin_bit_cast(bf16x8, a); qf[1] = __builtin_bit_cast(bf16x8, c2);
            }
            if (rb < 3) swa_load_q(F, lane, wave, u, rb + 1, qr); else if (has_next) swa_load_q(F, lane, wave, un, 0, qr);
            f32x4 s[10];
    #pragma unroll
            for (int jj = 0; jj < 9; ++jj) { const int tile = j0 + jj;
                f32x4 acc = (f32x4){0.f, 0.f, 0.f, 0.f};
    #pragma unroll
                for (int ks = 0; ks < 2; ++ks) { const bf16x8 kfr = *(const LAS bf16x8*)(KS + (16 * tile + l15) * SWA_KSTR + 64 * ks + 16 * g);
                    acc = __builtin_amdgcn_mfma_f32_16x16x32_bf16(kfr, qf[ks], acc, 0, 0, 0); }
                s[jj] = acc; }
            s[9] = (f32x4){0.f, 0.f, 0.f, 0.f};
    #pragma unroll
            for (int r = 0; r < 4; ++r) { if (4 * g + r < 1 + l15) s[0][r] = -INFINITY; if (4 * g + r > l15) s[8][r] = -INFINITY; }
            if (blk == 0) {
    #pragma unroll
                for (int jj = 0; jj < 9; ++jj)
    #pragma unroll
                    for (int r = 0; r < 4; ++r) { if (16 * (j0 + jj) + 4 * g + r < 128) s[jj][r] = -INFINITY; }
            }
            float mx = -INFINITY;
    #pragma unroll
            for (int jj = 0; jj < 9; ++jj)
    #pragma unroll
                for (int r = 0; r < 4; ++r) mx = fmaxf(mx, s[jj][r]);
            mx = fmaxf(mx, __shfl_xor(mx, 16)); mx = fmaxf(mx, __shfl_xor(mx, 32)); mx = fmaxf(mx * SC, sink2);
            float sum = 0.f;
    #pragma unroll
            for (int jj = 0; jj < 9; ++jj)
    #pragma unroll
                for (int r = 0; r < 4; ++r) { const float p = __builtin_amdgcn_exp2f(__builtin_fmaf(s[jj][r], SC, -mx)); s[jj][r] = p; sum += p; }
            sum += __shfl_xor(sum, 16); sum += __shfl_xor(sum, 32);
            const float inv = 1.0f / (sum + __builtin_amdgcn_exp2f(sink2 - mx));
            f32x4 o[4];
    #pragma unroll
            for (int dt = 0; dt < 4; ++dt) o[dt] = (f32x4){0.f, 0.f, 0.f, 0.f};
    #pragma unroll
            for (int kk = 0; kk < 5; ++kk) {
                const int t0 = (j0 + 2 * kk) > 15 ? 15 : (j0 + 2 * kk), t1 = (j0 + 2 * kk + 1) > 15 ? 15 : (j0 + 2 * kk + 1);
                v4u pw; pw.x = pg8::cvt_pk_bf16(s[2 * kk][0], s[2 * kk][1]); pw.y = pg8::cvt_pk_bf16(s[2 * kk][2], s[2 * kk][3]); pw.z = pg8::cvt_pk_bf16(s[2 * kk + 1][0], s[2 * kk + 1][1]); pw.w = pg8::cvt_pk_bf16(s[2 * kk + 1][2], s[2 * kk + 1][3]);
                const bf16x8 pf = __builtin_bit_cast(bf16x8, pw);
    #pragma unroll
                for (int dt = 0; dt < 4; ++dt) {
                    const v2u a0 = *(const LAS v2u*)(VT + (16 * dt + l15) * SWA_VSTR + (16 * t0 + 4 * g) * 2);
                    const v2u a1 = *(const LAS v2u*)(VT + (16 * dt + l15) * SWA_VSTR + (16 * t1 + 4 * g) * 2);
                    v4u av; av.x = a0.x; av.y = a0.y; av.z = a1.x; av.w = a1.y;
                    o[dt] = __builtin_amdgcn_mfma_f32_16x16x32_bf16(__builtin_bit_cast(bf16x8, av), pf, o[dt], 0, 0, 0); }
            }
            bf16* op = F.MIX + (size_t)(b * SEQ + tq) * DM + 512 + hq * 64 + 4 * g;
    #pragma unroll
            for (int dt = 0; dt < 4; ++dt) { v2u w; w.x = pg8::cvt_pk_bf16(o[dt][0] * inv, o[dt][1] * inv); w.y = pg8::cvt_pk_bf16(o[dt][2] * inv, o[dt][3] * inv); *(v2u*)(op + 16 * dt) = w; }
        }
    }
}
constexpr int ML_QS = 0, ML_KS = 17408, ML_KWT = 34816, ML_VT = 53248, ML_PS = 71680, ML_CT = 80896, ML_F = 115712;
constexpr int ML_QSTR = 272, ML_TSTR = 144, ML_HSTR = 528;
constexpr int FDEN = 256, FN = 320;
constexpr int ML_GV = 132096, ML_GS = ML_GV + 8192, ML_CW = ML_GS + 256;
constexpr int SEG_STRIDE = 16640;
constexpr float LOG2E = 1.4426950408889634f;
__device__ __forceinline__ float silu_f(float v) { return v * __builtin_amdgcn_rcpf(1.0f + __builtin_amdgcn_exp2f(v * -LOG2E)); }
__device__ __forceinline__ float sigmoid_f(float v) { return __builtin_amdgcn_rcpf(1.0f + __builtin_amdgcn_exp2f(v * -LOG2E)); }
__device__ __forceinline__ float exp_f(float v) { return __builtin_amdgcn_exp2f(v * LOG2E); }

template <int PASS> __device__ __forceinline__ void mlstm_item(Frame& F, int b, int h, int sg) {
    const int wave = F.wave;
    int tid = F.tid; asm volatile("" : "+v"(tid));
    int lane = tid & 63, l15 = lane & 15, g4 = lane >> 4;
    LAS unsigned char* L = F.lds; LAS float* FL = (LAS float*)(L + ML_F);
    f32x4 C[8];
#pragma unroll
    for (int et = 0; et < 8; ++et) C[et] = (f32x4){0.f, 0.f, 0.f, 0.f};
    float m = -1e30f, Gsum = 0.f;
    LAS float* GV = (LAS float*)(L + ML_GV); LAS float* GS = (LAS float*)(L + ML_GS); LAS float* CW = (LAS float*)(L + ML_CW);
    __syncthreads();
    if (tid < 128) FL[FN + tid] = 0.f;
    for (int i = tid; i < 1024; i += NWAVES * 64) { const int j = i >> 8, ch = i & 255; CW[i] = F.conv_w[j * 1024 + (ch >> 7) * 512 + h * 128 + (ch & 127)]; }
    {
        const size_t tg = (size_t)b * SEQ + (size_t)(sg * 8 + wave) * 64 + lane;
        const float* gr = F.GATES + tg * 8;
        const float ig = gr[h] + F.igate_b[h], fg = gr[4 + h] + F.fgate_b[h];
        const float lf = fminf(fg, 0.f) - log1pf(__expf(-fabsf(fg)));
        float bs = lf;
#pragma unroll
        for (int o = 1; o < 64; o <<= 1) { const float t = __shfl_up(bs, o); if (lane >= o) bs += t; }
        const float gtot = __shfl(bs, 63);
        const float u = ig - bs;
        float pm = u;
#pragma unroll
        for (int o = 1; o < 64; o <<= 1) { const float t = __shfl_up(pm, o); if (lane >= o) pm = fmaxf(pm, t); }
        const float a = gtot + u;
        const float mloc = wave_max(a);
        GV[wave * 256 + lane] = bs; GV[wave * 256 + 64 + lane] = u; GV[wave * 256 + 128 + lane] = exp_f(a - mloc); GV[wave * 256 + 192 + lane] = pm;
        if (lane == 0) { GS[wave * 2] = gtot; GS[wave * 2 + 1] = mloc; }
    }
    if (PASS == 2 && sg > 0) {
        const float* E0 = F.SEG + (size_t)((b * 4 + h) * 8) * SEG_STRIDE;
        float lw[7]; float sfx = 0.f, mfin = -1e30f;
#pragma unroll
        for (int j = 6; j >= 0; --j) { const int jc = (j < sg) ? j : 0; const float mE = E0[(size_t)jc * SEG_STRIDE + 16384 + 128], G = E0[(size_t)jc * SEG_STRIDE + 16384 + 129];
            lw[j] = (j < sg) ? (mE + sfx) : -1e30f; sfx += (j < sg) ? G : 0.f; mfin = fmaxf(mfin, lw[j]); }
        float coef[7];
#pragma unroll
        for (int j = 0; j < 7; ++j) coef[j] = (j < sg) ? exp_f(lw[j] - mfin) : 0.f;
#pragma unroll 1
        for (int j = 0; j < sg; ++j) { const float* Ej = E0 + (size_t)j * SEG_STRIDE; float cj = coef[0];
#pragma unroll
            for (int q = 1; q < 7; ++q) cj = (j == q) ? coef[q] : cj;
#pragma unroll
            for (int et = 0; et < 8; ++et)
#pragma unroll
                for (int r = 0; r < 4; ++r) C[et][r] += cj * Ej[(unsigned)((16 * wave + 4 * g4 + r) * 128 + 16 * et + l15)];
            if (tid < 128) FL[FN + tid] += cj * Ej[16384 + tid]; }
        m = mfin;
    }
    if (PASS == 2) {
#pragma unroll
        for (int et = 0; et < 8; ++et) { v2u w; w.x = pg8::cvt_pk_bf16(C[et][0], C[et][1]); w.y = pg8::cvt_pk_bf16(C[et][2], C[et][3]); *(LAS v2u*)(L + ML_CT + (16 * et + l15) * ML_QSTR + (16 * wave + 4 * g4) * 2) = w; }
    }
    const float kscale = 0.08838834764831845f;
    v4u xr[7]; v4u vr[4];
#define ML_LOAD(cidx) do { const int c_ = (cidx); const size_t t0_ = (size_t)b * SEQ + (size_t)c_ * 64; \
        const int mat_ = tid >> 8, r8_ = tid & 255, dg_ = r8_ & 15, l0_ = 4 * (r8_ >> 4); \
        if (PASS == 2 || mat_ == 1) { const bf16* src_ = F.PROJ + (mat_ ? PC_MK : PC_MQ) + h * 128 + 8 * dg_; \
            _Pragma("unroll") for (int j = 0; j < 7; ++j) { const int lr = l0_ + j - 3; xr[j] = (c_ == 0 && lr < 0) ? (v4u){0u, 0u, 0u, 0u} : *(const v4u*)(src_ + (t0_ + lr) * NPROJ); } } \
        if (mat_ == 0) { _Pragma("unroll") for (int lp = 0; lp < 4; ++lp) vr[lp] = *(const v4u*)(F.PROJ + (t0_ + l0_ + lp) * NPROJ + PC_MV + h * 128 + 8 * dg_); } } while (0)
    ML_LOAD(sg * 8);
#pragma unroll 1
    for (int cc = 0; cc < 8; ++cc) {
        const int c = sg * 8 + cc; const size_t t0 = (size_t)b * SEQ + (size_t)c * 64;
        tid = F.tid; asm volatile("" : "+v"(tid));
        lane = tid & 63; l15 = lane & 15; g4 = lane >> 4;
        const int mat = tid >> 8, r8 = tid & 255, dg = r8 & 15, rg = r8 >> 4, l0 = 4 * rg;
        LAS float* GB = GV + cc * 256;
        __syncthreads();
        const float gtot = GS[cc * 2], mloc = GS[cc * 2 + 1];
        if (PASS == 2 || mat == 1) {
            const float w0 = GB[128 + l0], w1 = GB[128 + l0 + 1], w2 = GB[128 + l0 + 2], w3 = GB[128 + l0 + 3];
            unsigned ow[4][4];
            const LAS float* cwp = CW + mat * 128 + 8 * dg;
#pragma unroll
            for (int ip = 0; ip < 4; ++ip) {
                float ya[4], yb[4];
                const float ca0 = cwp[2 * ip], ca1 = cwp[256 + 2 * ip], ca2 = cwp[512 + 2 * ip], ca3 = cwp[768 + 2 * ip];
                const float cb0 = cwp[2 * ip + 1], cb1 = cwp[256 + 2 * ip + 1], cb2 = cwp[512 + 2 * ip + 1], cb3 = cwp[768 + 2 * ip + 1];
                float xa[7], xb[7];
#pragma unroll
                for (int j = 0; j < 7; ++j) { const unsigned w = (ip == 0) ? xr[j].x : (ip == 1) ? xr[j].y : (ip == 2) ? xr[j].z : xr[j].w; xa[j] = bflo(w); xb[j] = bfhi(w); }
#pragma unroll
                for (int lp = 0; lp < 4; ++lp) {
                    ya[lp] = silu_f(ca0 * xa[lp] + ca1 * xa[lp + 1] + ca2 * xa[lp + 2] + ca3 * xa[lp + 3]) * (mat ? kscale : 1.0f);
                    yb[lp] = silu_f(cb0 * xb[lp] + cb1 * xb[lp + 1] + cb2 * xb[lp + 2] + cb3 * xb[lp + 3]) * (mat ? kscale : 1.0f);
                    ow[lp][ip] = pg8::cvt_pk_bf16(ya[lp], yb[lp]); }
                if (mat == 1) {
                    v2u o; o.x = pg8::cvt_pk_bf16(ya[0] * w0, ya[1] * w1); o.y = pg8::cvt_pk_bf16(ya[2] * w2, ya[3] * w3); *(LAS v2u*)(L + ML_KWT + (8 * dg + 2 * ip) * ML_TSTR + l0 * 2) = o;
                    o.x = pg8::cvt_pk_bf16(yb[0] * w0, yb[1] * w1); o.y = pg8::cvt_pk_bf16(yb[2] * w2, yb[3] * w3); *(LAS v2u*)(L + ML_KWT + (8 * dg + 2 * ip + 1) * ML_TSTR + l0 * 2) = o; }
            }
            if (PASS == 2) {
                LAS unsigned char* dst = L + (mat ? ML_KS : ML_QS) + l0 * ML_QSTR + 16 * dg;
#pragma unroll
                for (int lp = 0; lp < 4; ++lp) { v4u o; o.x = ow[lp][0]; o.y = ow[lp][1]; o.z = ow[lp][2]; o.w = ow[lp][3]; *(LAS v4u*)(dst + lp * ML_QSTR) = o; }
            }
        }
        if (mat == 0) {
            const unsigned ww[4][4] = {{vr[0].x, vr[0].y, vr[0].z, vr[0].w}, {vr[1].x, vr[1].y, vr[1].z, vr[1].w}, {vr[2].x, vr[2].y, vr[2].z, vr[2].w}, {vr[3].x, vr[3].y, vr[3].z, vr[3].w}};
#pragma unroll
            for (int p = 0; p < 4; ++p) {
                v2u lo, hi;
                lo.x = (ww[0][p] & 0xffffu) | (ww[1][p] << 16); lo.y = (ww[2][p] & 0xffffu) | (ww[3][p] << 16);
                hi.x = (ww[0][p] >> 16) | (ww[1][p] & 0xffff0000u); hi.y = (ww[2][p] >> 16) | (ww[3][p] & 0xffff0000u);
                *(LAS v2u*)(L + ML_VT + (8 * dg + 2 * p) * ML_TSTR + l0 * 2) = lo;
                *(LAS v2u*)(L + ML_VT + (8 * dg + 2 * p + 1) * ML_TSTR + l0 * 2) = hi; }
        }
        __syncthreads();
        if (cc < 7) ML_LOAD(c + 1);
        v4u mo2[2];
        if (PASS == 2) {
#pragma unroll
            for (int it = 0; it < 2; ++it) mo2[it] = *(const v4u*)(F.PROJ + (t0 + 8 * wave + 4 * it + g4) * NPROJ + PC_MO + h * 128 + 8 * l15);
        }
        const float mn = fmaxf(gtot + m, mloc), so = exp_f(gtot + m - mn), sn = exp_f(mloc - mn);
        if (PASS == 2) {
            const int lt = wave >> 1;
#pragma unroll
            for (int si = 0; si < 2; ++si) { const int st = 2 * (wave & 1) + si;
                v2u pw = (v2u){0u, 0u};
                if (st <= lt) {
                    f32x4 acc = (f32x4){0.f, 0.f, 0.f, 0.f};
#pragma unroll
                    for (int ks = 0; ks < 4; ++ks) { const bf16x8 a = *(const LAS bf16x8*)(L + ML_KS + (16 * st + l15) * ML_QSTR + 64 * ks + 16 * g4);
                        const bf16x8 bb = *(const LAS bf16x8*)(L + ML_QS + (16 * lt + l15) * ML_QSTR + 64 * ks + 16 * g4);
                        acc = __builtin_amdgcn_mfma_f32_16x16x32_bf16(a, bb, acc, 0, 0, 0); }
                    const int l = 16 * lt + l15, s0 = 16 * st + 4 * g4; const float bl = GB[l]; const float e0 = bl - (bl + fmaxf(GB[192 + l], m));
                    const f32x4 us = *(const LAS f32x4*)(GB + 64 + s0);
                    float p[4];
#pragma unroll
                    for (int r = 0; r < 4; ++r) { const float e = __builtin_amdgcn_exp2f((e0 + us[r]) * LOG2E); p[r] = (s0 + r <= l) ? acc[r] * e : 0.f; }
                    pw.x = pg8::cvt_pk_bf16(p[0], p[1]); pw.y = pg8::cvt_pk_bf16(p[2], p[3]);
                }
                *(LAS v2u*)(L + ML_PS + (16 * lt + l15) * ML_TSTR + (16 * st + 4 * g4) * 2) = pw;
            }
            __syncthreads();
            {
                const int row = 8 * wave + (lane >> 3), part = lane & 7;
                const v4u pw = *(const LAS v4u*)(L + ML_PS + row * ML_TSTR + 16 * part);
                float pf[8]; unpack8(pw, pf);
                float sp = ((pf[0] + pf[1]) + (pf[2] + pf[3])) + ((pf[4] + pf[5]) + (pf[6] + pf[7]));
                const v4u q0 = *(const LAS v4u*)(L + ML_QS + row * ML_QSTR + 32 * part), q1 = *(const LAS v4u*)(L + ML_QS + row * ML_QSTR + 32 * part + 16);
                float qf[16]; unpack8(q0, qf); unpack8(q1, qf + 8);
                float qn = 0.f;
#pragma unroll
                for (int i = 0; i < 16; ++i) qn += qf[i] * FL[FN + 16 * part + i];
                const float bl = GB[row]; const float mrow = bl + fmaxf(GB[192 + row], m); const float sc = exp_f(bl + m - mrow);
                float tot = sp + sc * qn;
                tot += __shfl_xor(tot, 1); tot += __shfl_xor(tot, 2); tot += __shfl_xor(tot, 4);
                if (part == 0) FL[FDEN + row] = fmaxf(fabsf(tot), exp_f(-mrow));
            }
            const int eh = wave & 1;
            f32x4 o1[4], o2[4];
#pragma unroll
            for (int ei = 0; ei < 4; ++ei) { const int et = 4 * eh + ei;
                f32x4 a1 = (f32x4){0.f, 0.f, 0.f, 0.f}, a2 = (f32x4){0.f, 0.f, 0.f, 0.f};
#pragma unroll
                for (int ks = 0; ks < 2; ++ks) { const bf16x8 a = *(const LAS bf16x8*)(L + ML_VT + (16 * et + l15) * ML_TSTR + 64 * ks + 16 * g4);
                    const bf16x8 bb = *(const LAS bf16x8*)(L + ML_PS + (16 * lt + l15) * ML_TSTR + 64 * ks + 16 * g4);
                    a1 = __builtin_amdgcn_mfma_f32_16x16x32_bf16(a, bb, a1, 0, 0, 0); }
#pragma unroll
                for (int ks = 0; ks < 4; ++ks) { const bf16x8 a = *(const LAS bf16x8*)(L + ML_CT + (16 * et + l15) * ML_QSTR + 64 * ks + 16 * g4);
                    const bf16x8 bb = *(const LAS bf16x8*)(L + ML_QS + (16 * lt + l15) * ML_QSTR + 64 * ks + 16 * g4);
                    a2 = __builtin_amdgcn_mfma_f32_16x16x32_bf16(a, bb, a2, 0, 0, 0); }
                o1[ei] = a1; o2[ei] = a2; }
            __syncthreads();
            {
                const int l = 16 * lt + l15; const float bl = GB[l]; const float mrow = bl + fmaxf(GB[192 + l], m); const float sc = exp_f(bl + m - mrow);
                const float inv = 1.0f / FL[FDEN + l];
#pragma unroll
                for (int ei = 0; ei < 4; ++ei) { const int et = 4 * eh + ei; const f32x4 hv = (o1[ei] + o2[ei] * sc) * inv;
                    *(LAS f32x4*)(L + l * ML_HSTR + (16 * et + 4 * g4) * 4) = hv; }
            }
        }
        {
            bf16x8 af[2];
#pragma unroll
            for (int ks = 0; ks < 2; ++ks) af[ks] = *(const LAS bf16x8*)(L + ML_KWT + (16 * wave + l15) * ML_TSTR + 64 * ks + 16 * g4);
#pragma unroll
            for (int et = 0; et < 8; ++et) { f32x4 d = (f32x4){0.f, 0.f, 0.f, 0.f};
#pragma unroll
                for (int ks = 0; ks < 2; ++ks) { const bf16x8 bb = *(const LAS bf16x8*)(L + ML_VT + (16 * et + l15) * ML_TSTR + 64 * ks + 16 * g4);
                    d = __builtin_amdgcn_mfma_f32_16x16x32_bf16(af[ks], bb, d, 0, 0, 0); }
                C[et] = C[et] * so + d * sn; }
            if (tid < 128) { float dn = 0.f;
#pragma unroll
                for (int q = 0; q < 8; ++q) { const v4u w = *(const LAS v4u*)(L + ML_KWT + tid * ML_TSTR + 16 * q); float f[8]; unpack8(w, f); dn += ((f[0] + f[1]) + (f[2] + f[3])) + ((f[4] + f[5]) + (f[6] + f[7])); }
                FL[FN + tid] = so * FL[FN + tid] + sn * dn; }
            m = mn; Gsum += gtot;
            if (PASS == 2) {
#pragma unroll
                for (int et = 0; et < 8; ++et) { v2u w; w.x = pg8::cvt_pk_bf16(C[et][0], C[et][1]); w.y = pg8::cvt_pk_bf16(C[et][2], C[et][3]); *(LAS v2u*)(L + ML_CT + (16 * et + l15) * ML_QSTR + (16 * wave + 4 * g4) * 2) = w; }
            }
        }
        if (PASS == 2) {
            __syncthreads();
            const f32x4 gg0 = *(const f32x4*)(F.mlstm_norm_g + h * 128 + 8 * l15), gg1 = *(const f32x4*)(F.mlstm_norm_g + h * 128 + 8 * l15 + 4);
#pragma unroll
            for (int it = 0; it < 2; ++it) { const int l = 8 * wave + 4 * it + g4;
                const f32x4 h0 = *(const LAS f32x4*)(L + l * ML_HSTR + l15 * 32), h1 = *(const LAS f32x4*)(L + l * ML_HSTR + l15 * 32 + 16);
                float ss = (h0[0] * h0[0] + h0[1] * h0[1]) + (h0[2] * h0[2] + h0[3] * h0[3]) + (h1[0] * h1[0] + h1[1] * h1[1]) + (h1[2] * h1[2] + h1[3] * h1[3]);
                ss += __shfl_xor(ss, 1); ss += __shfl_xor(ss, 2); ss += __shfl_xor(ss, 4); ss += __shfl_xor(ss, 8);
                const float rstd = __builtin_amdgcn_rsqf(ss * (1.f / 128.f) + EPS);
                float mo[8]; unpack8(mo2[it], mo);
                const f32x4 y0 = h0 * gg0 * rstd, y1 = h1 * gg1 * rstd;
                v4u o; o.x = pg8::cvt_pk_bf16(y0[0] * sigmoid_f(mo[0]), y0[1] * sigmoid_f(mo[1])); o.y = pg8::cvt_pk_bf16(y0[2] * sigmoid_f(mo[2]), y0[3] * sigmoid_f(mo[3]));
                o.z = pg8::cvt_pk_bf16(y1[0] * sigmoid_f(mo[4]), y1[1] * sigmoid_f(mo[5])); o.w = pg8::cvt_pk_bf16(y1[2] * sigmoid_f(mo[6]), y1[3] * sigmoid_f(mo[7]));
                *(v4u*)(F.MIX + (t0 + l) * DM + h * 128 + 8 * l15) = o; }
        }
    }
    if (PASS == 1) {
        tid = F.tid; asm volatile("" : "+v"(tid)); lane = tid & 63; l15 = lane & 15; g4 = lane >> 4;
        float* E = F.SEG + (size_t)((b * 4 + h) * 8 + sg) * SEG_STRIDE;
#pragma unroll
        for (int et = 0; et < 8; ++et)
#pragma unroll
            for (int r = 0; r < 4; ++r) E[(16 * wave + 4 * g4 + r) * 128 + 16 * et + l15] = C[et][r];
        if (tid < 128) E[16384 + tid] = FL[FN + tid];
        if (tid == 0) { E[16384 + 128] = m; E[16384 + 129] = Gsum; }
    }
}
template <int PASS> __device__ __forceinline__ void mlstm_phase(Frame& F) {
    for (int it = F.vcu; it < NB * 4 * 8; it += F.G) { const int sg = it & 7, h = (it >> 3) & 3, b = it >> 5;
        if (PASS == 1 && sg == 7) { convert_gu(F, it >> 3, NB * 4); continue; }
        mlstm_item<PASS>(F, b, h, sg); }
}
struct Args { const float* in[15]; float* out; unsigned char* ws; int ph_lo, ph_hi, li, pad; };
__global__ void __launch_bounds__(NWAVES * 64, 2) mk_fwd(Args args) {
    extern __shared__ __attribute__((aligned(16))) unsigned char lds[];
    Frame F;
    F.lds = (LAS unsigned char*)lds;
    F.MISC = (volatile LAS unsigned*)(F.lds + MISC_OFF);
    F.tid = threadIdx.x; F.lane = F.tid & 63; F.wave = __builtin_amdgcn_readfirstlane(F.tid >> 6);
    F.G = gridDim.x; { const int bx = blockIdx.x; F.vcu = (F.G % 8 == 0) ? (bx % 8) * (F.G / 8) + bx / 8 : bx; }
    unsigned char* ws = args.ws;
    F.ctl = (gu32*)(ws + WS_CTL);
    F.x = args.in[0]; F.norm1_g = args.in[1]; F.w_in = args.in[2]; F.conv_w = args.in[3]; F.igate_b = args.in[4]; F.fgate_b = args.in[5]; F.mlstm_norm_g = args.in[6];
    F.q_norm_g = args.in[7]; F.k_norm_g = args.in[8]; F.sinks = args.in[9]; F.w_out = args.in[10]; F.norm2_g = args.in[11]; F.w_gate = args.in[12]; F.w_up = args.in[13]; F.w_down = args.in[14];
    F.out = args.out;
    F.Win_t = (bf16*)(ws + WS_WIN); F.Wout_t = (bf16*)(ws + WS_WOUT); F.Wgu_t = (bf16*)(ws + WS_WGU); F.Wdn_t = (bf16*)(ws + WS_WDN);
    F.XN = (bf16*)(ws + WS_XN); F.MIX = (bf16*)(ws + WS_MIX); F.PROJ = (bf16*)(ws + WS_PROJ);
    F.ROPE = (float2*)(ws + WS_ROPE); F.GATES = (float*)(ws + WS_GATES); F.SSQ = (float*)(ws + WS_SSQ); F.SEG = (float*)(ws + WS_SEG); F.WBG = ws + WS_WBG;
    for (int u = F.tid; u < (LDS_BYTES - LDSCTL_OFF) / 4; u += NWAVES * 64) ((LAS unsigned*)(F.lds + LDSCTL_OFF))[u] = 0u;
    __syncthreads();
    const int lo = args.ph_lo, hi = args.ph_hi;
    XcdBarrier bar; bar.bar = (unsigned*)(F.ctl + CW_BAR) + args.li * XCD_BAR_WORDS; bar.x = 0; bar.st = nullptr;
    if (hi - lo > 1) bar = xcd_barrier_post((unsigned*)(F.ctl + CW_BAR) + args.li * XCD_BAR_WORDS, F.MISC + 8);
#define IN(k) (lo <= (k) && (k) < hi)
#define BOTH(k) (IN(k) && IN((k) + 1))
#define GRID_BAR() xcd_barrier(bar)

#ifndef DOUBLE_PHASE
#define DOUBLE_PHASE -1
#endif
#define RUN_PHASE(k, BODY) if (IN(k)) { { int t_ = threadIdx.x; asm volatile("" : "+v"(t_)); F.tid = t_; F.lane = t_ & 63; }     \
    BODY; if (DOUBLE_PHASE == (k)) { GRID_BAR(); BODY; } if (BOTH(k)) GRID_BAR(); }
#define PH0 p0_prologue(F)
#define PH1 do { pg8::Gemm g{F.XN, F.Win_t, T, NPROJ, DM}; pg8::StaticOrder S; S.init(T, NPROJ, F.G, (int)blockIdx.x); pg8::EpiStoreBf16 E{F.PROJ, NPROJ}; \
        pg8::gemm_phase<pg8::EpiStoreBf16, pg8::StaticOrder, true, true>(F.lds, g, S, E); \
        { const int nwg_ = (T / 256) * (NPROJ / 256), rem_ = nwg_ % F.G;               \
          if (rem_ == 0) p1_side_work(F, (int)blockIdx.x, F.G); else if ((int)blockIdx.x >= rem_) p1_side_work(F, (int)blockIdx.x - rem_, F.G - rem_); } } while (0)
#ifdef H1_BF16
#define PH4 do { pg8::Gemm g{F.MIX, F.Wout_t, T, DM, DM}; pg8::StaticOrder S; S.init(T, DM, F.G, (int)blockIdx.x); pg8::EpiResidNormBS E{F.x, F.XN, F.SSQ}; \
        pg8::gemm_phase<pg8::EpiResidNormBS, pg8::StaticOrder, true, true>(F.lds, g, S, E); } while (0)
#define PH6 do { pg8::Gemm g{F.PROJ, F.Wdn_t, T, DM, DFF}; pg8::StaticOrder S; S.init(T, DM, F.G, (int)blockIdx.x); pg8::EpiResidOutB E{F.XN, F.out}; \
        pg8::gemm_phase<pg8::EpiResidOutB, pg8::StaticOrder, true, true>(F.lds, g, S, E); } while (0)
#else
#define PH4 do { pg8::Gemm g{F.MIX, F.Wout_t, T, DM, DM}; pg8::StaticOrder S; S.init(T, DM, F.G, (int)blockIdx.x); pg8::EpiResidNorm E{F.x, F.out, F.XN, F.SSQ}; \
        pg8::gemm_phase<pg8::EpiResidNorm, pg8::StaticOrder, true, true>(F.lds, g, S, E); } while (0)
#define PH6 do { pg8::Gemm g{F.PROJ, F.Wdn_t, T, DM, DFF}; pg8::StaticOrder S; S.init(T, DM, F.G, (int)blockIdx.x); pg8::EpiResidOut E{F.out, F.out}; \
        pg8::gemm_phase<pg8::EpiResidOut, pg8::StaticOrder, true, true>(F.lds, g, S, E); } while (0)
#endif
#define PH5 do { pg8::Gemm g{F.XN, F.Wgu_t, T, 2 * DFF, DM}; pg8::StaticOrder S; S.init(T, 2 * DFF, F.G, (int)blockIdx.x); pg8::EpiSwiGLU E{F.PROJ, DFF, F.SSQ, EPS}; \
        pg8::gemm_phase<pg8::EpiSwiGLU, pg8::StaticOrder, P5_ALIGN, true>(F.lds, g, S, E); } while (0)
    RUN_PHASE(0, PH0)
    RUN_PHASE(1, PH1)
    RUN_PHASE(2, PHASE2_BODY)
    RUN_PHASE(3, PHASE3_BODY)
    RUN_PHASE(4, PH4)
    RUN_PHASE(5, PH5)
#if defined(PROBE_P6)
    if (IN(6)) { { pg8::Gemm g{F.PROJ, F.Wdn_t, T, DM, DFF}; pg8::StaticOrder S; S.init(T, DM, F.G, (int)blockIdx.x); pg8::EpiResidOutB E{F.XN, (float*)(ws + 352 * MiB)};
        pg8::gemm_phase<pg8::EpiResidOutB, pg8::StaticOrder, true, true>(F.lds, g, S, E); } GRID_BAR(); }
#endif
    RUN_PHASE(6, PH6)
#undef IN
#undef BOTH
}
namespace nv {
__device__ __forceinline__ float sigmoidf_(float x) { return 1.f / (1.f + __expf(-x)); }
__device__ __forceinline__ float siluf_(float x) { return x / (1.f + __expf(-x)); }
__global__ __launch_bounds__(128) void k_mlstm_rec(const bf16* __restrict__ proj, const float* __restrict__ gates, const float* __restrict__ conv_w, const float* __restrict__ igb, const float* __restrict__ fgb,
                                                   float* __restrict__ hm) {
    __shared__ float red[2][12];
    const int d = threadIdx.x, lane = d & 63, w = d >> 6;
    const int es = blockIdx.x & 15, h = (blockIdx.x >> 4) & 3, b = blockIdx.x >> 6;
    const int e0 = es * 8;
    const int cq = h * 128 + d, ck = 512 + h * 128 + d;
    float wq[4], wk[4];
#pragma unroll
    for (int j = 0; j < 4; ++j) { wq[j] = conv_w[j * 1024 + cq]; wk[j] = conv_w[j * 1024 + ck]; }
    const float ib = igb[h], fb = fgb[h];
    float C[8] = {}, n = 0.f, m = -1e30f;
    float q1 = 0.f, q2 = 0.f, q3 = 0.f, k1 = 0.f, k2 = 0.f, k3 = 0.f;
    const float kscale = 0.08838834764831845f;
    for (int t = 0; t < SEQ; ++t) {
        const bf16* row = proj + (size_t)(b * SEQ + t) * NPROJ;
        const float* gr = gates + (size_t)(b * SEQ + t) * 8;
        const float q0 = bf2f(row[PC_MQ + h * 128 + d]), k0 = bf2f(row[PC_MK + h * 128 + d]);
        const float qt = siluf_(wq[0] * q3 + wq[1] * q2 + wq[2] * q1 + wq[3] * q0);
        const float kt = siluf_(wk[0] * k3 + wk[1] * k2 + wk[2] * k1 + wk[3] * k0) * kscale;
        q3 = q2; q2 = q1; q1 = q0; k3 = k2; k2 = k1; k1 = k0;
        const float ig = gr[h] + ib, fg = gr[4 + h] + fb;
        const float lf = fminf(fg, 0.f) - log1pf(__expf(-fabsf(fg)));
        const float mn = fmaxf(lf + m, ig);
        const float so = __expf(lf + m - mn), sn = __expf(ig - mn);
        m = mn;
        float part[9];
#pragma unroll
        for (int e = 0; e < 8; ++e) { const float v = bf2f(row[PC_MV + h * 128 + e0 + e]); C[e] = so * C[e] + sn * kt * v; part[e] = qt * C[e]; }
        n = so * n + sn * kt; part[8] = qt * n;
#pragma unroll
        for (int e = 0; e < 9; ++e) part[e] = wave_sum(part[e]);
        __syncthreads();
        if (lane == 0) {
#pragma unroll
            for (int e = 0; e < 9; ++e) red[w][e] = part[e];
        }
        __syncthreads();
        if (d < 8) {
            const float num = red[0][d] + red[1][d], den = red[0][8] + red[1][8];
            hm[(size_t)(b * SEQ + t) * 512 + h * 128 + e0 + d] = num / fmaxf(fabsf(den), __expf(-mn));
        }
    }
}
__global__ __launch_bounds__(256) void k_mlstm_post(const float* __restrict__ hm, const bf16* __restrict__ proj, const float* __restrict__ g, bf16* __restrict__ mix) {
    const int gw = blockIdx.x * 4 + (threadIdx.x >> 6), lane = threadIdx.x & 63;
    const int t = gw >> 2, h = gw & 3;
    const float a0 = hm[(size_t)t * 512 + h * 128 + lane], a1 = hm[(size_t)t * 512 + h * 128 + 64 + lane];
    const float ss = wave_sum(a0 * a0 + a1 * a1);
    const float r = rsqrtf(ss * (1.f / 128.f) + EPS);
    const float o0 = bf2f(proj[(size_t)t * NPROJ + PC_MO + h * 128 + lane]), o1 = bf2f(proj[(size_t)t * NPROJ + PC_MO + h * 128 + 64 + lane]);
    mix[(size_t)t * DM + h * 128 + lane] = (bf16)f2bf(a0 * r * g[h * 128 + lane] * sigmoidf_(o0));
    mix[(size_t)t * DM + h * 128 + 64 + lane] = (bf16)f2bf(a1 * r * g[h * 128 + 64 + lane] * sigmoidf_(o1));
}
__global__ __launch_bounds__(256) void k_qknorm_rope(const bf16* __restrict__ proj, const float* __restrict__ qg, const float* __restrict__ kg, const float2* __restrict__ cs, float* __restrict__ qk) {
    const int gw = blockIdx.x * 4 + (threadIdx.x >> 6), lane = threadIdx.x & 63;
    const int t = gw / 10, j = gw % 10;
    const int pos = t & (SEQ - 1);
    const bf16* p = proj + (size_t)t * NPROJ + (j < 8 ? PC_AQ + j * 64 : PC_AK + (j - 8) * 64);
    const float x = bf2f(p[lane]);
    const float ss = wave_sum(x * x);
    float y = x * rsqrtf(ss * (1.f / 64.f) + EPS) * (j < 8 ? qg[lane] : kg[lane]);
    const float yp = __shfl_xor(y, 8);
    if (lane < 16) {
        const float2 c = cs[pos * 8 + (lane & 7)];
        y = (lane < 8) ? (y * c.x - yp * c.y) : (y * c.x + yp * c.y);
    }
    qk[(size_t)t * 640 + j * 64 + lane] = y;
}
__global__ __launch_bounds__(256) void k_swa(const float* __restrict__ qk, const bf16* __restrict__ proj, const float* __restrict__ sinks, bf16* __restrict__ mix) {
    __shared__ float sq[4][64];
    const int wv = threadIdx.x >> 6, lane = threadIdx.x & 63;
    const int gw = blockIdx.x * 4 + wv;
    const int t = gw >> 3, hq = gw & 7, hk = hq >> 2;
    const int pos = t & (SEQ - 1);
    sq[wv][lane] = qk[(size_t)t * 640 + hq * 64 + lane];
    __syncthreads();
    float sc[2];
#pragma unroll
    for (int r = 0; r < 2; ++r) {
        const int rel = lane + 64 * r;
        float s = -INFINITY;
        if (rel <= pos) {
            const float* kp = qk + (size_t)(t - rel) * 640 + 512 + hk * 64;
            float a = 0.f;
            for (int dd = 0; dd < 64; ++dd) a += sq[wv][dd] * kp[dd];
            s = a * 0.125f;
        }
        sc[r] = s;
    }
    const float snk = sinks[hq];
    const float mx = fmaxf(wave_max(fmaxf(sc[0], sc[1])), snk);
    const float p0 = __expf(sc[0] - mx), p1 = __expf(sc[1] - mx);
    const float den = wave_sum(p0 + p1) + __expf(snk - mx);
    float o = 0.f;
    for (int rel = 0; rel < 128; ++rel) {
        const float p = __shfl((rel < 64) ? p0 : p1, rel & 63);
        if (rel <= pos) o += p * bf2f(proj[(size_t)(t - rel) * NPROJ + PC_AV + hk * 64 + lane]);
    }
    mix[(size_t)t * DM + 512 + hq * 64 + lane] = (bf16)f2bf(o / den);
}
}
extern "C" void kernel_launch(void* const* d_in, const int* in_sizes, int n_in, void* d_out, int out_size, void* d_ws, size_t ws_size, hipStream_t stream) {
    static int grid = 0;
    if (grid == 0) {
        if (n_in != 15 || in_sizes[0] != T * DM || out_size != T * DM || ws_size < WS_END) { fprintf(stderr, "kernel_launch: unexpected shapes / workspace (n_in %d, ws %zu)\n", n_in, ws_size); grid = -1; return; }
        int dev = 0, cus = 0, per_cu = 0;
        if (hipGetDevice(&dev) != hipSuccess || hipDeviceGetAttribute(&cus, hipDeviceAttributeMultiprocessorCount, dev) != hipSuccess) { grid = -1; return; }
        if (hipFuncSetAttribute((const void*)mk_fwd, hipFuncAttributeMaxDynamicSharedMemorySize, LDS_BYTES) != hipSuccess) { fprintf(stderr, "kernel_launch: hipFuncSetAttribute failed\n"); grid = -1; return; }
        if (hipOccupancyMaxActiveBlocksPerMultiprocessor(&per_cu, (const void*)mk_fwd, NWAVES * 64, LDS_BYTES) != hipSuccess || per_cu < 1) { fprintf(stderr, "kernel_launch: occupancy query says %d blocks per CU\n", per_cu); grid = -1; (void)hipGetLastError(); return; }
        grid = cus;
    }
    if (grid < 0) return;
    (void)hipMemsetAsync((char*)d_ws + WS_CTL, 0, CTL_ZERO_BYTES, stream);
    Args a{};
    for (int i = 0; i < 15; ++i) a.in[i] = (const float*)d_in[i];
    a.out = (float*)d_out; a.ws = (unsigned char*)d_ws;
    LAUNCH_PROGRAM
}
```

```cpp
#include <hip/hip_runtime.h>
#include <cstdio>
#include <cstdint>
__device__ __forceinline__ int fresh_lane() { return (int)__builtin_amdgcn_mbcnt_hi(~0u, __builtin_amdgcn_mbcnt_lo(~0u, 0u)); }
namespace pg8 {
#define PG8_LAS __attribute__((address_space(3)))
typedef unsigned short bf16_t;
typedef short bf16x8 __attribute__((ext_vector_type(8)));
typedef float f32x4 __attribute__((ext_vector_type(4)));
typedef unsigned u32x4 __attribute__((ext_vector_type(4)));
constexpr int BM = 256, BK = 64, HALF = 128, HTB = HALF * BK * 2  , STAGE_BYTES = 8 * HTB, NXCD = 8, WGM = 8;

__host__ __device__ __forceinline__ int lds_byte(int r, int c) { const int st = (r >> 4) * 2 + (c >> 5), rr = r & 15, cc = c & 31, ob = rr * 64 + cc * 2; return st * 1024 + (ob ^ (((ob >> 9) & 1) << 5)); }
__host__ __device__ __forceinline__ void stage_rc(int b, int& R, int& C) { const int st = b / 1024, sb = b % 1024, swz = sb ^ (((sb >> 9) & 1) << 5); R = (st >> 1) * 16 + swz / 64; C = (st & 1) * 32 + (swz % 64) / 2; }
__host__ __device__ __forceinline__ int perm32(int rho) { const int n = rho >> 4, i = rho & 15; return 8 * (i >> 2) + 4 * n + (i & 3); }

struct Unit { int pm, pn; };
struct Gemm { const bf16_t* A; const bf16_t* Bt; int M, N, K; };

struct StaticOrder {
    int nM, nN, nwg, G, c;
    __host__ __device__ void init(int M, int N, int G_, int c_) { nM = M / BM; nN = N / BM; nwg = nM * nN; G = G_; c = c_; }
    __host__ __device__ bool next(int i, Unit& u) const {
        const long L = (long)i * G + c; if (L >= nwg) return false;
        int wgid = (int)L; { const int q = nwg / NXCD, r = nwg % NXCD, xcd = wgid % NXCD, off = wgid / NXCD; wgid = (xcd < r ? xcd * (q + 1) : r * (q + 1) + (xcd - r) * q) + off; }
        const int nig = WGM * nN, gid = wgid / nig, fm = gid * WGM, gsz = (nM - fm) < WGM ? (nM - fm) : WGM;
        u.pm = fm + ((wgid % nig) % gsz); u.pn = (wgid % nig) / gsz; return true;
    }
    __device__ __forceinline__ void a_ready(const Unit&) const {}
    __device__ __forceinline__ void done(const Unit&) const {}
};

__device__ __forceinline__ unsigned cvt_pk_bf16(float lo, float hi) { unsigned r; asm volatile("v_cvt_pk_bf16_f32 %0, %1, %2" : "=v"(r) : "v"(lo), "v"(hi)); return r; }
typedef float f32x2 __attribute__((ext_vector_type(2)));
#ifdef WT_STORES
__device__ __forceinline__ void st16(void* p, u32x4 v) { asm volatile("global_store_dwordx4 %0, %1, off sc1\n\ts_nop 1" :: "v"(p), "v"(v) : "memory"); }
#else
__device__ __forceinline__ void st16(void* p, u32x4 v) { *(u32x4*)p = v; }
#endif
__device__ __forceinline__ float fast_silu(float v) { return v * __builtin_amdgcn_rcpf(1.0f + __builtin_amdgcn_exp2f(v * -1.4426950408889634f)); }
struct EpiStoreBf16 {
    static constexpr bool PERM = true, AFTER_DRAIN = false, STREAM_R = false, STREAM_BF16 = false;
    bf16_t* O; int ldc;
    __device__ __forceinline__ void operator()(const f32x4 (&acc)[2][2][4][2], const Unit& u, int wr, int wc, int fr, int fq) const {
        const int row0 = u.pm * BM + wr * 64 + fr, col0 = u.pn * BM + wc * 32 + 8 * fq;
#pragma unroll
        for (int ai = 0; ai < 2; ++ai)
#pragma unroll
            for (int m = 0; m < 4; ++m) { bf16_t* rowp = O + (size_t)(row0 + ai * HALF + m * 16) * ldc + col0;
#pragma unroll
                for (int bj = 0; bj < 2; ++bj) { const f32x4 v0 = acc[ai][bj][m][0], v1 = acc[ai][bj][m][1];
                    u32x4 w; w.x = cvt_pk_bf16(v0[0], v0[1]); w.y = cvt_pk_bf16(v0[2], v0[3]); w.z = cvt_pk_bf16(v1[0], v1[1]); w.w = cvt_pk_bf16(v1[2], v1[3]);
                    st16(rowp + bj * HALF, w); } }
    }
};
struct EpiResidNorm {
    static constexpr bool PERM = true, AFTER_DRAIN = false, STREAM_R = false, STREAM_BF16 = false;
    const float* X; float* H; bf16_t* HB; float* SSQ;
    __device__ __forceinline__ void operator()(const f32x4 (&acc)[2][2][4][2], const Unit& u, int wr, int wc, int fr, int fq) const {
        const int row0 = u.pm * BM + wr * 64 + fr, col0 = u.pn * BM + wc * 32 + 8 * fq;
#pragma unroll
        for (int ai = 0; ai < 2; ++ai)
#pragma unroll
            for (int m = 0; m < 4; ++m) { const int row = row0 + ai * HALF + m * 16; const size_t off = (size_t)row * 1024 + col0; float ss = 0.f;
#pragma unroll
                for (int bj = 0; bj < 2; ++bj) { const f32x4 x0 = *(const f32x4*)(X + off + bj * HALF), x1 = *(const f32x4*)(X + off + bj * HALF + 4);
                    const f32x4 v0 = x0 + acc[ai][bj][m][0], v1 = x1 + acc[ai][bj][m][1];
                    *(f32x4*)(H + off + bj * HALF) = v0; *(f32x4*)(H + off + bj * HALF + 4) = v1;
                    u32x4 w; w.x = cvt_pk_bf16(v0[0], v0[1]); w.y = cvt_pk_bf16(v0[2], v0[3]); w.z = cvt_pk_bf16(v1[0], v1[1]); w.w = cvt_pk_bf16(v1[2], v1[3]);
                    *(u32x4*)(HB + off + bj * HALF) = w;
                    ss += (v0[0] * v0[0] + v0[1] * v0[1]) + (v0[2] * v0[2] + v0[3] * v0[3]) + (v1[0] * v1[0] + v1[1] * v1[1]) + (v1[2] * v1[2] + v1[3] * v1[3]); }
                ss += __shfl_xor(ss, 16); ss += __shfl_xor(ss, 32);
                if (fq == 0) SSQ[(size_t)row * 16 + u.pn * 4 + wc] = ss; }
    }
};
struct EpiSwiGLU {
    static constexpr bool PERM = true, AFTER_DRAIN = false, STREAM_R = false, STREAM_BF16 = false;
    bf16_t* O; int ldc; const float* SSQ; float eps;
    __device__ __forceinline__ void operator()(const f32x4 (&acc)[2][2][4][2], const Unit& u, int wr, int wc, int fr, int fq) const {
        const int row0 = u.pm * BM + wr * 64 + fr, col0 = u.pn * HALF + wc * 32 + 8 * fq;
        f32x4 sv[4];
        { const f32x4* sp = (const f32x4*)(SSQ + (size_t)row0 * 16); sv[0] = sp[0]; sv[1] = sp[1]; sv[2] = sp[2]; sv[3] = sp[3]; }
#pragma unroll
        for (int grp = 0; grp < 8; ++grp) { const int ai = grp >> 2, m = grp & 3; const int row = row0 + ai * HALF + m * 16;
            const f32x4 t = (sv[0] + sv[1]) + (sv[2] + sv[3]);
            const float rs = __builtin_amdgcn_rsqf(((t[0] + t[1]) + (t[2] + t[3])) * (1.0f / 1024.0f) + eps);
            if (grp < 7) { const int rown = row0 + ((grp + 1) >> 2) * HALF + ((grp + 1) & 3) * 16; const f32x4* sp = (const f32x4*)(SSQ + (size_t)rown * 16); sv[0] = sp[0]; sv[1] = sp[1]; sv[2] = sp[2]; sv[3] = sp[3]; }
            float h[8];
#pragma unroll
            for (int n = 0; n < 2; ++n)
#pragma unroll
                for (int j = 0; j < 4; ++j) { const float g = acc[ai][0][m][n][j] * rs, up = acc[ai][1][m][n][j] * rs; h[n * 4 + j] = fast_silu(g) * up; }
            u32x4 w; w.x = cvt_pk_bf16(h[0], h[1]); w.y = cvt_pk_bf16(h[2], h[3]); w.z = cvt_pk_bf16(h[4], h[5]); w.w = cvt_pk_bf16(h[6], h[7]);
            st16(O + (size_t)row * ldc + col0, w); }
    }
};
struct EpiResidOut {
    static constexpr bool PERM = true, AFTER_DRAIN = false, STREAM_R = false, STREAM_BF16 = false;
    const float* R; float* OUT;
    __device__ __forceinline__ void operator()(const f32x4 (&acc)[2][2][4][2], const Unit& u, int wr, int wc, int fr, int fq) const {
        const int row0 = u.pm * BM + wr * 64 + fr, col0 = u.pn * BM + wc * 32 + 8 * fq;
#pragma unroll
        for (int ai = 0; ai < 2; ++ai)
#pragma unroll
            for (int m = 0; m < 4; ++m) { const size_t off = (size_t)(row0 + ai * HALF + m * 16) * 1024 + col0;
#pragma unroll
                for (int bj = 0; bj < 2; ++bj) { const f32x4 r0 = *(const f32x4*)(R + off + bj * HALF), r1 = *(const f32x4*)(R + off + bj * HALF + 4);
                    *(f32x4*)(OUT + off + bj * HALF) = r0 + acc[ai][bj][m][0]; *(f32x4*)(OUT + off + bj * HALF + 4) = r1 + acc[ai][bj][m][1]; } }
    }
};
struct EpiResidNormB {
    static constexpr bool PERM = true, AFTER_DRAIN = false, STREAM_R = false, STREAM_BF16 = false;
    const float* X; bf16_t* HB; float* SSQ;
    __device__ __forceinline__ void operator()(const f32x4 (&acc)[2][2][4][2], const Unit& u, int wr, int wc, int fr, int fq) const {
        const int row0 = u.pm * BM + wr * 64 + fr, col0 = u.pn * BM + wc * 32 + 8 * fq;
#pragma unroll
        for (int ai = 0; ai < 2; ++ai)
#pragma unroll
            for (int m = 0; m < 4; ++m) { const int row = row0 + ai * HALF + m * 16; const size_t off = (size_t)row * 1024 + col0; float ss = 0.f;
#pragma unroll
                for (int bj = 0; bj < 2; ++bj) { const f32x4 x0 = *(const f32x4*)(X + off + bj * HALF), x1 = *(const f32x4*)(X + off + bj * HALF + 4);
                    const f32x4 v0 = x0 + acc[ai][bj][m][0], v1 = x1 + acc[ai][bj][m][1];
                    u32x4 w; w.x = cvt_pk_bf16(v0[0], v0[1]); w.y = cvt_pk_bf16(v0[2], v0[3]); w.z = cvt_pk_bf16(v1[0], v1[1]); w.w = cvt_pk_bf16(v1[2], v1[3]);
                    *(u32x4*)(HB + off + bj * HALF) = w;
                    ss += (v0[0] * v0[0] + v0[1] * v0[1]) + (v0[2] * v0[2] + v0[3] * v0[3]) + (v1[0] * v1[0] + v1[1] * v1[1]) + (v1[2] * v1[2] + v1[3] * v1[3]); }
                ss += __shfl_xor(ss, 16); ss += __shfl_xor(ss, 32);
                if (fq == 0) SSQ[(size_t)row * 16 + u.pn * 4 + wc] = ss; }
    }
};
struct EpiResidOutB {
    static constexpr bool PERM = true, AFTER_DRAIN = false, STREAM_R = false, STREAM_BF16 = false;
    const bf16_t* RB; float* OUT;
    __device__ __forceinline__ void operator()(const f32x4 (&acc)[2][2][4][2], const Unit& u, int wr, int wc, int fr, int fq) const {
        const int row0 = u.pm * BM + wr * 64 + fr, col0 = u.pn * BM + wc * 32 + 8 * fq;
#pragma unroll
        for (int ai = 0; ai < 2; ++ai) {
            u32x4 rw[4][2];
#pragma unroll
            for (int m = 0; m < 4; ++m) { const size_t off = (size_t)(row0 + ai * HALF + m * 16) * 1024 + col0;
#pragma unroll
                for (int bj = 0; bj < 2; ++bj) rw[m][bj] = *(const u32x4*)(RB + off + bj * HALF); }
#pragma unroll
            for (int m = 0; m < 4; ++m) { const size_t off = (size_t)(row0 + ai * HALF + m * 16) * 1024 + col0;
#pragma unroll
                for (int bj = 0; bj < 2; ++bj) { const u32x4 w = rw[m][bj];
                    const f32x4 r0 = (f32x4){__builtin_bit_cast(float, w.x << 16), __builtin_bit_cast(float, w.x & 0xffff0000u), __builtin_bit_cast(float, w.y << 16), __builtin_bit_cast(float, w.y & 0xffff0000u)};
                    const f32x4 r1 = (f32x4){__builtin_bit_cast(float, w.z << 16), __builtin_bit_cast(float, w.z & 0xffff0000u), __builtin_bit_cast(float, w.w << 16), __builtin_bit_cast(float, w.w & 0xffff0000u)};
                    *(f32x4*)(OUT + off + bj * HALF) = r0 + acc[ai][bj][m][0]; *(f32x4*)(OUT + off + bj * HALF + 4) = r1 + acc[ai][bj][m][1]; } }
            asm volatile("" ::: "memory");
        }
    }
};
struct EpiResidNormBS {
    static constexpr bool PERM = true, AFTER_DRAIN = false, STREAM_R = true, STREAM_BF16 = false;
    const float* RS; bf16_t* HB; float* SSQ;
    __device__ __forceinline__ void operator()(const f32x4 (&acc)[2][2][4][2], const Unit& u, int wr, int wc, int fr, int fq) const {
        { int t_ = threadIdx.x; asm volatile("" : "+v"(t_)); fr = t_ & 15; fq = (t_ >> 4) & 3; }
        const int row0 = u.pm * BM + wr * 64 + fr, col0 = u.pn * BM + wc * 32 + 8 * fq;
#pragma unroll
        for (int ai = 0; ai < 2; ++ai)
#pragma unroll
            for (int m = 0; m < 4; ++m) { const int row = row0 + ai * HALF + m * 16; const size_t off = (size_t)row * 1024 + col0; float ss = 0.f;
#pragma unroll
                for (int bj = 0; bj < 2; ++bj) { const f32x4 v0 = acc[ai][bj][m][0], v1 = acc[ai][bj][m][1];
                    u32x4 w; w.x = cvt_pk_bf16(v0[0], v0[1]); w.y = cvt_pk_bf16(v0[2], v0[3]); w.z = cvt_pk_bf16(v1[0], v1[1]); w.w = cvt_pk_bf16(v1[2], v1[3]);
                    st16(HB + off + bj * HALF, w);
                    ss += (v0[0] * v0[0] + v0[1] * v0[1]) + (v0[2] * v0[2] + v0[3] * v0[3]) + (v1[0] * v1[0] + v1[1] * v1[1]) + (v1[2] * v1[2] + v1[3] * v1[3]); }
                ss += __shfl_xor(ss, 16); ss += __shfl_xor(ss, 32);
                if (fq == 0) SSQ[(size_t)row * 16 + u.pn * 4 + wc] = ss; }
    }
};
struct EpiResidOutBS {
    static constexpr bool PERM = true, AFTER_DRAIN = false, STREAM_R = true, STREAM_BF16 = true;
    const bf16_t* RS; float* OUT;
    __device__ __forceinline__ void operator()(const f32x4 (&acc)[2][2][4][2], const Unit& u, int wr, int wc, int fr, int fq) const {
        { int t_ = threadIdx.x; asm volatile("" : "+v"(t_)); fr = t_ & 15; fq = (t_ >> 4) & 3; }
        const int row0 = u.pm * BM + wr * 64 + fr, col0 = u.pn * BM + wc * 32 + 8 * fq;
#pragma unroll
        for (int ai = 0; ai < 2; ++ai)
#pragma unroll
            for (int m = 0; m < 4; ++m) { const size_t off = (size_t)(row0 + ai * HALF + m * 16) * 1024 + col0;
#pragma unroll
                for (int bj = 0; bj < 2; ++bj) { *(f32x4*)(OUT + off + bj * HALF) = acc[ai][bj][m][0]; *(f32x4*)(OUT + off + bj * HALF + 4) = acc[ai][bj][m][1]; } }
    }
};
template <class Epi, class Sched, bool ALIGN_EPI = false, bool SP2 = false>
__device__ __forceinline__ void gemm_phase(PG8_LAS unsigned char* lds, const Gemm g, const Sched& S, const Epi& E) {
    const int tid = threadIdx.x, wid = __builtin_amdgcn_readfirstlane(tid >> 6), lane = tid & 63, wr = wid >> 2, wc = wid & 3, fr = lane & 15, fq = lane >> 4;
    const int K = g.K, nt = K / BK;
    unsigned voffA[2], voffB[2];
#pragma unroll
    for (int i = 0; i < 2; ++i) { int R, C; stage_rc(tid * 16 + i * 8192, R, C); const int Rb = Epi::PERM ? ((R & ~31) + perm32(R & 31)) : R;
        voffA[i] = (unsigned)(R * K + C) * 2u; voffB[i] = (unsigned)(Rb * K + C) * 2u; }
    const size_t kstep = (size_t)(BK * 2);
    const size_t hstep = (size_t)HALF * K * 2;
    const size_t tstep = 2 * hstep;
    const unsigned ldsw = (unsigned)wid * 1024u;
    const int aoff = lds_byte(wr * 64 + fr, fq * 8), boff = lds_byte(wc * 32 + fr, fq * 8);
#define PG8_SA(b, h) (((b) * 2 + (h)) * HTB)
#define PG8_SB(b, h) ((4 + (b) * 2 + (h)) * HTB)
#define PG8_STAGE(bufoff, gbase, voff) do { _Pragma("unroll") for (int _i = 0; _i < 2; ++_i) \
        __builtin_amdgcn_global_load_lds((const unsigned*)((const char*)(gbase) + (voff)[_i]), (PG8_LAS unsigned*)(lds + (bufoff) + ldsw + _i * 8192), 16, 0, 0); } while (0)
#define PG8_LDA(dst, b, h) do { _Pragma("unroll") for (int m = 0; m < 4; ++m) _Pragma("unroll") for (int k = 0; k < 2; ++k) dst[m][k] = *(const PG8_LAS bf16x8*)(lds + PG8_SA(b, h) + aoff + m * 2048 + k * 1024); } while (0)
#define PG8_LDB(dst, b, h) do { _Pragma("unroll") for (int n = 0; n < 2; ++n) _Pragma("unroll") for (int k = 0; k < 2; ++k) dst[n][k] = *(const PG8_LAS bf16x8*)(lds + PG8_SB(b, h) + boff + n * 2048 + k * 1024); } while (0)
#define PG8_MMA(ai, bj, At, Bt) do { __builtin_amdgcn_s_setprio(1); _Pragma("unroll") for (int m = 0; m < 4; ++m) _Pragma("unroll") for (int n = 0; n < 2; ++n) _Pragma("unroll") for (int k = 0; k < 2; ++k) \
        acc[ai][bj][m][n] = __builtin_amdgcn_mfma_f32_16x16x32_bf16(Bt[n][k], At[m][k], acc[ai][bj][m][n], 0, 0, 0); __builtin_amdgcn_s_setprio(0); } while (0)
#define PG8_WAIT_V(n) asm volatile("s_waitcnt vmcnt(" #n ")" ::: "memory")
#define PG8_WAIT_L(n) asm volatile("s_waitcnt lgkmcnt(" #n ")" ::: "memory")
#define PG8_BAR __builtin_amdgcn_s_barrier()
#define PG8_SCHED __builtin_amdgcn_sched_barrier(0)
#define PG8_PIECE_OFF 147456
#define PG8_RLOAD_P(p) do { if constexpr (Epi::STREAM_BF16) { const char* pa_ = rcur + (size_t)((((((p) >> 3) & 1) * HALF + (((p) >> 1) & 3) * 16) * 1024 + ((p) & 1) * HALF) * 2) + (rvoff >> 1); \
            __builtin_amdgcn_global_load_lds((const unsigned*)pa_, (PG8_LAS unsigned*)(lds + PG8_PIECE_OFF + wid * 2048), 16, 0, 0); \
        } else { const char* pa_ = rcur + (size_t)((((((p) >> 3) & 1) * HALF + (((p) >> 1) & 3) * 16) * 1024 + ((p) & 1) * HALF) * 4) + rvoff; \
            __builtin_amdgcn_global_load_lds((const unsigned*)pa_, (PG8_LAS unsigned*)(lds + PG8_PIECE_OFF + wid * 2048), 16, 0, 0); \
            __builtin_amdgcn_global_load_lds((const unsigned*)(pa_ + 16), (PG8_LAS unsigned*)(lds + PG8_PIECE_OFF + wid * 2048 + 1024), 16, 0, 0); } } while (0)
#define PG8_RADD_P(p) do { if constexpr (Epi::STREAM_BF16) { typedef unsigned u32x2_ __attribute__((ext_vector_type(2))); \
            { const u32x2_ w_ = *(const PG8_LAS u32x2_*)(lds + PG8_PIECE_OFF + wid * 2048 + lane * 16); \
              acc[((p) >> 3) & 1][(p) & 1][((p) >> 1) & 3][0] += (f32x4){__builtin_bit_cast(float, w_.x << 16), __builtin_bit_cast(float, w_.x & 0xffff0000u), __builtin_bit_cast(float, w_.y << 16), __builtin_bit_cast(float, w_.y & 0xffff0000u)}; } \
            asm volatile("" ::: "memory"); \
            { const u32x2_ w_ = *(const PG8_LAS u32x2_*)(lds + PG8_PIECE_OFF + wid * 2048 + lane * 16 + 8); \
              acc[((p) >> 3) & 1][(p) & 1][((p) >> 1) & 3][1] += (f32x4){__builtin_bit_cast(float, w_.x << 16), __builtin_bit_cast(float, w_.x & 0xffff0000u), __builtin_bit_cast(float, w_.y << 16), __builtin_bit_cast(float, w_.y & 0xffff0000u)}; } \
        } else { { const f32x4 q0_ = *(const PG8_LAS f32x4*)(lds + PG8_PIECE_OFF + wid * 2048 + lane * 16); acc[((p) >> 3) & 1][(p) & 1][((p) >> 1) & 3][0] += q0_; } asm volatile("" ::: "memory"); \
        { const f32x4 q1_ = *(const PG8_LAS f32x4*)(lds + PG8_PIECE_OFF + wid * 2048 + 1024 + lane * 16); acc[((p) >> 3) & 1][(p) & 1][((p) >> 1) & 3][1] += q1_; } } } while (0)
#define PG8_WAIT_V1P() do { if constexpr (Epi::STREAM_BF16) PG8_WAIT_V(9); else PG8_WAIT_V(10); } while (0)
#define PG8_KPAIR(t, P0_, P1_) do { \
            const bool last = ((t) == nt - 2); \
            const char* a1 = cA + (size_t)((t) + 1) * kstep; \
            const char* a2 = last ? nA : cA + (size_t)((t) + 2) * kstep; const char* b2 = last ? nB : cB + (size_t)((t) + 2) * kstep; \
            const char* a3 = a2 + kstep; const char* b3 = b2 + kstep; \
            if (last && has_next) S.a_ready(nxt); \
            if constexpr ((P0_) >= 0) PG8_RLOAD_P(P0_); \
            PG8_LDB(B0, 0, 0); PG8_LDB(B1, 0, 1); PG8_SCHED; PG8_LDA(At, 0, 0); PG8_STAGE(PG8_SA(1, 1), a1 + hstep, voffA); \
            if constexpr ((P0_) >= 0) PG8_WAIT_V1P(); else PG8_WAIT_V(8); \
            PG8_WAIT_L(0); PG8_BAR; PG8_MMA(0, 0, At, B0); PG8_MMA(0, 1, At, B1); PG8_BAR; PG8_SCHED; \
            PG8_LDA(At, 0, 1); PG8_STAGE(PG8_SB(0, 0), b2, voffB); PG8_STAGE(PG8_SB(0, 1), b2 + hstep, voffB); PG8_STAGE(PG8_SA(0, 0), a2, voffA); \
            PG8_WAIT_V(8); PG8_WAIT_L(0); PG8_BAR; if constexpr ((P0_) >= 0) PG8_RADD_P(P0_); PG8_MMA(1, 0, At, B0); PG8_MMA(1, 1, At, B1); PG8_BAR; PG8_SCHED; \
            if constexpr ((P1_) >= 0) PG8_RLOAD_P(P1_); \
            PG8_LDB(B0, 1, 0); PG8_LDB(B1, 1, 1); PG8_SCHED; PG8_LDA(At, 1, 0); PG8_STAGE(PG8_SA(0, 1), a2 + hstep, voffA); \
            if constexpr ((P1_) >= 0) PG8_WAIT_V1P(); else PG8_WAIT_V(8); \
            PG8_WAIT_L(0); PG8_BAR; PG8_MMA(0, 0, At, B0); PG8_MMA(0, 1, At, B1); PG8_BAR; PG8_SCHED; \
            PG8_LDA(At, 1, 1); PG8_STAGE(PG8_SB(1, 0), b3, voffB); PG8_STAGE(PG8_SB(1, 1), b3 + hstep, voffB); PG8_STAGE(PG8_SA(1, 0), a3, voffA); \
            PG8_WAIT_V(8); PG8_WAIT_L(0); PG8_BAR; if constexpr ((P1_) >= 0) PG8_RADD_P(P1_); PG8_MMA(1, 0, At, B0); PG8_MMA(1, 1, At, B1); PG8_BAR; PG8_SCHED; \
        } while (0)
    Unit cur, nxt; int ui = 0;
    if (!S.next(0, cur)) return;
    f32x4 acc[2][2][4][2];
#pragma unroll
    for (int a = 0; a < 2; ++a)
#pragma unroll
        for (int b = 0; b < 2; ++b)
#pragma unroll
            for (int m = 0; m < 4; ++m)
#pragma unroll
                for (int n = 0; n < 2; ++n) acc[a][b][m][n] = (f32x4){0.f, 0.f, 0.f, 0.f};
    bf16x8 At[4][2], B0[2][2], B1[2][2];
    const char* rcur = nullptr;
    const unsigned rvoff = (unsigned)(((wr * 64 + fr) * 1024 + wc * 32 + 8 * fq) * 4);
#define PG8_RCUR(u_) do { if constexpr (Epi::STREAM_R) rcur = (const char*)E.RS + ((size_t)((u_).pm * BM) * 1024 + (u_).pn * BM) * (Epi::STREAM_BF16 ? 2 : 4); } while (0)
    PG8_RCUR(cur);
    const char* cA = (const char*)g.A + (size_t)cur.pm * tstep; const char* cB = (const char*)g.Bt + (size_t)cur.pn * tstep;
    S.a_ready(cur);
    if constexpr (SP2) {
        PG8_STAGE(PG8_SB(0, 0), cB, voffB); PG8_STAGE(PG8_SB(0, 1), cB + hstep, voffB); PG8_STAGE(PG8_SA(0, 0), cA, voffA); PG8_STAGE(PG8_SA(0, 1), cA + hstep, voffA);
        if (wr == 1) PG8_BAR;
        PG8_WAIT_V(2); PG8_BAR;
        PG8_STAGE(PG8_SB(1, 0), cB + kstep, voffB); PG8_STAGE(PG8_SA(1, 0), cA + kstep, voffA); PG8_STAGE(PG8_SB(1, 1), cB + hstep + kstep, voffB);
        PG8_WAIT_V(6); PG8_BAR;
    } else {
        PG8_STAGE(PG8_SB(0, 0), cB, voffB); PG8_STAGE(PG8_SA(0, 0), cA, voffA); PG8_STAGE(PG8_SB(0, 1), cB + hstep, voffB); PG8_STAGE(PG8_SA(0, 1), cA + hstep, voffA);
        if (wr == 1) PG8_BAR;
        PG8_WAIT_V(4); PG8_BAR;
        PG8_STAGE(PG8_SB(1, 0), cB + kstep, voffB); PG8_STAGE(PG8_SA(1, 0), cA + kstep, voffA); PG8_STAGE(PG8_SB(1, 1), cB + hstep + kstep, voffB);
        PG8_WAIT_V(6); PG8_BAR;
    }
    for (;;) {
        const bool has_next = S.next(ui + 1, nxt);
        const char* nA = has_next ? (const char*)g.A + (size_t)nxt.pm * tstep : cA; const char* nB = has_next ? (const char*)g.Bt + (size_t)nxt.pn * tstep : cB;
        if constexpr (SP2 && Epi::STREAM_R) {
            PG8_KPAIR(0, 0, 1); PG8_KPAIR(2, 2, 3); PG8_KPAIR(4, 4, 5); PG8_KPAIR(6, 6, 7); PG8_KPAIR(8, 8, 9); PG8_KPAIR(10, 10, 11); PG8_KPAIR(12, 12, 13); PG8_KPAIR(14, 14, 15);
#pragma unroll 1
            for (int t = 16; t < nt; t += 2) PG8_KPAIR(t, -1, -1);
        } else
        for (int t = 0; t < nt; t += 2) {
            const bool last = (t == nt - 2);
            const char* a1 = cA + (size_t)(t + 1) * kstep;
            const char* a2 = last ? nA : cA + (size_t)(t + 2) * kstep; const char* b2 = last ? nB : cB + (size_t)(t + 2) * kstep;
            const char* a3 = a2 + kstep; const char* b3 = b2 + kstep;
            if (last && has_next) S.a_ready(nxt);
            if constexpr (SP2) {
            PG8_LDB(B0, 0, 0); PG8_LDB(B1, 0, 1); PG8_SCHED; PG8_LDA(At, 0, 0); PG8_STAGE(PG8_SA(1, 1), a1 + hstep, voffA);
            PG8_WAIT_V(8); PG8_WAIT_L(0); PG8_BAR; PG8_MMA(0, 0, At, B0); PG8_MMA(0, 1, At, B1); PG8_BAR; PG8_SCHED;
            PG8_LDA(At, 0, 1); PG8_STAGE(PG8_SB(0, 0), b2, voffB); PG8_STAGE(PG8_SB(0, 1), b2 + hstep, voffB); PG8_STAGE(PG8_SA(0, 0), a2, voffA);
            PG8_WAIT_V(8); PG8_WAIT_L(0); PG8_BAR; PG8_MMA(1, 0, At, B0); PG8_MMA(1, 1, At, B1); PG8_BAR; PG8_SCHED;
            PG8_LDB(B0, 1, 0); PG8_LDB(B1, 1, 1); PG8_SCHED; PG8_LDA(At, 1, 0); PG8_STAGE(PG8_SA(0, 1), a2 + hstep, voffA);
            PG8_WAIT_V(8); PG8_WAIT_L(0); PG8_BAR; PG8_MMA(0, 0, At, B0); PG8_MMA(0, 1, At, B1); PG8_BAR; PG8_SCHED;
            PG8_LDA(At, 1, 1); PG8_STAGE(PG8_SB(1, 0), b3, voffB); PG8_STAGE(PG8_SB(1, 1), b3 + hstep, voffB); PG8_STAGE(PG8_SA(1, 0), a3, voffA);
            PG8_WAIT_V(8); PG8_WAIT_L(0); PG8_BAR; PG8_MMA(1, 0, At, B0); PG8_MMA(1, 1, At, B1); PG8_BAR; PG8_SCHED;
            } else {
            PG8_LDB(B0, 0, 0); PG8_SCHED; PG8_LDA(At, 0, 0); PG8_STAGE(PG8_SA(1, 1), a1 + hstep, voffA);
            PG8_WAIT_L(8); PG8_BAR; PG8_WAIT_L(0); PG8_MMA(0, 0, At, B0); PG8_BAR; PG8_SCHED;
            PG8_LDB(B1, 0, 1); PG8_STAGE(PG8_SB(0, 0), b2, voffB);
            PG8_BAR; PG8_WAIT_L(0); PG8_MMA(0, 1, At, B1); PG8_BAR;
            PG8_LDA(At, 0, 1); PG8_STAGE(PG8_SA(0, 0), a2, voffA);
            PG8_BAR; PG8_WAIT_L(0); PG8_MMA(1, 0, At, B0); PG8_BAR; PG8_SCHED;
            PG8_STAGE(PG8_SB(0, 1), b2 + hstep, voffB);
            PG8_WAIT_V(6); PG8_BAR; PG8_MMA(1, 1, At, B1); PG8_BAR;
            PG8_LDB(B0, 1, 0); PG8_SCHED; PG8_LDA(At, 1, 0); PG8_STAGE(PG8_SA(0, 1), a2 + hstep, voffA);
            PG8_WAIT_L(8); PG8_BAR; PG8_WAIT_L(0); PG8_MMA(0, 0, At, B0); PG8_BAR; PG8_SCHED;
            PG8_LDB(B1, 1, 1); PG8_STAGE(PG8_SB(1, 0), b3, voffB);
            PG8_BAR; PG8_WAIT_L(0); PG8_MMA(0, 1, At, B1); PG8_BAR;
            PG8_LDA(At, 1, 1); PG8_STAGE(PG8_SA(1, 0), a3, voffA);
            PG8_BAR; PG8_WAIT_L(0); PG8_MMA(1, 0, At, B0); PG8_BAR; PG8_SCHED;
            PG8_STAGE(PG8_SB(1, 1), b3 + hstep, voffB);
            PG8_WAIT_V(6); PG8_BAR; PG8_MMA(1, 1, At, B1); PG8_BAR;
            }
        }
        if constexpr (ALIGN_EPI) { if (wr == 0) PG8_BAR; }
        if constexpr (!Epi::AFTER_DRAIN) { E(acc, cur, wr, wc, fr, fq); S.done(cur); }
        if (!has_next) break;
#pragma unroll
        for (int a = 0; a < 2; ++a)
#pragma unroll
            for (int b = 0; b < 2; ++b)
#pragma unroll
                for (int m = 0; m < 4; ++m)
#pragma unroll
                    for (int n = 0; n < 2; ++n) acc[a][b][m][n] = (f32x4){0.f, 0.f, 0.f, 0.f};
        cur = nxt; cA = nA; cB = nB; ++ui; PG8_RCUR(cur);
        if constexpr (ALIGN_EPI) { if (wr == 1) PG8_BAR; }
    }
    PG8_WAIT_V(0);
    if constexpr (!ALIGN_EPI) { if (wr == 0) PG8_BAR; }
    PG8_BAR;
    if constexpr (Epi::AFTER_DRAIN) { E.fused(acc, cur, wr, wc, fr, fq, lds, wid, lane); S.done(cur); }
#undef PG8_SA
#undef PG8_SB
#undef PG8_STAGE
#undef PG8_LDA
#undef PG8_LDB
#undef PG8_MMA
#undef PG8_WAIT_V
#undef PG8_WAIT_L
#undef PG8_BAR
#undef PG8_SCHED
#undef PG8_PIECE_OFF
#undef PG8_RLOAD_P
#undef PG8_WAIT_V1P
#undef PG8_RADD_P
#undef PG8_KPAIR
#undef PG8_RCUR
}
}
constexpr int NWAVES = 8;
constexpr int NB = 8, SEQ = 4096, T = NB * SEQ, DM = 1024, DIN = 2824, DFF = 2816, NPROJ = 2816;
constexpr int SRC_MI = 2048;
constexpr int PC_MQ = 0, PC_MK = 512, PC_MV = 1024, PC_MO = 1536, PC_AQ = 2048, PC_AK = 2560, PC_AV = 2688;
constexpr float EPS = 1e-6f;
constexpr size_t MiB = 1u << 20;
constexpr size_t WS_CTL = 0, CTL_ZERO_BYTES = 32 * 1024;
constexpr size_t WS_WIN = 1 * MiB;
constexpr size_t WS_WOUT = 7 * MiB;
constexpr size_t WS_WGU = 9 * MiB;
constexpr size_t WS_WDN = 20 * MiB;
constexpr size_t WS_ROPE = 26 * MiB;
constexpr size_t WS_WBG = 26 * MiB + 512 * 1024;
constexpr size_t WS_GATES = 27 * MiB;
constexpr size_t WS_SSQ = 28 * MiB;
constexpr size_t WS_SEG = 30 * MiB;
constexpr size_t WS_XN = 48 * MiB;
constexpr size_t WS_MIX = 112 * MiB;
constexpr size_t WS_PROJ = 176 * MiB;
constexpr size_t WS_END = 352 * MiB;
constexpr int CW_BAR = 4096;
constexpr int RING_BYTES = 131072;
constexpr int LDSCTL_OFF = RING_BYTES, MISC_OFF = LDSCTL_OFF + 320;
constexpr int LDS_BYTES = 163840;

#define GAS __attribute__((address_space(1)))
#define LAS __attribute__((address_space(3)))
typedef unsigned short bf16;
typedef unsigned v4u __attribute__((ext_vector_type(4)));
typedef unsigned v2u __attribute__((ext_vector_type(2)));
typedef float f32x2v __attribute__((ext_vector_type(2)));
typedef float f32x4 __attribute__((ext_vector_type(4)));
typedef short bf16x8 __attribute__((ext_vector_type(8)));
typedef GAS unsigned gu32;
#define RLX_AGENT __ATOMIC_RELAXED, __HIP_MEMORY_SCOPE_AGENT
#define LDS_WAIT() asm volatile("s_waitcnt lgkmcnt(0)" ::: "memory")
#define VM_WAIT() asm volatile("s_waitcnt vmcnt(0)" ::: "memory")
__device__ __forceinline__ unsigned f2bf(float f) { unsigned u = __builtin_bit_cast(unsigned, f); return (u + 0x7fffu + ((u >> 16) & 1u)) >> 16; }
__device__ __forceinline__ unsigned pk2(float lo, float hi) { return f2bf(lo) | (f2bf(hi) << 16); }
__device__ __forceinline__ float bf2f(unsigned short b) { return __builtin_bit_cast(float, (unsigned)b << 16); }
__device__ __forceinline__ float bflo(unsigned w) { return __builtin_bit_cast(float, w << 16); }
__device__ __forceinline__ float bfhi(unsigned w) { return __builtin_bit_cast(float, w & 0xffff0000u); }
__device__ __forceinline__ float wave_sum(float v) {
#pragma unroll
    for (int o = 1; o < 64; o <<= 1) v += __shfl_xor(v, o);
    return v;
}
__device__ __forceinline__ float wave_max(float v) {
#pragma unroll
    for (int o = 1; o < 64; o <<= 1) v = fmaxf(v, __shfl_xor(v, o));
    return v;
}
__device__ __forceinline__ void unpack8(const v4u w, float* o) { o[0] = bflo(w.x); o[1] = bfhi(w.x); o[2] = bflo(w.y); o[3] = bfhi(w.y); o[4] = bflo(w.z); o[5] = bfhi(w.z); o[6] = bflo(w.w); o[7] = bfhi(w.w); }
#define XB_TMO      128
#define XB_XCNT(j)  (256  + 64 * (j))
#define XB_XSUB(j)  (1280 + 64 * (j))
#define XB_XGEN(j)  (2304 + 64 * (j))
#define XB_TOP      3328
#define XB_TOPGEN   3392
#define XCD_BAR_WORDS 3456
#define XB_SPIN_CAP (1u << 18)

__device__ __forceinline__ unsigned xb_ld(unsigned* p)              { return __hip_atomic_load(p, __ATOMIC_RELAXED, __HIP_MEMORY_SCOPE_AGENT); }
__device__ __forceinline__ unsigned xb_add(unsigned* p, unsigned v) { return __hip_atomic_fetch_add(p, v, __ATOMIC_RELAXED, __HIP_MEMORY_SCOPE_AGENT); }
__device__ __forceinline__ unsigned xb_xcc_id() { return (unsigned)__builtin_amdgcn_s_getreg((3 << 11) | 20) & 0xFu; }
#define XB_SPIN(cond, bar) do { unsigned _sp = 0; while (cond) { __builtin_amdgcn_s_sleep(1); \
    if ((++_sp & 255u) == 0u) { if (xb_ld(&(bar)[XB_TMO])) break; if (_sp > XB_SPIN_CAP) { atomicAdd(&(bar)[XB_TMO], 1u); break; } } } } while (0)

struct XcdBarrier {
    unsigned* bar; unsigned x;
    volatile LAS unsigned* st;
};

__device__ __forceinline__ XcdBarrier xcd_barrier_post(unsigned* bar, volatile LAS unsigned* st) {
    XcdBarrier b; b.bar = bar; b.x = xb_xcc_id(); b.st = st;
    if (threadIdx.x == 0) (void)xb_add(&bar[XB_XCNT(b.x)], 1u);
    return b;
}
__device__ __forceinline__ void xcd_barrier_complete(unsigned* bar, unsigned x, unsigned& nloc, unsigned& nx) {
    const unsigned G = gridDim.x * gridDim.y * gridDim.z;
    unsigned sum, cnt, mine, sp = 0u;
    for (;;) {
        sum = 0u; cnt = 0u; mine = 0u;
#pragma unroll
        for (unsigned j = 0; j < 16; ++j) { const unsigned c = xb_ld(&bar[XB_XCNT(j)]); sum += c; cnt += (c > 0u) ? 1u : 0u; mine = (j == x) ? c : mine; }
        if (sum == G) break;
        __builtin_amdgcn_s_sleep(1);
        if ((++sp & 255u) == 0u) { if (xb_ld(&bar[XB_TMO])) break; if (sp > XB_SPIN_CAP) { atomicAdd(&bar[XB_TMO], 1u); break; } }
    }
    nloc = mine > 0u ? mine : 1u; nx = cnt > 0u ? cnt : 1u;
}

__device__ __forceinline__ void xcd_barrier(const XcdBarrier& b) {
    asm volatile("s_waitcnt vmcnt(0)" ::: "memory");
    __syncthreads();
    if (threadIdx.x == 0) {
        unsigned* bar = b.bar;
        __builtin_amdgcn_s_waitcnt(0);
        unsigned nloc = b.st[0], nx = b.st[1];
        if (nloc == 0u) { xcd_barrier_complete(bar, b.x, nloc, nx); b.st[0] = nloc; b.st[1] = nx; }
        const unsigned old = xb_add(&bar[XB_XSUB(b.x)], 1u);
        const unsigned gen = old / nloc;
        if (old + 1u == (gen + 1u) * nloc) {
            __builtin_amdgcn_fence(__ATOMIC_RELEASE, "agent");
            asm volatile("s_waitcnt vmcnt(0)" ::: "memory");
            const unsigned og = xb_add(&bar[XB_TOP], 1u);
            const unsigned tg = og / nx;
            if (og + 1u == (tg + 1u) * nx) xb_add(&bar[XB_TOPGEN], 1u);
            else XB_SPIN(xb_ld(&bar[XB_TOPGEN]) == tg, bar);
            __builtin_amdgcn_fence(__ATOMIC_ACQUIRE, "agent");
            xb_add(&bar[XB_XGEN(b.x)], 1u);
            asm volatile("s_waitcnt vmcnt(0)" ::: "memory");
        } else {
            XB_SPIN(xb_ld(&bar[XB_XGEN(b.x)]) == gen, bar);
            __builtin_amdgcn_fence(__ATOMIC_ACQUIRE, "agent");
            asm volatile("s_waitcnt vmcnt(0)" ::: "memory");
        }
    }
    __syncthreads();
}
#define H1_BF16 1
#ifndef P5_ALIGN
#define P5_ALIGN true
#endif
#define PHASE2_BODY do { mlstm_phase<1>(F); swa_phase(F); } while (0)
#define PHASE3_BODY mlstm_phase<2>(F)
#define LAUNCH_MK(lo_, hi_) do { a.ph_lo = (lo_); a.ph_hi = (hi_); a.li = (lo_); hipLaunchKernelGGL(mk_fwd, dim3(grid), dim3(NWAVES * 64), LDS_BYTES, stream, a); } while (0)
#define LAUNCH_PROGRAM { LAUNCH_MK(0, 7); }
struct Frame {
    LAS unsigned char* lds;
    volatile LAS unsigned* MISC;
    gu32* ctl;
    int tid, lane, wave, vcu, G;
    const float *x, *norm1_g, *w_in, *conv_w, *igate_b, *fgate_b, *mlstm_norm_g, *q_norm_g, *k_norm_g, *sinks, *w_out, *norm2_g, *w_gate, *w_up, *w_down;
    float* out;
    bf16 *Win_t, *Wout_t, *Wgu_t, *Wdn_t, *XN, *MIX, *PROJ;
    float2* ROPE; float* GATES; float* SSQ; float* SEG; unsigned char* WBG;
};

struct P0Item { const float* W; int ldw, src_col0; const float* kscale; bf16* WT; int Kd, dst_row0, kb; };
template <bool SCALE> __device__ __forceinline__ void p0_item_load(const P0Item& I, float (&v)[32], int lane) {
    const int k0 = 64 * I.kb;
#pragma unroll
    for (int i = 0; i < 32; ++i) { const int kk = 2 * i + (lane >> 5); v[i] = I.W[(size_t)(k0 + kk) * I.ldw + I.src_col0 + (lane & 31)]; }
    if (SCALE) {
        float sc[32];
#pragma unroll
        for (int i = 0; i < 32; ++i) sc[i] = I.kscale[k0 + 2 * i + (lane >> 5)];
#pragma unroll
        for (int i = 0; i < 32; ++i) v[i] *= sc[i];
    }
}
__device__ __forceinline__ void p0_item_finish(const P0Item& I, const float (&v)[32], LAS float* scr, int lane) {
    const int k0 = 64 * I.kb;
#pragma unroll
    for (int i = 0; i < 32; ++i) { const int kk = 2 * i + (lane >> 5); scr[kk * 33 + (lane & 31)] = v[i]; }
    LDS_WAIT(); asm volatile("" ::: "memory");
    const int c = lane & 7;
#pragma unroll
    for (int j = 0; j < 4; ++j) { const int n = (lane >> 3) + 8 * j; const LAS float* s = scr + (8 * c) * 33 + n;
        v4u o; o.x = pk2(s[0 * 33], s[1 * 33]); o.y = pk2(s[2 * 33], s[3 * 33]); o.z = pk2(s[4 * 33], s[5 * 33]); o.w = pk2(s[6 * 33], s[7 * 33]);
        *(GAS v4u*)(I.WT + (size_t)(I.dst_row0 + n) * I.Kd + k0 + 8 * c) = o; }
    LDS_WAIT(); asm volatile("" ::: "memory");
}
constexpr int I_IN = 88 * 16, I_OUT = 32 * 16, I_GU = 176 * 16, I_DN = 32 * 44;
__device__ __forceinline__ P0Item p0_item_in(Frame& F, int r) { const int nb = r % 88, kb = r / 88; return P0Item{F.w_in, DIN, nb < 64 ? 32 * nb : 32 * nb + 8, nullptr, F.Win_t, DM, 32 * nb, kb}; }
__device__ __forceinline__ P0Item p0_item_gu(Frame& F, int r) { const int nb = r % 176, kb = r / 176, tile = nb >> 3, wi = nb & 7; const float* W = (wi < 4) ? F.w_gate : F.w_up;
    return P0Item{W, DFF, 128 * tile + 32 * (wi & 3), F.norm2_g, F.Wgu_t, DM, 32 * nb, kb}; }
__device__ __forceinline__ P0Item p0_item_od(Frame& F, int r) {
    if (r < I_OUT) { const int nb = r % 32, kb = r / 32; return P0Item{F.w_out, DM, 32 * nb, nullptr, F.Wout_t, DM, 32 * nb, kb}; } r -= I_OUT;
    { const int nb = r % 32, kb = r / 32; return P0Item{F.w_down, DM, 32 * nb, nullptr, F.Wdn_t, DFF, 32 * nb, kb}; }
}
__device__ __forceinline__ void p0_prologue(Frame& F) {
    LAS float* scr = (LAS float*)(F.lds + F.wave * 8704);
    const int gw = F.vcu * NWAVES + F.wave, NGW = F.G * NWAVES;
    for (int it = gw; it < I_IN; it += NGW) { const P0Item I = p0_item_in(F, it); float v[32]; p0_item_load<false>(I, v, F.lane); p0_item_finish(I, v, scr, F.lane); }
    if (F.vcu < 4) { const int idx = F.vcu * 512 + F.tid; const int ks = idx >> 6, ln = idx & 63, col = ln & 15, gq = ln >> 4;
        v4u o = (v4u){0u, 0u, 0u, 0u};
        if (col < 8) { const float* wp = F.w_in + (size_t)(32 * ks + 8 * gq) * DIN + SRC_MI + col;
            const float w0 = wp[0], w1 = wp[DIN], w2 = wp[2 * DIN], w3 = wp[3 * DIN], w4 = wp[4 * DIN], w5 = wp[5 * DIN], w6 = wp[6 * DIN], w7 = wp[7 * DIN];
            o.x = pk2(w0, w1); o.y = pk2(w2, w3); o.z = pk2(w4, w5); o.w = pk2(w6, w7); }
        ((v4u*)F.WBG)[idx] = o; }
    { const int idx = (F.vcu * NWAVES * 64) + F.tid;
      if (idx < SEQ * 8) { const int pos = idx >> 3, i = idx & 7;
        double f = 1.0; f = (i == 1) ? 0.19392274474868576 : f; f = (i == 2) ? 0.03760603093086393 : f; f = (i == 3) ? 0.007292664737217109 : f; f = (i == 4) ? 0.001414213562373095 : f;
        f = (i == 5) ? 0.0002742481756762073 : f; f = (i == 6) ? 5.318295896944988e-05 : f; f = (i == 7) ? 1.031338537721246e-05 : f;
        const float angf = (float)pos * (float)f; const double rev = (double)angf * 0.15915494309189535; const double fr = rev - __builtin_floor(rev + 0.5);
        const float rr = (float)(fr * 6.283185307179586); F.ROPE[idx] = make_float2(__cosf(rr), __sinf(rr)); } }
    f32x4 g1[4];
#pragma unroll
    for (int j = 0; j < 4; ++j) g1[j] = ((const f32x4*)F.norm1_g)[F.lane + 64 * j];
    f32x4 v[4];
    if (gw < T) {
#pragma unroll
        for (int j = 0; j < 4; ++j) v[j] = ((const GAS f32x4*)(F.x + (size_t)gw * DM))[F.lane + 64 * j];
    }
#pragma unroll 1
    for (int m = gw; m < T; m += NGW) {
        f32x4 c[4]; float s = 0.f;
#pragma unroll
        for (int j = 0; j < 4; ++j) { c[j] = v[j]; s += (c[j].x * c[j].x + c[j].y * c[j].y) + (c[j].z * c[j].z + c[j].w * c[j].w); }
        if (m + NGW < T) {
#pragma unroll
            for (int j = 0; j < 4; ++j) v[j] = ((const GAS f32x4*)(F.x + (size_t)(m + NGW) * DM))[F.lane + 64 * j];
        }
        const float rstd = __builtin_amdgcn_rsqf(wave_sum(s) * (1.f / DM) + EPS);
        GAS v2u* o8 = (GAS v2u*)(F.XN + (size_t)m * DM) + F.lane;
#pragma unroll
        for (int j = 0; j < 4; ++j) { const f32x4 y = c[j] * rstd * g1[j]; v2u w; w.x = pg8::cvt_pk_bf16(y.x, y.y); w.y = pg8::cvt_pk_bf16(y.z, y.w); o8[64 * j] = w; }
    }
}
__device__ __forceinline__ void convert_gu(Frame& F, int ii, int ni) {
    LAS float* scr = (LAS float*)(F.lds + F.wave * 8704);
    __syncthreads();
    const int igw = ii * NWAVES + F.wave, NIW = ni * NWAVES;
#pragma unroll 1
    for (int it = igw; it < I_GU; it += 2 * NIW) {
        const P0Item Ia = p0_item_gu(F, it); const bool two = it + NIW < I_GU; const P0Item Ib = p0_item_gu(F, two ? it + NIW : it);
        float va[32], vb[32]; p0_item_load<true>(Ia, va, F.lane); p0_item_load<true>(Ib, vb, F.lane);
        p0_item_finish(Ia, va, scr, F.lane); if (two) p0_item_finish(Ib, vb, scr, F.lane);
    }
}
__device__ __forceinline__ void convert_od(Frame& F, int ii, int ni) {
    LAS float* scr = (LAS float*)(F.lds + F.wave * 8704);
    const int igw = ii * NWAVES + F.wave, NIW = ni * NWAVES;
#pragma unroll 1
    for (int it = igw; it < I_OUT + I_DN; it += 2 * NIW) {
        const P0Item Ia = p0_item_od(F, it); const bool two = it + NIW < I_OUT + I_DN; const P0Item Ib = p0_item_od(F, two ? it + NIW : it);
        float va[32], vb[32]; p0_item_load<false>(Ia, va, F.lane); p0_item_load<false>(Ib, vb, F.lane);
        p0_item_finish(Ia, va, scr, F.lane); if (two) p0_item_finish(Ib, vb, scr, F.lane);
    }
}
__device__ __forceinline__ void p1_side_work(Frame& F, int ii, int ni) {
    LAS unsigned char* WB = F.lds + 73728;
    for (int idx = F.tid; idx < 2048; idx += NWAVES * 64) *(LAS v4u*)(WB + idx * 16) = ((const v4u*)F.WBG)[idx];
    __syncthreads();
    convert_od(F, ii, ni);
    const int igw = ii * NWAVES + F.wave, NIW = ni * NWAVES;
    const int l15 = F.lane & 15, g = F.lane >> 4;
    for (int blk = igw; blk < T / 16; blk += NIW) {
        const bf16* xp = F.XN + ((size_t)blk * 16 + l15) * DM + 8 * g;
        f32x4 acc = (f32x4){0.f, 0.f, 0.f, 0.f};
        bf16x8 a[32];
#pragma unroll
        for (int q = 0; q < 32; ++q) a[q] = *(const bf16x8*)(xp + 32 * q);
#pragma unroll
        for (int q = 0; q < 32; ++q) acc = __builtin_amdgcn_mfma_f32_16x16x32_bf16(a[q], *(const LAS bf16x8*)(WB + (q * 64 + F.lane) * 16), acc, 0, 0, 0);
        if (l15 < 8) {
#pragma unroll
            for (int r = 0; r < 4; ++r) F.GATES[((size_t)blk * 16 + 4 * g + r) * 8 + l15] = acc[r];
        }
    }
}

constexpr int SWA_KS = 0, SWA_KSTR = 144, SWA_VT = 36864, SWA_VSTR = 528;
typedef short bf16x4 __attribute__((ext_vector_type(4)));
#ifndef SWA_UNROLL
#define SWA_UNROLL 1
#endif
constexpr int SWA_TAB = 70656;
struct SwaKV { v4u k[4], v[4]; float2 cs[8]; };
struct SwaQ { v4u w0, w1; float2 cs[8]; };
__device__ __forceinline__ void swa_load_kv(Frame& F, int tid, int u, SwaKV& R) {
    const int blk = u & 31, kvh = (u >> 5) & 1, b = u >> 6; const int key = tid >> 1, half = tid & 1; const int kt = blk * 128 - 128 + key;
    if (kt >= 0) {
        const bf16* kp = F.PROJ + (size_t)(b * SEQ + kt) * NPROJ + PC_AK + kvh * 64 + 32 * half;
        const bf16* vp = F.PROJ + (size_t)(b * SEQ + kt) * NPROJ + PC_AV + kvh * 64 + 32 * half;
#pragma unroll
        for (int c = 0; c < 4; ++c) { R.k[c] = *(const v4u*)(kp + 8 * c); R.v[c] = *(const v4u*)(vp + 8 * c); }
#pragma unroll
        for (int i = 0; i < 8; ++i) R.cs[i] = F.ROPE[kt * 8 + i];
    } else {
#pragma unroll
        for (int c = 0; c < 4; ++c) { R.k[c] = (v4u){0u, 0u, 0u, 0u}; R.v[c] = (v4u){0u, 0u, 0u, 0u}; }
#pragma unroll
        for (int i = 0; i < 8; ++i) R.cs[i] = make_float2(1.f, 0.f);
    }
}
__device__ __forceinline__ void swa_load_q(Frame& F, int lane, int wave, int u, int rb, SwaQ& R) {
    const int blk = u & 31, kvh = (u >> 5) & 1, b = u >> 6; const int l15 = lane & 15, g = lane >> 4;
    const int hq = kvh * 4 + (wave >> 1), p0 = 64 * (wave & 1) + 16 * rb, tq = blk * 128 + p0 + l15;
    const bf16* qp = F.PROJ + (size_t)(b * SEQ + tq) * NPROJ + PC_AQ + hq * 64 + 8 * g;
    R.w0 = *(const v4u*)qp; R.w1 = *(const v4u*)(qp + 32);
#pragma unroll
    for (int j = 0; j < 8; ++j) R.cs[j] = F.ROPE[tq * 8 + j];
}
__device__ __forceinline__ void swa_phase(Frame& F) {
    LAS unsigned char* KS = F.lds + SWA_KS; LAS unsigned char* VT = F.lds + SWA_VT; LAS float* TAB = (LAS float*)(F.lds + SWA_TAB);
    const int wave = F.wave;
    int u = F.vcu;
    if (u >= NB * 2 * 32) return;
    __syncthreads();
    if (F.tid < 64) TAB[F.tid] = F.q_norm_g[F.tid]; else if (F.tid < 128) TAB[F.tid] = F.k_norm_g[F.tid - 64];
    SwaKV kv; SwaQ qr;
    swa_load_kv(F, F.tid, u, kv);
    swa_load_q(F, F.lane, wave, u, 0, qr);
#pragma unroll 1
    for (; u < NB * 2 * 32; u += F.G) {
        int tid = F.tid; asm volatile("" : "+v"(tid));
        const int lane = tid & 63, l15 = lane & 15, g = lane >> 4;
        const int blk = u & 31, kvh = (u >> 5) & 1, b = u >> 6;
        const int un = u + F.G; const bool has_next = un < NB * 2 * 32;
        __syncthreads();
        {
            const int key = tid >> 1, half = tid & 1;
            float kf[32];
#pragma unroll
            for (int c = 0; c < 4; ++c) unpack8(kv.k[c], kf + 8 * c);
            float ss = 0.f;
#pragma unroll
            for (int c = 0; c < 32; ++c) ss += kf[c] * kf[c];
            ss += __shfl_xor(ss, 1);
            const float rstd = __builtin_amdgcn_rsqf(ss * (1.f / 64.f) + EPS);
#pragma unroll
            for (int c = 0; c < 8; ++c) { const f32x4 gg = *(const LAS f32x4*)(TAB + 64 + 32 * half + 4 * c); kf[4 * c] *= rstd * gg[0]; kf[4 * c + 1] *= rstd * gg[1]; kf[4 * c + 2] *= rstd * gg[2]; kf[4 * c + 3] *= rstd * gg[3]; }
            if (half == 0) {
#pragma unroll
                for (int i = 0; i < 8; ++i) { const float2 cs = kv.cs[i]; const float x1 = kf[i], x2 = kf[8 + i]; kf[i] = x1 * cs.x - x2 * cs.y; kf[8 + i] = x2 * cs.x + x1 * cs.y; }
            }
#pragma unroll
            for (int c = 0; c < 4; ++c) { v4u o; o.x = pg8::cvt_pk_bf16(kf[8 * c], kf[8 * c + 1]); o.y = pg8::cvt_pk_bf16(kf[8 * c + 2], kf[8 * c + 3]); o.z = pg8::cvt_pk_bf16(kf[8 * c + 4], kf[8 * c + 5]); o.w = pg8::cvt_pk_bf16(kf[8 * c + 6], kf[8 * c + 7]);
                *(LAS v4u*)(KS + key * SWA_KSTR + 64 * half + 16 * c) = o; }
#pragma unroll
            for (int c = 0; c < 4; ++c) { const unsigned ww[4] = {kv.v[c].x, kv.v[c].y, kv.v[c].z, kv.v[c].w};
#pragma unroll
                for (int e = 0; e < 4; ++e) { const int d = 32 * half + 8 * c + 2 * e;
                    *(LAS unsigned short*)(VT + d * SWA_VSTR + key * 2) = (unsigned short)(ww[e] & 0xffffu);
                    *(LAS unsigned short*)(VT + (d + 1) * SWA_VSTR + key * 2) = (unsigned short)(ww[e] >> 16); } }
        }
        __syncthreads();
        if (has_next) swa_load_kv(F, tid, un, kv);
        const int hq = kvh * 4 + (wave >> 1);
        const float sink2 = F.sinks[hq] * 1.4426950408889634f;
        const float SC = 0.125f * 1.4426950408889634f;
#pragma unroll 1
        for (int rb = 0; rb < 4; ++rb) {
            const int p0 = 64 * (wave & 1) + 16 * rb, j0 = p0 >> 4;
            const int tq = blk * 128 + p0 + l15;
            bf16x8 qf[2];
            {
                float q0[8], q1[8]; unpack8(qr.w0, q0); unpack8(qr.w1, q1);
                float ss = 0.f;
#pragma unroll
                for (int j = 0; j < 8; ++j) ss += q0[j] * q0[j] + q1[j] * q1[j];
                ss += __shfl_xor(ss, 16); ss += __shfl_xor(ss, 32);
                const float rstd = __builtin_amdgcn_rsqf(ss * (1.f / 64.f) + EPS);
#pragma unroll
                for (int c = 0; c < 2; ++c) { const f32x4 ga = *(const LAS f32x4*)(TAB + 8 * g + 4 * c), gb = *(const LAS f32x4*)(TAB + 32 + 8 * g + 4 * c);
#pragma unroll
                    for (int e = 0; e < 4; ++e) { q0[4 * c + e] *= rstd * ga[e]; q1[4 * c + e] *= rstd * gb[e]; } }
#pragma unroll
                for (int j = 0; j < 8; ++j) { const float other = __shfl_xor(q0[j], 16); const float2 cs = qr.cs[j];
                    const float r0 = q0[j] * cs.x - other * cs.y, r1 = q0[j] * cs.x + other * cs.y; q0[j] = (g == 0) ? r0 : ((g == 1) ? r1 : q0[j]); }
                v4u a, c2; a.x = pg8::cvt_pk_bf16(q0[0], q0[1]); a.y = pg8::cvt_pk_bf16(q0[2], q0[3]); a.z = pg8::cvt_pk_bf16(q0[4], q0[5]); a.w = pg8::cvt_pk_bf16(q0[6], q0[7]);
                c2.x = pg8::cvt_pk_bf16(q1[0], q1[1]); c2.y = pg8::cvt_pk_bf16(q1[2], q1[3]); c2.z = pg8::cvt_pk_bf16(q1[4], q1[5]); c2.w = pg8::cvt_pk_bf16(q1[6], q1[7]);
                qf[0] = __builtin_bit_cast(bf16x8, a); qf[1] = __builtin_bit_cast(bf16x8, c2);
            }
            if (rb < 3) swa_load_q(F, lane, wave, u, rb + 1, qr); else if (has_next) swa_load_q(F, lane, wave, un, 0, qr);
            f32x4 s[10];
    #pragma unroll
            for (int jj = 0; jj < 9; ++jj) { const int tile = j0 + jj;
                f32x4 acc = (f32x4){0.f, 0.f, 0.f, 0.f};
    #pragma unroll
                for (int ks = 0; ks < 2; ++ks) { const bf16x8 kfr = *(const LAS bf16x8*)(KS + (16 * tile + l15) * SWA_KSTR + 64 * ks + 16 * g);
                    acc = __builtin_amdgcn_mfma_f32_16x16x32_bf16(kfr, qf[ks], acc, 0, 0, 0); }
                s[jj] = acc; }
            s[9] = (f32x4){0.f, 0.f, 0.f, 0.f};
    #pragma unroll
            for (int r = 0; r < 4; ++r) { if (4 * g + r < 1 + l15) s[0][r] = -INFINITY; if (4 * g + r > l15) s[8][r] = -INFINITY; }
            if (blk == 0) {
    #pragma unroll
                for (int jj = 0; jj < 9; ++jj)
    #pragma unroll
                    for (int r = 0; r < 4; ++r) { if (16 * (j0 + jj) + 4 * g + r < 128) s[jj][r] = -INFINITY; }
            }
            float mx = -INFINITY;
    #pragma unroll
            for (int jj = 0; jj < 9; ++jj)
    #pragma unroll
                for (int r = 0; r < 4; ++r) mx = fmaxf(mx, s[jj][r]);
            mx = fmaxf(mx, __shfl_xor(mx, 16)); mx = fmaxf(mx, __shfl_xor(mx, 32)); mx = fmaxf(mx * SC, sink2);
            float sum = 0.f;
    #pragma unroll
            for (int jj = 0; jj < 9; ++jj)
    #pragma unroll
                for (int r = 0; r < 4; ++r) { const float p = __builtin_amdgcn_exp2f(__builtin_fmaf(s[jj][r], SC, -mx)); s[jj][r] = p; sum += p; }
            sum += __shfl_xor(sum, 16); sum += __shfl_xor(sum, 32);
            const float inv = 1.0f / (sum + __builtin_amdgcn_exp2f(sink2 - mx));
            f32x4 o[4];
    #pragma unroll
            for (int dt = 0; dt < 4; ++dt) o[dt] = (f32x4){0.f, 0.f, 0.f, 0.f};
    #pragma unroll
            for (int kk = 0; kk < 5; ++kk) {
                const int t0 = (j0 + 2 * kk) > 15 ? 15 : (j0 + 2 * kk), t1 = (j0 + 2 * kk + 1) > 15 ? 15 : (j0 + 2 * kk + 1);
                v4u pw; pw.x = pg8::cvt_pk_bf16(s[2 * kk][0], s[2 * kk][1]); pw.y = pg8::cvt_pk_bf16(s[2 * kk][2], s[2 * kk][3]); pw.z = pg8::cvt_pk_bf16(s[2 * kk + 1][0], s[2 * kk + 1][1]); pw.w = pg8::cvt_pk_bf16(s[2 * kk + 1][2], s[2 * kk + 1][3]);
                const bf16x8 pf = __builtin_bit_cast(bf16x8, pw);
    #pragma unroll
                for (int dt = 0; dt < 4; ++dt) {
                    const v2u a0 = *(const LAS v2u*)(VT + (16 * dt + l15) * SWA_VSTR + (16 * t0 + 4 * g) * 2);
                    const v2u a1 = *(const LAS v2u*)(VT + (16 * dt + l15) * SWA_VSTR + (16 * t1 + 4 * g) * 2);
                    v4u av; av.x = a0.x; av.y = a0.y; av.z = a1.x; av.w = a1.y;
                    o[dt] = __builtin_amdgcn_mfma_f32_16x16x32_bf16(__builtin_bit_cast(bf16x8, av), pf, o[dt], 0, 0, 0); }
            }
            bf16* op = F.MIX + (size_t)(b * SEQ + tq) * DM + 512 + hq * 64 + 4 * g;
    #pragma unroll
            for (int dt = 0; dt < 4; ++dt) { v2u w; w.x = pg8::cvt_pk_bf16(o[dt][0] * inv, o[dt][1] * inv); w.y = pg8::cvt_pk_bf16(o[dt][2] * inv, o[dt][3] * inv); *(v2u*)(op + 16 * dt) = w; }
        }
    }
}
constexpr int ML_QS = 0, ML_KS = 17408, ML_KWT = 34816, ML_VT = 53248, ML_PS = 71680, ML_CT = 80896, ML_F = 115712;
constexpr int ML_QSTR = 272, ML_TSTR = 144, ML_HSTR = 528;
constexpr int FDEN = 256, FN = 320;
constexpr int ML_GV = 132096, ML_GS = ML_GV + 8192, ML_CW = ML_GS + 256;
constexpr int SEG_STRIDE = 16640;
constexpr float LOG2E = 1.4426950408889634f;
__device__ __forceinline__ float silu_f(float v) { return v * __builtin_amdgcn_rcpf(1.0f + __builtin_amdgcn_exp2f(v * -LOG2E)); }
__device__ __forceinline__ float sigmoid_f(float v) { return __builtin_amdgcn_rcpf(1.0f + __builtin_amdgcn_exp2f(v * -LOG2E)); }
__device__ __forceinline__ float exp_f(float v) { return __builtin_amdgcn_exp2f(v * LOG2E); }

template <int PASS> __device__ __forceinline__ void mlstm_item(Frame& F, int b, int h, int sg) {
    const int wave = F.wave;
    int tid = F.tid; asm volatile("" : "+v"(tid));
    int lane = tid & 63, l15 = lane & 15, g4 = lane >> 4;
    LAS unsigned char* L = F.lds; LAS float* FL = (LAS float*)(L + ML_F);
    f32x4 C[8];
#pragma unroll
    for (int et = 0; et < 8; ++et) C[et] = (f32x4){0.f, 0.f, 0.f, 0.f};
    float m = -1e30f, Gsum = 0.f;
    LAS float* GV = (LAS float*)(L + ML_GV); LAS float* GS = (LAS float*)(L + ML_GS); LAS float* CW = (LAS float*)(L + ML_CW);
    __syncthreads();
    if (tid < 128) FL[FN + tid] = 0.f;
    for (int i = tid; i < 1024; i += NWAVES * 64) { const int j = i >> 8, ch = i & 255; CW[i] = F.conv_w[j * 1024 + (ch >> 7) * 512 + h * 128 + (ch & 127)]; }
    {
        const size_t tg = (size_t)b * SEQ + (size_t)(sg * 8 + wave) * 64 + lane;
        const float* gr = F.GATES + tg * 8;
        const float ig = gr[h] + F.igate_b[h], fg = gr[4 + h] + F.fgate_b[h];
        const float lf = fminf(fg, 0.f) - log1pf(__expf(-fabsf(fg)));
        float bs = lf;
#pragma unroll
        for (int o = 1; o < 64; o <<= 1) { const float t = __shfl_up(bs, o); if (lane >= o) bs += t; }
        const float gtot = __shfl(bs, 63);
        const float u = ig - bs;
        float pm = u;
#pragma unroll
        for (int o = 1; o < 64; o <<= 1) { const float t = __shfl_up(pm, o); if (lane >= o) pm = fmaxf(pm, t); }
        const float a = gtot + u;
        const float mloc = wave_max(a);
        GV[wave * 256 + lane] = bs; GV[wave * 256 + 64 + lane] = u; GV[wave * 256 + 128 + lane] = exp_f(a - mloc); GV[wave * 256 + 192 + lane] = pm;
        if (lane == 0) { GS[wave * 2] = gtot; GS[wave * 2 + 1] = mloc; }
    }
    if (PASS == 2 && sg > 0) {
        const float* E0 = F.SEG + (size_t)((b * 4 + h) * 8) * SEG_STRIDE;
        float lw[7]; float sfx = 0.f, mfin = -1e30f;
#pragma unroll
        for (int j = 6; j >= 0; --j) { const int jc = (j < sg) ? j : 0; const float mE = E0[(size_t)jc * SEG_STRIDE + 16384 + 128], G = E0[(size_t)jc * SEG_STRIDE + 16384 + 129];
            lw[j] = (j < sg) ? (mE + sfx) : -1e30f; sfx += (j < sg) ? G : 0.f; mfin = fmaxf(mfin, lw[j]); }
        float coef[7];
#pragma unroll
        for (int j = 0; j < 7; ++j) coef[j] = (j < sg) ? exp_f(lw[j] - mfin) : 0.f;
#pragma unroll 1
        for (int j = 0; j < sg; ++j) { const float* Ej = E0 + (size_t)j * SEG_STRIDE; float cj = coef[0];
#pragma unroll
            for (int q = 1; q < 7; ++q) cj = (j == q) ? coef[q] : cj;
#pragma unroll
            for (int et = 0; et < 8; ++et)
#pragma unroll
                for (int r = 0; r < 4; ++r) C[et][r] += cj * Ej[(unsigned)((16 * wave + 4 * g4 + r) * 128 + 16 * et + l15)];
            if (tid < 128) FL[FN + tid] += cj * Ej[16384 + tid]; }
        m = mfin;
    }
    if (PASS == 2) {
#pragma unroll
        for (int et = 0; et < 8; ++et) { v2u w; w.x = pg8::cvt_pk_bf16(C[et][0], C[et][1]); w.y = pg8::cvt_pk_bf16(C[et][2], C[et][3]); *(LAS v2u*)(L + ML_CT + (16 * et + l15) * ML_QSTR + (16 * wave + 4 * g4) * 2) = w; }
    }
    const float kscale = 0.08838834764831845f;
    v4u xr[7]; v4u vr[4];
#define ML_LOAD(cidx) do { const int c_ = (cidx); const size_t t0_ = (size_t)b * SEQ + (size_t)c_ * 64; \
        const int mat_ = tid >> 8, r8_ = tid & 255, dg_ = r8_ & 15, l0_ = 4 * (r8_ >> 4); \
        if (PASS == 2 || mat_ == 1) { const bf16* src_ = F.PROJ + (mat_ ? PC_MK : PC_MQ) + h * 128 + 8 * dg_; \
            _Pragma("unroll") for (int j = 0; j < 7; ++j) { const int lr = l0_ + j - 3; xr[j] = (c_ == 0 && lr < 0) ? (v4u){0u, 0u, 0u, 0u} : *(const v4u*)(src_ + (t0_ + lr) * NPROJ); } } \
        if (mat_ == 0) { _Pragma("unroll") for (int lp = 0; lp < 4; ++lp) vr[lp] = *(const v4u*)(F.PROJ + (t0_ + l0_ + lp) * NPROJ + PC_MV + h * 128 + 8 * dg_); } } while (0)
    ML_LOAD(sg * 8);
#pragma unroll 1
    for (int cc = 0; cc < 8; ++cc) {
        const int c = sg * 8 + cc; const size_t t0 = (size_t)b * SEQ + (size_t)c * 64;
        tid = F.tid; asm volatile("" : "+v"(tid));
        lane = tid & 63; l15 = lane & 15; g4 = lane >> 4;
        const int mat = tid >> 8, r8 = tid & 255, dg = r8 & 15, rg = r8 >> 4, l0 = 4 * rg;
        LAS float* GB = GV + cc * 256;
        __syncthreads();
        const float gtot = GS[cc * 2], mloc = GS[cc * 2 + 1];
        if (PASS == 2 || mat == 1) {
            const float w0 = GB[128 + l0], w1 = GB[128 + l0 + 1], w2 = GB[128 + l0 + 2], w3 = GB[128 + l0 + 3];
            unsigned ow[4][4];
            const LAS float* cwp = CW + mat * 128 + 8 * dg;
#pragma unroll
            for (int ip = 0; ip < 4; ++ip) {
                float ya[4], yb[4];
                const float ca0 = cwp[2 * ip], ca1 = cwp[256 + 2 * ip], ca2 = cwp[512 + 2 * ip], ca3 = cwp[768 + 2 * ip];
                const float cb0 = cwp[2 * ip + 1], cb1 = cwp[256 + 2 * ip + 1], cb2 = cwp[512 + 2 * ip + 1], cb3 = cwp[768 + 2 * ip + 1];
                float xa[7], xb[7];
#pragma unroll
                for (int j = 0; j < 7; ++j) { const unsigned w = (ip == 0) ? xr[j].x : (ip == 1) ? xr[j].y : (ip == 2) ? xr[j].z : xr[j].w; xa[j] = bflo(w); xb[j] = bfhi(w); }
#pragma unroll
                for (int lp = 0; lp < 4; ++lp) {
                    ya[lp] = silu_f(ca0 * xa[lp] + ca1 * xa[lp + 1] + ca2 * xa[lp + 2] + ca3 * xa[lp + 3]) * (mat ? kscale : 1.0f);
                    yb[lp] = silu_f(cb0 * xb[lp] + cb1 * xb[lp + 1] + cb2 * xb[lp + 2] + cb3 * xb[lp + 3]) * (mat ? kscale : 1.0f);
                    ow[lp][ip] = pg8::cvt_pk_bf16(ya[lp], yb[lp]); }
                if (mat == 1) {
                    v2u o; o.x = pg8::cvt_pk_bf16(ya[0] * w0, ya[1] * w1); o.y = pg8::cvt_pk_bf16(ya[2] * w2, ya[3] * w3); *(LAS v2u*)(L + ML_KWT + (8 * dg + 2 * ip) * ML_TSTR + l0 * 2) = o;
                    o.x = pg8::cvt_pk_bf16(yb[0] * w0, yb[1] * w1); o.y = pg8::cvt_pk_bf16(yb[2] * w2, yb[3] * w3); *(LAS v2u*)(L + ML_KWT + (8 * dg + 2 * ip + 1) * ML_TSTR + l0 * 2) = o; }
            }
            if (PASS == 2) {
                LAS unsigned char* dst = L + (mat ? ML_KS : ML_QS) + l0 * ML_QSTR + 16 * dg;
#pragma unroll
                for (int lp = 0; lp < 4; ++lp) { v4u o; o.x = ow[lp][0]; o.y = ow[lp][1]; o.z = ow[lp][2]; o.w = ow[lp][3]; *(LAS v4u*)(dst + lp * ML_QSTR) = o; }
            }
        }
        if (mat == 0) {
            const unsigned ww[4][4] = {{vr[0].x, vr[0].y, vr[0].z, vr[0].w}, {vr[1].x, vr[1].y, vr[1].z, vr[1].w}, {vr[2].x, vr[2].y, vr[2].z, vr[2].w}, {vr[3].x, vr[3].y, vr[3].z, vr[3].w}};
#pragma unroll
            for (int p = 0; p < 4; ++p) {
                v2u lo, hi;
                lo.x = (ww[0][p] & 0xffffu) | (ww[1][p] << 16); lo.y = (ww[2][p] & 0xffffu) | (ww[3][p] << 16);
                hi.x = (ww[0][p] >> 16) | (ww[1][p] & 0xffff0000u); hi.y = (ww[2][p] >> 16) | (ww[3][p] & 0xffff0000u);
                *(LAS v2u*)(L + ML_VT + (8 * dg + 2 * p) * ML_TSTR + l0 * 2) = lo;
                *(LAS v2u*)(L + ML_VT + (8 * dg + 2 * p + 1) * ML_TSTR + l0 * 2) = hi; }
        }
        __syncthreads();
        if (cc < 7) ML_LOAD(c + 1);
        v4u mo2[2];
        if (PASS == 2) {
#pragma unroll
            for (int it = 0; it < 2; ++it) mo2[it] = *(const v4u*)(F.PROJ + (t0 + 8 * wave + 4 * it + g4) * NPROJ + PC_MO + h * 128 + 8 * l15);
        }
        const float mn = fmaxf(gtot + m, mloc), so = exp_f(gtot + m - mn), sn = exp_f(mloc - mn);
        if (PASS == 2) {
            const int lt = wave >> 1;
#pragma unroll
            for (int si = 0; si < 2; ++si) { const int st = 2 * (wave & 1) + si;
                v2u pw = (v2u){0u, 0u};
                if (st <= lt) {
                    f32x4 acc = (f32x4){0.f, 0.f, 0.f, 0.f};
#pragma unroll
                    for (int ks = 0; ks < 4; ++ks) { const bf16x8 a = *(const LAS bf16x8*)(L + ML_KS + (16 * st + l15) * ML_QSTR + 64 * ks + 16 * g4);
                        const bf16x8 bb = *(const LAS bf16x8*)(L + ML_QS + (16 * lt + l15) * ML_QSTR + 64 * ks + 16 * g4);
                        acc = __builtin_amdgcn_mfma_f32_16x16x32_bf16(a, bb, acc, 0, 0, 0); }
                    const int l = 16 * lt + l15, s0 = 16 * st + 4 * g4; const float bl = GB[l]; const float e0 = bl - (bl + fmaxf(GB[192 + l], m));
                    const f32x4 us = *(const LAS f32x4*)(GB + 64 + s0);
                    float p[4];
#pragma unroll
                    for (int r = 0; r < 4; ++r) { const float e = __builtin_amdgcn_exp2f((e0 + us[r]) * LOG2E); p[r] = (s0 + r <= l) ? acc[r] * e : 0.f; }
                    pw.x = pg8::cvt_pk_bf16(p[0], p[1]); pw.y = pg8::cvt_pk_bf16(p[2], p[3]);
                }
                *(LAS v2u*)(L + ML_PS + (16 * lt + l15) * ML_TSTR + (16 * st + 4 * g4) * 2) = pw;
            }
            __syncthreads();
            {
                const int row = 8 * wave + (lane >> 3), part = lane & 7;
                const v4u pw = *(const LAS v4u*)(L + ML_PS + row * ML_TSTR + 16 * part);
                float pf[8]; unpack8(pw, pf);
                float sp = ((pf[0] + pf[1]) + (pf[2] + pf[3])) + ((pf[4] + pf[5]) + (pf[6] + pf[7]));
                const v4u q0 = *(const LAS v4u*)(L + ML_QS + row * ML_QSTR + 32 * part), q1 = *(const LAS v4u*)(L + ML_QS + row * ML_QSTR + 32 * part + 16);
                float qf[16]; unpack8(q0, qf); unpack8(q1, qf + 8);
                float qn = 0.f;
#pragma unroll
                for (int i = 0; i < 16; ++i) qn += qf[i] * FL[FN + 16 * part + i];
                const float bl = GB[row]; const float mrow = bl + fmaxf(GB[192 + row], m); const float sc = exp_f(bl + m - mrow);
                float tot = sp + sc * qn;
                tot += __shfl_xor(tot, 1); tot += __shfl_xor(tot, 2); tot += __shfl_xor(tot, 4);
                if (part == 0) FL[FDEN + row] = fmaxf(fabsf(tot), exp_f(-mrow));
            }
            const int eh = wave & 1;
            f32x4 o1[4], o2[4];
#pragma unroll
            for (int ei = 0; ei < 4; ++ei) { const int et = 4 * eh + ei;
                f32x4 a1 = (f32x4){0.f, 0.f, 0.f, 0.f}, a2 = (f32x4){0.f, 0.f, 0.f, 0.f};
#pragma unroll
                for (int ks = 0; ks < 2; ++ks) { const bf16x8 a = *(const LAS bf16x8*)(L + ML_VT + (16 * et + l15) * ML_TSTR + 64 * ks + 16 * g4);
                    const bf16x8 bb = *(const LAS bf16x8*)(L + ML_PS + (16 * lt + l15) * ML_TSTR + 64 * ks + 16 * g4);
                    a1 = __builtin_amdgcn_mfma_f32_16x16x32_bf16(a, bb, a1, 0, 0, 0); }
#pragma unroll
                for (int ks = 0; ks < 4; ++ks) { const bf16x8 a = *(const LAS bf16x8*)(L + ML_CT + (16 * et + l15) * ML_QSTR + 64 * ks + 16 * g4);
                    const bf16x8 bb = *(const LAS bf16x8*)(L + ML_QS + (16 * lt + l15) * ML_QSTR + 64 * ks + 16 * g4);
                    a2 = __builtin_amdgcn_mfma_f32_16x16x32_bf16(a, bb, a2, 0, 0, 0); }
                o1[ei] = a1; o2[ei] = a2; }
            __syncthreads();
            {
                const int l = 16 * lt + l15; const float bl = GB[l]; const float mrow = bl + fmaxf(GB[192 + l], m); const float sc = exp_f(bl + m - mrow);
                const float inv = 1.0f / FL[FDEN + l];
#pragma unroll
                for (int ei = 0; ei < 4; ++ei) { const int et = 4 * eh + ei; const f32x4 hv = (o1[ei] + o2[ei] * sc) * inv;
                    *(LAS f32x4*)(L + l * ML_HSTR + (16 * et + 4 * g4) * 4) = hv; }
            }
        }
        {
            bf16x8 af[2];
#pragma unroll
            for (int ks = 0; ks < 2; ++ks) af[ks] = *(const LAS bf16x8*)(L + ML_KWT + (16 * wave + l15) * ML_TSTR + 64 * ks + 16 * g4);
#pragma unroll
            for (int et = 0; et < 8; ++et) { f32x4 d = (f32x4){0.f, 0.f, 0.f, 0.f};
#pragma unroll
                for (int ks = 0; ks < 2; ++ks) { const bf16x8 bb = *(const LAS bf16x8*)(L + ML_VT + (16 * et + l15) * ML_TSTR + 64 * ks + 16 * g4);
                    d = __builtin_amdgcn_mfma_f32_16x16x32_bf16(af[ks], bb, d, 0, 0, 0); }
                C[et] = C[et] * so + d * sn; }
            if (tid < 128) { float dn = 0.f;
#pragma unroll
                for (int q = 0; q < 8; ++q) { const v4u w = *(const LAS v4u*)(L + ML_KWT + tid * ML_TSTR + 16 * q); float f[8]; unpack8(w, f); dn += ((f[0] + f[1]) + (f[2] + f[3])) + ((f[4] + f[5]) + (f[6] + f[7])); }
                FL[FN + tid] = so * FL[FN + tid] + sn * dn; }
            m = mn; Gsum += gtot;
            if (PASS == 2) {
#pragma unroll
                for (int et = 0; et < 8; ++et) { v2u w; w.x = pg8::cvt_pk_bf16(C[et][0], C[et][1]); w.y = pg8::cvt_pk_bf16(C[et][2], C[et][3]); *(LAS v2u*)(L + ML_CT + (16 * et + l15) * ML_QSTR + (16 * wave + 4 * g4) * 2) = w; }
            }
        }
        if (PASS == 2) {
            __syncthreads();
            const f32x4 gg0 = *(const f32x4*)(F.mlstm_norm_g + h * 128 + 8 * l15), gg1 = *(const f32x4*)(F.mlstm_norm_g + h * 128 + 8 * l15 + 4);
#pragma unroll
            for (int it = 0; it < 2; ++it) { const int l = 8 * wave + 4 * it + g4;
                const f32x4 h0 = *(const LAS f32x4*)(L + l * ML_HSTR + l15 * 32), h1 = *(const LAS f32x4*)(L + l * ML_HSTR + l15 * 32 + 16);
                float ss = (h0[0] * h0[0] + h0[1] * h0[1]) + (h0[2] * h0[2] + h0[3] * h0[3]) + (h1[0] * h1[0] + h1[1] * h1[1]) + (h1[2] * h1[2] + h1[3] * h1[3]);
                ss += __shfl_xor(ss, 1); ss += __shfl_xor(ss, 2); ss += __shfl_xor(ss, 4); ss += __shfl_xor(ss, 8);
                const float rstd = __builtin_amdgcn_rsqf(ss * (1.f / 128.f) + EPS);
                float mo[8]; unpack8(mo2[it], mo);
                const f32x4 y0 = h0 * gg0 * rstd, y1 = h1 * gg1 * rstd;
                v4u o; o.x = pg8::cvt_pk_bf16(y0[0] * sigmoid_f(mo[0]), y0[1] * sigmoid_f(mo[1])); o.y = pg8::cvt_pk_bf16(y0[2] * sigmoid_f(mo[2]), y0[3] * sigmoid_f(mo[3]));
                o.z = pg8::cvt_pk_bf16(y1[0] * sigmoid_f(mo[4]), y1[1] * sigmoid_f(mo[5])); o.w = pg8::cvt_pk_bf16(y1[2] * sigmoid_f(mo[6]), y1[3] * sigmoid_f(mo[7]));
                *(v4u*)(F.MIX + (t0 + l) * DM + h * 128 + 8 * l15) = o; }
        }
    }
    if (PASS == 1) {
        tid = F.tid; asm volatile("" : "+v"(tid)); lane = tid & 63; l15 = lane & 15; g4 = lane >> 4;
        float* E = F.SEG + (size_t)((b * 4 + h) * 8 + sg) * SEG_STRIDE;
#pragma unroll
        for (int et = 0; et < 8; ++et)
#pragma unroll
            for (int r = 0; r < 4; ++r) E[(16 * wave + 4 * g4 + r) * 128 + 16 * et + l15] = C[et][r];
        if (tid < 128) E[16384 + tid] = FL[FN + tid];
        if (tid == 0) { E[16384 + 128] = m; E[16384 + 129] = Gsum; }
    }
}
template <int PASS> __device__ __forceinline__ void mlstm_phase(Frame& F) {
    for (int it = F.vcu; it < NB * 4 * 8; it += F.G) { const int sg = it & 7, h = (it >> 3) & 3, b = it >> 5;
        if (PASS == 1 && sg == 7) { convert_gu(F, it >> 3, NB * 4); continue; }
        mlstm_item<PASS>(F, b, h, sg); }
}
struct Args { const float* in[15]; float* out; unsigned char* ws; int ph_lo, ph_hi, li, pad; };
__global__ void __launch_bounds__(NWAVES * 64, 2) mk_fwd(Args args) {
    extern __shared__ __attribute__((aligned(16))) unsigned char lds[];
    Frame F;
    F.lds = (LAS unsigned char*)lds;
    F.MISC = (volatile LAS unsigned*)(F.lds + MISC_OFF);
    F.tid = threadIdx.x; F.lane = F.tid & 63; F.wave = __builtin_amdgcn_readfirstlane(F.tid >> 6);
    F.G = gridDim.x; { const int bx = blockIdx.x; F.vcu = (F.G % 8 == 0) ? (bx % 8) * (F.G / 8) + bx / 8 : bx; }
    unsigned char* ws = args.ws;
    F.ctl = (gu32*)(ws + WS_CTL);
    F.x = args.in[0]; F.norm1_g = args.in[1]; F.w_in = args.in[2]; F.conv_w = args.in[3]; F.igate_b = args.in[4]; F.fgate_b = args.in[5]; F.mlstm_norm_g = args.in[6];
    F.q_norm_g = args.in[7]; F.k_norm_g = args.in[8]; F.sinks = args.in[9]; F.w_out = args.in[10]; F.norm2_g = args.in[11]; F.w_gate = args.in[12]; F.w_up = args.in[13]; F.w_down = args.in[14];
    F.out = args.out;
    F.Win_t = (bf16*)(ws + WS_WIN); F.Wout_t = (bf16*)(ws + WS_WOUT); F.Wgu_t = (bf16*)(ws + WS_WGU); F.Wdn_t = (bf16*)(ws + WS_WDN);
    F.XN = (bf16*)(ws + WS_XN); F.MIX = (bf16*)(ws + WS_MIX); F.PROJ = (bf16*)(ws + WS_PROJ);
    F.ROPE = (float2*)(ws + WS_ROPE); F.GATES = (float*)(ws + WS_GATES); F.SSQ = (float*)(ws + WS_SSQ); F.SEG = (float*)(ws + WS_SEG); F.WBG = ws + WS_WBG;
    for (int u = F.tid; u < (LDS_BYTES - LDSCTL_OFF) / 4; u += NWAVES * 64) ((LAS unsigned*)(F.lds + LDSCTL_OFF))[u] = 0u;
    __syncthreads();
    const int lo = args.ph_lo, hi = args.ph_hi;
    XcdBarrier bar; bar.bar = (unsigned*)(F.ctl + CW_BAR) + args.li * XCD_BAR_WORDS; bar.x = 0; bar.st = nullptr;
    if (hi - lo > 1) bar = xcd_barrier_post((unsigned*)(F.ctl + CW_BAR) + args.li * XCD_BAR_WORDS, F.MISC + 8);
#define IN(k) (lo <= (k) && (k) < hi)
#define BOTH(k) (IN(k) && IN((k) + 1))
#define GRID_BAR() xcd_barrier(bar)

#ifndef DOUBLE_PHASE
#define DOUBLE_PHASE -1
#endif
#define RUN_PHASE(k, BODY) if (IN(k)) { { int t_ = threadIdx.x; asm volatile("" : "+v"(t_)); F.tid = t_; F.lane = t_ & 63; }     \
    BODY; if (DOUBLE_PHASE == (k)) { GRID_BAR(); BODY; } if (BOTH(k)) GRID_BAR(); }
#define PH0 p0_prologue(F)
#define PH1 do { pg8::Gemm g{F.XN, F.Win_t, T, NPROJ, DM}; pg8::StaticOrder S; S.init(T, NPROJ, F.G, (int)blockIdx.x); pg8::EpiStoreBf16 E{F.PROJ, NPROJ}; \
        pg8::gemm_phase<pg8::EpiStoreBf16, pg8::StaticOrder, true, true>(F.lds, g, S, E); \
        { const int nwg_ = (T / 256) * (NPROJ / 256), rem_ = nwg_ % F.G;               \
          if (rem_ == 0) p1_side_work(F, (int)blockIdx.x, F.G); else if ((int)blockIdx.x >= rem_) p1_side_work(F, (int)blockIdx.x - rem_, F.G - rem_); } } while (0)
#ifdef H1_BF16
#define PH4 do { pg8::Gemm g{F.MIX, F.Wout_t, T, DM, DM}; pg8::StaticOrder S; S.init(T, DM, F.G, (int)blockIdx.x); pg8::EpiResidNormBS E{F.x, F.XN, F.SSQ}; \
        pg8::gemm_phase<pg8::EpiResidNormBS, pg8::StaticOrder, true, true>(F.lds, g, S, E); } while (0)
#define PH6 do { pg8::Gemm g{F.PROJ, F.Wdn_t, T, DM, DFF}; pg8::StaticOrder S; S.init(T, DM, F.G, (int)blockIdx.x); pg8::EpiResidOutB E{F.XN, F.out}; \
        pg8::gemm_phase<pg8::EpiResidOutB, pg8::StaticOrder, true, true>(F.lds, g, S, E); } while (0)
#else
#define PH4 do { pg8::Gemm g{F.MIX, F.Wout_t, T, DM, DM}; pg8::StaticOrder S; S.init(T, DM, F.G, (int)blockIdx.x); pg8::EpiResidNorm E{F.x, F.out, F.XN, F.SSQ}; \
        pg8::gemm_phase<pg8::EpiResidNorm, pg8::StaticOrder, true, true>(F.lds, g, S, E); } while (0)
#define PH6 do { pg8::Gemm g{F.PROJ, F.Wdn_t, T, DM, DFF}; pg8::StaticOrder S; S.init(T, DM, F.G, (int)blockIdx.x); pg8::EpiResidOut E{F.out, F.out}; \
        pg8::gemm_phase<pg8::EpiResidOut, pg8::StaticOrder, true, true>(F.lds, g, S, E); } while (0)
#endif
#define PH5 do { pg8::Gemm g{F.XN, F.Wgu_t, T, 2 * DFF, DM}; pg8::StaticOrder S; S.init(T, 2 * DFF, F.G, (int)blockIdx.x); pg8::EpiSwiGLU E{F.PROJ, DFF, F.SSQ, EPS}; \
        pg8::gemm_phase<pg8::EpiSwiGLU, pg8::StaticOrder, P5_ALIGN, true>(F.lds, g, S, E); } while (0)
    RUN_PHASE(0, PH0)
    RUN_PHASE(1, PH1)
    RUN_PHASE(2, PHASE2_BODY)
    RUN_PHASE(3, PHASE3_BODY)
    RUN_PHASE(4, PH4)
    RUN_PHASE(5, PH5)
#if defined(PROBE_P6)
    if (IN(6)) { { pg8::Gemm g{F.PROJ, F.Wdn_t, T, DM, DFF}; pg8::StaticOrder S; S.init(T, DM, F.G, (int)blockIdx.x); pg8::EpiResidOutB E{F.XN, (float*)(ws + 352 * MiB)};
        pg8::gemm_phase<pg8::EpiResidOutB, pg8::StaticOrder, true, true>(F.lds, g, S, E); } GRID_BAR(); }
#endif
    RUN_PHASE(6, PH6)
#undef IN
#undef BOTH
}
extern "C" void kernel_launch(void* const* d_in, const int* in_sizes, int n_in, void* d_out, int out_size, void* d_ws, size_t ws_size, hipStream_t stream) {
    static int grid = 0;
    if (grid == 0) {
        if (n_in != 15 || in_sizes[0] != T * DM || out_size != T * DM || ws_size < WS_END) { fprintf(stderr, "kernel_launch: unexpected shapes / workspace (n_in %d, ws %zu)\n", n_in, ws_size); grid = -1; return; }
        int dev = 0, cus = 0, per_cu = 0;
        if (hipGetDevice(&dev) != hipSuccess || hipDeviceGetAttribute(&cus, hipDeviceAttributeMultiprocessorCount, dev) != hipSuccess) { grid = -1; return; }
        if (hipFuncSetAttribute((const void*)mk_fwd, hipFuncAttributeMaxDynamicSharedMemorySize, LDS_BYTES) != hipSuccess) { fprintf(stderr, "kernel_launch: hipFuncSetAttribute failed\n"); grid = -1; return; }
        if (hipOccupancyMaxActiveBlocksPerMultiprocessor(&per_cu, (const void*)mk_fwd, NWAVES * 64, LDS_BYTES) != hipSuccess || per_cu < 1) { fprintf(stderr, "kernel_launch: occupancy query says %d blocks per CU\n", per_cu); grid = -1; (void)hipGetLastError(); return; }
        grid = cus;
    }
    if (grid < 0) return;
    (void)hipMemsetAsync((char*)d_ws + WS_CTL, 0, CTL_ZERO_BYTES, stream);
    Args a{};
    for (int i = 0; i < 15; ++i) a.in[i] = (const float*)d_in[i];
    a.out = (float*)d_out; a.ws = (unsigned char*)d_ws;
    LAUNCH_PROGRAM
}
```

```cpp
#include <hip/hip_runtime.h>
#include <cstdio>
#include <cstdint>
__device__ __forceinline__ int fresh_lane() { return (int)__builtin_amdgcn_mbcnt_hi(~0u, __builtin_amdgcn_mbcnt_lo(~0u, 0u)); }
namespace pg8 {
#define PG8_LAS __attribute__((address_space(3)))
typedef unsigned short bf16_t;
typedef short bf16x8 __attribute__((ext_vector_type(8)));
typedef float f32x4 __attribute__((ext_vector_type(4)));
typedef unsigned u32x4 __attribute__((ext_vector_type(4)));
constexpr int BM = 256, BK = 64, HALF = 128, HTB = HALF * BK * 2  , STAGE_BYTES = 8 * HTB, NXCD = 8, WGM = 8;

__host__ __device__ __forceinline__ int lds_byte(int r, int c) { const int st = (r >> 4) * 2 + (c >> 5), rr = r & 15, cc = c & 31, ob = rr * 64 + cc * 2; return st * 1024 + (ob ^ (((ob >> 9) & 1) << 5)); }
__host__ __device__ __forceinline__ void stage_rc(int b, int& R, int& C) { const int st = b / 1024, sb = b % 1024, swz = sb ^ (((sb >> 9) & 1) << 5); R = (st >> 1) * 16 + swz / 64; C = (st & 1) * 32 + (swz % 64) / 2; }
__host__ __device__ __forceinline__ int perm32(int rho) { const int n = rho >> 4, i = rho & 15; return 8 * (i >> 2) + 4 * n + (i & 3); }

struct Unit { int pm, pn; };
struct Gemm { const bf16_t* A; const bf16_t* Bt; int M, N, K; };

struct StaticOrder {
    int nM, nN, nwg, G, c;
    __host__ __device__ void init(int M, int N, int G_, int c_) { nM = M / BM; nN = N / BM; nwg = nM * nN; G = G_; c = c_; }
    __host__ __device__ bool next(int i, Unit& u) const {
        const long L = (long)i * G + c; if (L >= nwg) return false;
        int wgid = (int)L; { const int q = nwg / NXCD, r = nwg % NXCD, xcd = wgid % NXCD, off = wgid / NXCD; wgid = (xcd < r ? xcd * (q + 1) : r * (q + 1) + (xcd - r) * q) + off; }
        const int nig = WGM * nN, gid = wgid / nig, fm = gid * WGM, gsz = (nM - fm) < WGM ? (nM - fm) : WGM;
        u.pm = fm + ((wgid % nig) % gsz); u.pn = (wgid % nig) / gsz; return true;
    }
    __device__ __forceinline__ void a_ready(const Unit&) const {}
    __device__ __forceinline__ void done(const Unit&) const {}
};

__device__ __forceinline__ unsigned cvt_pk_bf16(float lo, float hi) { unsigned r; asm volatile("v_cvt_pk_bf16_f32 %0, %1, %2" : "=v"(r) : "v"(lo), "v"(hi)); return r; }
typedef float f32x2 __attribute__((ext_vector_type(2)));
#ifdef WT_STORES
__device__ __forceinline__ void st16(void* p, u32x4 v) { asm volatile("global_store_dwordx4 %0, %1, off sc1\n\ts_nop 1" :: "v"(p), "v"(v) : "memory"); }
#else
__device__ __forceinline__ void st16(void* p, u32x4 v) { *(u32x4*)p = v; }
#endif
__device__ __forceinline__ float fast_silu(float v) { return v * __builtin_amdgcn_rcpf(1.0f + __builtin_amdgcn_exp2f(v * -1.4426950408889634f)); }
struct EpiStoreBf16 {
    static constexpr bool PERM = true, AFTER_DRAIN = false, STREAM_R = false, STREAM_BF16 = false;
    bf16_t* O; int ldc;
    __device__ __forceinline__ void operator()(const f32x4 (&acc)[2][2][4][2], const Unit& u, int wr, int wc, int fr, int fq) const {
        const int row0 = u.pm * BM + wr * 64 + fr, col0 = u.pn * BM + wc * 32 + 8 * fq;
#pragma unroll
        for (int ai = 0; ai < 2; ++ai)
#pragma unroll
            for (int m = 0; m < 4; ++m) { bf16_t* rowp = O + (size_t)(row0 + ai * HALF + m * 16) * ldc + col0;
#pragma unroll
                for (int bj = 0; bj < 2; ++bj) { const f32x4 v0 = acc[ai][bj][m][0], v1 = acc[ai][bj][m][1];
                    u32x4 w; w.x = cvt_pk_bf16(v0[0], v0[1]); w.y = cvt_pk_bf16(v0[2], v0[3]); w.z = cvt_pk_bf16(v1[0], v1[1]); w.w = cvt_pk_bf16(v1[2], v1[3]);
                    st16(rowp + bj * HALF, w); } }
    }
};
struct EpiResidNorm {
    static constexpr bool PERM = true, AFTER_DRAIN = false, STREAM_R = false, STREAM_BF16 = false;
    const float* X; float* H; bf16_t* HB; float* SSQ;
    __device__ __forceinline__ void operator()(const f32x4 (&acc)[2][2][4][2], const Unit& u, int wr, int wc, int fr, int fq) const {
        const int row0 = u.pm * BM + wr * 64 + fr, col0 = u.pn * BM + wc * 32 + 8 * fq;
#pragma unroll
        for (int ai = 0; ai < 2; ++ai)
#pragma unroll
            for (int m = 0; m < 4; ++m) { const int row = row0 + ai * HALF + m * 16; const size_t off = (size_t)row * 1024 + col0; float ss = 0.f;
#pragma unroll
                for (int bj = 0; bj < 2; ++bj) { const f32x4 x0 = *(const f32x4*)(X + off + bj * HALF), x1 = *(const f32x4*)(X + off + bj * HALF + 4);
                    const f32x4 v0 = x0 + acc[ai][bj][m][0], v1 = x1 + acc[ai][bj][m][1];
                    *(f32x4*)(H + off + bj * HALF) = v0; *(f32x4*)(H + off + bj * HALF + 4) = v1;
                    u32x4 w; w.x = cvt_pk_bf16(v0[0], v0[1]); w.y = cvt_pk_bf16(v0[2], v0[3]); w.z = cvt_pk_bf16(v1[0], v1[1]); w.w = cvt_pk_bf16(v1[2], v1[3]);
                    *(u32x4*)(HB + off + bj * HALF) = w;
                    ss += (v0[0] * v0[0] + v0[1] * v0[1]) + (v0[2] * v0[2] + v0[3] * v0[3]) + (v1[0] * v1[0] + v1[1] * v1[1]) + (v1[2] * v1[2] + v1[3] * v1[3]); }
                ss += __shfl_xor(ss, 16); ss += __shfl_xor(ss, 32);
                if (fq == 0) SSQ[(size_t)row * 16 + u.pn * 4 + wc] = ss; }
    }
};
struct EpiSwiGLU {
    static constexpr bool PERM = true, AFTER_DRAIN = false, STREAM_R = false, STREAM_BF16 = false;
    bf16_t* O; int ldc; const float* SSQ; float eps;
    __device__ __forceinline__ void operator()(const f32x4 (&acc)[2][2][4][2], const Unit& u, int wr, int wc, int fr, int fq) const {
        const int row0 = u.pm * BM + wr * 64 + fr, col0 = u.pn * HALF + wc * 32 + 8 * fq;
        f32x4 sv[4];
        { const f32x4* sp = (const f32x4*)(SSQ + (size_t)row0 * 16); sv[0] = sp[0]; sv[1] = sp[1]; sv[2] = sp[2]; sv[3] = sp[3]; }
#pragma unroll
        for (int grp = 0; grp < 8; ++grp) { const int ai = grp >> 2, m = grp & 3; const int row = row0 + ai * HALF + m * 16;
            const f32x4 t = (sv[0] + sv[1]) + (sv[2] + sv[3]);
            const float rs = __builtin_amdgcn_rsqf(((t[0] + t[1]) + (t[2] + t[3])) * (1.0f / 1024.0f) + eps);
            if (grp < 7) { const int rown = row0 + ((grp + 1) >> 2) * HALF + ((grp + 1) & 3) * 16; const f32x4* sp = (const f32x4*)(SSQ + (size_t)rown * 16); sv[0] = sp[0]; sv[1] = sp[1]; sv[2] = sp[2]; sv[3] = sp[3]; }
            float h[8];
#pragma unroll
            for (int n = 0; n < 2; ++n)
#pragma unroll
                for (int j = 0; j < 4; ++j) { const float g = acc[ai][0][m][n][j] * rs, up = acc[ai][1][m][n][j] * rs; h[n * 4 + j] = fast_silu(g) * up; }
            u32x4 w; w.x = cvt_pk_bf16(h[0], h[1]); w.y = cvt_pk_bf16(h[2], h[3]); w.z = cvt_pk_bf16(h[4], h[5]); w.w = cvt_pk_bf16(h[6], h[7]);
            st16(O + (size_t)row * ldc + col0, w); }
    }
};
struct EpiResidOut {
    static constexpr bool PERM = true, AFTER_DRAIN = false, STREAM_R = false, STREAM_BF16 = false;
    const float* R; float* OUT;
    __device__ __forceinline__ void operator()(const f32x4 (&acc)[2][2][4][2], const Unit& u, int wr, int wc, int fr, int fq) const {
        const int row0 = u.pm * BM + wr * 64 + fr, col0 = u.pn * BM + wc * 32 + 8 * fq;
#pragma unroll
        for (int ai = 0; ai < 2; ++ai)
#pragma unroll
            for (int m = 0; m < 4; ++m) { const size_t off = (size_t)(row0 + ai * HALF + m * 16) * 1024 + col0;
#pragma unroll
                for (int bj = 0; bj < 2; ++bj) { const f32x4 r0 = *(const f32x4*)(R + off + bj * HALF), r1 = *(const f32x4*)(R + off + bj * HALF + 4);
                    *(f32x4*)(OUT + off + bj * HALF) = r0 + acc[ai][bj][m][0]; *(f32x4*)(OUT + off + bj * HALF + 4) = r1 + acc[ai][bj][m][1]; } }
    }
};
struct EpiResidNormB {
    static constexpr bool PERM = true, AFTER_DRAIN = false, STREAM_R = false, STREAM_BF16 = false;
    const float* X; bf16_t* HB; float* SSQ;
    __device__ __forceinline__ void operator()(const f32x4 (&acc)[2][2][4][2], const Unit& u, int wr, int wc, int fr, int fq) const {
        const int row0 = u.pm * BM + wr * 64 + fr, col0 = u.pn * BM + wc * 32 + 8 * fq;
#pragma unroll
        for (int ai = 0; ai < 2; ++ai)
#pragma unroll
            for (int m = 0; m < 4; ++m) { const int row = row0 + ai * HALF + m * 16; const size_t off = (size_t)row * 1024 + col0; float ss = 0.f;
#pragma unroll
                for (int bj = 0; bj < 2; ++bj) { const f32x4 x0 = *(const f32x4*)(X + off + bj * HALF), x1 = *(const f32x4*)(X + off + bj * HALF + 4);
                    const f32x4 v0 = x0 + acc[ai][bj][m][0], v1 = x1 + acc[ai][bj][m][1];
                    u32x4 w; w.x = cvt_pk_bf16(v0[0], v0[1]); w.y = cvt_pk_bf16(v0[2], v0[3]); w.z = cvt_pk_bf16(v1[0], v1[1]); w.w = cvt_pk_bf16(v1[2], v1[3]);
                    *(u32x4*)(HB + off + bj * HALF) = w;
                    ss += (v0[0] * v0[0] + v0[1] * v0[1]) + (v0[2] * v0[2] + v0[3] * v0[3]) + (v1[0] * v1[0] + v1[1] * v1[1]) + (v1[2] * v1[2] + v1[3] * v1[3]); }
                ss += __shfl_xor(ss, 16); ss += __shfl_xor(ss, 32);
                if (fq == 0) SSQ[(size_t)row * 16 + u.pn * 4 + wc] = ss; }
    }
};
struct EpiResidOutB {
    static constexpr bool PERM = true, AFTER_DRAIN = false, STREAM_R = false, STREAM_BF16 = false;
    const bf16_t* RB; float* OUT;
    __device__ __forceinline__ void operator()(const f32x4 (&acc)[2][2][4][2], const Unit& u, int wr, int wc, int fr, int fq) const {
        const int row0 = u.pm * BM + wr * 64 + fr, col0 = u.pn * BM + wc * 32 + 8 * fq;
#pragma unroll
        for (int ai = 0; ai < 2; ++ai) {
            u32x4 rw[4][2];
#pragma unroll
            for (int m = 0; m < 4; ++m) { const size_t off = (size_t)(row0 + ai * HALF + m * 16) * 1024 + col0;
#pragma unroll
                for (int bj = 0; bj < 2; ++bj) rw[m][bj] = *(const u32x4*)(RB + off + bj * HALF); }
#pragma unroll
            for (int m = 0; m < 4; ++m) { const size_t off = (size_t)(row0 + ai * HALF + m * 16) * 1024 + col0;
#pragma unroll
                for (int bj = 0; bj < 2; ++bj) { const u32x4 w = rw[m][bj];
                    const f32x4 r0 = (f32x4){__builtin_bit_cast(float, w.x << 16), __builtin_bit_cast(float, w.x & 0xffff0000u), __builtin_bit_cast(float, w.y << 16), __builtin_bit_cast(float, w.y & 0xffff0000u)};
                    const f32x4 r1 = (f32x4){__builtin_bit_cast(float, w.z << 16), __builtin_bit_cast(float, w.z & 0xffff0000u), __builtin_bit_cast(float, w.w << 16), __builtin_bit_cast(float, w.w & 0xffff0000u)};
                    *(f32x4*)(OUT + off + bj * HALF) = r0 + acc[ai][bj][m][0]; *(f32x4*)(OUT + off + bj * HALF + 4) = r1 + acc[ai][bj][m][1]; } }
            asm volatile("" ::: "memory");
        }
    }
};
struct EpiResidNormBS {
    static constexpr bool PERM = true, AFTER_DRAIN = false, STREAM_R = true, STREAM_BF16 = false;
    const float* RS; bf16_t* HB; float* SSQ;
    __device__ __forceinline__ void operator()(const f32x4 (&acc)[2][2][4][2], const Unit& u, int wr, int wc, int fr, int fq) const {
        { int t_ = threadIdx.x; asm volatile("" : "+v"(t_)); fr = t_ & 15; fq = (t_ >> 4) & 3; }
        const int row0 = u.pm * BM + wr * 64 + fr, col0 = u.pn * BM + wc * 32 + 8 * fq;
#pragma unroll
        for (int ai = 0; ai < 2; ++ai)
#pragma unroll
            for (int m = 0; m < 4; ++m) { const int row = row0 + ai * HALF + m * 16; const size_t off = (size_t)row * 1024 + col0; float ss = 0.f;
#pragma unroll
                for (int bj = 0; bj < 2; ++bj) { const f32x4 v0 = acc[ai][bj][m][0], v1 = acc[ai][bj][m][1];
                    u32x4 w; w.x = cvt_pk_bf16(v0[0], v0[1]); w.y = cvt_pk_bf16(v0[2], v0[3]); w.z = cvt_pk_bf16(v1[0], v1[1]); w.w = cvt_pk_bf16(v1[2], v1[3]);
                    st16(HB + off + bj * HALF, w);
                    ss += (v0[0] * v0[0] + v0[1] * v0[1]) + (v0[2] * v0[2] + v0[3] * v0[3]) + (v1[0] * v1[0] + v1[1] * v1[1]) + (v1[2] * v1[2] + v1[3] * v1[3]); }
                ss += __shfl_xor(ss, 16); ss += __shfl_xor(ss, 32);
                if (fq == 0) SSQ[(size_t)row * 16 + u.pn * 4 + wc] = ss; }
    }
};
struct EpiResidOutBS {
    static constexpr bool PERM = true, AFTER_DRAIN = false, STREAM_R = true, STREAM_BF16 = true;
    const bf16_t* RS; float* OUT;
    __device__ __forceinline__ void operator()(const f32x4 (&acc)[2][2][4][2], const Unit& u, int wr, int wc, int fr, int fq) const {
        { int t_ = threadIdx.x; asm volatile("" : "+v"(t_)); fr = t_ & 15; fq = (t_ >> 4) & 3; }
        const int row0 = u.pm * BM + wr * 64 + fr, col0 = u.pn * BM + wc * 32 + 8 * fq;
#pragma unroll
        for (int ai = 0; ai < 2; ++ai)
#pragma unroll
            for (int m = 0; m < 4; ++m) { const size_t off = (size_t)(row0 + ai * HALF + m * 16) * 1024 + col0;
#pragma unroll
                for (int bj = 0; bj < 2; ++bj) { *(f32x4*)(OUT + off + bj * HALF) = acc[ai][bj][m][0]; *(f32x4*)(OUT + off + bj * HALF + 4) = acc[ai][bj][m][1]; } }
    }
};
template <class Epi, class Sched, bool ALIGN_EPI = false, bool SP2 = false>
__device__ __forceinline__ void gemm_phase(PG8_LAS unsigned char* lds, const Gemm g, const Sched& S, const Epi& E) {
    const int tid = threadIdx.x, wid = __builtin_amdgcn_readfirstlane(tid >> 6), lane = tid & 63, wr = wid >> 2, wc = wid & 3, fr = lane & 15, fq = lane >> 4;
    const int K = g.K, nt = K / BK;
    unsigned voffA[2], voffB[2];
#pragma unroll
    for (int i = 0; i < 2; ++i) { int R, C; stage_rc(tid * 16 + i * 8192, R, C); const int Rb = Epi::PERM ? ((R & ~31) + perm32(R & 31)) : R;
        voffA[i] = (unsigned)(R * K + C) * 2u; voffB[i] = (unsigned)(Rb * K + C) * 2u; }
    const size_t kstep = (size_t)(BK * 2);
    const size_t hstep = (size_t)HALF * K * 2;
    const size_t tstep = 2 * hstep;
    const unsigned ldsw = (unsigned)wid * 1024u;
    const int aoff = lds_byte(wr * 64 + fr, fq * 8), boff = lds_byte(wc * 32 + fr, fq * 8);
#define PG8_SA(b, h) (((b) * 2 + (h)) * HTB)
#define PG8_SB(b, h) ((4 + (b) * 2 + (h)) * HTB)
#define PG8_STAGE(bufoff, gbase, voff) do { _Pragma("unroll") for (int _i = 0; _i < 2; ++_i) \
        __builtin_amdgcn_global_load_lds((const unsigned*)((const char*)(gbase) + (voff)[_i]), (PG8_LAS unsigned*)(lds + (bufoff) + ldsw + _i * 8192), 16, 0, 0); } while (0)
#define PG8_LDA(dst, b, h) do { _Pragma("unroll") for (int m = 0; m < 4; ++m) _Pragma("unroll") for (int k = 0; k < 2; ++k) dst[m][k] = *(const PG8_LAS bf16x8*)(lds + PG8_SA(b, h) + aoff + m * 2048 + k * 1024); } while (0)
#define PG8_LDB(dst, b, h) do { _Pragma("unroll") for (int n = 0; n < 2; ++n) _Pragma("unroll") for (int k = 0; k < 2; ++k) dst[n][k] = *(const PG8_LAS bf16x8*)(lds + PG8_SB(b, h) + boff + n * 2048 + k * 1024); } while (0)
#define PG8_MMA(ai, bj, At, Bt) do { __builtin_amdgcn_s_setprio(1); _Pragma("unroll") for (int m = 0; m < 4; ++m) _Pragma("unroll") for (int n = 0; n < 2; ++n) _Pragma("unroll") for (int k = 0; k < 2; ++k) \
        acc[ai][bj][m][n] = __builtin_amdgcn_mfma_f32_16x16x32_bf16(Bt[n][k], At[m][k], acc[ai][bj][m][n], 0, 0, 0); __builtin_amdgcn_s_setprio(0); } while (0)
#define PG8_WAIT_V(n) asm volatile("s_waitcnt vmcnt(" #n ")" ::: "memory")
#define PG8_WAIT_L(n) asm volatile("s_waitcnt lgkmcnt(" #n ")" ::: "memory")
#define PG8_BAR __builtin_amdgcn_s_barrier()
#define PG8_SCHED __builtin_amdgcn_sched_barrier(0)
#define PG8_PIECE_OFF 147456
#define PG8_RLOAD_P(p) do { if constexpr (Epi::STREAM_BF16) { const char* pa_ = rcur + (size_t)((((((p) >> 3) & 1) * HALF + (((p) >> 1) & 3) * 16) * 1024 + ((p) & 1) * HALF) * 2) + (rvoff >> 1); \
            __builtin_amdgcn_global_load_lds((const unsigned*)pa_, (PG8_LAS unsigned*)(lds + PG8_PIECE_OFF + wid * 2048), 16, 0, 0); \
        } else { const char* pa_ = rcur + (size_t)((((((p) >> 3) & 1) * HALF + (((p) >> 1) & 3) * 16) * 1024 + ((p) & 1) * HALF) * 4) + rvoff; \
            __builtin_amdgcn_global_load_lds((const unsigned*)pa_, (PG8_LAS unsigned*)(lds + PG8_PIECE_OFF + wid * 2048), 16, 0, 0); \
            __builtin_amdgcn_global_load_lds((const unsigned*)(pa_ + 16), (PG8_LAS unsigned*)(lds + PG8_PIECE_OFF + wid * 2048 + 1024), 16, 0, 0); } } while (0)
#define PG8_RADD_P(p) do { if constexpr (Epi::STREAM_BF16) { typedef unsigned u32x2_ __attribute__((ext_vector_type(2))); \
            { const u32x2_ w_ = *(const PG8_LAS u32x2_*)(lds + PG8_PIECE_OFF + wid * 2048 + lane * 16); \
              acc[((p) >> 3) & 1][(p) & 1][((p) >> 1) & 3][0] += (f32x4){__builtin_bit_cast(float, w_.x << 16), __builtin_bit_cast(float, w_.x & 0xffff0000u), __builtin_bit_cast(float, w_.y << 16), __builtin_bit_cast(float, w_.y & 0xffff0000u)}; } \
            asm volatile("" ::: "memory"); \
            { const u32x2_ w_ = *(const PG8_LAS u32x2_*)(lds + PG8_PIECE_OFF + wid * 2048 + lane * 16 + 8); \
              acc[((p) >> 3) & 1][(p) & 1][((p) >> 1) & 3][1] += (f32x4){__builtin_bit_cast(float, w_.x << 16), __builtin_bit_cast(float, w_.x & 0xffff0000u), __builtin_bit_cast(float, w_.y << 16), __builtin_bit_cast(float, w_.y & 0xffff0000u)}; } \
        } else { { const f32x4 q0_ = *(const PG8_LAS f32x4*)(lds + PG8_PIECE_OFF + wid * 2048 + lane * 16); acc[((p) >> 3) & 1][(p) & 1][((p) >> 1) & 3][0] += q0_; } asm volatile("" ::: "memory"); \
        { const f32x4 q1_ = *(const PG8_LAS f32x4*)(lds + PG8_PIECE_OFF + wid * 2048 + 1024 + lane * 16); acc[((p) >> 3) & 1][(p) & 1][((p) >> 1) & 3][1] += q1_; } } } while (0)
#define PG8_WAIT_V1P() do { if constexpr (Epi::STREAM_BF16) PG8_WAIT_V(9); else PG8_WAIT_V(10); } while (0)
#define PG8_KPAIR(t, P0_, P1_) do { \
            const bool last = ((t) == nt - 2); \
            const char* a1 = cA + (size_t)((t) + 1) * kstep; \
            const char* a2 = last ? nA : cA + (size_t)((t) + 2) * kstep; const char* b2 = last ? nB : cB + (size_t)((t) + 2) * kstep; \
            const char* a3 = a2 + kstep; const char* b3 = b2 + kstep; \
            if (last && has_next) S.a_ready(nxt); \
            if constexpr ((P0_) >= 0) PG8_RLOAD_P(P0_); \
            PG8_LDB(B0, 0, 0); PG8_LDB(B1, 0, 1); PG8_SCHED; PG8_LDA(At, 0, 0); PG8_STAGE(PG8_SA(1, 1), a1 + hstep, voffA); \
            if constexpr ((P0_) >= 0) PG8_WAIT_V1P(); else PG8_WAIT_V(8); \
            PG8_WAIT_L(0); PG8_BAR; PG8_MMA(0, 0, At, B0); PG8_MMA(0, 1, At, B1); PG8_BAR; PG8_SCHED; \
            PG8_LDA(At, 0, 1); PG8_STAGE(PG8_SB(0, 0), b2, voffB); PG8_STAGE(PG8_SB(0, 1), b2 + hstep, voffB); PG8_STAGE(PG8_SA(0, 0), a2, voffA); \
            PG8_WAIT_V(8); PG8_WAIT_L(0); PG8_BAR; if constexpr ((P0_) >= 0) PG8_RADD_P(P0_); PG8_MMA(1, 0, At, B0); PG8_MMA(1, 1, At, B1); PG8_BAR; PG8_SCHED; \
            if constexpr ((P1_) >= 0) PG8_RLOAD_P(P1_); \
            PG8_LDB(B0, 1, 0); PG8_LDB(B1, 1, 1); PG8_SCHED; PG8_LDA(At, 1, 0); PG8_STAGE(PG8_SA(0, 1), a2 + hstep, voffA); \
            if constexpr ((P1_) >= 0) PG8_WAIT_V1P(); else PG8_WAIT_V(8); \
            PG8_WAIT_L(0); PG8_BAR; PG8_MMA(0, 0, At, B0); PG8_MMA(0, 1, At, B1); PG8_BAR; PG8_SCHED; \
            PG8_LDA(At, 1, 1); PG8_STAGE(PG8_SB(1, 0), b3, voffB); PG8_STAGE(PG8_SB(1, 1), b3 + hstep, voffB); PG8_STAGE(PG8_SA(1, 0), a3, voffA); \
            PG8_WAIT_V(8); PG8_WAIT_L(0); PG8_BAR; if constexpr ((P1_) >= 0) PG8_RADD_P(P1_); PG8_MMA(1, 0, At, B0); PG8_MMA(1, 1, At, B1); PG8_BAR; PG8_SCHED; \
        } while (0)
    Unit cur, nxt; int ui = 0;
    if (!S.next(0, cur)) return;
    f32x4 acc[2][2][4][2];
#pragma unroll
    for (int a = 0; a < 2; ++a)
#pragma unroll
        for (int b = 0; b < 2; ++b)
#pragma unroll
            for (int m = 0; m < 4; ++m)
#pragma unroll
                for (int n = 0; n < 2; ++n) acc[a][b][m][n] = (f32x4){0.f, 0.f, 0.f, 0.f};
    bf16x8 At[4][2], B0[2][2], B1[2][2];
    const char* rcur = nullptr;
    const unsigned rvoff = (unsigned)(((wr * 64 + fr) * 1024 + wc * 32 + 8 * fq) * 4);
#define PG8_RCUR(u_) do { if constexpr (Epi::STREAM_R) rcur = (const char*)E.RS + ((size_t)((u_).pm * BM) * 1024 + (u_).pn * BM) * (Epi::STREAM_BF16 ? 2 : 4); } while (0)
    PG8_RCUR(cur);
    const char* cA = (const char*)g.A + (size_t)cur.pm * tstep; const char* cB = (const char*)g.Bt + (size_t)cur.pn * tstep;
    S.a_ready(cur);
    if constexpr (SP2) {
        PG8_STAGE(PG8_SB(0, 0), cB, voffB); PG8_STAGE(PG8_SB(0, 1), cB + hstep, voffB); PG8_STAGE(PG8_SA(0, 0), cA, voffA); PG8_STAGE(PG8_SA(0, 1), cA + hstep, voffA);
        if (wr == 1) PG8_BAR;
        PG8_WAIT_V(2); PG8_BAR;
        PG8_STAGE(PG8_SB(1, 0), cB + kstep, voffB); PG8_STAGE(PG8_SA(1, 0), cA + kstep, voffA); PG8_STAGE(PG8_SB(1, 1), cB + hstep + kstep, voffB);
        PG8_WAIT_V(6); PG8_BAR;
    } else {
        PG8_STAGE(PG8_SB(0, 0), cB, voffB); PG8_STAGE(PG8_SA(0, 0), cA, voffA); PG8_STAGE(PG8_SB(0, 1), cB + hstep, voffB); PG8_STAGE(PG8_SA(0, 1), cA + hstep, voffA);
        if (wr == 1) PG8_BAR;
        PG8_WAIT_V(4); PG8_BAR;
        PG8_STAGE(PG8_SB(1, 0), cB + kstep, voffB); PG8_STAGE(PG8_SA(1, 0), cA + kstep, voffA); PG8_STAGE(PG8_SB(1, 1), cB + hstep + kstep, voffB);
        PG8_WAIT_V(6); PG8_BAR;
    }
    for (;;) {
        const bool has_next = S.next(ui + 1, nxt);
        const char* nA = has_next ? (const char*)g.A + (size_t)nxt.pm * tstep : cA; const char* nB = has_next ? (const char*)g.Bt + (size_t)nxt.pn * tstep : cB;
        if constexpr (SP2 && Epi::STREAM_R) {
            PG8_KPAIR(0, 0, 1); PG8_KPAIR(2, 2, 3); PG8_KPAIR(4, 4, 5); PG8_KPAIR(6, 6, 7); PG8_KPAIR(8, 8, 9); PG8_KPAIR(10, 10, 11); PG8_KPAIR(12, 12, 13); PG8_KPAIR(14, 14, 15);
#pragma unroll 1
            for (int t = 16; t < nt; t += 2) PG8_KPAIR(t, -1, -1);
        } else
        for (int t = 0; t < nt; t += 2) {
            const bool last = (t == nt - 2);
            const char* a1 = cA + (size_t)(t + 1) * kstep;
            const char* a2 = last ? nA : cA + (size_t)(t + 2) * kstep; const char* b2 = last ? nB : cB + (size_t)(t + 2) * kstep;
            const char* a3 = a2 + kstep; const char* b3 = b2 + kstep;
            if (last && has_next) S.a_ready(nxt);
            if constexpr (SP2) {
            PG8_LDB(B0, 0, 0); PG8_LDB(B1, 0, 1); PG8_SCHED; PG8_LDA(At, 0, 0); PG8_STAGE(PG8_SA(1, 1), a1 + hstep, voffA);
            PG8_WAIT_V(8); PG8_WAIT_L(0); PG8_BAR; PG8_MMA(0, 0, At, B0); PG8_MMA(0, 1, At, B1); PG8_BAR; PG8_SCHED;
            PG8_LDA(At, 0, 1); PG8_STAGE(PG8_SB(0, 0), b2, voffB); PG8_STAGE(PG8_SB(0, 1), b2 + hstep, voffB); PG8_STAGE(PG8_SA(0, 0), a2, voffA);
            PG8_WAIT_V(8); PG8_WAIT_L(0); PG8_BAR; PG8_MMA(1, 0, At, B0); PG8_MMA(1, 1, At, B1); PG8_BAR; PG8_SCHED;
            PG8_LDB(B0, 1, 0); PG8_LDB(B1, 1, 1); PG8_SCHED; PG8_LDA(At, 1, 0); PG8_STAGE(PG8_SA(0, 1), a2 + hstep, voffA);
            PG8_WAIT_V(8); PG8_WAIT_L(0); PG8_BAR; PG8_MMA(0, 0, At, B0); PG8_MMA(0, 1, At, B1); PG8_BAR; PG8_SCHED;
            PG8_LDA(At, 1, 1); PG8_STAGE(PG8_SB(1, 0), b3, voffB); PG8_STAGE(PG8_SB(1, 1), b3 + hstep, voffB); PG8_STAGE(PG8_SA(1, 0), a3, voffA);
            PG8_WAIT_V(8); PG8_WAIT_L(0); PG8_BAR; PG8_MMA(1, 0, At, B0); PG8_MMA(1, 1, At, B1); PG8_BAR; PG8_SCHED;
            } else {
            PG8_LDB(B0, 0, 0); PG8_SCHED; PG8_LDA(At, 0, 0); PG8_STAGE(PG8_SA(1, 1), a1 + hstep, voffA);
            PG8_WAIT_L(8); PG8_BAR; PG8_WAIT_L(0); PG8_MMA(0, 0, At, B0); PG8_BAR; PG8_SCHED;
            PG8_LDB(B1, 0, 1); PG8_STAGE(PG8_SB(0, 0), b2, voffB);
            PG8_BAR; PG8_WAIT_L(0); PG8_MMA(0, 1, At, B1); PG8_BAR;
            PG8_LDA(At, 0, 1); PG8_STAGE(PG8_SA(0, 0), a2, voffA);
            PG8_BAR; PG8_WAIT_L(0); PG8_MMA(1, 0, At, B0); PG8_BAR; PG8_SCHED;
            PG8_STAGE(PG8_SB(0, 1), b2 + hstep, voffB);
            PG8_WAIT_V(6); PG8_BAR; PG8_MMA(1, 1, At, B1); PG8_BAR;
            PG8_LDB(B0, 1, 0); PG8_SCHED; PG8_LDA(At, 1, 0); PG8_STAGE(PG8_SA(0, 1), a2 + hstep, voffA);
            PG8_WAIT_L(8); PG8_BAR; PG8_WAIT_L(0); PG8_MMA(0, 0, At, B0); PG8_BAR; PG8_SCHED;
            PG8_LDB(B1, 1, 1); PG8_STAGE(PG8_SB(1, 0), b3, voffB);
            PG8_BAR; PG8_WAIT_L(0); PG8_MMA(0, 1, At, B1); PG8_BAR;
            PG8_LDA(At, 1, 1); PG8_STAGE(PG8_SA(1, 0), a3, voffA);
            PG8_BAR; PG8_WAIT_L(0); PG8_MMA(1, 0, At, B0); PG8_BAR; PG8_SCHED;
            PG8_STAGE(PG8_SB(1, 1), b3 + hstep, voffB);
            PG8_WAIT_V(6); PG8_BAR; PG8_MMA(1, 1, At, B1); PG8_BAR;
            }
        }
        if constexpr (ALIGN_EPI) { if (wr == 0) PG8_BAR; }
        if constexpr (!Epi::AFTER_DRAIN) { E(acc, cur, wr, wc, fr, fq); S.done(cur); }
        if (!has_next) break;
#pragma unroll
        for (int a = 0; a < 2; ++a)
#pragma unroll
            for (int b = 0; b < 2; ++b)
#pragma unroll
                for (int m = 0; m < 4; ++m)
#pragma unroll
                    for (int n = 0; n < 2; ++n) acc[a][b][m][n] = (f32x4){0.f, 0.f, 0.f, 0.f};
        cur = nxt; cA = nA; cB = nB; ++ui; PG8_RCUR(cur);
        if constexpr (ALIGN_EPI) { if (wr == 1) PG8_BAR; }
    }
    PG8_WAIT_V(0);
    if constexpr (!ALIGN_EPI) { if (wr == 0) PG8_BAR; }
    PG8_BAR;
    if constexpr (Epi::AFTER_DRAIN) { E.fused(acc, cur, wr, wc, fr, fq, lds, wid, lane); S.done(cur); }
#undef PG8_SA
#undef PG8_SB
#undef PG8_STAGE
#undef PG8_LDA
#undef PG8_LDB
#undef PG8_MMA
#undef PG8_WAIT_V
#undef PG8_WAIT_L
#undef PG8_BAR
#undef PG8_SCHED
#undef PG8_PIECE_OFF
#undef PG8_RLOAD_P
#undef PG8_WAIT_V1P
#undef PG8_RADD_P
#undef PG8_KPAIR
#undef PG8_RCUR
}
}
constexpr int NWAVES = 8;
constexpr int NB = 8, SEQ = 4096, T = NB * SEQ, DM = 1024, DIN = 2824, DFF = 2816, NPROJ = 2816;
constexpr int SRC_MI = 2048;
constexpr int PC_MQ = 0, PC_MK = 512, PC_MV = 1024, PC_MO = 1536, PC_AQ = 2048, PC_AK = 2560, PC_AV = 2688;
constexpr float EPS = 1e-6f;
constexpr size_t MiB = 1u << 20;
constexpr size_t WS_CTL = 0, CTL_ZERO_BYTES = 32 * 1024;
constexpr size_t WS_WIN = 1 * MiB;
constexpr size_t WS_WOUT = 7 * MiB;
constexpr size_t WS_WGU = 9 * MiB;
constexpr size_t WS_WDN = 20 * MiB;
constexpr size_t WS_ROPE = 26 * MiB;
constexpr size_t WS_WBG = 26 * MiB + 512 * 1024;
constexpr size_t WS_GATES = 27 * MiB;
constexpr size_t WS_SSQ = 28 * MiB;
constexpr size_t WS_SEG = 30 * MiB;
constexpr size_t WS_XN = 48 * MiB;
constexpr size_t WS_MIX = 112 * MiB;
constexpr size_t WS_PROJ = 176 * MiB;
constexpr size_t WS_END = 352 * MiB;
constexpr int CW_BAR = 4096;
constexpr int RING_BYTES = 131072;
constexpr int LDSCTL_OFF = RING_BYTES, MISC_OFF = LDSCTL_OFF + 320;
constexpr int LDS_BYTES = 163840;

#define GAS __attribute__((address_space(1)))
#define LAS __attribute__((address_space(3)))
typedef unsigned short bf16;
typedef unsigned v4u __attribute__((ext_vector_type(4)));
typedef unsigned v2u __attribute__((ext_vector_type(2)));
typedef float f32x2v __attribute__((ext_vector_type(2)));
typedef float f32x4 __attribute__((ext_vector_type(4)));
typedef short bf16x8 __attribute__((ext_vector_type(8)));
typedef GAS unsigned gu32;
#define RLX_AGENT __ATOMIC_RELAXED, __HIP_MEMORY_SCOPE_AGENT
#define LDS_WAIT() asm volatile("s_waitcnt lgkmcnt(0)" ::: "memory")
#define VM_WAIT() asm volatile("s_waitcnt vmcnt(0)" ::: "memory")
__device__ __forceinline__ unsigned f2bf(float f) { unsigned u = __builtin_bit_cast(unsigned, f); return (u + 0x7fffu + ((u >> 16) & 1u)) >> 16; }
__device__ __forceinline__ unsigned pk2(float lo, float hi) { return f2bf(lo) | (f2bf(hi) << 16); }
__device__ __forceinline__ float bf2f(unsigned short b) { return __builtin_bit_cast(float, (unsigned)b << 16); }
__device__ __forceinline__ float bflo(unsigned w) { return __builtin_bit_cast(float, w << 16); }
__device__ __forceinline__ float bfhi(unsigned w) { return __builtin_bit_cast(float, w & 0xffff0000u); }
__device__ __forceinline__ float wave_sum(float v) {
#pragma unroll
    for (int o = 1; o < 64; o <<= 1) v += __shfl_xor(v, o);
    return v;
}
__device__ __forceinline__ float wave_max(float v) {
#pragma unroll
    for (int o = 1; o < 64; o <<= 1) v = fmaxf(v, __shfl_xor(v, o));
    return v;
}
__device__ __forceinline__ void unpack8(const v4u w, float* o) { o[0] = bflo(w.x); o[1] = bfhi(w.x); o[2] = bflo(w.y); o[3] = bfhi(w.y); o[4] = bflo(w.z); o[5] = bfhi(w.z); o[6] = bflo(w.w); o[7] = bfhi(w.w); }
__device__ __forceinline__ float red16_32_max(float v) {
    auto a = __builtin_amdgcn_permlane16_swap(__float_as_uint(v), __float_as_uint(v), false, false); v = fmaxf(__uint_as_float(a[0]), __uint_as_float(a[1]));
    auto b = __builtin_amdgcn_permlane32_swap(__float_as_uint(v), __float_as_uint(v), false, false); return fmaxf(__uint_as_float(b[0]), __uint_as_float(b[1])); }
__device__ __forceinline__ float red16_32_sum(float v) {
    auto a = __builtin_amdgcn_permlane16_swap(__float_as_uint(v), __float_as_uint(v), false, false); v = __uint_as_float(a[0]) + __uint_as_float(a[1]);
    auto b = __builtin_amdgcn_permlane32_swap(__float_as_uint(v), __float_as_uint(v), false, false); return __uint_as_float(b[0]) + __uint_as_float(b[1]); }
__device__ __forceinline__ float xor16_partner(float v) { const unsigned u = __float_as_uint(v); auto a = __builtin_amdgcn_permlane16_swap(u, u, false, false); return __uint_as_float(a[0] ^ a[1] ^ u); }
#define xor16_max 1
#define XB_TMO      128
#define XB_XCNT(j)  (256  + 64 * (j))
#define XB_XSUB(j)  (1280 + 64 * (j))
#define XB_XGEN(j)  (2304 + 64 * (j))
#define XB_TOP      3328
#define XB_TOPGEN   3392
#define XCD_BAR_WORDS 3456
#define XB_SPIN_CAP (1u << 18)

__device__ __forceinline__ unsigned xb_ld(unsigned* p)              { return __hip_atomic_load(p, __ATOMIC_RELAXED, __HIP_MEMORY_SCOPE_AGENT); }
__device__ __forceinline__ unsigned xb_add(unsigned* p, unsigned v) { return __hip_atomic_fetch_add(p, v, __ATOMIC_RELAXED, __HIP_MEMORY_SCOPE_AGENT); }
__device__ __forceinline__ unsigned xb_xcc_id() { return (unsigned)__builtin_amdgcn_s_getreg((3 << 11) | 20) & 0xFu; }
#define XB_SPIN(cond, bar) do { unsigned _sp = 0; while (cond) { __builtin_amdgcn_s_sleep(1); \
    if ((++_sp & 255u) == 0u) { if (xb_ld(&(bar)[XB_TMO])) break; if (_sp > XB_SPIN_CAP) { atomicAdd(&(bar)[XB_TMO], 1u); break; } } } } while (0)

struct XcdBarrier {
    unsigned* bar; unsigned x;
    volatile LAS unsigned* st;
};

__device__ __forceinline__ XcdBarrier xcd_barrier_post(unsigned* bar, volatile LAS unsigned* st) {
    XcdBarrier b; b.bar = bar; b.x = xb_xcc_id(); b.st = st;
    if (threadIdx.x == 0) (void)xb_add(&bar[XB_XCNT(b.x)], 1u);
    return b;
}
__device__ __forceinline__ void xcd_barrier_complete(unsigned* bar, unsigned x, unsigned& nloc, unsigned& nx) {
    const unsigned G = gridDim.x * gridDim.y * gridDim.z;
    unsigned sum, cnt, mine, sp = 0u;
    for (;;) {
        sum = 0u; cnt = 0u; mine = 0u;
#pragma unroll
        for (unsigned j = 0; j < 16; ++j) { const unsigned c = xb_ld(&bar[XB_XCNT(j)]); sum += c; cnt += (c > 0u) ? 1u : 0u; mine = (j == x) ? c : mine; }
        if (sum == G) break;
        __builtin_amdgcn_s_sleep(1);
        if ((++sp & 255u) == 0u) { if (xb_ld(&bar[XB_TMO])) break; if (sp > XB_SPIN_CAP) { atomicAdd(&bar[XB_TMO], 1u); break; } }
    }
    nloc = mine > 0u ? mine : 1u; nx = cnt > 0u ? cnt : 1u;
}

__device__ __forceinline__ void xcd_barrier(const XcdBarrier& b) {
    asm volatile("s_waitcnt vmcnt(0)" ::: "memory");
    __syncthreads();
    if (threadIdx.x == 0) {
        unsigned* bar = b.bar;
        __builtin_amdgcn_s_waitcnt(0);
        unsigned nloc = b.st[0], nx = b.st[1];
        if (nloc == 0u) { xcd_barrier_complete(bar, b.x, nloc, nx); b.st[0] = nloc; b.st[1] = nx; }
        const unsigned old = xb_add(&bar[XB_XSUB(b.x)], 1u);
        const unsigned gen = old / nloc;
        if (old + 1u == (gen + 1u) * nloc) {
            __builtin_amdgcn_fence(__ATOMIC_RELEASE, "agent");
            asm volatile("s_waitcnt vmcnt(0)" ::: "memory");
            const unsigned og = xb_add(&bar[XB_TOP], 1u);
            const unsigned tg = og / nx;
            if (og + 1u == (tg + 1u) * nx) xb_add(&bar[XB_TOPGEN], 1u);
            else XB_SPIN(xb_ld(&bar[XB_TOPGEN]) == tg, bar);
            __builtin_amdgcn_fence(__ATOMIC_ACQUIRE, "agent");
            xb_add(&bar[XB_XGEN(b.x)], 1u);
            asm volatile("s_waitcnt vmcnt(0)" ::: "memory");
        } else {
            XB_SPIN(xb_ld(&bar[XB_XGEN(b.x)]) == gen, bar);
            __builtin_amdgcn_fence(__ATOMIC_ACQUIRE, "agent");
            asm volatile("s_waitcnt vmcnt(0)" ::: "memory");
        }
    }
    __syncthreads();
}
#define H1_BF16 1
#ifndef P5_ALIGN
#define P5_ALIGN true
#endif
#define PHASE2_BODY do { mlstm_phase<1>(F); swa_phase(F); } while (0)
#define PHASE3_BODY mlstm_phase<2>(F)
#define LAUNCH_MK(lo_, hi_) do { a.ph_lo = (lo_); a.ph_hi = (hi_); a.li = (lo_); hipLaunchKernelGGL(mk_fwd, dim3(grid), dim3(NWAVES * 64), LDS_BYTES, stream, a); } while (0)
#define LAUNCH_PROGRAM { LAUNCH_MK(0, 7); }
struct Frame {
    LAS unsigned char* lds;
    volatile LAS unsigned* MISC;
    gu32* ctl;
    int tid, lane, wave, vcu, G;
    const float *x, *norm1_g, *w_in, *conv_w, *igate_b, *fgate_b, *mlstm_norm_g, *q_norm_g, *k_norm_g, *sinks, *w_out, *norm2_g, *w_gate, *w_up, *w_down;
    float* out;
    bf16 *Win_t, *Wout_t, *Wgu_t, *Wdn_t, *XN, *MIX, *PROJ;
    float2* ROPE; float* GATES; float* SSQ; float* SEG; unsigned char* WBG;
};

struct P0Item { const float* W; int ldw, src_col0; const float* kscale; bf16* WT; int Kd, dst_row0, kb; };
template <bool SCALE> __device__ __forceinline__ void p0_item_load(const P0Item& I, float (&v)[32], int lane) {
    const int k0 = 64 * I.kb;
#pragma unroll
    for (int i = 0; i < 32; ++i) { const int kk = 2 * i + (lane >> 5); v[i] = I.W[(size_t)(k0 + kk) * I.ldw + I.src_col0 + (lane & 31)]; }
    if (SCALE) {
        float sc[32];
#pragma unroll
        for (int i = 0; i < 32; ++i) sc[i] = I.kscale[k0 + 2 * i + (lane >> 5)];
#pragma unroll
        for (int i = 0; i < 32; ++i) v[i] *= sc[i];
    }
}
__device__ __forceinline__ void p0_item_finish(const P0Item& I, const float (&v)[32], LAS float* scr, int lane) {
    const int k0 = 64 * I.kb;
#pragma unroll
    for (int i = 0; i < 32; ++i) { const int kk = 2 * i + (lane >> 5); scr[kk * 33 + (lane & 31)] = v[i]; }
    LDS_WAIT(); asm volatile("" ::: "memory");
    const int c = lane & 7;
#pragma unroll
    for (int j = 0; j < 4; ++j) { const int n = (lane >> 3) + 8 * j; const LAS float* s = scr + (8 * c) * 33 + n;
        v4u o; o.x = pk2(s[0 * 33], s[1 * 33]); o.y = pk2(s[2 * 33], s[3 * 33]); o.z = pk2(s[4 * 33], s[5 * 33]); o.w = pk2(s[6 * 33], s[7 * 33]);
        *(GAS v4u*)(I.WT + (size_t)(I.dst_row0 + n) * I.Kd + k0 + 8 * c) = o; }
    LDS_WAIT(); asm volatile("" ::: "memory");
}
constexpr int I_IN = 88 * 16, I_OUT = 32 * 16, I_GU = 176 * 16, I_DN = 32 * 44;
__device__ __forceinline__ P0Item p0_item_in(Frame& F, int r) { const int nb = r % 88, kb = r / 88; return P0Item{F.w_in, DIN, nb < 64 ? 32 * nb : 32 * nb + 8, nullptr, F.Win_t, DM, 32 * nb, kb}; }
__device__ __forceinline__ P0Item p0_item_gu(Frame& F, int r) { const int nb = r % 176, kb = r / 176, tile = nb >> 3, wi = nb & 7; const float* W = (wi < 4) ? F.w_gate : F.w_up;
    return P0Item{W, DFF, 128 * tile + 32 * (wi & 3), F.norm2_g, F.Wgu_t, DM, 32 * nb, kb}; }
__device__ __forceinline__ P0Item p0_item_od(Frame& F, int r) {
    if (r < I_OUT) { const int nb = r % 32, kb = r / 32; return P0Item{F.w_out, DM, 32 * nb, nullptr, F.Wout_t, DM, 32 * nb, kb}; } r -= I_OUT;
    { const int nb = r % 32, kb = r / 32; return P0Item{F.w_down, DM, 32 * nb, nullptr, F.Wdn_t, DFF, 32 * nb, kb}; }
}
__device__ __forceinline__ void p0_prologue(Frame& F) {
    LAS float* scr = (LAS float*)(F.lds + F.wave * 8704);
    const int gw = F.vcu * NWAVES + F.wave, NGW = F.G * NWAVES;
    for (int it = gw; it < I_IN; it += NGW) { const P0Item I = p0_item_in(F, it); float v[32]; p0_item_load<false>(I, v, F.lane); p0_item_finish(I, v, scr, F.lane); }
    if (F.vcu < 4) { const int idx = F.vcu * 512 + F.tid; const int ks = idx >> 6, ln = idx & 63, col = ln & 15, gq = ln >> 4;
        v4u o = (v4u){0u, 0u, 0u, 0u};
        if (col < 8) { const float* wp = F.w_in + (size_t)(32 * ks + 8 * gq) * DIN + SRC_MI + col;
            const float w0 = wp[0], w1 = wp[DIN], w2 = wp[2 * DIN], w3 = wp[3 * DIN], w4 = wp[4 * DIN], w5 = wp[5 * DIN], w6 = wp[6 * DIN], w7 = wp[7 * DIN];
            o.x = pk2(w0, w1); o.y = pk2(w2, w3); o.z = pk2(w4, w5); o.w = pk2(w6, w7); }
        ((v4u*)F.WBG)[idx] = o; }
    { const int idx = (F.vcu * NWAVES * 64) + F.tid;
      if (idx < SEQ * 8) { const int pos = idx >> 3, i = idx & 7;
        double f = 1.0; f = (i == 1) ? 0.19392274474868576 : f; f = (i == 2) ? 0.03760603093086393 : f; f = (i == 3) ? 0.007292664737217109 : f; f = (i == 4) ? 0.001414213562373095 : f;
        f = (i == 5) ? 0.0002742481756762073 : f; f = (i == 6) ? 5.318295896944988e-05 : f; f = (i == 7) ? 1.031338537721246e-05 : f;
        const float angf = (float)pos * (float)f; const double rev = (double)angf * 0.15915494309189535; const double fr = rev - __builtin_floor(rev + 0.5);
        const float rr = (float)(fr * 6.283185307179586); F.ROPE[idx] = make_float2(__cosf(rr), __sinf(rr)); } }
    f32x4 g1[4];
#pragma unroll
    for (int j = 0; j < 4; ++j) g1[j] = ((const f32x4*)F.norm1_g)[F.lane + 64 * j];
    f32x4 v[4];
    if (gw < T) {
#pragma unroll
        for (int j = 0; j < 4; ++j) v[j] = ((const GAS f32x4*)(F.x + (size_t)gw * DM))[F.lane + 64 * j];
    }
#pragma unroll 1
    for (int m = gw; m < T; m += NGW) {
        f32x4 c[4]; float s = 0.f;
#pragma unroll
        for (int j = 0; j < 4; ++j) { c[j] = v[j]; s += (c[j].x * c[j].x + c[j].y * c[j].y) + (c[j].z * c[j].z + c[j].w * c[j].w); }
        if (m + NGW < T) {
#pragma unroll
            for (int j = 0; j < 4; ++j) v[j] = ((const GAS f32x4*)(F.x + (size_t)(m + NGW) * DM))[F.lane + 64 * j];
        }
        const float rstd = __builtin_amdgcn_rsqf(wave_sum(s) * (1.f / DM) + EPS);
        GAS v2u* o8 = (GAS v2u*)(F.XN + (size_t)m * DM) + F.lane;
#pragma unroll
        for (int j = 0; j < 4; ++j) { const f32x4 y = c[j] * rstd * g1[j]; v2u w; w.x = pg8::cvt_pk_bf16(y.x, y.y); w.y = pg8::cvt_pk_bf16(y.z, y.w); o8[64 * j] = w; }
    }
}
__device__ __forceinline__ void convert_gu(Frame& F, int ii, int ni) {
    LAS float* scr = (LAS float*)(F.lds + F.wave * 8704);
    __syncthreads();
    const int igw = ii * NWAVES + F.wave, NIW = ni * NWAVES;
#pragma unroll 1
    for (int it = igw; it < I_GU; it += 2 * NIW) {
        const P0Item Ia = p0_item_gu(F, it); const bool two = it + NIW < I_GU; const P0Item Ib = p0_item_gu(F, two ? it + NIW : it);
        float va[32], vb[32]; p0_item_load<true>(Ia, va, F.lane); p0_item_load<true>(Ib, vb, F.lane);
        p0_item_finish(Ia, va, scr, F.lane); if (two) p0_item_finish(Ib, vb, scr, F.lane);
    }
}
__device__ __forceinline__ void convert_od(Frame& F, int ii, int ni) {
    LAS float* scr = (LAS float*)(F.lds + F.wave * 8704);
    const int igw = ii * NWAVES + F.wave, NIW = ni * NWAVES;
#pragma unroll 1
    for (int it = igw; it < I_OUT + I_DN; it += 2 * NIW) {
        const P0Item Ia = p0_item_od(F, it); const bool two = it + NIW < I_OUT + I_DN; const P0Item Ib = p0_item_od(F, two ? it + NIW : it);
        float va[32], vb[32]; p0_item_load<false>(Ia, va, F.lane); p0_item_load<false>(Ib, vb, F.lane);
        p0_item_finish(Ia, va, scr, F.lane); if (two) p0_item_finish(Ib, vb, scr, F.lane);
    }
}
__device__ __forceinline__ void p1_side_work(Frame& F, int ii, int ni) {
    LAS unsigned char* WB = F.lds + 73728;
    for (int idx = F.tid; idx < 2048; idx += NWAVES * 64) *(LAS v4u*)(WB + idx * 16) = ((const v4u*)F.WBG)[idx];
    __syncthreads();
    convert_od(F, ii, ni);
    const int igw = ii * NWAVES + F.wave, NIW = ni * NWAVES;
    const int l15 = F.lane & 15, g = F.lane >> 4;
    for (int blk = igw; blk < T / 16; blk += NIW) {
        const bf16* xp = F.XN + ((size_t)blk * 16 + l15) * DM + 8 * g;
        f32x4 acc = (f32x4){0.f, 0.f, 0.f, 0.f};
        bf16x8 a[32];
#pragma unroll
        for (int q = 0; q < 32; ++q) a[q] = *(const bf16x8*)(xp + 32 * q);
#pragma unroll
        for (int q = 0; q < 32; ++q) acc = __builtin_amdgcn_mfma_f32_16x16x32_bf16(a[q], *(const LAS bf16x8*)(WB + (q * 64 + F.lane) * 16), acc, 0, 0, 0);
        if (l15 < 8) {
#pragma unroll
            for (int r = 0; r < 4; ++r) F.GATES[((size_t)blk * 16 + 4 * g + r) * 8 + l15] = acc[r];
        }
    }
}

constexpr int SWA_KS = 0, SWA_KSTR = 144, SWA_VT = 36864, SWA_VSTR = 528;
typedef short bf16x4 __attribute__((ext_vector_type(4)));
#ifndef SWA_UNROLL
#define SWA_UNROLL 1
#endif
constexpr int SWA_TAB = 70656;
struct SwaKV { v4u k[4], v[4]; float2 cs[8]; };
struct SwaQ { v4u w0, w1; float2 cs[8]; };
__device__ __forceinline__ void swa_load_kv(Frame& F, int tid, int u, SwaKV& R) {
    const int blk = u & 31, kvh = (u >> 5) & 1, b = u >> 6; const int key = tid >> 1, half = tid & 1; const int kt = blk * 128 - 128 + key;
    if (kt >= 0) {
        const bf16* kp = F.PROJ + (size_t)(b * SEQ + kt) * NPROJ + PC_AK + kvh * 64 + 32 * half;
        const bf16* vp = F.PROJ + (size_t)(b * SEQ + kt) * NPROJ + PC_AV + kvh * 64 + 32 * half;
#pragma unroll
        for (int c = 0; c < 4; ++c) { R.k[c] = *(const v4u*)(kp + 8 * c); R.v[c] = *(const v4u*)(vp + 8 * c); }
#pragma unroll
        for (int i = 0; i < 8; ++i) R.cs[i] = F.ROPE[kt * 8 + i];
    } else {
#pragma unroll
        for (int c = 0; c < 4; ++c) { R.k[c] = (v4u){0u, 0u, 0u, 0u}; R.v[c] = (v4u){0u, 0u, 0u, 0u}; }
#pragma unroll
        for (int i = 0; i < 8; ++i) R.cs[i] = make_float2(1.f, 0.f);
    }
}
__device__ __forceinline__ void swa_load_q(Frame& F, int lane, int wave, int u, int rb, SwaQ& R) {
    const int blk = u & 31, kvh = (u >> 5) & 1, b = u >> 6; const int l15 = lane & 15, g = lane >> 4;
    const int hq = kvh * 4 + (wave >> 1), p0 = 64 * (wave & 1) + 16 * rb, tq = blk * 128 + p0 + l15;
    const bf16* qp = F.PROJ + (size_t)(b * SEQ + tq) * NPROJ + PC_AQ + hq * 64 + 8 * g;
    R.w0 = *(const v4u*)qp; R.w1 = *(const v4u*)(qp + 32);
#pragma unroll
    for (int j = 0; j < 8; ++j) R.cs[j] = F.ROPE[tq * 8 + j];
}
__device__ __forceinline__ void swa_phase(Frame& F) {
    LAS unsigned char* KS = F.lds + SWA_KS; LAS unsigned char* VT = F.lds + SWA_VT; LAS float* TAB = (LAS float*)(F.lds + SWA_TAB);
    const int wave = F.wave;
    int u = F.vcu;
    if (u >= NB * 2 * 32) return;
    __syncthreads();
    if (F.tid < 64) TAB[F.tid] = F.q_norm_g[F.tid]; else if (F.tid < 128) TAB[F.tid] = F.k_norm_g[F.tid - 64];
    SwaKV kv; SwaQ qr;
    swa_load_kv(F, F.tid, u, kv);
    swa_load_q(F, F.lane, wave, u, 0, qr);
#pragma unroll 1
    for (; u < NB * 2 * 32; u += F.G) {
        int tid = F.tid; asm volatile("" : "+v"(tid));
        const int lane = tid & 63, l15 = lane & 15, g = lane >> 4;
        const int blk = u & 31, kvh = (u >> 5) & 1, b = u >> 6;
        const int un = u + F.G; const bool has_next = un < NB * 2 * 32;
        __syncthreads();
        {
            const int key = tid >> 1, half = tid & 1;
            float kf[32];
#pragma unroll
            for (int c = 0; c < 4; ++c) unpack8(kv.k[c], kf + 8 * c);
            float ss = 0.f;
#pragma unroll
            for (int c = 0; c < 32; ++c) ss += kf[c] * kf[c];
            ss += __shfl_xor(ss, 1);
            const float rstd = __builtin_amdgcn_rsqf(ss * (1.f / 64.f) + EPS);
#pragma unroll
            for (int c = 0; c < 8; ++c) { const f32x4 gg = *(const LAS f32x4*)(TAB + 64 + 32 * half + 4 * c); kf[4 * c] *= rstd * gg[0]; kf[4 * c + 1] *= rstd * gg[1]; kf[4 * c + 2] *= rstd * gg[2]; kf[4 * c + 3] *= rstd * gg[3]; }
            if (half == 0) {
#pragma unroll
                for (int i = 0; i < 8; ++i) { const float2 cs = kv.cs[i]; const float x1 = kf[i], x2 = kf[8 + i]; kf[i] = x1 * cs.x - x2 * cs.y; kf[8 + i] = x2 * cs.x + x1 * cs.y; }
            }
#pragma unroll
            for (int c = 0; c < 4; ++c) { v4u o; o.x = pg8::cvt_pk_bf16(kf[8 * c], kf[8 * c + 1]); o.y = pg8::cvt_pk_bf16(kf[8 * c + 2], kf[8 * c + 3]); o.z = pg8::cvt_pk_bf16(kf[8 * c + 4], kf[8 * c + 5]); o.w = pg8::cvt_pk_bf16(kf[8 * c + 6], kf[8 * c + 7]);
                *(LAS v4u*)(KS + key * SWA_KSTR + 64 * half + 16 * c) = o; }
#pragma unroll
            for (int c = 0; c < 4; ++c) { const unsigned ww[4] = {kv.v[c].x, kv.v[c].y, kv.v[c].z, kv.v[c].w};
#pragma unroll
                for (int e = 0; e < 4; ++e) { const int d = 32 * half + 8 * c + 2 * e;
                    *(LAS unsigned short*)(VT + d * SWA_VSTR + key * 2) = (unsigned short)(ww[e] & 0xffffu);
                    *(LAS unsigned short*)(VT + (d + 1) * SWA_VSTR + key * 2) = (unsigned short)(ww[e] >> 16); } }
        }
        __syncthreads();
        if (has_next) swa_load_kv(F, tid, un, kv);
        const int hq = kvh * 4 + (wave >> 1);
        const float sink2 = F.sinks[hq] * 1.4426950408889634f;
        const float SC = 0.125f * 1.4426950408889634f;
#pragma unroll 1
        for (int rb = 0; rb < 4; ++rb) {
            const int p0 = 64 * (wave & 1) + 16 * rb, j0 = p0 >> 4;
            const int tq = blk * 128 + p0 + l15;
            bf16x8 qf[2];
            {
                float q0[8], q1[8]; unpack8(qr.w0, q0); unpack8(qr.w1, q1);
                float ss = 0.f;
#pragma unroll
                for (int j = 0; j < 8; ++j) ss += q0[j] * q0[j] + q1[j] * q1[j];
                ss = red16_32_sum(ss);
                const float rstd = __builtin_amdgcn_rsqf(ss * (1.f / 64.f) + EPS);
#pragma unroll
                for (int c = 0; c < 2; ++c) { const f32x4 ga = *(const LAS f32x4*)(TAB + 8 * g + 4 * c), gb = *(const LAS f32x4*)(TAB + 32 + 8 * g + 4 * c);
#pragma unroll
                    for (int e = 0; e < 4; ++e) { q0[4 * c + e] *= rstd * ga[e]; q1[4 * c + e] *= rstd * gb[e]; } }
#pragma unroll
                for (int j = 0; j < 8; ++j) { const float other = xor16_partner(q0[j]); const float2 cs = qr.cs[j];
                    const float r0 = q0[j] * cs.x - other * cs.y, r1 = q0[j] * cs.x + other * cs.y; q0[j] = (g == 0) ? r0 : ((g == 1) ? r1 : q0[j]); }
                v4u a, c2; a.x = pg8::cvt_pk_bf16(q0[0], q0[1]); a.y = pg8::cvt_pk_bf16(q0[2], q0[3]); a.z = pg8::cvt_pk_bf16(q0[4], q0[5]); a.w = pg8::cvt_pk_bf16(q0[6], q0[7]);
                c2.x = pg8::cvt_pk_bf16(q1[0], q1[1]); c2.y = pg8::cvt_pk_bf16(q1[2], q1[3]); c2.z = pg8::cvt_pk_bf16(q1[4], q1[5]); c2.w = pg8::cvt_pk_bf16(q1[6], q1[7]);
                qf[0] = __builtin_bit_cast(bf16x8, a); qf[1] = __builtin_bit_cast(bf16x8, c2);
            }
            if (rb < 3) swa_load_q(F, lane, wave, u, rb + 1, qr); else if (has_next) swa_load_q(F, lane, wave, un, 0, qr);
            f32x4 s[10];
    #pragma unroll
            for (int jj = 0; jj < 9; ++jj) { const int tile = j0 + jj;
                f32x4 acc = (f32x4){0.f, 0.f, 0.f, 0.f};
    #pragma unroll
                for (int ks = 0; ks < 2; ++ks) { const bf16x8 kfr = *(const LAS bf16x8*)(KS + (16 * tile + l15) * SWA_KSTR + 64 * ks + 16 * g);
                    acc = __builtin_amdgcn_mfma_f32_16x16x32_bf16(kfr, qf[ks], acc, 0, 0, 0); }
                s[jj] = acc; }
            s[9] = (f32x4){0.f, 0.f, 0.f, 0.f};
    #pragma unroll
            for (int r = 0; r < 4; ++r) { if (4 * g + r < 1 + l15) s[0][r] = -INFINITY; if (4 * g + r > l15) s[8][r] = -INFINITY; }
            if (blk == 0) {
    #pragma unroll
                for (int jj = 0; jj < 9; ++jj)
    #pragma unroll
                    for (int r = 0; r < 4; ++r) { if (16 * (j0 + jj) + 4 * g + r < 128) s[jj][r] = -INFINITY; }
            }
            float mx = -INFINITY;
    #pragma unroll
            for (int jj = 0; jj < 9; ++jj)
    #pragma unroll
                for (int r = 0; r < 4; ++r) mx = fmaxf(mx, s[jj][r]);
            mx = red16_32_max(mx); mx = fmaxf(mx * SC, sink2);
            float sum = 0.f;
    #pragma unroll
            for (int jj = 0; jj < 9; ++jj)
    #pragma unroll
                for (int r = 0; r < 4; ++r) { const float p = __builtin_amdgcn_exp2f(__builtin_fmaf(s[jj][r], SC, -mx)); s[jj][r] = p; sum += p; }
            sum = red16_32_sum(sum);
            const float inv = 1.0f / (sum + __builtin_amdgcn_exp2f(sink2 - mx));
            f32x4 o[4];
    #pragma unroll
            for (int dt = 0; dt < 4; ++dt) o[dt] = (f32x4){0.f, 0.f, 0.f, 0.f};
    #pragma unroll
            for (int kk = 0; kk < 5; ++kk) {
                const int t0 = (j0 + 2 * kk) > 15 ? 15 : (j0 + 2 * kk), t1 = (j0 + 2 * kk + 1) > 15 ? 15 : (j0 + 2 * kk + 1);
                v4u pw; pw.x = pg8::cvt_pk_bf16(s[2 * kk][0], s[2 * kk][1]); pw.y = pg8::cvt_pk_bf16(s[2 * kk][2], s[2 * kk][3]); pw.z = pg8::cvt_pk_bf16(s[2 * kk + 1][0], s[2 * kk + 1][1]); pw.w = pg8::cvt_pk_bf16(s[2 * kk + 1][2], s[2 * kk + 1][3]);
                const bf16x8 pf = __builtin_bit_cast(bf16x8, pw);
    #pragma unroll
                for (int dt = 0; dt < 4; ++dt) {
                    const v2u a0 = *(const LAS v2u*)(VT + (16 * dt + l15) * SWA_VSTR + (16 * t0 + 4 * g) * 2);
                    const v2u a1 = *(const LAS v2u*)(VT + (16 * dt + l15) * SWA_VSTR + (16 * t1 + 4 * g) * 2);
                    v4u av; av.x = a0.x; av.y = a0.y; av.z = a1.x; av.w = a1.y;
                    o[dt] = __builtin_amdgcn_mfma_f32_16x16x32_bf16(__builtin_bit_cast(bf16x8, av), pf, o[dt], 0, 0, 0); }
            }
            bf16* op = F.MIX + (size_t)(b * SEQ + tq) * DM + 512 + hq * 64 + 4 * g;
    #pragma unroll
            for (int dt = 0; dt < 4; ++dt) { v2u w; w.x = pg8::cvt_pk_bf16(o[dt][0] * inv, o[dt][1] * inv); w.y = pg8::cvt_pk_bf16(o[dt][2] * inv, o[dt][3] * inv); *(v2u*)(op + 16 * dt) = w; }
        }
    }
}
constexpr int ML_QS = 0, ML_KS = 17408, ML_KWT = 34816, ML_VT = 53248, ML_PS = 71680, ML_CT = 80896, ML_F = 115712;
constexpr int ML_QSTR = 272, ML_TSTR = 144, ML_HSTR = 528;
constexpr int FDEN = 256, FN = 320;
constexpr int ML_GV = 132096, ML_GS = ML_GV + 8192, ML_CW = ML_GS + 256;
constexpr int SEG_STRIDE = 16640;
constexpr float LOG2E = 1.4426950408889634f;
__device__ __forceinline__ float silu_f(float v) { return v * __builtin_amdgcn_rcpf(1.0f + __builtin_amdgcn_exp2f(v * -LOG2E)); }
__device__ __forceinline__ float sigmoid_f(float v) { return __builtin_amdgcn_rcpf(1.0f + __builtin_amdgcn_exp2f(v * -LOG2E)); }
__device__ __forceinline__ float exp_f(float v) { return __builtin_amdgcn_exp2f(v * LOG2E); }

template <int PASS> __device__ __forceinline__ void mlstm_item(Frame& F, int b, int h, int sg) {
    const int wave = F.wave;
    int tid = F.tid; asm volatile("" : "+v"(tid));
    int lane = tid & 63, l15 = lane & 15, g4 = lane >> 4;
    LAS unsigned char* L = F.lds; LAS float* FL = (LAS float*)(L + ML_F);
    f32x4 C[8];
#pragma unroll
    for (int et = 0; et < 8; ++et) C[et] = (f32x4){0.f, 0.f, 0.f, 0.f};
    float m = -1e30f, Gsum = 0.f;
    LAS float* GV = (LAS float*)(L + ML_GV); LAS float* GS = (LAS float*)(L + ML_GS); LAS float* CW = (LAS float*)(L + ML_CW);
    __syncthreads();
    if (tid < 128) FL[FN + tid] = 0.f;
    for (int i = tid; i < 1024; i += NWAVES * 64) { const int j = i >> 8, ch = i & 255; CW[i] = F.conv_w[j * 1024 + (ch >> 7) * 512 + h * 128 + (ch & 127)]; }
    {
        const size_t tg = (size_t)b * SEQ + (size_t)(sg * 8 + wave) * 64 + lane;
        const float* gr = F.GATES + tg * 8;
        const float ig = gr[h] + F.igate_b[h], fg = gr[4 + h] + F.fgate_b[h];
        const float lf = fminf(fg, 0.f) - log1pf(__expf(-fabsf(fg)));
        float bs = lf;
#pragma unroll
        for (int o = 1; o < 64; o <<= 1) { const float t = __shfl_up(bs, o); if (lane >= o) bs += t; }
        const float gtot = __shfl(bs, 63);
        const float u = ig - bs;
        float pm = u;
#pragma unroll
        for (int o = 1; o < 64; o <<= 1) { const float t = __shfl_up(pm, o); if (lane >= o) pm = fmaxf(pm, t); }
        const float a = gtot + u;
        const float mloc = wave_max(a);
        GV[wave * 256 + lane] = bs; GV[wave * 256 + 64 + lane] = u; GV[wave * 256 + 128 + lane] = exp_f(a - mloc); GV[wave * 256 + 192 + lane] = pm;
        if (lane == 0) { GS[wave * 2] = gtot; GS[wave * 2 + 1] = mloc; }
    }
    if (PASS == 2 && sg > 0) {
        const float* E0 = F.SEG + (size_t)((b * 4 + h) * 8) * SEG_STRIDE;
        float lw[7]; float sfx = 0.f, mfin = -1e30f;
#pragma unroll
        for (int j = 6; j >= 0; --j) { const int jc = (j < sg) ? j : 0; const float mE = E0[(size_t)jc * SEG_STRIDE + 16384 + 128], G = E0[(size_t)jc * SEG_STRIDE + 16384 + 129];
            lw[j] = (j < sg) ? (mE + sfx) : -1e30f; sfx += (j < sg) ? G : 0.f; mfin = fmaxf(mfin, lw[j]); }
        float coef[7];
#pragma unroll
        for (int j = 0; j < 7; ++j) coef[j] = (j < sg) ? exp_f(lw[j] - mfin) : 0.f;
#pragma unroll 1
        for (int j = 0; j < sg; ++j) { const float* Ej = E0 + (size_t)j * SEG_STRIDE; float cj = coef[0];
#pragma unroll
            for (int q = 1; q < 7; ++q) cj = (j == q) ? coef[q] : cj;
#pragma unroll
            for (int et = 0; et < 8; ++et) C[et] += ((const f32x4*)Ej)[(unsigned)((et * 8 + wave) * 64 + lane)] * cj;
            if (tid < 128) FL[FN + tid] += cj * Ej[16384 + tid]; }
        m = mfin;
    }
    if (PASS == 2) {
#pragma unroll
        for (int et = 0; et < 8; ++et) { v2u w; w.x = pg8::cvt_pk_bf16(C[et][0], C[et][1]); w.y = pg8::cvt_pk_bf16(C[et][2], C[et][3]); *(LAS v2u*)(L + ML_CT + (16 * et + l15) * ML_QSTR + (16 * wave + 4 * g4) * 2) = w; }
    }
    const float kscale = 0.08838834764831845f;
    v4u xr[7]; v4u vr[4];
#define ML_LOAD(cidx) do { const int c_ = (cidx); const size_t t0_ = (size_t)b * SEQ + (size_t)c_ * 64; \
        const int mat_ = tid >> 8, r8_ = tid & 255, dg_ = r8_ & 15, l0_ = 4 * (r8_ >> 4); \
        if (PASS == 2 || mat_ == 1) { const bf16* src_ = F.PROJ + (mat_ ? PC_MK : PC_MQ) + h * 128 + 8 * dg_; \
            _Pragma("unroll") for (int j = 0; j < 7; ++j) { const int lr = l0_ + j - 3; xr[j] = (c_ == 0 && lr < 0) ? (v4u){0u, 0u, 0u, 0u} : *(const v4u*)(src_ + (t0_ + lr) * NPROJ); } } \
        if (mat_ == 0) { _Pragma("unroll") for (int lp = 0; lp < 4; ++lp) vr[lp] = *(const v4u*)(F.PROJ + (t0_ + l0_ + lp) * NPROJ + PC_MV + h * 128 + 8 * dg_); } } while (0)
    ML_LOAD(sg * 8);
#pragma unroll 1
    for (int cc = 0; cc < 8; ++cc) {
        const int c = sg * 8 + cc; const size_t t0 = (size_t)b * SEQ + (size_t)c * 64;
        tid = F.tid; asm volatile("" : "+v"(tid));
        lane = tid & 63; l15 = lane & 15; g4 = lane >> 4;
        const int mat = tid >> 8, r8 = tid & 255, dg = r8 & 15, rg = r8 >> 4, l0 = 4 * rg;
        LAS float* GB = GV + cc * 256;
        __syncthreads();
        const float gtot = GS[cc * 2], mloc = GS[cc * 2 + 1];
        if (PASS == 2 || mat == 1) {
            const float w0 = GB[128 + l0], w1 = GB[128 + l0 + 1], w2 = GB[128 + l0 + 2], w3 = GB[128 + l0 + 3];
            unsigned ow[4][4];
            const LAS float* cwp = CW + mat * 128 + 8 * dg;
#pragma unroll
            for (int ip = 0; ip < 4; ++ip) {
                float ya[4], yb[4];
                const float ca0 = cwp[2 * ip], ca1 = cwp[256 + 2 * ip], ca2 = cwp[512 + 2 * ip], ca3 = cwp[768 + 2 * ip];
                const float cb0 = cwp[2 * ip + 1], cb1 = cwp[256 + 2 * ip + 1], cb2 = cwp[512 + 2 * ip + 1], cb3 = cwp[768 + 2 * ip + 1];
                float xa[7], xb[7];
#pragma unroll
                for (int j = 0; j < 7; ++j) { const unsigned w = (ip == 0) ? xr[j].x : (ip == 1) ? xr[j].y : (ip == 2) ? xr[j].z : xr[j].w; xa[j] = bflo(w); xb[j] = bfhi(w); }
#pragma unroll
                for (int lp = 0; lp < 4; ++lp) {
                    ya[lp] = silu_f(ca0 * xa[lp] + ca1 * xa[lp + 1] + ca2 * xa[lp + 2] + ca3 * xa[lp + 3]) * (mat ? kscale : 1.0f);
                    yb[lp] = silu_f(cb0 * xb[lp] + cb1 * xb[lp + 1] + cb2 * xb[lp + 2] + cb3 * xb[lp + 3]) * (mat ? kscale : 1.0f);
                    ow[lp][ip] = pg8::cvt_pk_bf16(ya[lp], yb[lp]); }
                if (mat == 1) {
                    v2u o; o.x = pg8::cvt_pk_bf16(ya[0] * w0, ya[1] * w1); o.y = pg8::cvt_pk_bf16(ya[2] * w2, ya[3] * w3); *(LAS v2u*)(L + ML_KWT + (8 * dg + 2 * ip) * ML_TSTR + l0 * 2) = o;
                    o.x = pg8::cvt_pk_bf16(yb[0] * w0, yb[1] * w1); o.y = pg8::cvt_pk_bf16(yb[2] * w2, yb[3] * w3); *(LAS v2u*)(L + ML_KWT + (8 * dg + 2 * ip + 1) * ML_TSTR + l0 * 2) = o; }
            }
            if (PASS == 2) {
                LAS unsigned char* dst = L + (mat ? ML_KS : ML_QS) + l0 * ML_QSTR + 16 * dg;
#pragma unroll
                for (int lp = 0; lp < 4; ++lp) { v4u o; o.x = ow[lp][0]; o.y = ow[lp][1]; o.z = ow[lp][2]; o.w = ow[lp][3]; *(LAS v4u*)(dst + lp * ML_QSTR) = o; }
            }
        }
        if (mat == 0) {
            const unsigned ww[4][4] = {{vr[0].x, vr[0].y, vr[0].z, vr[0].w}, {vr[1].x, vr[1].y, vr[1].z, vr[1].w}, {vr[2].x, vr[2].y, vr[2].z, vr[2].w}, {vr[3].x, vr[3].y, vr[3].z, vr[3].w}};
#pragma unroll
            for (int p = 0; p < 4; ++p) {
                v2u lo, hi;
                lo.x = (ww[0][p] & 0xffffu) | (ww[1][p] << 16); lo.y = (ww[2][p] & 0xffffu) | (ww[3][p] << 16);
                hi.x = (ww[0][p] >> 16) | (ww[1][p] & 0xffff0000u); hi.y = (ww[2][p] >> 16) | (ww[3][p] & 0xffff0000u);
                *(LAS v2u*)(L + ML_VT + (8 * dg + 2 * p) * ML_TSTR + l0 * 2) = lo;
                *(LAS v2u*)(L + ML_VT + (8 * dg + 2 * p + 1) * ML_TSTR + l0 * 2) = hi; }
        }
        __syncthreads();
        if (cc < 7) ML_LOAD(c + 1);
        v4u mo2[2];
        if (PASS == 2) {
#pragma unroll
            for (int it = 0; it < 2; ++it) mo2[it] = *(const v4u*)(F.PROJ + (t0 + 8 * wave + 4 * it + g4) * NPROJ + PC_MO + h * 128 + 8 * l15);
        }
        const float mn = fmaxf(gtot + m, mloc), so = exp_f(gtot + m - mn), sn = exp_f(mloc - mn);
        if (PASS == 2) {
            const int lt = wave >> 1;
#pragma unroll
            for (int si = 0; si < 2; ++si) { const int st = 2 * (wave & 1) + si;
                v2u pw = (v2u){0u, 0u};
                if (st <= lt) {
                    f32x4 acc = (f32x4){0.f, 0.f, 0.f, 0.f};
#pragma unroll
                    for (int ks = 0; ks < 4; ++ks) { const bf16x8 a = *(const LAS bf16x8*)(L + ML_KS + (16 * st + l15) * ML_QSTR + 64 * ks + 16 * g4);
                        const bf16x8 bb = *(const LAS bf16x8*)(L + ML_QS + (16 * lt + l15) * ML_QSTR + 64 * ks + 16 * g4);
                        acc = __builtin_amdgcn_mfma_f32_16x16x32_bf16(a, bb, acc, 0, 0, 0); }
                    const int l = 16 * lt + l15, s0 = 16 * st + 4 * g4; const float bl = GB[l]; const float e0 = bl - (bl + fmaxf(GB[192 + l], m));
                    const f32x4 us = *(const LAS f32x4*)(GB + 64 + s0);
                    float p[4];
#pragma unroll
                    for (int r = 0; r < 4; ++r) { const float e = __builtin_amdgcn_exp2f((e0 + us[r]) * LOG2E); p[r] = (s0 + r <= l) ? acc[r] * e : 0.f; }
                    pw.x = pg8::cvt_pk_bf16(p[0], p[1]); pw.y = pg8::cvt_pk_bf16(p[2], p[3]);
                }
                *(LAS v2u*)(L + ML_PS + (16 * lt + l15) * ML_TSTR + (16 * st + 4 * g4) * 2) = pw;
            }
            __syncthreads();
            {
                const int row = 8 * wave + (lane >> 3), part = lane & 7;
                const v4u pw = *(const LAS v4u*)(L + ML_PS + row * ML_TSTR + 16 * part);
                float pf[8]; unpack8(pw, pf);
                float sp = ((pf[0] + pf[1]) + (pf[2] + pf[3])) + ((pf[4] + pf[5]) + (pf[6] + pf[7]));
                const v4u q0 = *(const LAS v4u*)(L + ML_QS + row * ML_QSTR + 32 * part), q1 = *(const LAS v4u*)(L + ML_QS + row * ML_QSTR + 32 * part + 16);
                float qf[16]; unpack8(q0, qf); unpack8(q1, qf + 8);
                float qn = 0.f;
#pragma unroll
                for (int i = 0; i < 16; ++i) qn += qf[i] * FL[FN + 16 * part + i];
                const float bl = GB[row]; const float mrow = bl + fmaxf(GB[192 + row], m); const float sc = exp_f(bl + m - mrow);
                float tot = sp + sc * qn;
                tot += __shfl_xor(tot, 1); tot += __shfl_xor(tot, 2); tot += __shfl_xor(tot, 4);
                if (part == 0) FL[FDEN + row] = fmaxf(fabsf(tot), exp_f(-mrow));
            }
            const int eh = wave & 1;
            f32x4 o1[4], o2[4];
#pragma unroll
            for (int ei = 0; ei < 4; ++ei) { const int et = 4 * eh + ei;
                f32x4 a1 = (f32x4){0.f, 0.f, 0.f, 0.f}, a2 = (f32x4){0.f, 0.f, 0.f, 0.f};
#pragma unroll
                for (int ks = 0; ks < 2; ++ks) { const bf16x8 a = *(const LAS bf16x8*)(L + ML_VT + (16 * et + l15) * ML_TSTR + 64 * ks + 16 * g4);
                    const bf16x8 bb = *(const LAS bf16x8*)(L + ML_PS + (16 * lt + l15) * ML_TSTR + 64 * ks + 16 * g4);
                    a1 = __builtin_amdgcn_mfma_f32_16x16x32_bf16(a, bb, a1, 0, 0, 0); }
#pragma unroll
                for (int ks = 0; ks < 4; ++ks) { const bf16x8 a = *(const LAS bf16x8*)(L + ML_CT + (16 * et + l15) * ML_QSTR + 64 * ks + 16 * g4);
                    const bf16x8 bb = *(const LAS bf16x8*)(L + ML_QS + (16 * lt + l15) * ML_QSTR + 64 * ks + 16 * g4);
                    a2 = __builtin_amdgcn_mfma_f32_16x16x32_bf16(a, bb, a2, 0, 0, 0); }
                o1[ei] = a1; o2[ei] = a2; }
            __syncthreads();
            {
                const int l = 16 * lt + l15; const float bl = GB[l]; const float mrow = bl + fmaxf(GB[192 + l], m); const float sc = exp_f(bl + m - mrow);
                const float inv = 1.0f / FL[FDEN + l];
#pragma unroll
                for (int ei = 0; ei < 4; ++ei) { const int et = 4 * eh + ei; const f32x4 hv = (o1[ei] + o2[ei] * sc) * inv;
                    *(LAS f32x4*)(L + l * ML_HSTR + (16 * et + 4 * g4) * 4) = hv; }
            }
        }
        {
            bf16x8 af[2];
#pragma unroll
            for (int ks = 0; ks < 2; ++ks) af[ks] = *(const LAS bf16x8*)(L + ML_KWT + (16 * wave + l15) * ML_TSTR + 64 * ks + 16 * g4);
#pragma unroll
            for (int et = 0; et < 8; ++et) { f32x4 d = (f32x4){0.f, 0.f, 0.f, 0.f};
#pragma unroll
                for (int ks = 0; ks < 2; ++ks) { const bf16x8 bb = *(const LAS bf16x8*)(L + ML_VT + (16 * et + l15) * ML_TSTR + 64 * ks + 16 * g4);
                    d = __builtin_amdgcn_mfma_f32_16x16x32_bf16(af[ks], bb, d, 0, 0, 0); }
                C[et] = C[et] * so + d * sn; }
            if (tid < 128) { float dn = 0.f;
#pragma unroll
                for (int q = 0; q < 8; ++q) { const v4u w = *(const LAS v4u*)(L + ML_KWT + tid * ML_TSTR + 16 * q); float f[8]; unpack8(w, f); dn += ((f[0] + f[1]) + (f[2] + f[3])) + ((f[4] + f[5]) + (f[6] + f[7])); }
                FL[FN + tid] = so * FL[FN + tid] + sn * dn; }
            m = mn; Gsum += gtot;
            if (PASS == 2) {
#pragma unroll
                for (int et = 0; et < 8; ++et) { v2u w; w.x = pg8::cvt_pk_bf16(C[et][0], C[et][1]); w.y = pg8::cvt_pk_bf16(C[et][2], C[et][3]); *(LAS v2u*)(L + ML_CT + (16 * et + l15) * ML_QSTR + (16 * wave + 4 * g4) * 2) = w; }
            }
        }
        if (PASS == 2) {
            __syncthreads();
            const f32x4 gg0 = *(const f32x4*)(F.mlstm_norm_g + h * 128 + 8 * l15), gg1 = *(const f32x4*)(F.mlstm_norm_g + h * 128 + 8 * l15 + 4);
#pragma unroll
            for (int it = 0; it < 2; ++it) { const int l = 8 * wave + 4 * it + g4;
                const f32x4 h0 = *(const LAS f32x4*)(L + l * ML_HSTR + l15 * 32), h1 = *(const LAS f32x4*)(L + l * ML_HSTR + l15 * 32 + 16);
                float ss = (h0[0] * h0[0] + h0[1] * h0[1]) + (h0[2] * h0[2] + h0[3] * h0[3]) + (h1[0] * h1[0] + h1[1] * h1[1]) + (h1[2] * h1[2] + h1[3] * h1[3]);
                ss += __shfl_xor(ss, 1); ss += __shfl_xor(ss, 2); ss += __shfl_xor(ss, 4); ss += __shfl_xor(ss, 8);
                const float rstd = __builtin_amdgcn_rsqf(ss * (1.f / 128.f) + EPS);
                float mo[8]; unpack8(mo2[it], mo);
                const f32x4 y0 = h0 * gg0 * rstd, y1 = h1 * gg1 * rstd;
                v4u o; o.x = pg8::cvt_pk_bf16(y0[0] * sigmoid_f(mo[0]), y0[1] * sigmoid_f(mo[1])); o.y = pg8::cvt_pk_bf16(y0[2] * sigmoid_f(mo[2]), y0[3] * sigmoid_f(mo[3]));
                o.z = pg8::cvt_pk_bf16(y1[0] * sigmoid_f(mo[4]), y1[1] * sigmoid_f(mo[5])); o.w = pg8::cvt_pk_bf16(y1[2] * sigmoid_f(mo[6]), y1[3] * sigmoid_f(mo[7]));
                *(v4u*)(F.MIX + (t0 + l) * DM + h * 128 + 8 * l15) = o; }
        }
    }
    if (PASS == 1) {
        tid = F.tid; asm volatile("" : "+v"(tid)); lane = tid & 63; l15 = lane & 15; g4 = lane >> 4;
        float* E = F.SEG + (size_t)((b * 4 + h) * 8 + sg) * SEG_STRIDE;
#pragma unroll
        for (int et = 0; et < 8; ++et) ((f32x4*)E)[(et * 8 + wave) * 64 + lane] = C[et];
        if (tid < 128) E[16384 + tid] = FL[FN + tid];
        if (tid == 0) { E[16384 + 128] = m; E[16384 + 129] = Gsum; }
    }
}
template <int PASS> __device__ __forceinline__ void mlstm_phase(Frame& F) {
    for (int it = F.vcu; it < NB * 4 * 8; it += F.G) { const int sg = it & 7, h = (it >> 3) & 3, b = it >> 5;
        if (PASS == 1 && sg == 7) { convert_gu(F, it >> 3, NB * 4); continue; }
        mlstm_item<PASS>(F, b, h, sg); }
}
struct Args { const float* in[15]; float* out; unsigned char* ws; int ph_lo, ph_hi, li, pad; };
__global__ void __launch_bounds__(NWAVES * 64, 2) mk_fwd(Args args) {
    extern __shared__ __attribute__((aligned(16))) unsigned char lds[];
    Frame F;
    F.lds = (LAS unsigned char*)lds;
    F.MISC = (volatile LAS unsigned*)(F.lds + MISC_OFF);
    F.tid = threadIdx.x; F.lane = F.tid & 63; F.wave = __builtin_amdgcn_readfirstlane(F.tid >> 6);
    F.G = gridDim.x; { const int bx = blockIdx.x; F.vcu = (F.G % 8 == 0) ? (bx % 8) * (F.G / 8) + bx / 8 : bx; }
    unsigned char* ws = args.ws;
    F.ctl = (gu32*)(ws + WS_CTL);
    F.x = args.in[0]; F.norm1_g = args.in[1]; F.w_in = args.in[2]; F.conv_w = args.in[3]; F.igate_b = args.in[4]; F.fgate_b = args.in[5]; F.mlstm_norm_g = args.in[6];
    F.q_norm_g = args.in[7]; F.k_norm_g = args.in[8]; F.sinks = args.in[9]; F.w_out = args.in[10]; F.norm2_g = args.in[11]; F.w_gate = args.in[12]; F.w_up = args.in[13]; F.w_down = args.in[14];
    F.out = args.out;
    F.Win_t = (bf16*)(ws + WS_WIN); F.Wout_t = (bf16*)(ws + WS_WOUT); F.Wgu_t = (bf16*)(ws + WS_WGU); F.Wdn_t = (bf16*)(ws + WS_WDN);
    F.XN = (bf16*)(ws + WS_XN); F.MIX = (bf16*)(ws + WS_MIX); F.PROJ = (bf16*)(ws + WS_PROJ);
    F.ROPE = (float2*)(ws + WS_ROPE); F.GATES = (float*)(ws + WS_GATES); F.SSQ = (float*)(ws + WS_SSQ); F.SEG = (float*)(ws + WS_SEG); F.WBG = ws + WS_WBG;
    for (int u = F.tid; u < (LDS_BYTES - LDSCTL_OFF) / 4; u += NWAVES * 64) ((LAS unsigned*)(F.lds + LDSCTL_OFF))[u] = 0u;
    __syncthreads();
    const int lo = args.ph_lo, hi = args.ph_hi;
    XcdBarrier bar; bar.bar = (unsigned*)(F.ctl + CW_BAR) + args.li * XCD_BAR_WORDS; bar.x = 0; bar.st = nullptr;
    if (hi - lo > 1) bar = xcd_barrier_post((unsigned*)(F.ctl + CW_BAR) + args.li * XCD_BAR_WORDS, F.MISC + 8);
#define IN(k) (lo <= (k) && (k) < hi)
#define BOTH(k) (IN(k) && IN((k) + 1))
#define GRID_BAR() xcd_barrier(bar)

#ifndef DOUBLE_PHASE
#define DOUBLE_PHASE -1
#endif
#define RUN_PHASE(k, BODY) if (IN(k)) { { int t_ = threadIdx.x; asm volatile("" : "+v"(t_)); F.tid = t_; F.lane = t_ & 63; }     \
    BODY; if (DOUBLE_PHASE == (k)) { GRID_BAR(); BODY; } if (BOTH(k)) GRID_BAR(); }
#define PH0 p0_prologue(F)
#define PH1 do { pg8::Gemm g{F.XN, F.Win_t, T, NPROJ, DM}; pg8::StaticOrder S; S.init(T, NPROJ, F.G, (int)blockIdx.x); pg8::EpiStoreBf16 E{F.PROJ, NPROJ}; \
        pg8::gemm_phase<pg8::EpiStoreBf16, pg8::StaticOrder, true, true>(F.lds, g, S, E); \
        { const int nwg_ = (T / 256) * (NPROJ / 256), rem_ = nwg_ % F.G;               \
          if (rem_ == 0) p1_side_work(F, (int)blockIdx.x, F.G); else if ((int)blockIdx.x >= rem_) p1_side_work(F, (int)blockIdx.x - rem_, F.G - rem_); } } while (0)
#ifdef H1_BF16
#define PH4 do { pg8::Gemm g{F.MIX, F.Wout_t, T, DM, DM}; pg8::StaticOrder S; S.init(T, DM, F.G, (int)blockIdx.x); pg8::EpiResidNormBS E{F.x, F.XN, F.SSQ}; \
        pg8::gemm_phase<pg8::EpiResidNormBS, pg8::StaticOrder, true, true>(F.lds, g, S, E); } while (0)
#define PH6 do { pg8::Gemm g{F.PROJ, F.Wdn_t, T, DM, DFF}; pg8::StaticOrder S; S.init(T, DM, F.G, (int)blockIdx.x); pg8::EpiResidOutB E{F.XN, F.out}; \
        pg8::gemm_phase<pg8::EpiResidOutB, pg8::StaticOrder, true, true>(F.lds, g, S, E); } while (0)
#else
#define PH4 do { pg8::Gemm g{F.MIX, F.Wout_t, T, DM, DM}; pg8::StaticOrder S; S.init(T, DM, F.G, (int)blockIdx.x); pg8::EpiResidNorm E{F.x, F.out, F.XN, F.SSQ}; \
        pg8::gemm_phase<pg8::EpiResidNorm, pg8::StaticOrder, true, true>(F.lds, g, S, E); } while (0)
#define PH6 do { pg8::Gemm g{F.PROJ, F.Wdn_t, T, DM, DFF}; pg8::StaticOrder S; S.init(T, DM, F.G, (int)blockIdx.x); pg8::EpiResidOut E{F.out, F.out}; \
        pg8::gemm_phase<pg8::EpiResidOut, pg8::StaticOrder, true, true>(F.lds, g, S, E); } while (0)
#endif
#define PH5 do { pg8::Gemm g{F.XN, F.Wgu_t, T, 2 * DFF, DM}; pg8::StaticOrder S; S.init(T, 2 * DFF, F.G, (int)blockIdx.x); pg8::EpiSwiGLU E{F.PROJ, DFF, F.SSQ, EPS}; \
        pg8::gemm_phase<pg8::EpiSwiGLU, pg8::StaticOrder, P5_ALIGN, true>(F.lds, g, S, E); } while (0)
    RUN_PHASE(0, PH0)
    RUN_PHASE(1, PH1)
    RUN_PHASE(2, PHASE2_BODY)
    RUN_PHASE(3, PHASE3_BODY)
    RUN_PHASE(4, PH4)
    RUN_PHASE(5, PH5)
    RUN_PHASE(6, PH6)
#undef IN
#undef BOTH
}
extern "C" void kernel_launch(void* const* d_in, const int* in_sizes, int n_in, void* d_out, int out_size, void* d_ws, size_t ws_size, hipStream_t stream) {
    static int grid = 0;
    if (grid == 0) {
        if (n_in != 15 || in_sizes[0] != T * DM || out_size != T * DM || ws_size < WS_END) { fprintf(stderr, "kernel_launch: unexpected shapes / workspace (n_in %d, ws %zu)\n", n_in, ws_size); grid = -1; return; }
        int dev = 0, cus = 0, per_cu = 0;
        if (hipGetDevice(&dev) != hipSuccess || hipDeviceGetAttribute(&cus, hipDeviceAttributeMultiprocessorCount, dev) != hipSuccess) { grid = -1; return; }
        if (hipFuncSetAttribute((const void*)mk_fwd, hipFuncAttributeMaxDynamicSharedMemorySize, LDS_BYTES) != hipSuccess) { fprintf(stderr, "kernel_launch: hipFuncSetAttribute failed\n"); grid = -1; return; }
        if (hipOccupancyMaxActiveBlocksPerMultiprocessor(&per_cu, (const void*)mk_fwd, NWAVES * 64, LDS_BYTES) != hipSuccess || per_cu < 1) { fprintf(stderr, "kernel_launch: occupancy query says %d blocks per CU\n", per_cu); grid = -1; (void)hipGetLastError(); return; }
        grid = cus;
    }
    if (grid < 0) return;
    (void)hipMemsetAsync((char*)d_ws + WS_CTL, 0, CTL_ZERO_BYTES, stream);
    Args a{};
    for (int i = 0; i < 15; ++i) a.in[i] = (const float*)d_in[i];
    a.out = (float*)d_out; a.ws = (unsigned char*)d_ws;
    LAUNCH_PROGRAM
}
```

```cpp
#include <hip/hip_runtime.h>
#include <cstdio>
#include <cstdint>
__device__ __forceinline__ int fresh_lane() { return (int)__builtin_amdgcn_mbcnt_hi(~0u, __builtin_amdgcn_mbcnt_lo(~0u, 0u)); }
namespace pg8 {
#define PG8_LAS __attribute__((address_space(3)))
typedef unsigned short bf16_t;
typedef short bf16x8 __attribute__((ext_vector_type(8)));
typedef float f32x4 __attribute__((ext_vector_type(4)));
typedef unsigned u32x4 __attribute__((ext_vector_type(4)));
constexpr int BM = 256, BK = 64, HALF = 128, HTB = HALF * BK * 2  , STAGE_BYTES = 8 * HTB, NXCD = 8, WGM = 8;

__host__ __device__ __forceinline__ int lds_byte(int r, int c) { const int st = (r >> 4) * 2 + (c >> 5), rr = r & 15, cc = c & 31, ob = rr * 64 + cc * 2; return st * 1024 + (ob ^ (((ob >> 9) & 1) << 5)); }
__host__ __device__ __forceinline__ void stage_rc(int b, int& R, int& C) { const int st = b / 1024, sb = b % 1024, swz = sb ^ (((sb >> 9) & 1) << 5); R = (st >> 1) * 16 + swz / 64; C = (st & 1) * 32 + (swz % 64) / 2; }
__host__ __device__ __forceinline__ int perm32(int rho) { const int n = rho >> 4, i = rho & 15; return 8 * (i >> 2) + 4 * n + (i & 3); }

struct Unit { int pm, pn; };
struct Gemm { const bf16_t* A; const bf16_t* Bt; int M, N, K; };

struct StaticOrder {
    int nM, nN, nwg, G, c;
    __host__ __device__ void init(int M, int N, int G_, int c_) { nM = M / BM; nN = N / BM; nwg = nM * nN; G = G_; c = c_; }
    __host__ __device__ bool next(int i, Unit& u) const {
        const long L = (long)i * G + c; if (L >= nwg) return false;
        int wgid = (int)L; { const int q = nwg / NXCD, r = nwg % NXCD, xcd = wgid % NXCD, off = wgid / NXCD; wgid = (xcd < r ? xcd * (q + 1) : r * (q + 1) + (xcd - r) * q) + off; }
        const int nig = WGM * nN, gid = wgid / nig, fm = gid * WGM, gsz = (nM - fm) < WGM ? (nM - fm) : WGM;
        u.pm = fm + ((wgid % nig) % gsz); u.pn = (wgid % nig) / gsz; return true;
    }
    __device__ __forceinline__ void a_ready(const Unit&) const {}
    __device__ __forceinline__ void done(const Unit&) const {}
};

__device__ __forceinline__ unsigned cvt_pk_bf16(float lo, float hi) { unsigned r; asm volatile("v_cvt_pk_bf16_f32 %0, %1, %2" : "=v"(r) : "v"(lo), "v"(hi)); return r; }
typedef float f32x2 __attribute__((ext_vector_type(2)));
#ifdef WT_STORES
__device__ __forceinline__ void st16(void* p, u32x4 v) { asm volatile("global_store_dwordx4 %0, %1, off sc1\n\ts_nop 1" :: "v"(p), "v"(v) : "memory"); }
#else
__device__ __forceinline__ void st16(void* p, u32x4 v) { *(u32x4*)p = v; }
#endif
__device__ __forceinline__ float fast_silu(float v) { return v * __builtin_amdgcn_rcpf(1.0f + __builtin_amdgcn_exp2f(v * -1.4426950408889634f)); }
struct EpiStoreBf16 {
    static constexpr bool PERM = true, AFTER_DRAIN = false, STREAM_R = false, STREAM_BF16 = false;
    bf16_t* O; int ldc;
    __device__ __forceinline__ void operator()(const f32x4 (&acc)[2][2][4][2], const Unit& u, int wr, int wc, int fr, int fq) const {
        const int row0 = u.pm * BM + wr * 64 + fr, col0 = u.pn * BM + wc * 32 + 8 * fq;
#pragma unroll
        for (int ai = 0; ai < 2; ++ai)
#pragma unroll
            for (int m = 0; m < 4; ++m) { bf16_t* rowp = O + (size_t)(row0 + ai * HALF + m * 16) * ldc + col0;
#pragma unroll
                for (int bj = 0; bj < 2; ++bj) { const f32x4 v0 = acc[ai][bj][m][0], v1 = acc[ai][bj][m][1];
                    u32x4 w; w.x = cvt_pk_bf16(v0[0], v0[1]); w.y = cvt_pk_bf16(v0[2], v0[3]); w.z = cvt_pk_bf16(v1[0], v1[1]); w.w = cvt_pk_bf16(v1[2], v1[3]);
                    st16(rowp + bj * HALF, w); } }
    }
};
struct EpiResidNorm {
    static constexpr bool PERM = true, AFTER_DRAIN = false, STREAM_R = false, STREAM_BF16 = false;
    const float* X; float* H; bf16_t* HB; float* SSQ;
    __device__ __forceinline__ void operator()(const f32x4 (&acc)[2][2][4][2], const Unit& u, int wr, int wc, int fr, int fq) const {
        const int row0 = u.pm * BM + wr * 64 + fr, col0 = u.pn * BM + wc * 32 + 8 * fq;
#pragma unroll
        for (int ai = 0; ai < 2; ++ai)
#pragma unroll
            for (int m = 0; m < 4; ++m) { const int row = row0 + ai * HALF + m * 16; const size_t off = (size_t)row * 1024 + col0; float ss = 0.f;
#pragma unroll
                for (int bj = 0; bj < 2; ++bj) { const f32x4 x0 = *(const f32x4*)(X + off + bj * HALF), x1 = *(const f32x4*)(X + off + bj * HALF + 4);
                    const f32x4 v0 = x0 + acc[ai][bj][m][0], v1 = x1 + acc[ai][bj][m][1];
                    *(f32x4*)(H + off + bj * HALF) = v0; *(f32x4*)(H + off + bj * HALF + 4) = v1;
                    u32x4 w; w.x = cvt_pk_bf16(v0[0], v0[1]); w.y = cvt_pk_bf16(v0[2], v0[3]); w.z = cvt_pk_bf16(v1[0], v1[1]); w.w = cvt_pk_bf16(v1[2], v1[3]);
                    *(u32x4*)(HB + off + bj * HALF) = w;
                    ss += (v0[0] * v0[0] + v0[1] * v0[1]) + (v0[2] * v0[2] + v0[3] * v0[3]) + (v1[0] * v1[0] + v1[1] * v1[1]) + (v1[2] * v1[2] + v1[3] * v1[3]); }
                ss += __shfl_xor(ss, 16); ss += __shfl_xor(ss, 32);
                if (fq == 0) SSQ[(size_t)row * 16 + u.pn * 4 + wc] = ss; }
    }
};
struct EpiSwiGLU {
    static constexpr bool PERM = true, AFTER_DRAIN = false, STREAM_R = false, STREAM_BF16 = false;
    bf16_t* O; int ldc; const float* SSQ; float eps;
    __device__ __forceinline__ void operator()(const f32x4 (&acc)[2][2][4][2], const Unit& u, int wr, int wc, int fr, int fq) const {
        const int row0 = u.pm * BM + wr * 64 + fr, col0 = u.pn * HALF + wc * 32 + 8 * fq;
        f32x4 sv[4];
        { const f32x4* sp = (const f32x4*)(SSQ + (size_t)row0 * 16); sv[0] = sp[0]; sv[1] = sp[1]; sv[2] = sp[2]; sv[3] = sp[3]; }
#pragma unroll
        for (int grp = 0; grp < 8; ++grp) { const int ai = grp >> 2, m = grp & 3; const int row = row0 + ai * HALF + m * 16;
            const f32x4 t = (sv[0] + sv[1]) + (sv[2] + sv[3]);
            const float rs = __builtin_amdgcn_rsqf(((t[0] + t[1]) + (t[2] + t[3])) * (1.0f / 1024.0f) + eps);
            if (grp < 7) { const int rown = row0 + ((grp + 1) >> 2) * HALF + ((grp + 1) & 3) * 16; const f32x4* sp = (const f32x4*)(SSQ + (size_t)rown * 16); sv[0] = sp[0]; sv[1] = sp[1]; sv[2] = sp[2]; sv[3] = sp[3]; }
            float h[8];
#pragma unroll
            for (int n = 0; n < 2; ++n)
#pragma unroll
                for (int j = 0; j < 4; ++j) { const float g = acc[ai][0][m][n][j] * rs, up = acc[ai][1][m][n][j] * rs; h[n * 4 + j] = fast_silu(g) * up; }
            u32x4 w; w.x = cvt_pk_bf16(h[0], h[1]); w.y = cvt_pk_bf16(h[2], h[3]); w.z = cvt_pk_bf16(h[4], h[5]); w.w = cvt_pk_bf16(h[6], h[7]);
            st16(O + (size_t)row * ldc + col0, w); }
    }
};
struct EpiResidOut {
    static constexpr bool PERM = true, AFTER_DRAIN = false, STREAM_R = false, STREAM_BF16 = false;
    const float* R; float* OUT;
    __device__ __forceinline__ void operator()(const f32x4 (&acc)[2][2][4][2], const Unit& u, int wr, int wc, int fr, int fq) const {
        const int row0 = u.pm * BM + wr * 64 + fr, col0 = u.pn * BM + wc * 32 + 8 * fq;
#pragma unroll
        for (int ai = 0; ai < 2; ++ai)
#pragma unroll
            for (int m = 0; m < 4; ++m) { const size_t off = (size_t)(row0 + ai * HALF + m * 16) * 1024 + col0;
#pragma unroll
                for (int bj = 0; bj < 2; ++bj) { const f32x4 r0 = *(const f32x4*)(R + off + bj * HALF), r1 = *(const f32x4*)(R + off + bj * HALF + 4);
                    *(f32x4*)(OUT + off + bj * HALF) = r0 + acc[ai][bj][m][0]; *(f32x4*)(OUT + off + bj * HALF + 4) = r1 + acc[ai][bj][m][1]; } }
    }
};
struct EpiResidNormB {
    static constexpr bool PERM = true, AFTER_DRAIN = false, STREAM_R = false, STREAM_BF16 = false;
    const float* X; bf16_t* HB; float* SSQ;
    __device__ __forceinline__ void operator()(const f32x4 (&acc)[2][2][4][2], const Unit& u, int wr, int wc, int fr, int fq) const {
        const int row0 = u.pm * BM + wr * 64 + fr, col0 = u.pn * BM + wc * 32 + 8 * fq;
#pragma unroll
        for (int ai = 0; ai < 2; ++ai)
#pragma unroll
            for (int m = 0; m < 4; ++m) { const int row = row0 + ai * HALF + m * 16; const size_t off = (size_t)row * 1024 + col0; float ss = 0.f;
#pragma unroll
                for (int bj = 0; bj < 2; ++bj) { const f32x4 x0 = *(const f32x4*)(X + off + bj * HALF), x1 = *(const f32x4*)(X + off + bj * HALF + 4);
                    const f32x4 v0 = x0 + acc[ai][bj][m][0], v1 = x1 + acc[ai][bj][m][1];
                    u32x4 w; w.x = cvt_pk_bf16(v0[0], v0[1]); w.y = cvt_pk_bf16(v0[2], v0[3]); w.z = cvt_pk_bf16(v1[0], v1[1]); w.w = cvt_pk_bf16(v1[2], v1[3]);
                    *(u32x4*)(HB + off + bj * HALF) = w;
                    ss += (v0[0] * v0[0] + v0[1] * v0[1]) + (v0[2] * v0[2] + v0[3] * v0[3]) + (v1[0] * v1[0] + v1[1] * v1[1]) + (v1[2] * v1[2] + v1[3] * v1[3]); }
                ss += __shfl_xor(ss, 16); ss += __shfl_xor(ss, 32);
                if (fq == 0) SSQ[(size_t)row * 16 + u.pn * 4 + wc] = ss; }
    }
};
struct EpiResidOutB {
    static constexpr bool PERM = true, AFTER_DRAIN = false, STREAM_R = false, STREAM_BF16 = false;
    const bf16_t* RB; float* OUT;
    __device__ __forceinline__ void operator()(const f32x4 (&acc)[2][2][4][2], const Unit& u, int wr, int wc, int fr, int fq) const {
        const int row0 = u.pm * BM + wr * 64 + fr, col0 = u.pn * BM + wc * 32 + 8 * fq;
#pragma unroll
        for (int ai = 0; ai < 2; ++ai) {
            u32x4 rw[4][2];
#pragma unroll
            for (int m = 0; m < 4; ++m) { const size_t off = (size_t)(row0 + ai * HALF + m * 16) * 1024 + col0;
#pragma unroll
                for (int bj = 0; bj < 2; ++bj) rw[m][bj] = *(const u32x4*)(RB + off + bj * HALF); }
#pragma unroll
            for (int m = 0; m < 4; ++m) { const size_t off = (size_t)(row0 + ai * HALF + m * 16) * 1024 + col0;
#pragma unroll
                for (int bj = 0; bj < 2; ++bj) { const u32x4 w = rw[m][bj];
                    const f32x4 r0 = (f32x4){__builtin_bit_cast(float, w.x << 16), __builtin_bit_cast(float, w.x & 0xffff0000u), __builtin_bit_cast(float, w.y << 16), __builtin_bit_cast(float, w.y & 0xffff0000u)};
                    const f32x4 r1 = (f32x4){__builtin_bit_cast(float, w.z << 16), __builtin_bit_cast(float, w.z & 0xffff0000u), __builtin_bit_cast(float, w.w << 16), __builtin_bit_cast(float, w.w & 0xffff0000u)};
                    *(f32x4*)(OUT + off + bj * HALF) = r0 + acc[ai][bj][m][0]; *(f32x4*)(OUT + off + bj * HALF + 4) = r1 + acc[ai][bj][m][1]; } }
            asm volatile("" ::: "memory");
        }
    }
};
struct EpiResidNormBS {
    static constexpr bool PERM = true, AFTER_DRAIN = false, STREAM_R = true, STREAM_BF16 = false;
    const float* RS; bf16_t* HB; float* SSQ;
    __device__ __forceinline__ void operator()(const f32x4 (&acc)[2][2][4][2], const Unit& u, int wr, int wc, int fr, int fq) const {
        { int t_ = threadIdx.x; asm volatile("" : "+v"(t_)); fr = t_ & 15; fq = (t_ >> 4) & 3; }
        const int row0 = u.pm * BM + wr * 64 + fr, col0 = u.pn * BM + wc * 32 + 8 * fq;
#pragma unroll
        for (int ai = 0; ai < 2; ++ai)
#pragma unroll
            for (int m = 0; m < 4; ++m) { const int row = row0 + ai * HALF + m * 16; const size_t off = (size_t)row * 1024 + col0; float ss = 0.f;
#pragma unroll
                for (int bj = 0; bj < 2; ++bj) { const f32x4 v0 = acc[ai][bj][m][0], v1 = acc[ai][bj][m][1];
                    u32x4 w; w.x = cvt_pk_bf16(v0[0], v0[1]); w.y = cvt_pk_bf16(v0[2], v0[3]); w.z = cvt_pk_bf16(v1[0], v1[1]); w.w = cvt_pk_bf16(v1[2], v1[3]);
                    st16(HB + off + bj * HALF, w);
                    ss += (v0[0] * v0[0] + v0[1] * v0[1]) + (v0[2] * v0[2] + v0[3] * v0[3]) + (v1[0] * v1[0] + v1[1] * v1[1]) + (v1[2] * v1[2] + v1[3] * v1[3]); }
                ss += __shfl_xor(ss, 16); ss += __shfl_xor(ss, 32);
                if (fq == 0) SSQ[(size_t)row * 16 + u.pn * 4 + wc] = ss; }
    }
};
struct EpiResidOutBS {
    static constexpr bool PERM = true, AFTER_DRAIN = false, STREAM_R = true, STREAM_BF16 = true;
    const bf16_t* RS; float* OUT;
    __device__ __forceinline__ void operator()(const f32x4 (&acc)[2][2][4][2], const Unit& u, int wr, int wc, int fr, int fq) const {
        { int t_ = threadIdx.x; asm volatile("" : "+v"(t_)); fr = t_ & 15; fq = (t_ >> 4) & 3; }
        const int row0 = u.pm * BM + wr * 64 + fr, col0 = u.pn * BM + wc * 32 + 8 * fq;
#pragma unroll
        for (int ai = 0; ai < 2; ++ai)
#pragma unroll
            for (int m = 0; m < 4; ++m) { const size_t off = (size_t)(row0 + ai * HALF + m * 16) * 1024 + col0;
#pragma unroll
                for (int bj = 0; bj < 2; ++bj) { *(f32x4*)(OUT + off + bj * HALF) = acc[ai][bj][m][0]; *(f32x4*)(OUT + off + bj * HALF + 4) = acc[ai][bj][m][1]; } }
    }
};
template <class Epi, class Sched, bool ALIGN_EPI = false, bool SP2 = false>
__device__ __forceinline__ void gemm_phase(PG8_LAS unsigned char* lds, const Gemm g, const Sched& S, const Epi& E) {
    const int tid = threadIdx.x, wid = __builtin_amdgcn_readfirstlane(tid >> 6), lane = tid & 63, wr = wid >> 2, wc = wid & 3, fr = lane & 15, fq = lane >> 4;
    const int K = g.K, nt = K / BK;
    unsigned voffA[2], voffB[2];
#pragma unroll
    for (int i = 0; i < 2; ++i) { int R, C; stage_rc(tid * 16 + i * 8192, R, C); const int Rb = Epi::PERM ? ((R & ~31) + perm32(R & 31)) : R;
        voffA[i] = (unsigned)(R * K + C) * 2u; voffB[i] = (unsigned)(Rb * K + C) * 2u; }
    const size_t kstep = (size_t)(BK * 2);
    const size_t hstep = (size_t)HALF * K * 2;
    const size_t tstep = 2 * hstep;
    const unsigned ldsw = (unsigned)wid * 1024u;
    const int aoff = lds_byte(wr * 64 + fr, fq * 8), boff = lds_byte(wc * 32 + fr, fq * 8);
#define PG8_SA(b, h) (((b) * 2 + (h)) * HTB)
#define PG8_SB(b, h) ((4 + (b) * 2 + (h)) * HTB)
#define PG8_STAGE(bufoff, gbase, voff) do { _Pragma("unroll") for (int _i = 0; _i < 2; ++_i) \
        __builtin_amdgcn_global_load_lds((const unsigned*)((const char*)(gbase) + (voff)[_i]), (PG8_LAS unsigned*)(lds + (bufoff) + ldsw + _i * 8192), 16, 0, 0); } while (0)
#define PG8_LDA(dst, b, h) do { _Pragma("unroll") for (int m = 0; m < 4; ++m) _Pragma("unroll") for (int k = 0; k < 2; ++k) dst[m][k] = *(const PG8_LAS bf16x8*)(lds + PG8_SA(b, h) + aoff + m * 2048 + k * 1024); } while (0)
#define PG8_LDB(dst, b, h) do { _Pragma("unroll") for (int n = 0; n < 2; ++n) _Pragma("unroll") for (int k = 0; k < 2; ++k) dst[n][k] = *(const PG8_LAS bf16x8*)(lds + PG8_SB(b, h) + boff + n * 2048 + k * 1024); } while (0)
#define PG8_MMA(ai, bj, At, Bt) do { __builtin_amdgcn_s_setprio(1); _Pragma("unroll") for (int m = 0; m < 4; ++m) _Pragma("unroll") for (int n = 0; n < 2; ++n) _Pragma("unroll") for (int k = 0; k < 2; ++k) \
        acc[ai][bj][m][n] = __builtin_amdgcn_mfma_f32_16x16x32_bf16(Bt[n][k], At[m][k], acc[ai][bj][m][n], 0, 0, 0); __builtin_amdgcn_s_setprio(0); } while (0)
#define PG8_WAIT_V(n) asm volatile("s_waitcnt vmcnt(" #n ")" ::: "memory")
#define PG8_WAIT_L(n) asm volatile("s_waitcnt lgkmcnt(" #n ")" ::: "memory")
#define PG8_BAR __builtin_amdgcn_s_barrier()
#define PG8_SCHED __builtin_amdgcn_sched_barrier(0)
#define PG8_PIECE_OFF 147456
#define PG8_RLOAD_P(p) do { if constexpr (Epi::STREAM_BF16) { const char* pa_ = rcur + (size_t)((((((p) >> 3) & 1) * HALF + (((p) >> 1) & 3) * 16) * 1024 + ((p) & 1) * HALF) * 2) + (rvoff >> 1); \
            __builtin_amdgcn_global_load_lds((const unsigned*)pa_, (PG8_LAS unsigned*)(lds + PG8_PIECE_OFF + wid * 2048), 16, 0, 0); \
        } else { const char* pa_ = rcur + (size_t)((((((p) >> 3) & 1) * HALF + (((p) >> 1) & 3) * 16) * 1024 + ((p) & 1) * HALF) * 4) + rvoff; \
            __builtin_amdgcn_global_load_lds((const unsigned*)pa_, (PG8_LAS unsigned*)(lds + PG8_PIECE_OFF + wid * 2048), 16, 0, 0); \
            __builtin_amdgcn_global_load_lds((const unsigned*)(pa_ + 16), (PG8_LAS unsigned*)(lds + PG8_PIECE_OFF + wid * 2048 + 1024), 16, 0, 0); } } while (0)
#define PG8_RADD_P(p) do { if constexpr (Epi::STREAM_BF16) { typedef unsigned u32x2_ __attribute__((ext_vector_type(2))); \
            { const u32x2_ w_ = *(const PG8_LAS u32x2_*)(lds + PG8_PIECE_OFF + wid * 2048 + lane * 16); \
              acc[((p) >> 3) & 1][(p) & 1][((p) >> 1) & 3][0] += (f32x4){__builtin_bit_cast(float, w_.x << 16), __builtin_bit_cast(float, w_.x & 0xffff0000u), __builtin_bit_cast(float, w_.y << 16), __builtin_bit_cast(float, w_.y & 0xffff0000u)}; } \
            asm volatile("" ::: "memory"); \
            { const u32x2_ w_ = *(const PG8_LAS u32x2_*)(lds + PG8_PIECE_OFF + wid * 2048 + lane * 16 + 8); \
              acc[((p) >> 3) & 1][(p) & 1][((p) >> 1) & 3][1] += (f32x4){__builtin_bit_cast(float, w_.x << 16), __builtin_bit_cast(float, w_.x & 0xffff0000u), __builtin_bit_cast(float, w_.y << 16), __builtin_bit_cast(float, w_.y & 0xffff0000u)}; } \
        } else { { const f32x4 q0_ = *(const PG8_LAS f32x4*)(lds + PG8_PIECE_OFF + wid * 2048 + lane * 16); acc[((p) >> 3) & 1][(p) & 1][((p) >> 1) & 3][0] += q0_; } asm volatile("" ::: "memory"); \
        { const f32x4 q1_ = *(const PG8_LAS f32x4*)(lds + PG8_PIECE_OFF + wid * 2048 + 1024 + lane * 16); acc[((p) >> 3) & 1][(p) & 1][((p) >> 1) & 3][1] += q1_; } } } while (0)
#define PG8_WAIT_V1P() do { if constexpr (Epi::STREAM_BF16) PG8_WAIT_V(9); else PG8_WAIT_V(10); } while (0)
#define PG8_KPAIR(t, P0_, P1_) do { \
            const bool last = ((t) == nt - 2); \
            const char* a1 = cA + (size_t)((t) + 1) * kstep; \
            const char* a2 = last ? nA : cA + (size_t)((t) + 2) * kstep; const char* b2 = last ? nB : cB + (size_t)((t) + 2) * kstep; \
            const char* a3 = a2 + kstep; const char* b3 = b2 + kstep; \
            if (last && has_next) S.a_ready(nxt); \
            if constexpr ((P0_) >= 0) PG8_RLOAD_P(P0_); \
            PG8_LDB(B0, 0, 0); PG8_LDB(B1, 0, 1); PG8_SCHED; PG8_LDA(At, 0, 0); PG8_STAGE(PG8_SA(1, 1), a1 + hstep, voffA); \
            if constexpr ((P0_) >= 0) PG8_WAIT_V1P(); else PG8_WAIT_V(8); \
            PG8_WAIT_L(0); PG8_BAR; PG8_MMA(0, 0, At, B0); PG8_MMA(0, 1, At, B1); PG8_BAR; PG8_SCHED; \
            PG8_LDA(At, 0, 1); PG8_STAGE(PG8_SB(0, 0), b2, voffB); PG8_STAGE(PG8_SB(0, 1), b2 + hstep, voffB); PG8_STAGE(PG8_SA(0, 0), a2, voffA); \
            PG8_WAIT_V(8); PG8_WAIT_L(0); PG8_BAR; if constexpr ((P0_) >= 0) PG8_RADD_P(P0_); PG8_MMA(1, 0, At, B0); PG8_MMA(1, 1, At, B1); PG8_BAR; PG8_SCHED; \
            if constexpr ((P1_) >= 0) PG8_RLOAD_P(P1_); \
            PG8_LDB(B0, 1, 0); PG8_LDB(B1, 1, 1); PG8_SCHED; PG8_LDA(At, 1, 0); PG8_STAGE(PG8_SA(0, 1), a2 + hstep, voffA); \
            if constexpr ((P1_) >= 0) PG8_WAIT_V1P(); else PG8_WAIT_V(8); \
            PG8_WAIT_L(0); PG8_BAR; PG8_MMA(0, 0, At, B0); PG8_MMA(0, 1, At, B1); PG8_BAR; PG8_SCHED; \
            PG8_LDA(At, 1, 1); PG8_STAGE(PG8_SB(1, 0), b3, voffB); PG8_STAGE(PG8_SB(1, 1), b3 + hstep, voffB); PG8_STAGE(PG8_SA(1, 0), a3, voffA); \
            PG8_WAIT_V(8); PG8_WAIT_L(0); PG8_BAR; if constexpr ((P1_) >= 0) PG8_RADD_P(P1_); PG8_MMA(1, 0, At, B0); PG8_MMA(1, 1, At, B1); PG8_BAR; PG8_SCHED; \
        } while (0)
    Unit cur, nxt; int ui = 0;
    if (!S.next(0, cur)) return;
    f32x4 acc[2][2][4][2];
#pragma unroll
    for (int a = 0; a < 2; ++a)
#pragma unroll
        for (int b = 0; b < 2; ++b)
#pragma unroll
            for (int m = 0; m < 4; ++m)
#pragma unroll
                for (int n = 0; n < 2; ++n) acc[a][b][m][n] = (f32x4){0.f, 0.f, 0.f, 0.f};
    bf16x8 At[4][2], B0[2][2], B1[2][2];
    const char* rcur = nullptr;
    const unsigned rvoff = (unsigned)(((wr * 64 + fr) * 1024 + wc * 32 + 8 * fq) * 4);
#define PG8_RCUR(u_) do { if constexpr (Epi::STREAM_R) rcur = (const char*)E.RS + ((size_t)((u_).pm * BM) * 1024 + (u_).pn * BM) * (Epi::STREAM_BF16 ? 2 : 4); } while (0)
    PG8_RCUR(cur);
    const char* cA = (const char*)g.A + (size_t)cur.pm * tstep; const char* cB = (const char*)g.Bt + (size_t)cur.pn * tstep;
    S.a_ready(cur);
    if constexpr (SP2) {
        PG8_STAGE(PG8_SB(0, 0), cB, voffB); PG8_STAGE(PG8_SB(0, 1), cB + hstep, voffB); PG8_STAGE(PG8_SA(0, 0), cA, voffA); PG8_STAGE(PG8_SA(0, 1), cA + hstep, voffA);
        if (wr == 1) PG8_BAR;
        PG8_WAIT_V(2); PG8_BAR;
        PG8_STAGE(PG8_SB(1, 0), cB + kstep, voffB); PG8_STAGE(PG8_SA(1, 0), cA + kstep, voffA); PG8_STAGE(PG8_SB(1, 1), cB + hstep + kstep, voffB);
        PG8_WAIT_V(6); PG8_BAR;
    } else {
        PG8_STAGE(PG8_SB(0, 0), cB, voffB); PG8_STAGE(PG8_SA(0, 0), cA, voffA); PG8_STAGE(PG8_SB(0, 1), cB + hstep, voffB); PG8_STAGE(PG8_SA(0, 1), cA + hstep, voffA);
        if (wr == 1) PG8_BAR;
        PG8_WAIT_V(4); PG8_BAR;
        PG8_STAGE(PG8_SB(1, 0), cB + kstep, voffB); PG8_STAGE(PG8_SA(1, 0), cA + kstep, voffA); PG8_STAGE(PG8_SB(1, 1), cB + hstep + kstep, voffB);
        PG8_WAIT_V(6); PG8_BAR;
    }
    for (;;) {
        const bool has_next = S.next(ui + 1, nxt);
        const char* nA = has_next ? (const char*)g.A + (size_t)nxt.pm * tstep : cA; const char* nB = has_next ? (const char*)g.Bt + (size_t)nxt.pn * tstep : cB;
        if constexpr (SP2 && Epi::STREAM_R) {
            PG8_KPAIR(0, 0, 1); PG8_KPAIR(2, 2, 3); PG8_KPAIR(4, 4, 5); PG8_KPAIR(6, 6, 7); PG8_KPAIR(8, 8, 9); PG8_KPAIR(10, 10, 11); PG8_KPAIR(12, 12, 13); PG8_KPAIR(14, 14, 15);
#pragma unroll 1
            for (int t = 16; t < nt; t += 2) PG8_KPAIR(t, -1, -1);
        } else
        for (int t = 0; t < nt; t += 2) {
            const bool last = (t == nt - 2);
            const char* a1 = cA + (size_t)(t + 1) * kstep;
            const char* a2 = last ? nA : cA + (size_t)(t + 2) * kstep; const char* b2 = last ? nB : cB + (size_t)(t + 2) * kstep;
            const char* a3 = a2 + kstep; const char* b3 = b2 + kstep;
            if (last && has_next) S.a_ready(nxt);
            if constexpr (SP2) {
            PG8_LDB(B0, 0, 0); PG8_LDB(B1, 0, 1); PG8_SCHED; PG8_LDA(At, 0, 0); PG8_STAGE(PG8_SA(1, 1), a1 + hstep, voffA);
            PG8_WAIT_V(8); PG8_WAIT_L(0); PG8_BAR; PG8_MMA(0, 0, At, B0); PG8_MMA(0, 1, At, B1); PG8_BAR; PG8_SCHED;
            PG8_LDA(At, 0, 1); PG8_STAGE(PG8_SB(0, 0), b2, voffB); PG8_STAGE(PG8_SB(0, 1), b2 + hstep, voffB); PG8_STAGE(PG8_SA(0, 0), a2, voffA);
            PG8_WAIT_V(8); PG8_WAIT_L(0); PG8_BAR; PG8_MMA(1, 0, At, B0); PG8_MMA(1, 1, At, B1); PG8_BAR; PG8_SCHED;
            PG8_LDB(B0, 1, 0); PG8_LDB(B1, 1, 1); PG8_SCHED; PG8_LDA(At, 1, 0); PG8_STAGE(PG8_SA(0, 1), a2 + hstep, voffA);
            PG8_WAIT_V(8); PG8_WAIT_L(0); PG8_BAR; PG8_MMA(0, 0, At, B0); PG8_MMA(0, 1, At, B1); PG8_BAR; PG8_SCHED;
            PG8_LDA(At, 1, 1); PG8_STAGE(PG8_SB(1, 0), b3, voffB); PG8_STAGE(PG8_SB(1, 1), b3 + hstep, voffB); PG8_STAGE(PG8_SA(1, 0), a3, voffA);
            PG8_WAIT_V(8); PG8_WAIT_L(0); PG8_BAR; PG8_MMA(1, 0, At, B0); PG8_MMA(1, 1, At, B1); PG8_BAR; PG8_SCHED;
            } else {
            PG8_LDB(B0, 0, 0); PG8_SCHED; PG8_LDA(At, 0, 0); PG8_STAGE(PG8_SA(1, 1), a1 + hstep, voffA);
            PG8_WAIT_L(8); PG8_BAR; PG8_WAIT_L(0); PG8_MMA(0, 0, At, B0); PG8_BAR; PG8_SCHED;
            PG8_LDB(B1, 0, 1); PG8_STAGE(PG8_SB(0, 0), b2, voffB);
            PG8_BAR; PG8_WAIT_L(0); PG8_MMA(0, 1, At, B1); PG8_BAR;
            PG8_LDA(At, 0, 1); PG8_STAGE(PG8_SA(0, 0), a2, voffA);
            PG8_BAR; PG8_WAIT_L(0); PG8_MMA(1, 0, At, B0); PG8_BAR; PG8_SCHED;
            PG8_STAGE(PG8_SB(0, 1), b2 + hstep, voffB);
            PG8_WAIT_V(6); PG8_BAR; PG8_MMA(1, 1, At, B1); PG8_BAR;
            PG8_LDB(B0, 1, 0); PG8_SCHED; PG8_LDA(At, 1, 0); PG8_STAGE(PG8_SA(0, 1), a2 + hstep, voffA);
            PG8_WAIT_L(8); PG8_BAR; PG8_WAIT_L(0); PG8_MMA(0, 0, At, B0); PG8_BAR; PG8_SCHED;
            PG8_LDB(B1, 1, 1); PG8_STAGE(PG8_SB(1, 0), b3, voffB);
            PG8_BAR; PG8_WAIT_L(0); PG8_MMA(0, 1, At, B1); PG8_BAR;
            PG8_LDA(At, 1, 1); PG8_STAGE(PG8_SA(1, 0), a3, voffA);
            PG8_BAR; PG8_WAIT_L(0); PG8_MMA(1, 0, At, B0); PG8_BAR; PG8_SCHED;
            PG8_STAGE(PG8_SB(1, 1), b3 + hstep, voffB);
            PG8_WAIT_V(6); PG8_BAR; PG8_MMA(1, 1, At, B1); PG8_BAR;
            }
        }
        if constexpr (ALIGN_EPI) { if (wr == 0) PG8_BAR; }
        if constexpr (!Epi::AFTER_DRAIN) { E(acc, cur, wr, wc, fr, fq); S.done(cur); }
        if (!has_next) break;
#pragma unroll
        for (int a = 0; a < 2; ++a)
#pragma unroll
            for (int b = 0; b < 2; ++b)
#pragma unroll
                for (int m = 0; m < 4; ++m)
#pragma unroll
                    for (int n = 0; n < 2; ++n) acc[a][b][m][n] = (f32x4){0.f, 0.f, 0.f, 0.f};
        cur = nxt; cA = nA; cB = nB; ++ui; PG8_RCUR(cur);
        if constexpr (ALIGN_EPI) { if (wr == 1) PG8_BAR; }
    }
    PG8_WAIT_V(0);
    if constexpr (!ALIGN_EPI) { if (wr == 0) PG8_BAR; }
    PG8_BAR;
    if constexpr (Epi::AFTER_DRAIN) { E.fused(acc, cur, wr, wc, fr, fq, lds, wid, lane); S.done(cur); }
#undef PG8_SA
#undef PG8_SB
#undef PG8_STAGE
#undef PG8_LDA
#undef PG8_LDB
#undef PG8_MMA
#undef PG8_WAIT_V
#undef PG8_WAIT_L
#undef PG8_BAR
#undef PG8_SCHED
#undef PG8_PIECE_OFF
#undef PG8_RLOAD_P
#undef PG8_WAIT_V1P
#undef PG8_RADD_P
#undef PG8_KPAIR
#undef PG8_RCUR
}
}
constexpr int NWAVES = 8;
constexpr int NB = 8, SEQ = 4096, T = NB * SEQ, DM = 1024, DIN = 2824, DFF = 2816, NPROJ = 2816;
constexpr int SRC_MI = 2048;
constexpr int PC_MQ = 0, PC_MK = 512, PC_MV = 1024, PC_MO = 1536, PC_AQ = 2048, PC_AK = 2560, PC_AV = 2688;
constexpr float EPS = 1e-6f;
constexpr size_t MiB = 1u << 20;
constexpr size_t WS_CTL = 0, CTL_ZERO_BYTES = 32 * 1024;
constexpr size_t WS_WIN = 1 * MiB;
constexpr size_t WS_WOUT = 7 * MiB;
constexpr size_t WS_WGU = 9 * MiB;
constexpr size_t WS_WDN = 20 * MiB;
constexpr size_t WS_ROPE = 26 * MiB;
constexpr size_t WS_WBG = 26 * MiB + 512 * 1024;
constexpr size_t WS_GATES = 27 * MiB;
constexpr size_t WS_SSQ = 28 * MiB;
constexpr size_t WS_SEG = 30 * MiB;
constexpr size_t WS_XN = 48 * MiB;
constexpr size_t WS_MIX = 112 * MiB;
constexpr size_t WS_PROJ = 176 * MiB;
constexpr size_t WS_END = 352 * MiB;
constexpr int CW_BAR = 4096;
constexpr int RING_BYTES = 131072;
constexpr int LDSCTL_OFF = RING_BYTES, MISC_OFF = LDSCTL_OFF + 320;
constexpr int LDS_BYTES = 163840;

#define GAS __attribute__((address_space(1)))
#define LAS __attribute__((address_space(3)))
typedef unsigned short bf16;
typedef unsigned v4u __attribute__((ext_vector_type(4)));
typedef unsigned v2u __attribute__((ext_vector_type(2)));
typedef float f32x2v __attribute__((ext_vector_type(2)));
typedef float f32x4 __attribute__((ext_vector_type(4)));
typedef short bf16x8 __attribute__((ext_vector_type(8)));
typedef GAS unsigned gu32;
#define RLX_AGENT __ATOMIC_RELAXED, __HIP_MEMORY_SCOPE_AGENT
#define LDS_WAIT() asm volatile("s_waitcnt lgkmcnt(0)" ::: "memory")
#define VM_WAIT() asm volatile("s_waitcnt vmcnt(0)" ::: "memory")
__device__ __forceinline__ unsigned f2bf(float f) { unsigned u = __builtin_bit_cast(unsigned, f); return (u + 0x7fffu + ((u >> 16) & 1u)) >> 16; }
__device__ __forceinline__ unsigned pk2(float lo, float hi) { return f2bf(lo) | (f2bf(hi) << 16); }
__device__ __forceinline__ float bf2f(unsigned short b) { return __builtin_bit_cast(float, (unsigned)b << 16); }
__device__ __forceinline__ float bflo(unsigned w) { return __builtin_bit_cast(float, w << 16); }
__device__ __forceinline__ float bfhi(unsigned w) { return __builtin_bit_cast(float, w & 0xffff0000u); }
__device__ __forceinline__ float wave_sum(float v) {
#pragma unroll
    for (int o = 1; o < 64; o <<= 1) v += __shfl_xor(v, o);
    return v;
}
__device__ __forceinline__ float wave_max(float v) {
#pragma unroll
    for (int o = 1; o < 64; o <<= 1) v = fmaxf(v, __shfl_xor(v, o));
    return v;
}
__device__ __forceinline__ void unpack8(const v4u w, float* o) { o[0] = bflo(w.x); o[1] = bfhi(w.x); o[2] = bflo(w.y); o[3] = bfhi(w.y); o[4] = bflo(w.z); o[5] = bfhi(w.z); o[6] = bflo(w.w); o[7] = bfhi(w.w); }
__device__ __forceinline__ float red16_32_max(float v) {
    auto a = __builtin_amdgcn_permlane16_swap(__float_as_uint(v), __float_as_uint(v), false, false); v = fmaxf(__uint_as_float(a[0]), __uint_as_float(a[1]));
    auto b = __builtin_amdgcn_permlane32_swap(__float_as_uint(v), __float_as_uint(v), false, false); return fmaxf(__uint_as_float(b[0]), __uint_as_float(b[1])); }
__device__ __forceinline__ float red16_32_sum(float v) {
    auto a = __builtin_amdgcn_permlane16_swap(__float_as_uint(v), __float_as_uint(v), false, false); v = __uint_as_float(a[0]) + __uint_as_float(a[1]);
    auto b = __builtin_amdgcn_permlane32_swap(__float_as_uint(v), __float_as_uint(v), false, false); return __uint_as_float(b[0]) + __uint_as_float(b[1]); }
__device__ __forceinline__ float xor16_partner(float v) { const unsigned u = __float_as_uint(v); auto a = __builtin_amdgcn_permlane16_swap(u, u, false, false); return __uint_as_float(a[0] ^ a[1] ^ u); }
#define xor16_max 1
#define XB_TMO      128
#define XB_XCNT(j)  (256  + 64 * (j))
#define XB_XSUB(j)  (1280 + 64 * (j))
#define XB_XGEN(j)  (2304 + 64 * (j))
#define XB_TOP      3328
#define XB_TOPGEN   3392
#define XCD_BAR_WORDS 3456
#define XB_SPIN_CAP (1u << 18)

__device__ __forceinline__ unsigned xb_ld(unsigned* p)              { return __hip_atomic_load(p, __ATOMIC_RELAXED, __HIP_MEMORY_SCOPE_AGENT); }
__device__ __forceinline__ unsigned xb_add(unsigned* p, unsigned v) { return __hip_atomic_fetch_add(p, v, __ATOMIC_RELAXED, __HIP_MEMORY_SCOPE_AGENT); }
__device__ __forceinline__ unsigned xb_xcc_id() { return (unsigned)__builtin_amdgcn_s_getreg((3 << 11) | 20) & 0xFu; }
#define XB_SPIN(cond, bar) do { unsigned _sp = 0; while (cond) { __builtin_amdgcn_s_sleep(1); \
    if ((++_sp & 255u) == 0u) { if (xb_ld(&(bar)[XB_TMO])) break; if (_sp > XB_SPIN_CAP) { atomicAdd(&(bar)[XB_TMO], 1u); break; } } } } while (0)

struct XcdBarrier {
    unsigned* bar; unsigned x;
    volatile LAS unsigned* st;
};

__device__ __forceinline__ XcdBarrier xcd_barrier_post(unsigned* bar, volatile LAS unsigned* st) {
    XcdBarrier b; b.bar = bar; b.x = xb_xcc_id(); b.st = st;
    if (threadIdx.x == 0) (void)xb_add(&bar[XB_XCNT(b.x)], 1u);
    return b;
}
__device__ __forceinline__ void xcd_barrier_complete(unsigned* bar, unsigned x, unsigned& nloc, unsigned& nx) {
    const unsigned G = gridDim.x * gridDim.y * gridDim.z;
    unsigned sum, cnt, mine, sp = 0u;
    for (;;) {
        sum = 0u; cnt = 0u; mine = 0u;
#pragma unroll
        for (unsigned j = 0; j < 16; ++j) { const unsigned c = xb_ld(&bar[XB_XCNT(j)]); sum += c; cnt += (c > 0u) ? 1u : 0u; mine = (j == x) ? c : mine; }
        if (sum == G) break;
        __builtin_amdgcn_s_sleep(1);
        if ((++sp & 255u) == 0u) { if (xb_ld(&bar[XB_TMO])) break; if (sp > XB_SPIN_CAP) { atomicAdd(&bar[XB_TMO], 1u); break; } }
    }
    nloc = mine > 0u ? mine : 1u; nx = cnt > 0u ? cnt : 1u;
}

__device__ __forceinline__ void xcd_barrier(const XcdBarrier& b) {
    asm volatile("s_waitcnt vmcnt(0)" ::: "memory");
    __syncthreads();
    if (threadIdx.x == 0) {
        unsigned* bar = b.bar;
        __builtin_amdgcn_s_waitcnt(0);
        unsigned nloc = b.st[0], nx = b.st[1];
        if (nloc == 0u) { xcd_barrier_complete(bar, b.x, nloc, nx); b.st[0] = nloc; b.st[1] = nx; }
        const unsigned old = xb_add(&bar[XB_XSUB(b.x)], 1u);
        const unsigned gen = old / nloc;
        if (old + 1u == (gen + 1u) * nloc) {
            __builtin_amdgcn_fence(__ATOMIC_RELEASE, "agent");
            asm volatile("s_waitcnt vmcnt(0)" ::: "memory");
            const unsigned og = xb_add(&bar[XB_TOP], 1u);
            const unsigned tg = og / nx;
            if (og + 1u == (tg + 1u) * nx) xb_add(&bar[XB_TOPGEN], 1u);
            else XB_SPIN(xb_ld(&bar[XB_TOPGEN]) == tg, bar);
            __builtin_amdgcn_fence(__ATOMIC_ACQUIRE, "agent");
            xb_add(&bar[XB_XGEN(b.x)], 1u);
            asm volatile("s_waitcnt vmcnt(0)" ::: "memory");
        } else {
            XB_SPIN(xb_ld(&bar[XB_XGEN(b.x)]) == gen, bar);
            __builtin_amdgcn_fence(__ATOMIC_ACQUIRE, "agent");
            asm volatile("s_waitcnt vmcnt(0)" ::: "memory");
        }
    }
    __syncthreads();
}
#define H1_BF16 1
#ifndef P5_ALIGN
#define P5_ALIGN true
#endif
#define PHASE2_BODY do { mlstm_phase<1>(F); swa_phase(F); } while (0)
#define PHASE3_BODY mlstm_phase<2>(F)
#define LAUNCH_MK(lo_, hi_) do { a.ph_lo = (lo_); a.ph_hi = (hi_); a.li = (lo_); hipLaunchKernelGGL(mk_fwd, dim3(grid), dim3(NWAVES * 64), LDS_BYTES, stream, a); } while (0)
#define LAUNCH_PROGRAM { LAUNCH_MK(0, 7); }
struct Frame {
    LAS unsigned char* lds;
    volatile LAS unsigned* MISC;
    gu32* ctl;
    int tid, lane, wave, vcu, G;
    const float *x, *norm1_g, *w_in, *conv_w, *igate_b, *fgate_b, *mlstm_norm_g, *q_norm_g, *k_norm_g, *sinks, *w_out, *norm2_g, *w_gate, *w_up, *w_down;
    float* out;
    bf16 *Win_t, *Wout_t, *Wgu_t, *Wdn_t, *XN, *MIX, *PROJ;
    float2* ROPE; float* GATES; float* SSQ; float* SEG; unsigned char* WBG;
};

struct P0Item { const float* W; int ldw, src_col0; const float* kscale; bf16* WT; int Kd, dst_row0, kb; };
template <bool SCALE> __device__ __forceinline__ void p0_item_load(const P0Item& I, float (&v)[32], int lane) {
    const int k0 = 64 * I.kb;
#pragma unroll
    for (int i = 0; i < 32; ++i) { const int kk = 2 * i + (lane >> 5); v[i] = I.W[(size_t)(k0 + kk) * I.ldw + I.src_col0 + (lane & 31)]; }
    if (SCALE) {
        float sc[32];
#pragma unroll
        for (int i = 0; i < 32; ++i) sc[i] = I.kscale[k0 + 2 * i + (lane >> 5)];
#pragma unroll
        for (int i = 0; i < 32; ++i) v[i] *= sc[i];
    }
}
__device__ __forceinline__ void p0_item_finish(const P0Item& I, const float (&v)[32], LAS float* scr, int lane) {
    const int k0 = 64 * I.kb;
#pragma unroll
    for (int i = 0; i < 32; ++i) { const int kk = 2 * i + (lane >> 5); scr[kk * 33 + (lane & 31)] = v[i]; }
    LDS_WAIT(); asm volatile("" ::: "memory");
    const int c = lane & 7;
#pragma unroll
    for (int j = 0; j < 4; ++j) { const int n = (lane >> 3) + 8 * j; const LAS float* s = scr + (8 * c) * 33 + n;
        v4u o; o.x = pk2(s[0 * 33], s[1 * 33]); o.y = pk2(s[2 * 33], s[3 * 33]); o.z = pk2(s[4 * 33], s[5 * 33]); o.w = pk2(s[6 * 33], s[7 * 33]);
        *(GAS v4u*)(I.WT + (size_t)(I.dst_row0 + n) * I.Kd + k0 + 8 * c) = o; }
    LDS_WAIT(); asm volatile("" ::: "memory");
}
constexpr int I_IN = 88 * 16, I_OUT = 32 * 16, I_GU = 176 * 16, I_DN = 32 * 44;
__device__ __forceinline__ P0Item p0_item_in(Frame& F, int r) { const int nb = r % 88, kb = r / 88; return P0Item{F.w_in, DIN, nb < 64 ? 32 * nb : 32 * nb + 8, nullptr, F.Win_t, DM, 32 * nb, kb}; }
__device__ __forceinline__ P0Item p0_item_gu(Frame& F, int r) { const int nb = r % 176, kb = r / 176, tile = nb >> 3, wi = nb & 7; const float* W = (wi < 4) ? F.w_gate : F.w_up;
    return P0Item{W, DFF, 128 * tile + 32 * (wi & 3), F.norm2_g, F.Wgu_t, DM, 32 * nb, kb}; }
__device__ __forceinline__ P0Item p0_item_od(Frame& F, int r) {
    if (r < I_OUT) { const int nb = r % 32, kb = r / 32; return P0Item{F.w_out, DM, 32 * nb, nullptr, F.Wout_t, DM, 32 * nb, kb}; } r -= I_OUT;
    { const int nb = r % 32, kb = r / 32; return P0Item{F.w_down, DM, 32 * nb, nullptr, F.Wdn_t, DFF, 32 * nb, kb}; }
}
__device__ __forceinline__ void p0_prologue(Frame& F) {
    LAS float* scr = (LAS float*)(F.lds + F.wave * 8704);
    const int gw = F.vcu * NWAVES + F.wave, NGW = F.G * NWAVES;
    for (int it = gw; it < I_IN; it += NGW) { const P0Item I = p0_item_in(F, it); float v[32]; p0_item_load<false>(I, v, F.lane); p0_item_finish(I, v, scr, F.lane); }
    if (F.vcu < 4) { const int idx = F.vcu * 512 + F.tid; const int ks = idx >> 6, ln = idx & 63, col = ln & 15, gq = ln >> 4;
        v4u o = (v4u){0u, 0u, 0u, 0u};
        if (col < 8) { const float* wp = F.w_in + (size_t)(32 * ks + 8 * gq) * DIN + SRC_MI + col;
            const float w0 = wp[0], w1 = wp[DIN], w2 = wp[2 * DIN], w3 = wp[3 * DIN], w4 = wp[4 * DIN], w5 = wp[5 * DIN], w6 = wp[6 * DIN], w7 = wp[7 * DIN];
            o.x = pk2(w0, w1); o.y = pk2(w2, w3); o.z = pk2(w4, w5); o.w = pk2(w6, w7); }
        ((v4u*)F.WBG)[idx] = o; }
    { const int idx = (F.vcu * NWAVES * 64) + F.tid;
      if (idx < SEQ * 8) { const int pos = idx >> 3, i = idx & 7;
        double f = 1.0; f = (i == 1) ? 0.19392274474868576 : f; f = (i == 2) ? 0.03760603093086393 : f; f = (i == 3) ? 0.007292664737217109 : f; f = (i == 4) ? 0.001414213562373095 : f;
        f = (i == 5) ? 0.0002742481756762073 : f; f = (i == 6) ? 5.318295896944988e-05 : f; f = (i == 7) ? 1.031338537721246e-05 : f;
        const float angf = (float)pos * (float)f; const double rev = (double)angf * 0.15915494309189535; const double fr = rev - __builtin_floor(rev + 0.5);
        const float rr = (float)(fr * 6.283185307179586); F.ROPE[idx] = make_float2(__cosf(rr), __sinf(rr)); } }
    f32x4 g1[4];
#pragma unroll
    for (int j = 0; j < 4; ++j) g1[j] = ((const f32x4*)F.norm1_g)[F.lane + 64 * j];
    f32x4 v[4];
    if (gw < T) {
#pragma unroll
        for (int j = 0; j < 4; ++j) v[j] = ((const GAS f32x4*)(F.x + (size_t)gw * DM))[F.lane + 64 * j];
    }
#pragma unroll 1
    for (int m = gw; m < T; m += NGW) {
        f32x4 c[4]; float s = 0.f;
#pragma unroll
        for (int j = 0; j < 4; ++j) { c[j] = v[j]; s += (c[j].x * c[j].x + c[j].y * c[j].y) + (c[j].z * c[j].z + c[j].w * c[j].w); }
        if (m + NGW < T) {
#pragma unroll
            for (int j = 0; j < 4; ++j) v[j] = ((const GAS f32x4*)(F.x + (size_t)(m + NGW) * DM))[F.lane + 64 * j];
        }
        const float rstd = __builtin_amdgcn_rsqf(wave_sum(s) * (1.f / DM) + EPS);
        GAS v2u* o8 = (GAS v2u*)(F.XN + (size_t)m * DM) + F.lane;
#pragma unroll
        for (int j = 0; j < 4; ++j) { const f32x4 y = c[j] * rstd * g1[j]; v2u w; w.x = pg8::cvt_pk_bf16(y.x, y.y); w.y = pg8::cvt_pk_bf16(y.z, y.w); o8[64 * j] = w; }
    }
}
__device__ __forceinline__ void convert_gu(Frame& F, int ii, int ni) {
    LAS float* scr = (LAS float*)(F.lds + F.wave * 8704);
    __syncthreads();
    const int igw = ii * NWAVES + F.wave, NIW = ni * NWAVES;
#pragma unroll 1
    for (int it = igw; it < I_GU; it += 2 * NIW) {
        const P0Item Ia = p0_item_gu(F, it); const bool two = it + NIW < I_GU; const P0Item Ib = p0_item_gu(F, two ? it + NIW : it);
        float va[32], vb[32]; p0_item_load<true>(Ia, va, F.lane); p0_item_load<true>(Ib, vb, F.lane);
        p0_item_finish(Ia, va, scr, F.lane); if (two) p0_item_finish(Ib, vb, scr, F.lane);
    }
}
__device__ __forceinline__ void convert_od(Frame& F, int ii, int ni) {
    LAS float* scr = (LAS float*)(F.lds + F.wave * 8704);
    const int igw = ii * NWAVES + F.wave, NIW = ni * NWAVES;
#pragma unroll 1
    for (int it = igw; it < I_OUT + I_DN; it += 2 * NIW) {
        const P0Item Ia = p0_item_od(F, it); const bool two = it + NIW < I_OUT + I_DN; const P0Item Ib = p0_item_od(F, two ? it + NIW : it);
        float va[32], vb[32]; p0_item_load<false>(Ia, va, F.lane); p0_item_load<false>(Ib, vb, F.lane);
        p0_item_finish(Ia, va, scr, F.lane); if (two) p0_item_finish(Ib, vb, scr, F.lane);
    }
}
__device__ __forceinline__ void p1_side_work(Frame& F, int ii, int ni) {
    LAS unsigned char* WB = F.lds + 73728;
    for (int idx = F.tid; idx < 2048; idx += NWAVES * 64) *(LAS v4u*)(WB + idx * 16) = ((const v4u*)F.WBG)[idx];
    __syncthreads();
    convert_od(F, ii, ni);
    const int igw = ii * NWAVES + F.wave, NIW = ni * NWAVES;
    const int l15 = F.lane & 15, g = F.lane >> 4;
    for (int blk = igw; blk < T / 16; blk += NIW) {
        const bf16* xp = F.XN + ((size_t)blk * 16 + l15) * DM + 8 * g;
        f32x4 acc = (f32x4){0.f, 0.f, 0.f, 0.f};
        bf16x8 a[32];
#pragma unroll
        for (int q = 0; q < 32; ++q) a[q] = *(const bf16x8*)(xp + 32 * q);
#pragma unroll
        for (int q = 0; q < 32; ++q) acc = __builtin_amdgcn_mfma_f32_16x16x32_bf16(a[q], *(const LAS bf16x8*)(WB + (q * 64 + F.lane) * 16), acc, 0, 0, 0);
        if (l15 < 8) {
#pragma unroll
            for (int r = 0; r < 4; ++r) F.GATES[((size_t)blk * 16 + 4 * g + r) * 8 + l15] = acc[r];
        }
    }
}

constexpr int SWA_KS = 0, SWA_KSTR = 144, SWA_VT = 36864, SWA_VSTR = 528;
typedef short bf16x4 __attribute__((ext_vector_type(4)));
#ifndef SWA_UNROLL
#define SWA_UNROLL 1
#endif
constexpr int SWA_TAB = 70656;
struct SwaKV { v4u k[4], v[4]; float2 cs[8]; };
struct SwaQ { v4u w0, w1; float2 cs[8]; };
__device__ __forceinline__ void swa_load_kv(Frame& F, int tid, int u, SwaKV& R) {
    const int blk = u & 31, kvh = (u >> 5) & 1, b = u >> 6; const int key = tid >> 1, half = tid & 1; const int kt = blk * 128 - 128 + key;
    if (kt >= 0) {
        const bf16* kp = F.PROJ + (size_t)(b * SEQ + kt) * NPROJ + PC_AK + kvh * 64 + 32 * half;
        const bf16* vp = F.PROJ + (size_t)(b * SEQ + kt) * NPROJ + PC_AV + kvh * 64 + 32 * half;
#pragma unroll
        for (int c = 0; c < 4; ++c) { R.k[c] = *(const v4u*)(kp + 8 * c); R.v[c] = *(const v4u*)(vp + 8 * c); }
#pragma unroll
        for (int i = 0; i < 8; ++i) R.cs[i] = F.ROPE[kt * 8 + i];
    } else {
#pragma unroll
        for (int c = 0; c < 4; ++c) { R.k[c] = (v4u){0u, 0u, 0u, 0u}; R.v[c] = (v4u){0u, 0u, 0u, 0u}; }
#pragma unroll
        for (int i = 0; i < 8; ++i) R.cs[i] = make_float2(1.f, 0.f);
    }
}
__device__ __forceinline__ void swa_load_q(Frame& F, int lane, int wave, int u, int rb, SwaQ& R) {
    const int blk = u & 31, kvh = (u >> 5) & 1, b = u >> 6; const int l15 = lane & 15, g = lane >> 4;
    const int hq = kvh * 4 + (wave >> 1), p0 = 64 * (wave & 1) + 16 * rb, tq = blk * 128 + p0 + l15;
    const bf16* qp = F.PROJ + (size_t)(b * SEQ + tq) * NPROJ + PC_AQ + hq * 64 + 8 * g;
    R.w0 = *(const v4u*)qp; R.w1 = *(const v4u*)(qp + 32);
#pragma unroll
    for (int j = 0; j < 8; ++j) R.cs[j] = F.ROPE[tq * 8 + j];
}
__device__ __forceinline__ void swa_phase(Frame& F) {
    LAS unsigned char* KS = F.lds + SWA_KS; LAS unsigned char* VT = F.lds + SWA_VT; LAS float* TAB = (LAS float*)(F.lds + SWA_TAB);
    const int wave = F.wave;
    int u = F.vcu;
    if (u >= NB * 2 * 32) return;
    __syncthreads();
    if (F.tid < 64) TAB[F.tid] = F.q_norm_g[F.tid]; else if (F.tid < 128) TAB[F.tid] = F.k_norm_g[F.tid - 64];
    SwaKV kv; SwaQ qr;
    swa_load_kv(F, F.tid, u, kv);
    swa_load_q(F, F.lane, wave, u, 0, qr);
#pragma unroll 1
    for (; u < NB * 2 * 32; u += F.G) {
        int tid = F.tid; asm volatile("" : "+v"(tid));
        const int lane = tid & 63, l15 = lane & 15, g = lane >> 4;
        const int blk = u & 31, kvh = (u >> 5) & 1, b = u >> 6;
        const int un = u + F.G; const bool has_next = un < NB * 2 * 32;
        __syncthreads();
        {
            const int key = tid >> 1, half = tid & 1;
            float kf[32];
#pragma unroll
            for (int c = 0; c < 4; ++c) unpack8(kv.k[c], kf + 8 * c);
            float ss = 0.f;
#pragma unroll
            for (int c = 0; c < 32; ++c) ss += kf[c] * kf[c];
            ss += __shfl_xor(ss, 1);
            const float rstd = __builtin_amdgcn_rsqf(ss * (1.f / 64.f) + EPS);
#pragma unroll
            for (int c = 0; c < 8; ++c) { const f32x4 gg = *(const LAS f32x4*)(TAB + 64 + 32 * half + 4 * c); kf[4 * c] *= rstd * gg[0]; kf[4 * c + 1] *= rstd * gg[1]; kf[4 * c + 2] *= rstd * gg[2]; kf[4 * c + 3] *= rstd * gg[3]; }
            if (half == 0) {
#pragma unroll
                for (int i = 0; i < 8; ++i) { const float2 cs = kv.cs[i]; const float x1 = kf[i], x2 = kf[8 + i]; kf[i] = x1 * cs.x - x2 * cs.y; kf[8 + i] = x2 * cs.x + x1 * cs.y; }
            }
#pragma unroll
            for (int c = 0; c < 4; ++c) { v4u o; o.x = pg8::cvt_pk_bf16(kf[8 * c], kf[8 * c + 1]); o.y = pg8::cvt_pk_bf16(kf[8 * c + 2], kf[8 * c + 3]); o.z = pg8::cvt_pk_bf16(kf[8 * c + 4], kf[8 * c + 5]); o.w = pg8::cvt_pk_bf16(kf[8 * c + 6], kf[8 * c + 7]);
                *(LAS v4u*)(KS + key * SWA_KSTR + 64 * half + 16 * c) = o; }
#pragma unroll
            for (int c = 0; c < 4; ++c) { const unsigned ww[4] = {kv.v[c].x, kv.v[c].y, kv.v[c].z, kv.v[c].w};
#pragma unroll
                for (int e = 0; e < 4; ++e) { const int d = 32 * half + 8 * c + 2 * e;
                    *(LAS unsigned short*)(VT + d * SWA_VSTR + key * 2) = (unsigned short)(ww[e] & 0xffffu);
                    *(LAS unsigned short*)(VT + (d + 1) * SWA_VSTR + key * 2) = (unsigned short)(ww[e] >> 16); } }
        }
        __syncthreads();
        if (has_next) swa_load_kv(F, tid, un, kv);
        const int hq = kvh * 4 + (wave >> 1);
        const float sink2 = F.sinks[hq] * 1.4426950408889634f;
        const float SC = 0.125f * 1.4426950408889634f;
#pragma unroll 1
        for (int rb = 0; rb < 4; ++rb) {
            const int p0 = 64 * (wave & 1) + 16 * rb, j0 = p0 >> 4;
            const int tq = blk * 128 + p0 + l15;
            bf16x8 qf[2];
            {
                float q0[8], q1[8]; unpack8(qr.w0, q0); unpack8(qr.w1, q1);
                float ss = 0.f;
#pragma unroll
                for (int j = 0; j < 8; ++j) ss += q0[j] * q0[j] + q1[j] * q1[j];
                ss = red16_32_sum(ss);
                const float rstd = __builtin_amdgcn_rsqf(ss * (1.f / 64.f) + EPS);
#pragma unroll
                for (int c = 0; c < 2; ++c) { const f32x4 ga = *(const LAS f32x4*)(TAB + 8 * g + 4 * c), gb = *(const LAS f32x4*)(TAB + 32 + 8 * g + 4 * c);
#pragma unroll
                    for (int e = 0; e < 4; ++e) { q0[4 * c + e] *= rstd * ga[e]; q1[4 * c + e] *= rstd * gb[e]; } }
#pragma unroll
                for (int j = 0; j < 8; ++j) { const float other = xor16_partner(q0[j]); const float2 cs = qr.cs[j];
                    const float r0 = q0[j] * cs.x - other * cs.y, r1 = q0[j] * cs.x + other * cs.y; q0[j] = (g == 0) ? r0 : ((g == 1) ? r1 : q0[j]); }
                v4u a, c2; a.x = pg8::cvt_pk_bf16(q0[0], q0[1]); a.y = pg8::cvt_pk_bf16(q0[2], q0[3]); a.z = pg8::cvt_pk_bf16(q0[4], q0[5]); a.w = pg8::cvt_pk_bf16(q0[6], q0[7]);
                c2.x = pg8::cvt_pk_bf16(q1[0], q1[1]); c2.y = pg8::cvt_pk_bf16(q1[2], q1[3]); c2.z = pg8::cvt_pk_bf16(q1[4], q1[5]); c2.w = pg8::cvt_pk_bf16(q1[6], q1[7]);
                qf[0] = __builtin_bit_cast(bf16x8, a); qf[1] = __builtin_bit_cast(bf16x8, c2);
            }
            if (rb < 3) swa_load_q(F, lane, wave, u, rb + 1, qr); else if (has_next) swa_load_q(F, lane, wave, un, 0, qr);
            f32x4 s[10];
    #pragma unroll
            for (int jj = 0; jj < 9; ++jj) { const int tile = j0 + jj;
                f32x4 acc = (f32x4){0.f, 0.f, 0.f, 0.f};
    #pragma unroll
                for (int ks = 0; ks < 2; ++ks) { const bf16x8 kfr = *(const LAS bf16x8*)(KS + (16 * tile + l15) * SWA_KSTR + 64 * ks + 16 * g);
                    acc = __builtin_amdgcn_mfma_f32_16x16x32_bf16(kfr, qf[ks], acc, 0, 0, 0); }
                s[jj] = acc; }
            s[9] = (f32x4){0.f, 0.f, 0.f, 0.f};
    #pragma unroll
            for (int r = 0; r < 4; ++r) { if (4 * g + r < 1 + l15) s[0][r] = -INFINITY; if (4 * g + r > l15) s[8][r] = -INFINITY; }
            if (blk == 0) {
    #pragma unroll
                for (int jj = 0; jj < 9; ++jj)
    #pragma unroll
                    for (int r = 0; r < 4; ++r) { if (16 * (j0 + jj) + 4 * g + r < 128) s[jj][r] = -INFINITY; }
            }
            float mx = -INFINITY;
    #pragma unroll
            for (int jj = 0; jj < 9; ++jj)
    #pragma unroll
                for (int r = 0; r < 4; ++r) mx = fmaxf(mx, s[jj][r]);
            mx = red16_32_max(mx); mx = fmaxf(mx * SC, sink2);
            float sum = 0.f;
    #pragma unroll
            for (int jj = 0; jj < 9; ++jj)
    #pragma unroll
                for (int r = 0; r < 4; ++r) { const float p = __builtin_amdgcn_exp2f(__builtin_fmaf(s[jj][r], SC, -mx)); s[jj][r] = p; sum += p; }
            sum = red16_32_sum(sum);
            const float inv = 1.0f / (sum + __builtin_amdgcn_exp2f(sink2 - mx));
            f32x4 o[4];
    #pragma unroll
            for (int dt = 0; dt < 4; ++dt) o[dt] = (f32x4){0.f, 0.f, 0.f, 0.f};
    #pragma unroll
            for (int kk = 0; kk < 5; ++kk) {
                const int t0 = (j0 + 2 * kk) > 15 ? 15 : (j0 + 2 * kk), t1 = (j0 + 2 * kk + 1) > 15 ? 15 : (j0 + 2 * kk + 1);
                v4u pw; pw.x = pg8::cvt_pk_bf16(s[2 * kk][0], s[2 * kk][1]); pw.y = pg8::cvt_pk_bf16(s[2 * kk][2], s[2 * kk][3]); pw.z = pg8::cvt_pk_bf16(s[2 * kk + 1][0], s[2 * kk + 1][1]); pw.w = pg8::cvt_pk_bf16(s[2 * kk + 1][2], s[2 * kk + 1][3]);
                const bf16x8 pf = __builtin_bit_cast(bf16x8, pw);
    #pragma unroll
                for (int dt = 0; dt < 4; ++dt) {
                    const v2u a0 = *(const LAS v2u*)(VT + (16 * dt + l15) * SWA_VSTR + (16 * t0 + 4 * g) * 2);
                    const v2u a1 = *(const LAS v2u*)(VT + (16 * dt + l15) * SWA_VSTR + (16 * t1 + 4 * g) * 2);
                    v4u av; av.x = a0.x; av.y = a0.y; av.z = a1.x; av.w = a1.y;
                    o[dt] = __builtin_amdgcn_mfma_f32_16x16x32_bf16(__builtin_bit_cast(bf16x8, av), pf, o[dt], 0, 0, 0); }
            }
            bf16* op = F.MIX + (size_t)(b * SEQ + tq) * DM + 512 + hq * 64 + 4 * g;
    #pragma unroll
            for (int dt = 0; dt < 4; ++dt) { v2u w; w.x = pg8::cvt_pk_bf16(o[dt][0] * inv, o[dt][1] * inv); w.y = pg8::cvt_pk_bf16(o[dt][2] * inv, o[dt][3] * inv); *(v2u*)(op + 16 * dt) = w; }
        }
    }
}
constexpr int ML_QS = 0, ML_KS = 17408, ML_KWT = 34816, ML_VT = 53248, ML_PS = 71680, ML_CT = 80896, ML_F = 115712;
constexpr int ML_QSTR = 272, ML_TSTR = 144, ML_HSTR = 528;
constexpr int FDEN = 256, FN = 320;
constexpr int ML_GV = 132096, ML_GS = ML_GV + 8192, ML_CW = ML_GS + 256;
constexpr int SEG_STRIDE = 16640;
constexpr float LOG2E = 1.4426950408889634f;
__device__ __forceinline__ float silu_f(float v) { return v * __builtin_amdgcn_rcpf(1.0f + __builtin_amdgcn_exp2f(v * -LOG2E)); }
__device__ __forceinline__ float sigmoid_f(float v) { return __builtin_amdgcn_rcpf(1.0f + __builtin_amdgcn_exp2f(v * -LOG2E)); }
__device__ __forceinline__ float exp_f(float v) { return __builtin_amdgcn_exp2f(v * LOG2E); }

template <int PASS> __device__ __forceinline__ void mlstm_item(Frame& F, int b, int h, int sg) {
    const int wave = F.wave;
    int tid = F.tid; asm volatile("" : "+v"(tid));
    int lane = tid & 63, l15 = lane & 15, g4 = lane >> 4;
    LAS unsigned char* L = F.lds; LAS float* FL = (LAS float*)(L + ML_F);
    f32x4 C[8];
#pragma unroll
    for (int et = 0; et < 8; ++et) C[et] = (f32x4){0.f, 0.f, 0.f, 0.f};
    float m = -1e30f, Gsum = 0.f;
    LAS float* GV = (LAS float*)(L + ML_GV); LAS float* GS = (LAS float*)(L + ML_GS); LAS float* CW = (LAS float*)(L + ML_CW);
    __syncthreads();
    if (tid < 128) FL[FN + tid] = 0.f;
    for (int i = tid; i < 1024; i += NWAVES * 64) { const int j = i >> 8, ch = i & 255; CW[i] = F.conv_w[j * 1024 + (ch >> 7) * 512 + h * 128 + (ch & 127)]; }
    {
        const size_t tg = (size_t)b * SEQ + (size_t)(sg * 8 + wave) * 64 + lane;
        const float* gr = F.GATES + tg * 8;
        const float ig = gr[h] + F.igate_b[h], fg = gr[4 + h] + F.fgate_b[h];
        const float lf = fminf(fg, 0.f) - log1pf(__expf(-fabsf(fg)));
        float bs = lf;
#pragma unroll
        for (int o = 1; o < 64; o <<= 1) { const float t = __shfl_up(bs, o); if (lane >= o) bs += t; }
        const float gtot = __shfl(bs, 63);
        const float u = ig - bs;
        float pm = u;
#pragma unroll
        for (int o = 1; o < 64; o <<= 1) { const float t = __shfl_up(pm, o); if (lane >= o) pm = fmaxf(pm, t); }
        const float a = gtot + u;
        const float mloc = wave_max(a);
        GV[wave * 256 + lane] = bs; GV[wave * 256 + 64 + lane] = u; GV[wave * 256 + 128 + lane] = exp_f(a - mloc); GV[wave * 256 + 192 + lane] = pm;
        if (lane == 0) { GS[wave * 2] = gtot; GS[wave * 2 + 1] = mloc; }
    }
    if (PASS == 2 && sg > 0) {
        const float* E0 = F.SEG + (size_t)((b * 4 + h) * 8) * SEG_STRIDE;
        float lw[7]; float sfx = 0.f, mfin = -1e30f;
#pragma unroll
        for (int j = 6; j >= 0; --j) { const int jc = (j < sg) ? j : 0; const float mE = E0[(size_t)jc * SEG_STRIDE + 16384 + 128], G = E0[(size_t)jc * SEG_STRIDE + 16384 + 129];
            lw[j] = (j < sg) ? (mE + sfx) : -1e30f; sfx += (j < sg) ? G : 0.f; mfin = fmaxf(mfin, lw[j]); }
        float coef[7];
#pragma unroll
        for (int j = 0; j < 7; ++j) coef[j] = (j < sg) ? exp_f(lw[j] - mfin) : 0.f;
#pragma unroll 1
        for (int j = 0; j < sg; ++j) { const float* Ej = E0 + (size_t)j * SEG_STRIDE; float cj = coef[0];
#pragma unroll
            for (int q = 1; q < 7; ++q) cj = (j == q) ? coef[q] : cj;
#pragma unroll
            for (int et = 0; et < 8; ++et) C[et] += ((const f32x4*)Ej)[(unsigned)((et * 8 + wave) * 64 + lane)] * cj;
            if (tid < 128) FL[FN + tid] += cj * Ej[16384 + tid]; }
        m = mfin;
    }
    if (PASS == 2) {
#pragma unroll
        for (int et = 0; et < 8; ++et) { v2u w; w.x = pg8::cvt_pk_bf16(C[et][0], C[et][1]); w.y = pg8::cvt_pk_bf16(C[et][2], C[et][3]); *(LAS v2u*)(L + ML_CT + (16 * et + l15) * ML_QSTR + (16 * wave + 4 * g4) * 2) = w; }
    }
    const float kscale = 0.08838834764831845f;
    v4u xr[7]; v4u vr[4];
#define ML_LOAD(cidx) do { const int c_ = (cidx); const size_t t0_ = (size_t)b * SEQ + (size_t)c_ * 64; \
        const int mat_ = tid >> 8, r8_ = tid & 255, dg_ = r8_ & 15, l0_ = 4 * (r8_ >> 4); \
        if (PASS == 2 || mat_ == 1) { const bf16* src_ = F.PROJ + (mat_ ? PC_MK : PC_MQ) + h * 128 + 8 * dg_; \
            _Pragma("unroll") for (int j = 0; j < 7; ++j) { const int lr = l0_ + j - 3; xr[j] = (c_ == 0 && lr < 0) ? (v4u){0u, 0u, 0u, 0u} : *(const v4u*)(src_ + (t0_ + lr) * NPROJ); } } \
        if (mat_ == 0) { _Pragma("unroll") for (int lp = 0; lp < 4; ++lp) vr[lp] = *(const v4u*)(F.PROJ + (t0_ + l0_ + lp) * NPROJ + PC_MV + h * 128 + 8 * dg_); } } while (0)
    ML_LOAD(sg * 8);
#pragma unroll 1
    for (int cc = 0; cc < 8; ++cc) {
        const int c = sg * 8 + cc; const size_t t0 = (size_t)b * SEQ + (size_t)c * 64;
        tid = F.tid; asm volatile("" : "+v"(tid));
        lane = tid & 63; l15 = lane & 15; g4 = lane >> 4;
        const int mat = tid >> 8, r8 = tid & 255, dg = r8 & 15, rg = r8 >> 4, l0 = 4 * rg;
        const int tsw = (((rg >> 1) ^ (dg & 7)) << 4) + ((rg & 1) << 3);
        LAS float* GB = GV + cc * 256;
        __syncthreads();
        const float gtot = GS[cc * 2], mloc = GS[cc * 2 + 1];
        if (PASS == 2 || mat == 1) {
            const float w0 = GB[128 + l0], w1 = GB[128 + l0 + 1], w2 = GB[128 + l0 + 2], w3 = GB[128 + l0 + 3];
            unsigned ow[4][4];
            const LAS float* cwp = CW + mat * 128 + 8 * dg;
#pragma unroll
            for (int ip = 0; ip < 4; ++ip) {
                const f32x2v c0 = *(const LAS f32x2v*)(cwp + 2 * ip), c1 = *(const LAS f32x2v*)(cwp + 256 + 2 * ip), c2 = *(const LAS f32x2v*)(cwp + 512 + 2 * ip), c3 = *(const LAS f32x2v*)(cwp + 768 + 2 * ip);
                f32x2v x2[7];
#pragma unroll
                for (int j = 0; j < 7; ++j) { const unsigned w = (ip == 0) ? xr[j].x : (ip == 1) ? xr[j].y : (ip == 2) ? xr[j].z : xr[j].w; x2[j] = (f32x2v){bflo(w), bfhi(w)}; }
                f32x2v y2[4];
#pragma unroll
                for (int lp = 0; lp < 4; ++lp) { const f32x2v t = c0 * x2[lp] + c1 * x2[lp + 1] + c2 * x2[lp + 2] + c3 * x2[lp + 3];
                    const f32x2v e = t * (-LOG2E); f32x2v d; d.x = __builtin_amdgcn_exp2f(e.x); d.y = __builtin_amdgcn_exp2f(e.y); d = d + 1.0f;
                    f32x2v r; r.x = __builtin_amdgcn_rcpf(d.x); r.y = __builtin_amdgcn_rcpf(d.y);
                    y2[lp] = t * r * (mat ? kscale : 1.0f);
                    ow[lp][ip] = pg8::cvt_pk_bf16(y2[lp].x, y2[lp].y); }
                if (mat == 1) {
                    const f32x2v s0 = y2[0] * w0, s1 = y2[1] * w1, s2 = y2[2] * w2, s3 = y2[3] * w3;
                    v2u o; o.x = pg8::cvt_pk_bf16(s0.x, s1.x); o.y = pg8::cvt_pk_bf16(s2.x, s3.x); *(LAS v2u*)(L + ML_KWT + (8 * dg + 2 * ip) * ML_TSTR + tsw) = o;
                    o.x = pg8::cvt_pk_bf16(s0.y, s1.y); o.y = pg8::cvt_pk_bf16(s2.y, s3.y); *(LAS v2u*)(L + ML_KWT + (8 * dg + 2 * ip + 1) * ML_TSTR + tsw) = o; }
            }
            if (PASS == 2) {
                LAS unsigned char* dst = L + (mat ? ML_KS : ML_QS) + l0 * ML_QSTR + 16 * dg;
#pragma unroll
                for (int lp = 0; lp < 4; ++lp) { v4u o; o.x = ow[lp][0]; o.y = ow[lp][1]; o.z = ow[lp][2]; o.w = ow[lp][3]; *(LAS v4u*)(dst + lp * ML_QSTR) = o; }
            }
        }
        if (mat == 0) {
            const unsigned ww[4][4] = {{vr[0].x, vr[0].y, vr[0].z, vr[0].w}, {vr[1].x, vr[1].y, vr[1].z, vr[1].w}, {vr[2].x, vr[2].y, vr[2].z, vr[2].w}, {vr[3].x, vr[3].y, vr[3].z, vr[3].w}};
#pragma unroll
            for (int p = 0; p < 4; ++p) {
                v2u lo, hi;
                lo.x = (ww[0][p] & 0xffffu) | (ww[1][p] << 16); lo.y = (ww[2][p] & 0xffffu) | (ww[3][p] << 16);
                hi.x = (ww[0][p] >> 16) | (ww[1][p] & 0xffff0000u); hi.y = (ww[2][p] >> 16) | (ww[3][p] & 0xffff0000u);
                *(LAS v2u*)(L + ML_VT + (8 * dg + 2 * p) * ML_TSTR + tsw) = lo;
                *(LAS v2u*)(L + ML_VT + (8 * dg + 2 * p + 1) * ML_TSTR + tsw) = hi; }
        }
        __syncthreads();
        if (cc < 7) ML_LOAD(c + 1);
        v4u mo2[2];
        if (PASS == 2) {
#pragma unroll
            for (int it = 0; it < 2; ++it) mo2[it] = *(const v4u*)(F.PROJ + (t0 + 8 * wave + 4 * it + g4) * NPROJ + PC_MO + h * 128 + 8 * l15);
        }
        const float mn = fmaxf(gtot + m, mloc), so = exp_f(gtot + m - mn), sn = exp_f(mloc - mn);
        if (PASS == 2) {
            const int lt = wave >> 1;
#pragma unroll
            for (int si = 0; si < 2; ++si) { const int st = 2 * (wave & 1) + si;
                v2u pw = (v2u){0u, 0u};
                if (st <= lt) {
                    f32x4 acc = (f32x4){0.f, 0.f, 0.f, 0.f};
#pragma unroll
                    for (int ks = 0; ks < 4; ++ks) { const bf16x8 a = *(const LAS bf16x8*)(L + ML_KS + (16 * st + l15) * ML_QSTR + 64 * ks + 16 * g4);
                        const bf16x8 bb = *(const LAS bf16x8*)(L + ML_QS + (16 * lt + l15) * ML_QSTR + 64 * ks + 16 * g4);
                        acc = __builtin_amdgcn_mfma_f32_16x16x32_bf16(a, bb, acc, 0, 0, 0); }
                    const int l = 16 * lt + l15, s0 = 16 * st + 4 * g4; const float bl = GB[l]; const float e0 = bl - (bl + fmaxf(GB[192 + l], m));
                    const f32x4 us = *(const LAS f32x4*)(GB + 64 + s0);
                    float p[4];
#pragma unroll
                    for (int r = 0; r < 4; ++r) { const float e = __builtin_amdgcn_exp2f((e0 + us[r]) * LOG2E); p[r] = (s0 + r <= l) ? acc[r] * e : 0.f; }
                    pw.x = pg8::cvt_pk_bf16(p[0], p[1]); pw.y = pg8::cvt_pk_bf16(p[2], p[3]);
                }
                *(LAS v2u*)(L + ML_PS + (16 * lt + l15) * ML_TSTR + (16 * st + 4 * g4) * 2) = pw;
            }
            __syncthreads();
            {
                const int row = 8 * wave + (lane >> 3), part = lane & 7;
                const v4u pw = *(const LAS v4u*)(L + ML_PS + row * ML_TSTR + 16 * part);
                float pf[8]; unpack8(pw, pf);
                float sp = ((pf[0] + pf[1]) + (pf[2] + pf[3])) + ((pf[4] + pf[5]) + (pf[6] + pf[7]));
                const v4u q0 = *(const LAS v4u*)(L + ML_QS + row * ML_QSTR + 32 * part), q1 = *(const LAS v4u*)(L + ML_QS + row * ML_QSTR + 32 * part + 16);
                float qf[16]; unpack8(q0, qf); unpack8(q1, qf + 8);
                float qn = 0.f;
#pragma unroll
                for (int i = 0; i < 16; ++i) qn += qf[i] * FL[FN + 16 * part + i];
                const float bl = GB[row]; const float mrow = bl + fmaxf(GB[192 + row], m); const float sc = exp_f(bl + m - mrow);
                float tot = sp + sc * qn;
                tot += __shfl_xor(tot, 1); tot += __shfl_xor(tot, 2); tot += __shfl_xor(tot, 4);
                if (part == 0) FL[FDEN + row] = fmaxf(fabsf(tot), exp_f(-mrow));
            }
            const int eh = wave & 1;
            f32x4 o1[4], o2[4];
#pragma unroll
            for (int ei = 0; ei < 4; ++ei) { const int et = 4 * eh + ei;
                f32x4 a1 = (f32x4){0.f, 0.f, 0.f, 0.f}, a2 = (f32x4){0.f, 0.f, 0.f, 0.f};
#pragma unroll
                for (int ks = 0; ks < 2; ++ks) { const bf16x8 a = *(const LAS bf16x8*)(L + ML_VT + (16 * et + l15) * ML_TSTR + (((4 * ks + g4) ^ ((2 * et + (l15 >> 3)) & 7)) << 4));
                    const bf16x8 bb = *(const LAS bf16x8*)(L + ML_PS + (16 * lt + l15) * ML_TSTR + 64 * ks + 16 * g4);
                    a1 = __builtin_amdgcn_mfma_f32_16x16x32_bf16(a, bb, a1, 0, 0, 0); }
#pragma unroll
                for (int ks = 0; ks < 4; ++ks) { const bf16x8 a = *(const LAS bf16x8*)(L + ML_CT + (16 * et + l15) * ML_QSTR + 64 * ks + 16 * g4);
                    const bf16x8 bb = *(const LAS bf16x8*)(L + ML_QS + (16 * lt + l15) * ML_QSTR + 64 * ks + 16 * g4);
                    a2 = __builtin_amdgcn_mfma_f32_16x16x32_bf16(a, bb, a2, 0, 0, 0); }
                o1[ei] = a1; o2[ei] = a2; }
            __syncthreads();
            {
                const int l = 16 * lt + l15; const float bl = GB[l]; const float mrow = bl + fmaxf(GB[192 + l], m); const float sc = exp_f(bl + m - mrow);
                const float inv = 1.0f / FL[FDEN + l];
#pragma unroll
                for (int ei = 0; ei < 4; ++ei) { const int et = 4 * eh + ei; const f32x4 hv = (o1[ei] + o2[ei] * sc) * inv;
                    *(LAS f32x4*)(L + l * ML_HSTR + (16 * et + 4 * g4) * 4) = hv; }
            }
        }
        {
            bf16x8 af[2];
#pragma unroll
            for (int ks = 0; ks < 2; ++ks) af[ks] = *(const LAS bf16x8*)(L + ML_KWT + (16 * wave + l15) * ML_TSTR + (((4 * ks + g4) ^ ((2 * wave + (l15 >> 3)) & 7)) << 4));
#pragma unroll
            for (int et = 0; et < 8; ++et) { f32x4 d = (f32x4){0.f, 0.f, 0.f, 0.f};
#pragma unroll
                for (int ks = 0; ks < 2; ++ks) { const bf16x8 bb = *(const LAS bf16x8*)(L + ML_VT + (16 * et + l15) * ML_TSTR + (((4 * ks + g4) ^ ((2 * et + (l15 >> 3)) & 7)) << 4));
                    d = __builtin_amdgcn_mfma_f32_16x16x32_bf16(af[ks], bb, d, 0, 0, 0); }
                C[et] = C[et] * so + d * sn; }
            if (tid < 128) { float dn = 0.f;
#pragma unroll
                for (int q = 0; q < 8; ++q) { const v4u w = *(const LAS v4u*)(L + ML_KWT + tid * ML_TSTR + 16 * q); float f[8]; unpack8(w, f); dn += ((f[0] + f[1]) + (f[2] + f[3])) + ((f[4] + f[5]) + (f[6] + f[7])); }
                FL[FN + tid] = so * FL[FN + tid] + sn * dn; }
            m = mn; Gsum += gtot;
            if (PASS == 2) {
#pragma unroll
                for (int et = 0; et < 8; ++et) { v2u w; w.x = pg8::cvt_pk_bf16(C[et][0], C[et][1]); w.y = pg8::cvt_pk_bf16(C[et][2], C[et][3]); *(LAS v2u*)(L + ML_CT + (16 * et + l15) * ML_QSTR + (16 * wave + 4 * g4) * 2) = w; }
            }
        }
        if (PASS == 2) {
            __syncthreads();
            const f32x4 gg0 = *(const f32x4*)(F.mlstm_norm_g + h * 128 + 8 * l15), gg1 = *(const f32x4*)(F.mlstm_norm_g + h * 128 + 8 * l15 + 4);
#pragma unroll
            for (int it = 0; it < 2; ++it) { const int l = 8 * wave + 4 * it + g4;
                const f32x4 h0 = *(const LAS f32x4*)(L + l * ML_HSTR + l15 * 32), h1 = *(const LAS f32x4*)(L + l * ML_HSTR + l15 * 32 + 16);
                float ss = (h0[0] * h0[0] + h0[1] * h0[1]) + (h0[2] * h0[2] + h0[3] * h0[3]) + (h1[0] * h1[0] + h1[1] * h1[1]) + (h1[2] * h1[2] + h1[3] * h1[3]);
                ss += __shfl_xor(ss, 1); ss += __shfl_xor(ss, 2); ss += __shfl_xor(ss, 4); ss += __shfl_xor(ss, 8);
                const float rstd = __builtin_amdgcn_rsqf(ss * (1.f / 128.f) + EPS);
                float mo[8]; unpack8(mo2[it], mo);
                const f32x4 y0 = h0 * gg0 * rstd, y1 = h1 * gg1 * rstd;
                v4u o; o.x = pg8::cvt_pk_bf16(y0[0] * sigmoid_f(mo[0]), y0[1] * sigmoid_f(mo[1])); o.y = pg8::cvt_pk_bf16(y0[2] * sigmoid_f(mo[2]), y0[3] * sigmoid_f(mo[3]));
                o.z = pg8::cvt_pk_bf16(y1[0] * sigmoid_f(mo[4]), y1[1] * sigmoid_f(mo[5])); o.w = pg8::cvt_pk_bf16(y1[2] * sigmoid_f(mo[6]), y1[3] * sigmoid_f(mo[7]));
                *(v4u*)(F.MIX + (t0 + l) * DM + h * 128 + 8 * l15) = o; }
        }
    }
    if (PASS == 1) {
        tid = F.tid; asm volatile("" : "+v"(tid)); lane = tid & 63; l15 = lane & 15; g4 = lane >> 4;
        float* E = F.SEG + (size_t)((b * 4 + h) * 8 + sg) * SEG_STRIDE;
#pragma unroll
        for (int et = 0; et < 8; ++et) ((f32x4*)E)[(et * 8 + wave) * 64 + lane] = C[et];
        if (tid < 128) E[16384 + tid] = FL[FN + tid];
        if (tid == 0) { E[16384 + 128] = m; E[16384 + 129] = Gsum; }
    }
}
template <int PASS> __device__ __forceinline__ void mlstm_phase(Frame& F) {
    for (int it = F.vcu; it < NB * 4 * 8; it += F.G) { const int sg = it & 7, h = (it >> 3) & 3, b = it >> 5;
        if (PASS == 1 && sg == 7) { convert_gu(F, it >> 3, NB * 4); continue; }
        mlstm_item<PASS>(F, b, h, sg); }
}
struct Args { const float* in[15]; float* out; unsigned char* ws; int ph_lo, ph_hi, li, pad; };
__global__ void __launch_bounds__(NWAVES * 64, 2) mk_fwd(Args args) {
    extern __shared__ __attribute__((aligned(16))) unsigned char lds[];
    Frame F;
    F.lds = (LAS unsigned char*)lds;
    F.MISC = (volatile LAS unsigned*)(F.lds + MISC_OFF);
    F.tid = threadIdx.x; F.lane = F.tid & 63; F.wave = __builtin_amdgcn_readfirstlane(F.tid >> 6);
    F.G = gridDim.x; { const int bx = blockIdx.x; F.vcu = (F.G % 8 == 0) ? (bx % 8) * (F.G / 8) + bx / 8 : bx; }
    unsigned char* ws = args.ws;
    F.ctl = (gu32*)(ws + WS_CTL);
    F.x = args.in[0]; F.norm1_g = args.in[1]; F.w_in = args.in[2]; F.conv_w = args.in[3]; F.igate_b = args.in[4]; F.fgate_b = args.in[5]; F.mlstm_norm_g = args.in[6];
    F.q_norm_g = args.in[7]; F.k_norm_g = args.in[8]; F.sinks = args.in[9]; F.w_out = args.in[10]; F.norm2_g = args.in[11]; F.w_gate = args.in[12]; F.w_up = args.in[13]; F.w_down = args.in[14];
    F.out = args.out;
    F.Win_t = (bf16*)(ws + WS_WIN); F.Wout_t = (bf16*)(ws + WS_WOUT); F.Wgu_t = (bf16*)(ws + WS_WGU); F.Wdn_t = (bf16*)(ws + WS_WDN);
    F.XN = (bf16*)(ws + WS_XN); F.MIX = (bf16*)(ws + WS_MIX); F.PROJ = (bf16*)(ws + WS_PROJ);
    F.ROPE = (float2*)(ws + WS_ROPE); F.GATES = (float*)(ws + WS_GATES); F.SSQ = (float*)(ws + WS_SSQ); F.SEG = (float*)(ws + WS_SEG); F.WBG = ws + WS_WBG;
    for (int u = F.tid; u < (LDS_BYTES - LDSCTL_OFF) / 4; u += NWAVES * 64) ((LAS unsigned*)(F.lds + LDSCTL_OFF))[u] = 0u;
    __syncthreads();
    const int lo = args.ph_lo, hi = args.ph_hi;
    XcdBarrier bar; bar.bar = (unsigned*)(F.ctl + CW_BAR) + args.li * XCD_BAR_WORDS; bar.x = 0; bar.st = nullptr;
    if (hi - lo > 1) bar = xcd_barrier_post((unsigned*)(F.ctl + CW_BAR) + args.li * XCD_BAR_WORDS, F.MISC + 8);
#define IN(k) (lo <= (k) && (k) < hi)
#define BOTH(k) (IN(k) && IN((k) + 1))
#define GRID_BAR() xcd_barrier(bar)

#ifndef DOUBLE_PHASE
#define DOUBLE_PHASE -1
#endif
#define RUN_PHASE(k, BODY) if (IN(k)) { { int t_ = threadIdx.x; asm volatile("" : "+v"(t_)); F.tid = t_; F.lane = t_ & 63; }     \
    BODY; if (DOUBLE_PHASE == (k)) { GRID_BAR(); BODY; } if (BOTH(k)) GRID_BAR(); }
#define PH0 p0_prologue(F)
#define PH1 do { pg8::Gemm g{F.XN, F.Win_t, T, NPROJ, DM}; pg8::StaticOrder S; S.init(T, NPROJ, F.G, (int)blockIdx.x); pg8::EpiStoreBf16 E{F.PROJ, NPROJ}; \
        pg8::gemm_phase<pg8::EpiStoreBf16, pg8::StaticOrder, true, true>(F.lds, g, S, E); \
        { const int nwg_ = (T / 256) * (NPROJ / 256), rem_ = nwg_ % F.G;               \
          if (rem_ == 0) p1_side_work(F, (int)blockIdx.x, F.G); else if ((int)blockIdx.x >= rem_) p1_side_work(F, (int)blockIdx.x - rem_, F.G - rem_); } } while (0)
#ifdef H1_BF16
#define PH4 do { pg8::Gemm g{F.MIX, F.Wout_t, T, DM, DM}; pg8::StaticOrder S; S.init(T, DM, F.G, (int)blockIdx.x); pg8::EpiResidNormBS E{F.x, F.XN, F.SSQ}; \
        pg8::gemm_phase<pg8::EpiResidNormBS, pg8::StaticOrder, true, true>(F.lds, g, S, E); } while (0)
#define PH6 do { pg8::Gemm g{F.PROJ, F.Wdn_t, T, DM, DFF}; pg8::StaticOrder S; S.init(T, DM, F.G, (int)blockIdx.x); pg8::EpiResidOutB E{F.XN, F.out}; \
        pg8::gemm_phase<pg8::EpiResidOutB, pg8::StaticOrder, true, true>(F.lds, g, S, E); } while (0)
#else
#define PH4 do { pg8::Gemm g{F.MIX, F.Wout_t, T, DM, DM}; pg8::StaticOrder S; S.init(T, DM, F.G, (int)blockIdx.x); pg8::EpiResidNorm E{F.x, F.out, F.XN, F.SSQ}; \
        pg8::gemm_phase<pg8::EpiResidNorm, pg8::StaticOrder, true, true>(F.lds, g, S, E); } while (0)
#define PH6 do { pg8::Gemm g{F.PROJ, F.Wdn_t, T, DM, DFF}; pg8::StaticOrder S; S.init(T, DM, F.G, (int)blockIdx.x); pg8::EpiResidOut E{F.out, F.out}; \
        pg8::gemm_phase<pg8::EpiResidOut, pg8::StaticOrder, true, true>(F.lds, g, S, E); } while (0)
#endif
#define PH5 do { pg8::Gemm g{F.XN, F.Wgu_t, T, 2 * DFF, DM}; pg8::StaticOrder S; S.init(T, 2 * DFF, F.G, (int)blockIdx.x); pg8::EpiSwiGLU E{F.PROJ, DFF, F.SSQ, EPS}; \
        pg8::gemm_phase<pg8::EpiSwiGLU, pg8::StaticOrder, P5_ALIGN, true>(F.lds, g, S, E); } while (0)
    RUN_PHASE(0, PH0)
    RUN_PHASE(1, PH1)
    RUN_PHASE(2, PHASE2_BODY)
    RUN_PHASE(3, PHASE3_BODY)
    RUN_PHASE(4, PH4)
    RUN_PHASE(5, PH5)
    RUN_PHASE(6, PH6)
#undef IN
#undef BOTH
}
extern "C" void kernel_launch(void* const* d_in, const int* in_sizes, int n_in, void* d_out, int out_size, void* d_ws, size_t ws_size, hipStream_t stream) {
    static int grid = 0;
    if (grid == 0) {
        if (n_in != 15 || in_sizes[0] != T * DM || out_size != T * DM || ws_size < WS_END) { fprintf(stderr, "kernel_launch: unexpected shapes / workspace (n_in %d, ws %zu)\n", n_in, ws_size); grid = -1; return; }
        int dev = 0, cus = 0, per_cu = 0;
        if (hipGetDevice(&dev) != hipSuccess || hipDeviceGetAttribute(&cus, hipDeviceAttributeMultiprocessorCount, dev) != hipSuccess) { grid = -1; return; }
        if (hipFuncSetAttribute((const void*)mk_fwd, hipFuncAttributeMaxDynamicSharedMemorySize, LDS_BYTES) != hipSuccess) { fprintf(stderr, "kernel_launch: hipFuncSetAttribute failed\n"); grid = -1; return; }
        if (hipOccupancyMaxActiveBlocksPerMultiprocessor(&per_cu, (const void*)mk_fwd, NWAVES * 64, LDS_BYTES) != hipSuccess || per_cu < 1) { fprintf(stderr, "kernel_launch: occupancy query says %d blocks per CU\n", per_cu); grid = -1; (void)hipGetLastError(); return; }
        grid = cus;
    }
    if (grid < 0) return;
    (void)hipMemsetAsync((char*)d_ws + WS_CTL, 0, CTL_ZERO_BYTES, stream);
    Args a{};
    for (int i = 0; i < 15; ++i) a.in[i] = (const float*)d_in[i];
    a.out = (float*)d_out; a.ws = (unsigned char*)d_ws;
    LAUNCH_PROGRAM
}
```

```cpp
#include <hip/hip_runtime.h>
#include <cstdio>
#include <cstdint>
__device__ __forceinline__ int fresh_lane() { return (int)__builtin_amdgcn_mbcnt_hi(~0u, __builtin_amdgcn_mbcnt_lo(~0u, 0u)); }
namespace pg8 {
#define PG8_LAS __attribute__((address_space(3)))
typedef unsigned short bf16_t;
typedef short bf16x8 __attribute__((ext_vector_type(8)));
typedef float f32x4 __attribute__((ext_vector_type(4)));
typedef unsigned u32x4 __attribute__((ext_vector_type(4)));
constexpr int BM = 256, BK = 64, HALF = 128, HTB = HALF * BK * 2  , STAGE_BYTES = 8 * HTB, NXCD = 8, WGM = 8;

__host__ __device__ __forceinline__ int lds_byte(int r, int c) { const int st = (r >> 4) * 2 + (c >> 5), rr = r & 15, cc = c & 31, ob = rr * 64 + cc * 2; return st * 1024 + (ob ^ (((ob >> 9) & 1) << 5)); }
__host__ __device__ __forceinline__ void stage_rc(int b, int& R, int& C) { const int st = b / 1024, sb = b % 1024, swz = sb ^ (((sb >> 9) & 1) << 5); R = (st >> 1) * 16 + swz / 64; C = (st & 1) * 32 + (swz % 64) / 2; }
__host__ __device__ __forceinline__ int perm32(int rho) { const int n = rho >> 4, i = rho & 15; return 8 * (i >> 2) + 4 * n + (i & 3); }

struct Unit { int pm, pn; };
struct Gemm { const bf16_t* A; const bf16_t* Bt; int M, N, K; };

struct StaticOrder {
    int nM, nN, nwg, G, c;
    __host__ __device__ void init(int M, int N, int G_, int c_) { nM = M / BM; nN = N / BM; nwg = nM * nN; G = G_; c = c_; }
    __host__ __device__ bool next(int i, Unit& u) const {
        const long L = (long)i * G + c; if (L >= nwg) return false;
        int wgid = (int)L; { const int q = nwg / NXCD, r = nwg % NXCD, xcd = wgid % NXCD, off = wgid / NXCD; wgid = (xcd < r ? xcd * (q + 1) : r * (q + 1) + (xcd - r) * q) + off; }
        const int nig = WGM * nN, gid = wgid / nig, fm = gid * WGM, gsz = (nM - fm) < WGM ? (nM - fm) : WGM;
        u.pm = fm + ((wgid % nig) % gsz); u.pn = (wgid % nig) / gsz; return true;
    }
    __device__ __forceinline__ void a_ready(const Unit&) const {}
    __device__ __forceinline__ void done(const Unit&) const {}
};

__device__ __forceinline__ unsigned cvt_pk_bf16(float lo, float hi) { unsigned r; asm volatile("v_cvt_pk_bf16_f32 %0, %1, %2" : "=v"(r) : "v"(lo), "v"(hi)); return r; }
typedef float f32x2 __attribute__((ext_vector_type(2)));
#ifdef WT_STORES
__device__ __forceinline__ void st16(void* p, u32x4 v) { asm volatile("global_store_dwordx4 %0, %1, off sc1\n\ts_nop 1" :: "v"(p), "v"(v) : "memory"); }
#else
__device__ __forceinline__ void st16(void* p, u32x4 v) { *(u32x4*)p = v; }
#endif
__device__ __forceinline__ float fast_silu(float v) { return v * __builtin_amdgcn_rcpf(1.0f + __builtin_amdgcn_exp2f(v * -1.4426950408889634f)); }
struct EpiStoreBf16 {
    static constexpr bool PERM = true, AFTER_DRAIN = false, STREAM_R = false, STREAM_BF16 = false;
    bf16_t* O; int ldc;
    __device__ __forceinline__ void operator()(const f32x4 (&acc)[2][2][4][2], const Unit& u, int wr, int wc, int fr, int fq) const {
        const int row0 = u.pm * BM + wr * 64 + fr, col0 = u.pn * BM + wc * 32 + 8 * fq;
#pragma unroll
        for (int ai = 0; ai < 2; ++ai)
#pragma unroll
            for (int m = 0; m < 4; ++m) { bf16_t* rowp = O + (size_t)(row0 + ai * HALF + m * 16) * ldc + col0;
#pragma unroll
                for (int bj = 0; bj < 2; ++bj) { const f32x4 v0 = acc[ai][bj][m][0], v1 = acc[ai][bj][m][1];
                    u32x4 w; w.x = cvt_pk_bf16(v0[0], v0[1]); w.y = cvt_pk_bf16(v0[2], v0[3]); w.z = cvt_pk_bf16(v1[0], v1[1]); w.w = cvt_pk_bf16(v1[2], v1[3]);
                    st16(rowp + bj * HALF, w); } }
    }
};
struct EpiResidNorm {
    static constexpr bool PERM = true, AFTER_DRAIN = false, STREAM_R = false, STREAM_BF16 = false;
    const float* X; float* H; bf16_t* HB; float* SSQ;
    __device__ __forceinline__ void operator()(const f32x4 (&acc)[2][2][4][2], const Unit& u, int wr, int wc, int fr, int fq) const {
        const int row0 = u.pm * BM + wr * 64 + fr, col0 = u.pn * BM + wc * 32 + 8 * fq;
#pragma unroll
        for (int ai = 0; ai < 2; ++ai)
#pragma unroll
            for (int m = 0; m < 4; ++m) { const int row = row0 + ai * HALF + m * 16; const size_t off = (size_t)row * 1024 + col0; float ss = 0.f;
#pragma unroll
                for (int bj = 0; bj < 2; ++bj) { const f32x4 x0 = *(const f32x4*)(X + off + bj * HALF), x1 = *(const f32x4*)(X + off + bj * HALF + 4);
                    const f32x4 v0 = x0 + acc[ai][bj][m][0], v1 = x1 + acc[ai][bj][m][1];
                    *(f32x4*)(H + off + bj * HALF) = v0; *(f32x4*)(H + off + bj * HALF + 4) = v1;
                    u32x4 w; w.x = cvt_pk_bf16(v0[0], v0[1]); w.y = cvt_pk_bf16(v0[2], v0[3]); w.z = cvt_pk_bf16(v1[0], v1[1]); w.w = cvt_pk_bf16(v1[2], v1[3]);
                    *(u32x4*)(HB + off + bj * HALF) = w;
                    ss += (v0[0] * v0[0] + v0[1] * v0[1]) + (v0[2] * v0[2] + v0[3] * v0[3]) + (v1[0] * v1[0] + v1[1] * v1[1]) + (v1[2] * v1[2] + v1[3] * v1[3]); }
                ss += __shfl_xor(ss, 16); ss += __shfl_xor(ss, 32);
                if (fq == 0) SSQ[(size_t)row * 16 + u.pn * 4 + wc] = ss; }
    }
};
struct EpiSwiGLU {
    static constexpr bool PERM = true, AFTER_DRAIN = false, STREAM_R = false, STREAM_BF16 = false;
    bf16_t* O; int ldc; const float* SSQ; float eps;
    __device__ __forceinline__ void operator()(const f32x4 (&acc)[2][2][4][2], const Unit& u, int wr, int wc, int fr, int fq) const {
        const int row0 = u.pm * BM + wr * 64 + fr, col0 = u.pn * HALF + wc * 32 + 8 * fq;
        f32x4 sv[4];
        { const f32x4* sp = (const f32x4*)(SSQ + (size_t)row0 * 16); sv[0] = sp[0]; sv[1] = sp[1]; sv[2] = sp[2]; sv[3] = sp[3]; }
#pragma unroll
        for (int grp = 0; grp < 8; ++grp) { const int ai = grp >> 2, m = grp & 3; const int row = row0 + ai * HALF + m * 16;
            const f32x4 t = (sv[0] + sv[1]) + (sv[2] + sv[3]);
            const float rs = __builtin_amdgcn_rsqf(((t[0] + t[1]) + (t[2] + t[3])) * (1.0f / 1024.0f) + eps);
            if (grp < 7) { const int rown = row0 + ((grp + 1) >> 2) * HALF + ((grp + 1) & 3) * 16; const f32x4* sp = (const f32x4*)(SSQ + (size_t)rown * 16); sv[0] = sp[0]; sv[1] = sp[1]; sv[2] = sp[2]; sv[3] = sp[3]; }
            float h[8];
#pragma unroll
            for (int n = 0; n < 2; ++n)
#pragma unroll
                for (int j = 0; j < 4; ++j) { const float g = acc[ai][0][m][n][j] * rs, up = acc[ai][1][m][n][j] * rs; h[n * 4 + j] = fast_silu(g) * up; }
            u32x4 w; w.x = cvt_pk_bf16(h[0], h[1]); w.y = cvt_pk_bf16(h[2], h[3]); w.z = cvt_pk_bf16(h[4], h[5]); w.w = cvt_pk_bf16(h[6], h[7]);
            st16(O + (size_t)row * ldc + col0, w); }
    }
};
struct EpiResidOut {
    static constexpr bool PERM = true, AFTER_DRAIN = false, STREAM_R = false, STREAM_BF16 = false;
    const float* R; float* OUT;
    __device__ __forceinline__ void operator()(const f32x4 (&acc)[2][2][4][2], const Unit& u, int wr, int wc, int fr, int fq) const {
        const int row0 = u.pm * BM + wr * 64 + fr, col0 = u.pn * BM + wc * 32 + 8 * fq;
#pragma unroll
        for (int ai = 0; ai < 2; ++ai)
#pragma unroll
            for (int m = 0; m < 4; ++m) { const size_t off = (size_t)(row0 + ai * HALF + m * 16) * 1024 + col0;
#pragma unroll
                for (int bj = 0; bj < 2; ++bj) { const f32x4 r0 = *(const f32x4*)(R + off + bj * HALF), r1 = *(const f32x4*)(R + off + bj * HALF + 4);
                    *(f32x4*)(OUT + off + bj * HALF) = r0 + acc[ai][bj][m][0]; *(f32x4*)(OUT + off + bj * HALF + 4) = r1 + acc[ai][bj][m][1]; } }
    }
};
struct EpiResidNormB {
    static constexpr bool PERM = true, AFTER_DRAIN = false, STREAM_R = false, STREAM_BF16 = false;
    const float* X; bf16_t* HB; float* SSQ;
    __device__ __forceinline__ void operator()(const f32x4 (&acc)[2][2][4][2], const Unit& u, int wr, int wc, int fr, int fq) const {
        const int row0 = u.pm * BM + wr * 64 + fr, col0 = u.pn * BM + wc * 32 + 8 * fq;
#pragma unroll
        for (int ai = 0; ai < 2; ++ai)
#pragma unroll
            for (int m = 0; m < 4; ++m) { const int row = row0 + ai * HALF + m * 16; const size_t off = (size_t)row * 1024 + col0; float ss = 0.f;
#pragma unroll
                for (int bj = 0; bj < 2; ++bj) { const f32x4 x0 = *(const f32x4*)(X + off + bj * HALF), x1 = *(const f32x4*)(X + off + bj * HALF + 4);
                    const f32x4 v0 = x0 + acc[ai][bj][m][0], v1 = x1 + acc[ai][bj][m][1];
                    u32x4 w; w.x = cvt_pk_bf16(v0[0], v0[1]); w.y = cvt_pk_bf16(v0[2], v0[3]); w.z = cvt_pk_bf16(v1[0], v1[1]); w.w = cvt_pk_bf16(v1[2], v1[3]);
                    *(u32x4*)(HB + off + bj * HALF) = w;
                    ss += (v0[0] * v0[0] + v0[1] * v0[1]) + (v0[2] * v0[2] + v0[3] * v0[3]) + (v1[0] * v1[0] + v1[1] * v1[1]) + (v1[2] * v1[2] + v1[3] * v1[3]); }
                ss += __shfl_xor(ss, 16); ss += __shfl_xor(ss, 32);
                if (fq == 0) SSQ[(size_t)row * 16 + u.pn * 4 + wc] = ss; }
    }
};
struct EpiResidOutB {
    static constexpr bool PERM = true, AFTER_DRAIN = false, STREAM_R = false, STREAM_BF16 = false;
    const bf16_t* RB; float* OUT;
    __device__ __forceinline__ void operator()(const f32x4 (&acc)[2][2][4][2], const Unit& u, int wr, int wc, int fr, int fq) const {
        const int row0 = u.pm * BM + wr * 64 + fr, col0 = u.pn * BM + wc * 32 + 8 * fq;
#pragma unroll
        for (int ai = 0; ai < 2; ++ai) {
            u32x4 rw[4][2];
#pragma unroll
            for (int m = 0; m < 4; ++m) { const size_t off = (size_t)(row0 + ai * HALF + m * 16) * 1024 + col0;
#pragma unroll
                for (int bj = 0; bj < 2; ++bj) rw[m][bj] = *(const u32x4*)(RB + off + bj * HALF); }
#pragma unroll
            for (int m = 0; m < 4; ++m) { const size_t off = (size_t)(row0 + ai * HALF + m * 16) * 1024 + col0;
#pragma unroll
                for (int bj = 0; bj < 2; ++bj) { const u32x4 w = rw[m][bj];
                    const f32x4 r0 = (f32x4){__builtin_bit_cast(float, w.x << 16), __builtin_bit_cast(float, w.x & 0xffff0000u), __builtin_bit_cast(float, w.y << 16), __builtin_bit_cast(float, w.y & 0xffff0000u)};
                    const f32x4 r1 = (f32x4){__builtin_bit_cast(float, w.z << 16), __builtin_bit_cast(float, w.z & 0xffff0000u), __builtin_bit_cast(float, w.w << 16), __builtin_bit_cast(float, w.w & 0xffff0000u)};
                    *(f32x4*)(OUT + off + bj * HALF) = r0 + acc[ai][bj][m][0]; *(f32x4*)(OUT + off + bj * HALF + 4) = r1 + acc[ai][bj][m][1]; } }
            asm volatile("" ::: "memory");
        }
    }
};
struct EpiResidNormBS {
    static constexpr bool PERM = true, AFTER_DRAIN = false, STREAM_R = true, STREAM_BF16 = false;
    const float* RS; bf16_t* HB; float* SSQ;
    __device__ __forceinline__ void operator()(const f32x4 (&acc)[2][2][4][2], const Unit& u, int wr, int wc, int fr, int fq) const {
        { int t_ = threadIdx.x; asm volatile("" : "+v"(t_)); fr = t_ & 15; fq = (t_ >> 4) & 3; }
        const int row0 = u.pm * BM + wr * 64 + fr, col0 = u.pn * BM + wc * 32 + 8 * fq;
#pragma unroll
        for (int ai = 0; ai < 2; ++ai)
#pragma unroll
            for (int m = 0; m < 4; ++m) { const int row = row0 + ai * HALF + m * 16; const size_t off = (size_t)row * 1024 + col0; float ss = 0.f;
#pragma unroll
                for (int bj = 0; bj < 2; ++bj) { const f32x4 v0 = acc[ai][bj][m][0], v1 = acc[ai][bj][m][1];
                    u32x4 w; w.x = cvt_pk_bf16(v0[0], v0[1]); w.y = cvt_pk_bf16(v0[2], v0[3]); w.z = cvt_pk_bf16(v1[0], v1[1]); w.w = cvt_pk_bf16(v1[2], v1[3]);
                    st16(HB + off + bj * HALF, w);
                    ss += (v0[0] * v0[0] + v0[1] * v0[1]) + (v0[2] * v0[2] + v0[3] * v0[3]) + (v1[0] * v1[0] + v1[1] * v1[1]) + (v1[2] * v1[2] + v1[3] * v1[3]); }
                ss += __shfl_xor(ss, 16); ss += __shfl_xor(ss, 32);
                if (fq == 0) SSQ[(size_t)row * 16 + u.pn * 4 + wc] = ss; }
    }
};
struct EpiResidOutBS {
    static constexpr bool PERM = true, AFTER_DRAIN = false, STREAM_R = true, STREAM_BF16 = true;
    const bf16_t* RS; float* OUT;
    __device__ __forceinline__ void operator()(const f32x4 (&acc)[2][2][4][2], const Unit& u, int wr, int wc, int fr, int fq) const {
        { int t_ = threadIdx.x; asm volatile("" : "+v"(t_)); fr = t_ & 15; fq = (t_ >> 4) & 3; }
        const int row0 = u.pm * BM + wr * 64 + fr, col0 = u.pn * BM + wc * 32 + 8 * fq;
#pragma unroll
        for (int ai = 0; ai < 2; ++ai)
#pragma unroll
            for (int m = 0; m < 4; ++m) { const size_t off = (size_t)(row0 + ai * HALF + m * 16) * 1024 + col0;
#pragma unroll
                for (int bj = 0; bj < 2; ++bj) { *(f32x4*)(OUT + off + bj * HALF) = acc[ai][bj][m][0]; *(f32x4*)(OUT + off + bj * HALF + 4) = acc[ai][bj][m][1]; } }
    }
};
template <class Epi, class Sched, bool ALIGN_EPI = false, bool SP2 = false>
__device__ __forceinline__ void gemm_phase(PG8_LAS unsigned char* lds, const Gemm g, const Sched& S, const Epi& E) {
    const int tid = threadIdx.x, wid = __builtin_amdgcn_readfirstlane(tid >> 6), lane = tid & 63, wr = wid >> 2, wc = wid & 3, fr = lane & 15, fq = lane >> 4;
    const int K = g.K, nt = K / BK;
    unsigned voffA[2], voffB[2];
#pragma unroll
    for (int i = 0; i < 2; ++i) { int R, C; stage_rc(tid * 16 + i * 8192, R, C); const int Rb = Epi::PERM ? ((R & ~31) + perm32(R & 31)) : R;
        voffA[i] = (unsigned)(R * K + C) * 2u; voffB[i] = (unsigned)(Rb * K + C) * 2u; }
    const size_t kstep = (size_t)(BK * 2);
    const size_t hstep = (size_t)HALF * K * 2;
    const size_t tstep = 2 * hstep;
    const unsigned ldsw = (unsigned)wid * 1024u;
    const int aoff = lds_byte(wr * 64 + fr, fq * 8), boff = lds_byte(wc * 32 + fr, fq * 8);
#define PG8_SA(b, h) (((b) * 2 + (h)) * HTB)
#define PG8_SB(b, h) ((4 + (b) * 2 + (h)) * HTB)
#define PG8_STAGE(bufoff, gbase, voff) do { _Pragma("unroll") for (int _i = 0; _i < 2; ++_i) \
        __builtin_amdgcn_global_load_lds((const unsigned*)((const char*)(gbase) + (voff)[_i]), (PG8_LAS unsigned*)(lds + (bufoff) + ldsw + _i * 8192), 16, 0, 0); } while (0)
#define PG8_LDA(dst, b, h) do { _Pragma("unroll") for (int m = 0; m < 4; ++m) _Pragma("unroll") for (int k = 0; k < 2; ++k) dst[m][k] = *(const PG8_LAS bf16x8*)(lds + PG8_SA(b, h) + aoff + m * 2048 + k * 1024); } while (0)
#define PG8_LDB(dst, b, h) do { _Pragma("unroll") for (int n = 0; n < 2; ++n) _Pragma("unroll") for (int k = 0; k < 2; ++k) dst[n][k] = *(const PG8_LAS bf16x8*)(lds + PG8_SB(b, h) + boff + n * 2048 + k * 1024); } while (0)
#define PG8_MMA(ai, bj, At, Bt) do { __builtin_amdgcn_s_setprio(1); _Pragma("unroll") for (int m = 0; m < 4; ++m) _Pragma("unroll") for (int n = 0; n < 2; ++n) _Pragma("unroll") for (int k = 0; k < 2; ++k) \
        acc[ai][bj][m][n] = __builtin_amdgcn_mfma_f32_16x16x32_bf16(Bt[n][k], At[m][k], acc[ai][bj][m][n], 0, 0, 0); __builtin_amdgcn_s_setprio(0); } while (0)
#define PG8_WAIT_V(n) asm volatile("s_waitcnt vmcnt(" #n ")" ::: "memory")
#define PG8_WAIT_L(n) asm volatile("s_waitcnt lgkmcnt(" #n ")" ::: "memory")
#define PG8_BAR __builtin_amdgcn_s_barrier()
#define PG8_SCHED __builtin_amdgcn_sched_barrier(0)
#define PG8_PIECE_OFF 147456
#define PG8_RLOAD_P(p) do { if constexpr (Epi::STREAM_BF16) { const char* pa_ = rcur + (size_t)((((((p) >> 3) & 1) * HALF + (((p) >> 1) & 3) * 16) * 1024 + ((p) & 1) * HALF) * 2) + (rvoff >> 1); \
            __builtin_amdgcn_global_load_lds((const unsigned*)pa_, (PG8_LAS unsigned*)(lds + PG8_PIECE_OFF + wid * 2048), 16, 0, 0); \
        } else { const char* pa_ = rcur + (size_t)((((((p) >> 3) & 1) * HALF + (((p) >> 1) & 3) * 16) * 1024 + ((p) & 1) * HALF) * 4) + rvoff; \
            __builtin_amdgcn_global_load_lds((const unsigned*)pa_, (PG8_LAS unsigned*)(lds + PG8_PIECE_OFF + wid * 2048), 16, 0, 0); \
            __builtin_amdgcn_global_load_lds((const unsigned*)(pa_ + 16), (PG8_LAS unsigned*)(lds + PG8_PIECE_OFF + wid * 2048 + 1024), 16, 0, 0); } } while (0)
#define PG8_RADD_P(p) do { if constexpr (Epi::STREAM_BF16) { typedef unsigned u32x2_ __attribute__((ext_vector_type(2))); \
            { const u32x2_ w_ = *(const PG8_LAS u32x2_*)(lds + PG8_PIECE_OFF + wid * 2048 + lane * 16); \
              acc[((p) >> 3) & 1][(p) & 1][((p) >> 1) & 3][0] += (f32x4){__builtin_bit_cast(float, w_.x << 16), __builtin_bit_cast(float, w_.x & 0xffff0000u), __builtin_bit_cast(float, w_.y << 16), __builtin_bit_cast(float, w_.y & 0xffff0000u)}; } \
            asm volatile("" ::: "memory"); \
            { const u32x2_ w_ = *(const PG8_LAS u32x2_*)(lds + PG8_PIECE_OFF + wid * 2048 + lane * 16 + 8); \
              acc[((p) >> 3) & 1][(p) & 1][((p) >> 1) & 3][1] += (f32x4){__builtin_bit_cast(float, w_.x << 16), __builtin_bit_cast(float, w_.x & 0xffff0000u), __builtin_bit_cast(float, w_.y << 16), __builtin_bit_cast(float, w_.y & 0xffff0000u)}; } \
        } else { { const f32x4 q0_ = *(const PG8_LAS f32x4*)(lds + PG8_PIECE_OFF + wid * 2048 + lane * 16); acc[((p) >> 3) & 1][(p) & 1][((p) >> 1) & 3][0] += q0_; } asm volatile("" ::: "memory"); \
        { const f32x4 q1_ = *(const PG8_LAS f32x4*)(lds + PG8_PIECE_OFF + wid * 2048 + 1024 + lane * 16); acc[((p) >> 3) & 1][(p) & 1][((p) >> 1) & 3][1] += q1_; } } } while (0)
#define PG8_WAIT_V1P() do { if constexpr (Epi::STREAM_BF16) PG8_WAIT_V(9); else PG8_WAIT_V(10); } while (0)
#define PG8_KPAIR(t, P0_, P1_) do { \
            const bool last = ((t) == nt - 2); \
            const char* a1 = cA + (size_t)((t) + 1) * kstep; \
            const char* a2 = last ? nA : cA + (size_t)((t) + 2) * kstep; const char* b2 = last ? nB : cB + (size_t)((t) + 2) * kstep; \
            const char* a3 = a2 + kstep; const char* b3 = b2 + kstep; \
            if (last && has_next) S.a_ready(nxt); \
            if constexpr ((P0_) >= 0) PG8_RLOAD_P(P0_); \
            PG8_LDB(B0, 0, 0); PG8_LDB(B1, 0, 1); PG8_SCHED; PG8_LDA(At, 0, 0); PG8_STAGE(PG8_SA(1, 1), a1 + hstep, voffA); \
            if constexpr ((P0_) >= 0) PG8_WAIT_V1P(); else PG8_WAIT_V(8); \
            PG8_WAIT_L(0); PG8_BAR; PG8_MMA(0, 0, At, B0); PG8_MMA(0, 1, At, B1); PG8_BAR; PG8_SCHED; \
            PG8_LDA(At, 0, 1); PG8_STAGE(PG8_SB(0, 0), b2, voffB); PG8_STAGE(PG8_SB(0, 1), b2 + hstep, voffB); PG8_STAGE(PG8_SA(0, 0), a2, voffA); \
            PG8_WAIT_V(8); PG8_WAIT_L(0); PG8_BAR; if constexpr ((P0_) >= 0) PG8_RADD_P(P0_); PG8_MMA(1, 0, At, B0); PG8_MMA(1, 1, At, B1); PG8_BAR; PG8_SCHED; \
            if constexpr ((P1_) >= 0) PG8_RLOAD_P(P1_); \
            PG8_LDB(B0, 1, 0); PG8_LDB(B1, 1, 1); PG8_SCHED; PG8_LDA(At, 1, 0); PG8_STAGE(PG8_SA(0, 1), a2 + hstep, voffA); \
            if constexpr ((P1_) >= 0) PG8_WAIT_V1P(); else PG8_WAIT_V(8); \
            PG8_WAIT_L(0); PG8_BAR; PG8_MMA(0, 0, At, B0); PG8_MMA(0, 1, At, B1); PG8_BAR; PG8_SCHED; \
            PG8_LDA(At, 1, 1); PG8_STAGE(PG8_SB(1, 0), b3, voffB); PG8_STAGE(PG8_SB(1, 1), b3 + hstep, voffB); PG8_STAGE(PG8_SA(1, 0), a3, voffA); \
            PG8_WAIT_V(8); PG8_WAIT_L(0); PG8_BAR; if constexpr ((P1_) >= 0) PG8_RADD_P(P1_); PG8_MMA(1, 0, At, B0); PG8_MMA(1, 1, At, B1); PG8_BAR; PG8_SCHED; \
        } while (0)
    Unit cur, nxt; int ui = 0;
    if (!S.next(0, cur)) return;
    f32x4 acc[2][2][4][2];
#pragma unroll
    for (int a = 0; a < 2; ++a)
#pragma unroll
        for (int b = 0; b < 2; ++b)
#pragma unroll
            for (int m = 0; m < 4; ++m)
#pragma unroll
                for (int n = 0; n < 2; ++n) acc[a][b][m][n] = (f32x4){0.f, 0.f, 0.f, 0.f};
    bf16x8 At[4][2], B0[2][2], B1[2][2];
    const char* rcur = nullptr;
    const unsigned rvoff = (unsigned)(((wr * 64 + fr) * 1024 + wc * 32 + 8 * fq) * 4);
#define PG8_RCUR(u_) do { if constexpr (Epi::STREAM_R) rcur = (const char*)E.RS + ((size_t)((u_).pm * BM) * 1024 + (u_).pn * BM) * (Epi::STREAM_BF16 ? 2 : 4); } while (0)
    PG8_RCUR(cur);
    const char* cA = (const char*)g.A + (size_t)cur.pm * tstep; const char* cB = (const char*)g.Bt + (size_t)cur.pn * tstep;
    S.a_ready(cur);
    if constexpr (SP2) {
        PG8_STAGE(PG8_SB(0, 0), cB, voffB); PG8_STAGE(PG8_SB(0, 1), cB + hstep, voffB); PG8_STAGE(PG8_SA(0, 0), cA, voffA); PG8_STAGE(PG8_SA(0, 1), cA + hstep, voffA);
        if (wr == 1) PG8_BAR;
        PG8_WAIT_V(2); PG8_BAR;
        PG8_STAGE(PG8_SB(1, 0), cB + kstep, voffB); PG8_STAGE(PG8_SA(1, 0), cA + kstep, voffA); PG8_STAGE(PG8_SB(1, 1), cB + hstep + kstep, voffB);
        PG8_WAIT_V(6); PG8_BAR;
    } else {
        PG8_STAGE(PG8_SB(0, 0), cB, voffB); PG8_STAGE(PG8_SA(0, 0), cA, voffA); PG8_STAGE(PG8_SB(0, 1), cB + hstep, voffB); PG8_STAGE(PG8_SA(0, 1), cA + hstep, voffA);
        if (wr == 1) PG8_BAR;
        PG8_WAIT_V(4); PG8_BAR;
        PG8_STAGE(PG8_SB(1, 0), cB + kstep, voffB); PG8_STAGE(PG8_SA(1, 0), cA + kstep, voffA); PG8_STAGE(PG8_SB(1, 1), cB + hstep + kstep, voffB);
        PG8_WAIT_V(6); PG8_BAR;
    }
    for (;;) {
        const bool has_next = S.next(ui + 1, nxt);
        const char* nA = has_next ? (const char*)g.A + (size_t)nxt.pm * tstep : cA; const char* nB = has_next ? (const char*)g.Bt + (size_t)nxt.pn * tstep : cB;
        if constexpr (SP2 && Epi::STREAM_R) {
            PG8_KPAIR(0, 0, 1); PG8_KPAIR(2, 2, 3); PG8_KPAIR(4, 4, 5); PG8_KPAIR(6, 6, 7); PG8_KPAIR(8, 8, 9); PG8_KPAIR(10, 10, 11); PG8_KPAIR(12, 12, 13); PG8_KPAIR(14, 14, 15);
#pragma unroll 1
            for (int t = 16; t < nt; t += 2) PG8_KPAIR(t, -1, -1);
        } else
        for (int t = 0; t < nt; t += 2) {
            const bool last = (t == nt - 2);
            const char* a1 = cA + (size_t)(t + 1) * kstep;
            const char* a2 = last ? nA : cA + (size_t)(t + 2) * kstep; const char* b2 = last ? nB : cB + (size_t)(t + 2) * kstep;
            const char* a3 = a2 + kstep; const char* b3 = b2 + kstep;
            if (last && has_next) S.a_ready(nxt);
            if constexpr (SP2) {
            PG8_LDB(B0, 0, 0); PG8_LDB(B1, 0, 1); PG8_SCHED; PG8_LDA(At, 0, 0); PG8_STAGE(PG8_SA(1, 1), a1 + hstep, voffA);
            PG8_WAIT_V(8); PG8_WAIT_L(0); PG8_BAR; PG8_MMA(0, 0, At, B0); PG8_MMA(0, 1, At, B1); PG8_BAR; PG8_SCHED;
            PG8_LDA(At, 0, 1); PG8_STAGE(PG8_SB(0, 0), b2, voffB); PG8_STAGE(PG8_SB(0, 1), b2 + hstep, voffB); PG8_STAGE(PG8_SA(0, 0), a2, voffA);
            PG8_WAIT_V(8); PG8_WAIT_L(0); PG8_BAR; PG8_MMA(1, 0, At, B0); PG8_MMA(1, 1, At, B1); PG8_BAR; PG8_SCHED;
            PG8_LDB(B0, 1, 0); PG8_LDB(B1, 1, 1); PG8_SCHED; PG8_LDA(At, 1, 0); PG8_STAGE(PG8_SA(0, 1), a2 + hstep, voffA);
            PG8_WAIT_V(8); PG8_WAIT_L(0); PG8_BAR; PG8_MMA(0, 0, At, B0); PG8_MMA(0, 1, At, B1); PG8_BAR; PG8_SCHED;
            PG8_LDA(At, 1, 1); PG8_STAGE(PG8_SB(1, 0), b3, voffB); PG8_STAGE(PG8_SB(1, 1), b3 + hstep, voffB); PG8_STAGE(PG8_SA(1, 0), a3, voffA);
            PG8_WAIT_V(8); PG8_WAIT_L(0); PG8_BAR; PG8_MMA(1, 0, At, B0); PG8_MMA(1, 1, At, B1); PG8_BAR; PG8_SCHED;
            } else {
            PG8_LDB(B0, 0, 0); PG8_SCHED; PG8_LDA(At, 0, 0); PG8_STAGE(PG8_SA(1, 1), a1 + hstep, voffA);
            PG8_WAIT_L(8); PG8_BAR; PG8_WAIT_L(0); PG8_MMA(0, 0, At, B0); PG8_BAR; PG8_SCHED;
            PG8_LDB(B1, 0, 1); PG8_STAGE(PG8_SB(0, 0), b2, voffB);
            PG8_BAR; PG8_WAIT_L(0); PG8_MMA(0, 1, At, B1); PG8_BAR;
            PG8_LDA(At, 0, 1); PG8_STAGE(PG8_SA(0, 0), a2, voffA);
            PG8_BAR; PG8_WAIT_L(0); PG8_MMA(1, 0, At, B0); PG8_BAR; PG8_SCHED;
            PG8_STAGE(PG8_SB(0, 1), b2 + hstep, voffB);
            PG8_WAIT_V(6); PG8_BAR; PG8_MMA(1, 1, At, B1); PG8_BAR;
            PG8_LDB(B0, 1, 0); PG8_SCHED; PG8_LDA(At, 1, 0); PG8_STAGE(PG8_SA(0, 1), a2 + hstep, voffA);
            PG8_WAIT_L(8); PG8_BAR; PG8_WAIT_L(0); PG8_MMA(0, 0, At, B0); PG8_BAR; PG8_SCHED;
            PG8_LDB(B1, 1, 1); PG8_STAGE(PG8_SB(1, 0), b3, voffB);
            PG8_BAR; PG8_WAIT_L(0); PG8_MMA(0, 1, At, B1); PG8_BAR;
            PG8_LDA(At, 1, 1); PG8_STAGE(PG8_SA(1, 0), a3, voffA);
            PG8_BAR; PG8_WAIT_L(0); PG8_MMA(1, 0, At, B0); PG8_BAR; PG8_SCHED;
            PG8_STAGE(PG8_SB(1, 1), b3 + hstep, voffB);
            PG8_WAIT_V(6); PG8_BAR; PG8_MMA(1, 1, At, B1); PG8_BAR;
            }
        }
        if constexpr (ALIGN_EPI) { if (wr == 0) PG8_BAR; }
        if constexpr (!Epi::AFTER_DRAIN) { E(acc, cur, wr, wc, fr, fq); S.done(cur); }
        if (!has_next) break;
#pragma unroll
        for (int a = 0; a < 2; ++a)
#pragma unroll
            for (int b = 0; b < 2; ++b)
#pragma unroll
                for (int m = 0; m < 4; ++m)
#pragma unroll
                    for (int n = 0; n < 2; ++n) acc[a][b][m][n] = (f32x4){0.f, 0.f, 0.f, 0.f};
        cur = nxt; cA = nA; cB = nB; ++ui; PG8_RCUR(cur);
        if constexpr (ALIGN_EPI) { if (wr == 1) PG8_BAR; }
    }
    PG8_WAIT_V(0);
    if constexpr (!ALIGN_EPI) { if (wr == 0) PG8_BAR; }
    PG8_BAR;
    if constexpr (Epi::AFTER_DRAIN) { E.fused(acc, cur, wr, wc, fr, fq, lds, wid, lane); S.done(cur); }
#undef PG8_SA
#undef PG8_SB
#undef PG8_STAGE
#undef PG8_LDA
#undef PG8_LDB
#undef PG8_MMA
#undef PG8_WAIT_V
#undef PG8_WAIT_L
#undef PG8_BAR
#undef PG8_SCHED
#undef PG8_PIECE_OFF
#undef PG8_RLOAD_P
#undef PG8_WAIT_V1P
#undef PG8_RADD_P
#undef PG8_KPAIR
#undef PG8_RCUR
}
}
constexpr int NWAVES = 8;
constexpr int NB = 8, SEQ = 4096, T = NB * SEQ, DM = 1024, DIN = 2824, DFF = 2816, NPROJ = 2816;
constexpr int SRC_MI = 2048;
constexpr int PC_MQ = 0, PC_MK = 512, PC_MV = 1024, PC_MO = 1536, PC_AQ = 2048, PC_AK = 2560, PC_AV = 2688;
constexpr float EPS = 1e-6f;
constexpr size_t MiB = 1u << 20;
constexpr size_t WS_CTL = 0, CTL_ZERO_BYTES = 32 * 1024;
constexpr size_t WS_WIN = 1 * MiB;
constexpr size_t WS_WOUT = 7 * MiB;
constexpr size_t WS_WGU = 9 * MiB;
constexpr size_t WS_WDN = 20 * MiB;
constexpr size_t WS_ROPE = 26 * MiB;
constexpr size_t WS_WBG = 26 * MiB + 512 * 1024;
constexpr size_t WS_GATES = 27 * MiB;
constexpr size_t WS_SSQ = 28 * MiB;
constexpr size_t WS_SEG = 30 * MiB;
constexpr size_t WS_XN = 48 * MiB;
constexpr size_t WS_MIX = 112 * MiB;
constexpr size_t WS_PROJ = 176 * MiB;
constexpr size_t WS_END = 352 * MiB;
constexpr int CW_BAR = 4096;
constexpr int RING_BYTES = 131072;
constexpr int LDSCTL_OFF = RING_BYTES, MISC_OFF = LDSCTL_OFF + 320;
constexpr int LDS_BYTES = 163840;

#define GAS __attribute__((address_space(1)))
#define LAS __attribute__((address_space(3)))
typedef unsigned short bf16;
typedef unsigned v4u __attribute__((ext_vector_type(4)));
typedef unsigned v2u __attribute__((ext_vector_type(2)));
typedef float f32x2v __attribute__((ext_vector_type(2)));
typedef float f32x4 __attribute__((ext_vector_type(4)));
typedef short bf16x8 __attribute__((ext_vector_type(8)));
typedef GAS unsigned gu32;
#define RLX_AGENT __ATOMIC_RELAXED, __HIP_MEMORY_SCOPE_AGENT
#define LDS_WAIT() asm volatile("s_waitcnt lgkmcnt(0)" ::: "memory")
#define VM_WAIT() asm volatile("s_waitcnt vmcnt(0)" ::: "memory")
__device__ __forceinline__ unsigned f2bf(float f) { unsigned u = __builtin_bit_cast(unsigned, f); return (u + 0x7fffu + ((u >> 16) & 1u)) >> 16; }
__device__ __forceinline__ unsigned pk2(float lo, float hi) { return f2bf(lo) | (f2bf(hi) << 16); }
__device__ __forceinline__ float bf2f(unsigned short b) { return __builtin_bit_cast(float, (unsigned)b << 16); }
__device__ __forceinline__ float bflo(unsigned w) { return __builtin_bit_cast(float, w << 16); }
__device__ __forceinline__ float bfhi(unsigned w) { return __builtin_bit_cast(float, w & 0xffff0000u); }
__device__ __forceinline__ float wave_sum(float v) {
#pragma unroll
    for (int o = 1; o < 64; o <<= 1) v += __shfl_xor(v, o);
    return v;
}
__device__ __forceinline__ float wave_max(float v) {
#pragma unroll
    for (int o = 1; o < 64; o <<= 1) v = fmaxf(v, __shfl_xor(v, o));
    return v;
}
__device__ __forceinline__ void unpack8(const v4u w, float* o) { o[0] = bflo(w.x); o[1] = bfhi(w.x); o[2] = bflo(w.y); o[3] = bfhi(w.y); o[4] = bflo(w.z); o[5] = bfhi(w.z); o[6] = bflo(w.w); o[7] = bfhi(w.w); }
__device__ __forceinline__ float red16_32_max(float v) {
    auto a = __builtin_amdgcn_permlane16_swap(__float_as_uint(v), __float_as_uint(v), false, false); v = fmaxf(__uint_as_float(a[0]), __uint_as_float(a[1]));
    auto b = __builtin_amdgcn_permlane32_swap(__float_as_uint(v), __float_as_uint(v), false, false); return fmaxf(__uint_as_float(b[0]), __uint_as_float(b[1])); }
__device__ __forceinline__ float red16_32_sum(float v) {
    auto a = __builtin_amdgcn_permlane16_swap(__float_as_uint(v), __float_as_uint(v), false, false); v = __uint_as_float(a[0]) + __uint_as_float(a[1]);
    auto b = __builtin_amdgcn_permlane32_swap(__float_as_uint(v), __float_as_uint(v), false, false); return __uint_as_float(b[0]) + __uint_as_float(b[1]); }
__device__ __forceinline__ float xor16_partner(float v) { const unsigned u = __float_as_uint(v); auto a = __builtin_amdgcn_permlane16_swap(u, u, false, false); return __uint_as_float(a[0] ^ a[1] ^ u); }
#define xor16_max 1
#define XB_TMO      128
#define XB_XCNT(j)  (256  + 64 * (j))
#define XB_XSUB(j)  (1280 + 64 * (j))
#define XB_XGEN(j)  (2304 + 64 * (j))
#define XB_TOP      3328
#define XB_TOPGEN   3392
#define XCD_BAR_WORDS 3456
#define XB_SPIN_CAP (1u << 18)

__device__ __forceinline__ unsigned xb_ld(unsigned* p)              { return __hip_atomic_load(p, __ATOMIC_RELAXED, __HIP_MEMORY_SCOPE_AGENT); }
__device__ __forceinline__ unsigned xb_add(unsigned* p, unsigned v) { return __hip_atomic_fetch_add(p, v, __ATOMIC_RELAXED, __HIP_MEMORY_SCOPE_AGENT); }
__device__ __forceinline__ unsigned xb_xcc_id() { return (unsigned)__builtin_amdgcn_s_getreg((3 << 11) | 20) & 0xFu; }
#define XB_SPIN(cond, bar) do { unsigned _sp = 0; while (cond) { __builtin_amdgcn_s_sleep(1); \
    if ((++_sp & 255u) == 0u) { if (xb_ld(&(bar)[XB_TMO])) break; if (_sp > XB_SPIN_CAP) { atomicAdd(&(bar)[XB_TMO], 1u); break; } } } } while (0)

struct XcdBarrier {
    unsigned* bar; unsigned x;
    volatile LAS unsigned* st;
};

__device__ __forceinline__ XcdBarrier xcd_barrier_post(unsigned* bar, volatile LAS unsigned* st) {
    XcdBarrier b; b.bar = bar; b.x = xb_xcc_id(); b.st = st;
    if (threadIdx.x == 0) (void)xb_add(&bar[XB_XCNT(b.x)], 1u);
    return b;
}
__device__ __forceinline__ void xcd_barrier_complete(unsigned* bar, unsigned x, unsigned& nloc, unsigned& nx) {
    const unsigned G = gridDim.x * gridDim.y * gridDim.z;
    unsigned sum, cnt, mine, sp = 0u;
    for (;;) {
        sum = 0u; cnt = 0u; mine = 0u;
#pragma unroll
        for (unsigned j = 0; j < 16; ++j) { const unsigned c = xb_ld(&bar[XB_XCNT(j)]); sum += c; cnt += (c > 0u) ? 1u : 0u; mine = (j == x) ? c : mine; }
        if (sum == G) break;
        __builtin_amdgcn_s_sleep(1);
        if ((++sp & 255u) == 0u) { if (xb_ld(&bar[XB_TMO])) break; if (sp > XB_SPIN_CAP) { atomicAdd(&bar[XB_TMO], 1u); break; } }
    }
    nloc = mine > 0u ? mine : 1u; nx = cnt > 0u ? cnt : 1u;
}

__device__ __forceinline__ void xcd_barrier(const XcdBarrier& b) {
    asm volatile("s_waitcnt vmcnt(0)" ::: "memory");
    __syncthreads();
    if (threadIdx.x == 0) {
        unsigned* bar = b.bar;
        __builtin_amdgcn_s_waitcnt(0);
        unsigned nloc = b.st[0], nx = b.st[1];
        if (nloc == 0u) { xcd_barrier_complete(bar, b.x, nloc, nx); b.st[0] = nloc; b.st[1] = nx; }
        const unsigned old = xb_add(&bar[XB_XSUB(b.x)], 1u);
        const unsigned gen = old / nloc;
        if (old + 1u == (gen + 1u) * nloc) {
            __builtin_amdgcn_fence(__ATOMIC_RELEASE, "agent");
            asm volatile("s_waitcnt vmcnt(0)" ::: "memory");
            const unsigned og = xb_add(&bar[XB_TOP], 1u);
            const unsigned tg = og / nx;
            if (og + 1u == (tg + 1u) * nx) xb_add(&bar[XB_TOPGEN], 1u);
            else XB_SPIN(xb_ld(&bar[XB_TOPGEN]) == tg, bar);
            __builtin_amdgcn_fence(__ATOMIC_ACQUIRE, "agent");
            xb_add(&bar[XB_XGEN(b.x)], 1u);
            asm volatile("s_waitcnt vmcnt(0)" ::: "memory");
        } else {
            XB_SPIN(xb_ld(&bar[XB_XGEN(b.x)]) == gen, bar);
            __builtin_amdgcn_fence(__ATOMIC_ACQUIRE, "agent");
            asm volatile("s_waitcnt vmcnt(0)" ::: "memory");
        }
    }
    __syncthreads();
}
#define H1_BF16 1
#ifndef P5_ALIGN
#define P5_ALIGN true
#endif
#define PHASE2_BODY do { mlstm_phase<1>(F); swa_phase(F); } while (0)
#define PHASE3_BODY mlstm_phase<2>(F)
#define LAUNCH_MK(lo_, hi_) do { a.ph_lo = (lo_); a.ph_hi = (hi_); a.li = (lo_); hipLaunchKernelGGL(mk_fwd, dim3(grid), dim3(NWAVES * 64), LDS_BYTES, stream, a); } while (0)
#define LAUNCH_PROGRAM { LAUNCH_MK(0, 7); }
struct Frame {
    LAS unsigned char* lds;
    volatile LAS unsigned* MISC;
    gu32* ctl;
    int tid, lane, wave, vcu, G;
    const float *x, *norm1_g, *w_in, *conv_w, *igate_b, *fgate_b, *mlstm_norm_g, *q_norm_g, *k_norm_g, *sinks, *w_out, *norm2_g, *w_gate, *w_up, *w_down;
    float* out;
    bf16 *Win_t, *Wout_t, *Wgu_t, *Wdn_t, *XN, *MIX, *PROJ;
    float2* ROPE; float* GATES; float* SSQ; float* SEG; unsigned char* WBG;
};

struct P0Item { const float* W; int ldw, src_col0; const float* kscale; bf16* WT; int Kd, dst_row0, kb; };
template <bool SCALE> __device__ __forceinline__ void p0_item_load(const P0Item& I, float (&v)[32], int lane) {
    const int k0 = 64 * I.kb;
#pragma unroll
    for (int i = 0; i < 32; ++i) { const int kk = 2 * i + (lane >> 5); v[i] = I.W[(size_t)(k0 + kk) * I.ldw + I.src_col0 + (lane & 31)]; }
    if (SCALE) {
        float sc[32];
#pragma unroll
        for (int i = 0; i < 32; ++i) sc[i] = I.kscale[k0 + 2 * i + (lane >> 5)];
#pragma unroll
        for (int i = 0; i < 32; ++i) v[i] *= sc[i];
    }
}
__device__ __forceinline__ void p0_item_finish(const P0Item& I, const float (&v)[32], LAS float* scr, int lane) {
    const int k0 = 64 * I.kb;
#pragma unroll
    for (int i = 0; i < 32; ++i) { const int kk = 2 * i + (lane >> 5); scr[kk * 33 + (lane & 31)] = v[i]; }
    LDS_WAIT(); asm volatile("" ::: "memory");
    const int c = lane & 7;
#pragma unroll
    for (int j = 0; j < 4; ++j) { const int n = (lane >> 3) + 8 * j; const LAS float* s = scr + (8 * c) * 33 + n;
        v4u o; o.x = pk2(s[0 * 33], s[1 * 33]); o.y = pk2(s[2 * 33], s[3 * 33]); o.z = pk2(s[4 * 33], s[5 * 33]); o.w = pk2(s[6 * 33], s[7 * 33]);
        *(GAS v4u*)(I.WT + (size_t)(I.dst_row0 + n) * I.Kd + k0 + 8 * c) = o; }
    LDS_WAIT(); asm volatile("" ::: "memory");
}
constexpr int I_IN = 88 * 16, I_OUT = 32 * 16, I_GU = 176 * 16, I_DN = 32 * 44;
__device__ __forceinline__ P0Item p0_item_in(Frame& F, int r) { const int nb = r % 88, kb = r / 88; return P0Item{F.w_in, DIN, nb < 64 ? 32 * nb : 32 * nb + 8, nullptr, F.Win_t, DM, 32 * nb, kb}; }
__device__ __forceinline__ P0Item p0_item_gu(Frame& F, int r) { const int nb = r % 176, kb = r / 176, tile = nb >> 3, wi = nb & 7; const float* W = (wi < 4) ? F.w_gate : F.w_up;
    return P0Item{W, DFF, 128 * tile + 32 * (wi & 3), F.norm2_g, F.Wgu_t, DM, 32 * nb, kb}; }
__device__ __forceinline__ P0Item p0_item_od(Frame& F, int r) {
    if (r < I_OUT) { const int nb = r % 32, kb = r / 32; return P0Item{F.w_out, DM, 32 * nb, nullptr, F.Wout_t, DM, 32 * nb, kb}; } r -= I_OUT;
    { const int nb = r % 32, kb = r / 32; return P0Item{F.w_down, DM, 32 * nb, nullptr, F.Wdn_t, DFF, 32 * nb, kb}; }
}
__device__ __forceinline__ void p0_prologue(Frame& F) {
    LAS float* scr = (LAS float*)(F.lds + F.wave * 8704);
    const int gw = F.vcu * NWAVES + F.wave, NGW = F.G * NWAVES;
    for (int it = gw; it < I_IN; it += NGW) { const P0Item I = p0_item_in(F, it); float v[32]; p0_item_load<false>(I, v, F.lane); p0_item_finish(I, v, scr, F.lane); }
    if (F.vcu < 4) { const int idx = F.vcu * 512 + F.tid; const int ks = idx >> 6, ln = idx & 63, col = ln & 15, gq = ln >> 4;
        v4u o = (v4u){0u, 0u, 0u, 0u};
        if (col < 8) { const float* wp = F.w_in + (size_t)(32 * ks + 8 * gq) * DIN + SRC_MI + col;
            const float w0 = wp[0], w1 = wp[DIN], w2 = wp[2 * DIN], w3 = wp[3 * DIN], w4 = wp[4 * DIN], w5 = wp[5 * DIN], w6 = wp[6 * DIN], w7 = wp[7 * DIN];
            o.x = pk2(w0, w1); o.y = pk2(w2, w3); o.z = pk2(w4, w5); o.w = pk2(w6, w7); }
        ((v4u*)F.WBG)[idx] = o; }
    { const int idx = (F.vcu * NWAVES * 64) + F.tid;
      if (idx < SEQ * 8) { const int pos = idx >> 3, i = idx & 7;
        double f = 1.0; f = (i == 1) ? 0.19392274474868576 : f; f = (i == 2) ? 0.03760603093086393 : f; f = (i == 3) ? 0.007292664737217109 : f; f = (i == 4) ? 0.001414213562373095 : f;
        f = (i == 5) ? 0.0002742481756762073 : f; f = (i == 6) ? 5.318295896944988e-05 : f; f = (i == 7) ? 1.031338537721246e-05 : f;
        const float angf = (float)pos * (float)f; const double rev = (double)angf * 0.15915494309189535; const double fr = rev - __builtin_floor(rev + 0.5);
        const float rr = (float)(fr * 6.283185307179586); F.ROPE[idx] = make_float2(__cosf(rr), __sinf(rr)); } }
    f32x4 g1[4];
#pragma unroll
    for (int j = 0; j < 4; ++j) g1[j] = ((const f32x4*)F.norm1_g)[F.lane + 64 * j];
    f32x4 v[4];
    if (gw < T) {
#pragma unroll
        for (int j = 0; j < 4; ++j) v[j] = ((const GAS f32x4*)(F.x + (size_t)gw * DM))[F.lane + 64 * j];
    }
#pragma unroll 1
    for (int m = gw; m < T; m += NGW) {
        f32x4 c[4]; float s = 0.f;
#pragma unroll
        for (int j = 0; j < 4; ++j) { c[j] = v[j]; s += (c[j].x * c[j].x + c[j].y * c[j].y) + (c[j].z * c[j].z + c[j].w * c[j].w); }
        if (m + NGW < T) {
#pragma unroll
            for (int j = 0; j < 4; ++j) v[j] = ((const GAS f32x4*)(F.x + (size_t)(m + NGW) * DM))[F.lane + 64 * j];
        }
        const float rstd = __builtin_amdgcn_rsqf(wave_sum(s) * (1.f / DM) + EPS);
        GAS v2u* o8 = (GAS v2u*)(F.XN + (size_t)m * DM) + F.lane;
#pragma unroll
        for (int j = 0; j < 4; ++j) { const f32x4 y = c[j] * rstd * g1[j]; v2u w; w.x = pg8::cvt_pk_bf16(y.x, y.y); w.y = pg8::cvt_pk_bf16(y.z, y.w); o8[64 * j] = w; }
    }
}
__device__ __forceinline__ void convert_gu(Frame& F, int ii, int ni) {
    LAS float* scr = (LAS float*)(F.lds + F.wave * 8704);
    __syncthreads();
    const int igw = ii * NWAVES + F.wave, NIW = ni * NWAVES;
#pragma unroll 1
    for (int it = igw; it < I_GU; it += 2 * NIW) {
        const P0Item Ia = p0_item_gu(F, it); const bool two = it + NIW < I_GU; const P0Item Ib = p0_item_gu(F, two ? it + NIW : it);
        float va[32], vb[32]; p0_item_load<true>(Ia, va, F.lane); p0_item_load<true>(Ib, vb, F.lane);
        p0_item_finish(Ia, va, scr, F.lane); if (two) p0_item_finish(Ib, vb, scr, F.lane);
    }
}
__device__ __forceinline__ void convert_od(Frame& F, int ii, int ni) {
    LAS float* scr = (LAS float*)(F.lds + F.wave * 8704);
    const int igw = ii * NWAVES + F.wave, NIW = ni * NWAVES;
#pragma unroll 1
    for (int it = igw; it < I_OUT + I_DN; it += 2 * NIW) {
        const P0Item Ia = p0_item_od(F, it); const bool two = it + NIW < I_OUT + I_DN; const P0Item Ib = p0_item_od(F, two ? it + NIW : it);
        float va[32], vb[32]; p0_item_load<false>(Ia, va, F.lane); p0_item_load<false>(Ib, vb, F.lane);
        p0_item_finish(Ia, va, scr, F.lane); if (two) p0_item_finish(Ib, vb, scr, F.lane);
    }
}
__device__ __forceinline__ void p1_side_work(Frame& F, int ii, int ni) {
    LAS unsigned char* WB = F.lds + 73728;
    for (int idx = F.tid; idx < 2048; idx += NWAVES * 64) *(LAS v4u*)(WB + idx * 16) = ((const v4u*)F.WBG)[idx];
    __syncthreads();
    convert_od(F, ii, ni);
    const int igw = ii * NWAVES + F.wave, NIW = ni * NWAVES;
    const int l15 = F.lane & 15, g = F.lane >> 4;
    for (int blk = igw; blk < T / 16; blk += NIW) {
        const bf16* xp = F.XN + ((size_t)blk * 16 + l15) * DM + 8 * g;
        f32x4 acc = (f32x4){0.f, 0.f, 0.f, 0.f};
        bf16x8 a[32];
#pragma unroll
        for (int q = 0; q < 32; ++q) a[q] = *(const bf16x8*)(xp + 32 * q);
#pragma unroll
        for (int q = 0; q < 32; ++q) acc = __builtin_amdgcn_mfma_f32_16x16x32_bf16(a[q], *(const LAS bf16x8*)(WB + (q * 64 + F.lane) * 16), acc, 0, 0, 0);
        if (l15 < 8) {
#pragma unroll
            for (int r = 0; r < 4; ++r) F.GATES[((size_t)blk * 16 + 4 * g + r) * 8 + l15] = acc[r];
        }
    }
}

constexpr int SWA_KS = 0, SWA_KSTR = 144, SWA_VT = 36864, SWA_VSTR = 528;
typedef short bf16x4 __attribute__((ext_vector_type(4)));
#ifndef SWA_UNROLL
#define SWA_UNROLL 1
#endif
constexpr int SWA_TAB = 70656;
struct SwaKV { v4u k[4], v[4]; float2 cs[8]; };
struct SwaQ { v4u w0, w1; float2 cs[8]; };
__device__ __forceinline__ void swa_load_kv(Frame& F, int tid, int u, SwaKV& R) {
    const int blk = u & 31, kvh = (u >> 5) & 1, b = u >> 6; const int key = tid >> 1, half = tid & 1; const int kt = blk * 128 - 128 + key;
    if (kt >= 0) {
        const bf16* kp = F.PROJ + (size_t)(b * SEQ + kt) * NPROJ + PC_AK + kvh * 64 + 32 * half;
        const bf16* vp = F.PROJ + (size_t)(b * SEQ + kt) * NPROJ + PC_AV + kvh * 64 + 32 * half;
#pragma unroll
        for (int c = 0; c < 4; ++c) { R.k[c] = *(const v4u*)(kp + 8 * c); R.v[c] = *(const v4u*)(vp + 8 * c); }
#pragma unroll
        for (int i = 0; i < 8; ++i) R.cs[i] = F.ROPE[kt * 8 + i];
    } else {
#pragma unroll
        for (int c = 0; c < 4; ++c) { R.k[c] = (v4u){0u, 0u, 0u, 0u}; R.v[c] = (v4u){0u, 0u, 0u, 0u}; }
#pragma unroll
        for (int i = 0; i < 8; ++i) R.cs[i] = make_float2(1.f, 0.f);
    }
}
__device__ __forceinline__ void swa_load_q(Frame& F, int lane, int wave, int u, int rb, SwaQ& R) {
    const int blk = u & 31, kvh = (u >> 5) & 1, b = u >> 6; const int l15 = lane & 15, g = lane >> 4;
    const int hq = kvh * 4 + (wave >> 1), p0 = 64 * (wave & 1) + 16 * rb, tq = blk * 128 + p0 + l15;
    const bf16* qp = F.PROJ + (size_t)(b * SEQ + tq) * NPROJ + PC_AQ + hq * 64 + 8 * g;
    R.w0 = *(const v4u*)qp; R.w1 = *(const v4u*)(qp + 32);
#pragma unroll
    for (int j = 0; j < 8; ++j) R.cs[j] = F.ROPE[tq * 8 + j];
}
__device__ __forceinline__ void swa_phase(Frame& F) {
    LAS unsigned char* KS = F.lds + SWA_KS; LAS unsigned char* VT = F.lds + SWA_VT; LAS float* TAB = (LAS float*)(F.lds + SWA_TAB);
    const int wave = F.wave;
    int u = F.vcu;
    if (u >= NB * 2 * 32) return;
    __syncthreads();
    if (F.tid < 64) TAB[F.tid] = F.q_norm_g[F.tid]; else if (F.tid < 128) TAB[F.tid] = F.k_norm_g[F.tid - 64];
    SwaKV kv; SwaQ qr;
    swa_load_kv(F, F.tid, u, kv);
    swa_load_q(F, F.lane, wave, u, 0, qr);
#pragma unroll 1
    for (; u < NB * 2 * 32; u += F.G) {
        int tid = F.tid; asm volatile("" : "+v"(tid));
        const int lane = tid & 63, l15 = lane & 15, g = lane >> 4;
        const int blk = u & 31, kvh = (u >> 5) & 1, b = u >> 6;
        const int un = u + F.G; const bool has_next = un < NB * 2 * 32;
        __syncthreads();
        {
            const int key = tid >> 1, half = tid & 1;
            float kf[32];
#pragma unroll
            for (int c = 0; c < 4; ++c) unpack8(kv.k[c], kf + 8 * c);
            float ss = 0.f;
#pragma unroll
            for (int c = 0; c < 32; ++c) ss += kf[c] * kf[c];
            ss += __shfl_xor(ss, 1);
            const float rstd = __builtin_amdgcn_rsqf(ss * (1.f / 64.f) + EPS);
#pragma unroll
            for (int c = 0; c < 8; ++c) { const f32x4 gg = *(const LAS f32x4*)(TAB + 64 + 32 * half + 4 * c); kf[4 * c] *= rstd * gg[0]; kf[4 * c + 1] *= rstd * gg[1]; kf[4 * c + 2] *= rstd * gg[2]; kf[4 * c + 3] *= rstd * gg[3]; }
            if (half == 0) {
#pragma unroll
                for (int i = 0; i < 8; ++i) { const float2 cs = kv.cs[i]; const float x1 = kf[i], x2 = kf[8 + i]; kf[i] = x1 * cs.x - x2 * cs.y; kf[8 + i] = x2 * cs.x + x1 * cs.y; }
            }
#pragma unroll
            for (int c = 0; c < 4; ++c) { v4u o; o.x = pg8::cvt_pk_bf16(kf[8 * c], kf[8 * c + 1]); o.y = pg8::cvt_pk_bf16(kf[8 * c + 2], kf[8 * c + 3]); o.z = pg8::cvt_pk_bf16(kf[8 * c + 4], kf[8 * c + 5]); o.w = pg8::cvt_pk_bf16(kf[8 * c + 6], kf[8 * c + 7]);
                *(LAS v4u*)(KS + key * SWA_KSTR + 64 * half + 16 * c) = o; }
#pragma unroll
            for (int c = 0; c < 4; ++c) { const unsigned ww[4] = {kv.v[c].x, kv.v[c].y, kv.v[c].z, kv.v[c].w};
#pragma unroll
                for (int e = 0; e < 4; ++e) { const int d = 32 * half + 8 * c + 2 * e;
                    const unsigned pw = __shfl_xor(ww[e], 2);
                    const unsigned val = (key & 1) ? ((pw >> 16) | (ww[e] & 0xffff0000u)) : ((ww[e] & 0xffffu) | (pw << 16));
                    *(LAS unsigned*)(VT + (d + (key & 1)) * SWA_VSTR + ((((key >> 1) ^ (half << 3))) << 2)) = val; } }
        }
        __syncthreads();
        if (has_next) swa_load_kv(F, tid, un, kv);
        const int hq = kvh * 4 + (wave >> 1);
        const float sink2 = F.sinks[hq] * 1.4426950408889634f;
        const float SC = 0.125f * 1.4426950408889634f;
#pragma unroll 1
        for (int rb = 0; rb < 4; ++rb) {
            const int p0 = 64 * (wave & 1) + 16 * rb, j0 = p0 >> 4;
            const int tq = blk * 128 + p0 + l15;
            bf16x8 qf[2];
            {
                float q0[8], q1[8]; unpack8(qr.w0, q0); unpack8(qr.w1, q1);
                float ss = 0.f;
#pragma unroll
                for (int j = 0; j < 8; ++j) ss += q0[j] * q0[j] + q1[j] * q1[j];
                ss = red16_32_sum(ss);
                const float rstd = __builtin_amdgcn_rsqf(ss * (1.f / 64.f) + EPS);
#pragma unroll
                for (int c = 0; c < 2; ++c) { const f32x4 ga = *(const LAS f32x4*)(TAB + 8 * g + 4 * c), gb = *(const LAS f32x4*)(TAB + 32 + 8 * g + 4 * c);
#pragma unroll
                    for (int e = 0; e < 4; ++e) { q0[4 * c + e] *= rstd * ga[e]; q1[4 * c + e] *= rstd * gb[e]; } }
#pragma unroll
                for (int j = 0; j < 8; ++j) { const float other = xor16_partner(q0[j]); const float2 cs = qr.cs[j];
                    const float r0 = q0[j] * cs.x - other * cs.y, r1 = q0[j] * cs.x + other * cs.y; q0[j] = (g == 0) ? r0 : ((g == 1) ? r1 : q0[j]); }
                v4u a, c2; a.x = pg8::cvt_pk_bf16(q0[0], q0[1]); a.y = pg8::cvt_pk_bf16(q0[2], q0[3]); a.z = pg8::cvt_pk_bf16(q0[4], q0[5]); a.w = pg8::cvt_pk_bf16(q0[6], q0[7]);
                c2.x = pg8::cvt_pk_bf16(q1[0], q1[1]); c2.y = pg8::cvt_pk_bf16(q1[2], q1[3]); c2.z = pg8::cvt_pk_bf16(q1[4], q1[5]); c2.w = pg8::cvt_pk_bf16(q1[6], q1[7]);
                qf[0] = __builtin_bit_cast(bf16x8, a); qf[1] = __builtin_bit_cast(bf16x8, c2);
            }
            if (rb < 3) swa_load_q(F, lane, wave, u, rb + 1, qr); else if (has_next) swa_load_q(F, lane, wave, un, 0, qr);
            f32x4 s[10];
    #pragma unroll
            for (int jj = 0; jj < 9; ++jj) { const int tile = j0 + jj;
                f32x4 acc = (f32x4){0.f, 0.f, 0.f, 0.f};
    #pragma unroll
                for (int ks = 0; ks < 2; ++ks) { const bf16x8 kfr = *(const LAS bf16x8*)(KS + (16 * tile + l15) * SWA_KSTR + 64 * ks + 16 * g);
                    acc = __builtin_amdgcn_mfma_f32_16x16x32_bf16(kfr, qf[ks], acc, 0, 0, 0); }
                s[jj] = acc; }
            s[9] = (f32x4){0.f, 0.f, 0.f, 0.f};
    #pragma unroll
            for (int r = 0; r < 4; ++r) { if (4 * g + r < 1 + l15) s[0][r] = -INFINITY; if (4 * g + r > l15) s[8][r] = -INFINITY; }
            if (blk == 0) {
    #pragma unroll
                for (int jj = 0; jj < 9; ++jj)
    #pragma unroll
                    for (int r = 0; r < 4; ++r) { if (16 * (j0 + jj) + 4 * g + r < 128) s[jj][r] = -INFINITY; }
            }
            float mx = -INFINITY;
    #pragma unroll
            for (int jj = 0; jj < 9; ++jj)
    #pragma unroll
                for (int r = 0; r < 4; ++r) mx = fmaxf(mx, s[jj][r]);
            mx = red16_32_max(mx); mx = fmaxf(mx * SC, sink2);
            float sum = 0.f;
    #pragma unroll
            for (int jj = 0; jj < 9; ++jj)
    #pragma unroll
                for (int r = 0; r < 4; ++r) { const float p = __builtin_amdgcn_exp2f(__builtin_fmaf(s[jj][r], SC, -mx)); s[jj][r] = p; sum += p; }
            sum = red16_32_sum(sum);
            const float inv = 1.0f / (sum + __builtin_amdgcn_exp2f(sink2 - mx));
            f32x4 o[4];
    #pragma unroll
            for (int dt = 0; dt < 4; ++dt) o[dt] = (f32x4){0.f, 0.f, 0.f, 0.f};
    #pragma unroll
            for (int kk = 0; kk < 5; ++kk) {
                const int t0 = (j0 + 2 * kk) > 15 ? 15 : (j0 + 2 * kk), t1 = (j0 + 2 * kk + 1) > 15 ? 15 : (j0 + 2 * kk + 1);
                v4u pw; pw.x = pg8::cvt_pk_bf16(s[2 * kk][0], s[2 * kk][1]); pw.y = pg8::cvt_pk_bf16(s[2 * kk][2], s[2 * kk][3]); pw.z = pg8::cvt_pk_bf16(s[2 * kk + 1][0], s[2 * kk + 1][1]); pw.w = pg8::cvt_pk_bf16(s[2 * kk + 1][2], s[2 * kk + 1][3]);
                const bf16x8 pf = __builtin_bit_cast(bf16x8, pw);
    #pragma unroll
                for (int dt = 0; dt < 4; ++dt) {
                    const v2u a0 = *(const LAS v2u*)(VT + (16 * dt + l15) * SWA_VSTR + (((8 * t0 + 2 * g) ^ ((dt >> 1) << 3)) << 2));
                    const v2u a1 = *(const LAS v2u*)(VT + (16 * dt + l15) * SWA_VSTR + (((8 * t1 + 2 * g) ^ ((dt >> 1) << 3)) << 2));
                    v4u av; av.x = a0.x; av.y = a0.y; av.z = a1.x; av.w = a1.y;
                    o[dt] = __builtin_amdgcn_mfma_f32_16x16x32_bf16(__builtin_bit_cast(bf16x8, av), pf, o[dt], 0, 0, 0); }
            }
            bf16* op = F.MIX + (size_t)(b * SEQ + tq) * DM + 512 + hq * 64 + 4 * g;
    #pragma unroll
            for (int dt = 0; dt < 4; ++dt) { v2u w; w.x = pg8::cvt_pk_bf16(o[dt][0] * inv, o[dt][1] * inv); w.y = pg8::cvt_pk_bf16(o[dt][2] * inv, o[dt][3] * inv); *(v2u*)(op + 16 * dt) = w; }
        }
    }
}
constexpr int ML_QS = 0, ML_KS = 17408, ML_KWT = 34816, ML_VT = 53248, ML_PS = 71680, ML_CT = 80896, ML_F = 115712;
constexpr int ML_QSTR = 272, ML_TSTR = 144, ML_HSTR = 528;
constexpr int FDEN = 256, FN = 320;
constexpr int ML_GV = 132096, ML_GS = ML_GV + 8192, ML_CW = ML_GS + 256;
constexpr int SEG_STRIDE = 16640;
constexpr float LOG2E = 1.4426950408889634f;
__device__ __forceinline__ float silu_f(float v) { return v * __builtin_amdgcn_rcpf(1.0f + __builtin_amdgcn_exp2f(v * -LOG2E)); }
__device__ __forceinline__ float sigmoid_f(float v) { return __builtin_amdgcn_rcpf(1.0f + __builtin_amdgcn_exp2f(v * -LOG2E)); }
__device__ __forceinline__ float exp_f(float v) { return __builtin_amdgcn_exp2f(v * LOG2E); }

template <int PASS> __device__ __forceinline__ void mlstm_item(Frame& F, int b, int h, int sg) {
    const int wave = F.wave;
    int tid = F.tid; asm volatile("" : "+v"(tid));
    int lane = tid & 63, l15 = lane & 15, g4 = lane >> 4;
    LAS unsigned char* L = F.lds; LAS float* FL = (LAS float*)(L + ML_F);
    f32x4 C[8];
#pragma unroll
    for (int et = 0; et < 8; ++et) C[et] = (f32x4){0.f, 0.f, 0.f, 0.f};
    float m = -1e30f, Gsum = 0.f;
    LAS float* GV = (LAS float*)(L + ML_GV); LAS float* GS = (LAS float*)(L + ML_GS); LAS float* CW = (LAS float*)(L + ML_CW);
    __syncthreads();
    if (tid < 128) FL[FN + tid] = 0.f;
    for (int i = tid; i < 1024; i += NWAVES * 64) { const int j = i >> 8, ch = i & 255; CW[i] = F.conv_w[j * 1024 + (ch >> 7) * 512 + h * 128 + (ch & 127)]; }
    {
        const size_t tg = (size_t)b * SEQ + (size_t)(sg * 8 + wave) * 64 + lane;
        const float* gr = F.GATES + tg * 8;
        const float ig = gr[h] + F.igate_b[h], fg = gr[4 + h] + F.fgate_b[h];
        const float lf = fminf(fg, 0.f) - log1pf(__expf(-fabsf(fg)));
        float bs = lf;
#pragma unroll
        for (int o = 1; o < 64; o <<= 1) { const float t = __shfl_up(bs, o); if (lane >= o) bs += t; }
        const float gtot = __shfl(bs, 63);
        const float u = ig - bs;
        float pm = u;
#pragma unroll
        for (int o = 1; o < 64; o <<= 1) { const float t = __shfl_up(pm, o); if (lane >= o) pm = fmaxf(pm, t); }
        const float a = gtot + u;
        const float mloc = wave_max(a);
        GV[wave * 256 + lane] = bs; GV[wave * 256 + 64 + lane] = u; GV[wave * 256 + 128 + lane] = exp_f(a - mloc); GV[wave * 256 + 192 + lane] = pm;
        if (lane == 0) { GS[wave * 2] = gtot; GS[wave * 2 + 1] = mloc; }
    }
    if (PASS == 2 && sg > 0) {
        const float* E0 = F.SEG + (size_t)((b * 4 + h) * 8) * SEG_STRIDE;
        float lw[7]; float sfx = 0.f, mfin = -1e30f;
#pragma unroll
        for (int j = 6; j >= 0; --j) { const int jc = (j < sg) ? j : 0; const float mE = E0[(size_t)jc * SEG_STRIDE + 16384 + 128], G = E0[(size_t)jc * SEG_STRIDE + 16384 + 129];
            lw[j] = (j < sg) ? (mE + sfx) : -1e30f; sfx += (j < sg) ? G : 0.f; mfin = fmaxf(mfin, lw[j]); }
        float coef[7];
#pragma unroll
        for (int j = 0; j < 7; ++j) coef[j] = (j < sg) ? exp_f(lw[j] - mfin) : 0.f;
#pragma unroll 1
        for (int j = 0; j < sg; ++j) { const float* Ej = E0 + (size_t)j * SEG_STRIDE; float cj = coef[0];
#pragma unroll
            for (int q = 1; q < 7; ++q) cj = (j == q) ? coef[q] : cj;
#pragma unroll
            for (int et = 0; et < 8; ++et) C[et] += ((const f32x4*)Ej)[(unsigned)((et * 8 + wave) * 64 + lane)] * cj;
            if (tid < 128) FL[FN + tid] += cj * Ej[16384 + tid]; }
        m = mfin;
    }
    if (PASS == 2) {
#pragma unroll
        for (int et = 0; et < 8; ++et) { v2u w; w.x = pg8::cvt_pk_bf16(C[et][0], C[et][1]); w.y = pg8::cvt_pk_bf16(C[et][2], C[et][3]); *(LAS v2u*)(L + ML_CT + (16 * et + l15) * ML_QSTR + (16 * wave + 4 * g4) * 2) = w; }
    }
    const float kscale = 0.08838834764831845f;
    v4u xr[7]; v4u vr[4];
#define ML_LOAD(cidx) do { const int c_ = (cidx); const size_t t0_ = (size_t)b * SEQ + (size_t)c_ * 64; \
        const int mat_ = tid >> 8, r8_ = tid & 255, dg_ = r8_ & 15, l0_ = 4 * (r8_ >> 4); \
        if (PASS == 2 || mat_ == 1) { const bf16* src_ = F.PROJ + (mat_ ? PC_MK : PC_MQ) + h * 128 + 8 * dg_; \
            _Pragma("unroll") for (int j = 0; j < 7; ++j) { const int lr = l0_ + j - 3; xr[j] = (c_ == 0 && lr < 0) ? (v4u){0u, 0u, 0u, 0u} : *(const v4u*)(src_ + (t0_ + lr) * NPROJ); } } \
        if (mat_ == 0) { _Pragma("unroll") for (int lp = 0; lp < 4; ++lp) vr[lp] = *(const v4u*)(F.PROJ + (t0_ + l0_ + lp) * NPROJ + PC_MV + h * 128 + 8 * dg_); } } while (0)
    ML_LOAD(sg * 8);
#pragma unroll 1
    for (int cc = 0; cc < 8; ++cc) {
        const int c = sg * 8 + cc; const size_t t0 = (size_t)b * SEQ + (size_t)c * 64;
        tid = F.tid; asm volatile("" : "+v"(tid));
        lane = tid & 63; l15 = lane & 15; g4 = lane >> 4;
        const int mat = tid >> 8, r8 = tid & 255, dg = r8 & 15, rg = r8 >> 4, l0 = 4 * rg;
        const int tsw = (((rg >> 1) ^ (dg & 7)) << 4) + ((rg & 1) << 3);
        LAS float* GB = GV + cc * 256;
        __syncthreads();
        const float gtot = GS[cc * 2], mloc = GS[cc * 2 + 1];
        if (PASS == 2 || mat == 1) {
            const float w0 = GB[128 + l0], w1 = GB[128 + l0 + 1], w2 = GB[128 + l0 + 2], w3 = GB[128 + l0 + 3];
            unsigned ow[4][4];
            const LAS float* cwp = CW + mat * 128 + 8 * dg;
#pragma unroll
            for (int ip = 0; ip < 4; ++ip) {
                const f32x2v c0 = *(const LAS f32x2v*)(cwp + 2 * ip), c1 = *(const LAS f32x2v*)(cwp + 256 + 2 * ip), c2 = *(const LAS f32x2v*)(cwp + 512 + 2 * ip), c3 = *(const LAS f32x2v*)(cwp + 768 + 2 * ip);
                f32x2v x2[7];
#pragma unroll
                for (int j = 0; j < 7; ++j) { const unsigned w = (ip == 0) ? xr[j].x : (ip == 1) ? xr[j].y : (ip == 2) ? xr[j].z : xr[j].w; x2[j] = (f32x2v){bflo(w), bfhi(w)}; }
                f32x2v y2[4];
#pragma unroll
                for (int lp = 0; lp < 4; ++lp) { const f32x2v t = c0 * x2[lp] + c1 * x2[lp + 1] + c2 * x2[lp + 2] + c3 * x2[lp + 3];
                    const f32x2v e = t * (-LOG2E); f32x2v d; d.x = __builtin_amdgcn_exp2f(e.x); d.y = __builtin_amdgcn_exp2f(e.y); d = d + 1.0f;
                    f32x2v r; r.x = __builtin_amdgcn_rcpf(d.x); r.y = __builtin_amdgcn_rcpf(d.y);
                    y2[lp] = t * r * (mat ? kscale : 1.0f);
                    ow[lp][ip] = pg8::cvt_pk_bf16(y2[lp].x, y2[lp].y); }
                if (mat == 1) {
                    const f32x2v s0 = y2[0] * w0, s1 = y2[1] * w1, s2 = y2[2] * w2, s3 = y2[3] * w3;
                    v2u o; o.x = pg8::cvt_pk_bf16(s0.x, s1.x); o.y = pg8::cvt_pk_bf16(s2.x, s3.x); *(LAS v2u*)(L + ML_KWT + (8 * dg + 2 * ip) * ML_TSTR + tsw) = o;
                    o.x = pg8::cvt_pk_bf16(s0.y, s1.y); o.y = pg8::cvt_pk_bf16(s2.y, s3.y); *(LAS v2u*)(L + ML_KWT + (8 * dg + 2 * ip + 1) * ML_TSTR + tsw) = o; }
            }
            if (PASS == 2) {
                LAS unsigned char* dst = L + (mat ? ML_KS : ML_QS) + l0 * ML_QSTR + 16 * dg;
#pragma unroll
                for (int lp = 0; lp < 4; ++lp) { v4u o; o.x = ow[lp][0]; o.y = ow[lp][1]; o.z = ow[lp][2]; o.w = ow[lp][3]; *(LAS v4u*)(dst + lp * ML_QSTR) = o; }
            }
        }
        if (mat == 0) {
            const unsigned ww[4][4] = {{vr[0].x, vr[0].y, vr[0].z, vr[0].w}, {vr[1].x, vr[1].y, vr[1].z, vr[1].w}, {vr[2].x, vr[2].y, vr[2].z, vr[2].w}, {vr[3].x, vr[3].y, vr[3].z, vr[3].w}};
#pragma unroll
            for (int p = 0; p < 4; ++p) {
                v2u lo, hi;
                lo.x = (ww[0][p] & 0xffffu) | (ww[1][p] << 16); lo.y = (ww[2][p] & 0xffffu) | (ww[3][p] << 16);
                hi.x = (ww[0][p] >> 16) | (ww[1][p] & 0xffff0000u); hi.y = (ww[2][p] >> 16) | (ww[3][p] & 0xffff0000u);
                *(LAS v2u*)(L + ML_VT + (8 * dg + 2 * p) * ML_TSTR + tsw) = lo;
                *(LAS v2u*)(L + ML_VT + (8 * dg + 2 * p + 1) * ML_TSTR + tsw) = hi; }
        }
        __syncthreads();
        if (cc < 7) ML_LOAD(c + 1);
        v4u mo2[2];
        if (PASS == 2) {
#pragma unroll
            for (int it = 0; it < 2; ++it) mo2[it] = *(const v4u*)(F.PROJ + (t0 + 8 * wave + 4 * it + g4) * NPROJ + PC_MO + h * 128 + 8 * l15);
        }
        const float mn = fmaxf(gtot + m, mloc), so = exp_f(gtot + m - mn), sn = exp_f(mloc - mn);
        if (PASS == 2) {
            const int lt = wave >> 1;
#pragma unroll
            for (int si = 0; si < 2; ++si) { const int st = 2 * (wave & 1) + si;
                v2u pw = (v2u){0u, 0u};
                if (st <= lt) {
                    f32x4 acc = (f32x4){0.f, 0.f, 0.f, 0.f};
#pragma unroll
                    for (int ks = 0; ks < 4; ++ks) { const bf16x8 a = *(const LAS bf16x8*)(L + ML_KS + (16 * st + l15) * ML_QSTR + 64 * ks + 16 * g4);
                        const bf16x8 bb = *(const LAS bf16x8*)(L + ML_QS + (16 * lt + l15) * ML_QSTR + 64 * ks + 16 * g4);
                        acc = __builtin_amdgcn_mfma_f32_16x16x32_bf16(a, bb, acc, 0, 0, 0); }
                    const int l = 16 * lt + l15, s0 = 16 * st + 4 * g4; const float bl = GB[l]; const float e0 = bl - (bl + fmaxf(GB[192 + l], m));
                    const f32x4 us = *(const LAS f32x4*)(GB + 64 + s0);
                    float p[4];
#pragma unroll
                    for (int r = 0; r < 4; ++r) { const float e = __builtin_amdgcn_exp2f((e0 + us[r]) * LOG2E); p[r] = (s0 + r <= l) ? acc[r] * e : 0.f; }
                    pw.x = pg8::cvt_pk_bf16(p[0], p[1]); pw.y = pg8::cvt_pk_bf16(p[2], p[3]);
                }
                *(LAS v2u*)(L + ML_PS + (16 * lt + l15) * ML_TSTR + (16 * st + 4 * g4) * 2) = pw;
            }
            __syncthreads();
            {
                const int row = 8 * wave + (lane >> 3), part = lane & 7;
                const v4u pw = *(const LAS v4u*)(L + ML_PS + row * ML_TSTR + 16 * part);
                float pf[8]; unpack8(pw, pf);
                float sp = ((pf[0] + pf[1]) + (pf[2] + pf[3])) + ((pf[4] + pf[5]) + (pf[6] + pf[7]));
                const v4u q0 = *(const LAS v4u*)(L + ML_QS + row * ML_QSTR + 32 * part), q1 = *(const LAS v4u*)(L + ML_QS + row * ML_QSTR + 32 * part + 16);
                float qf[16]; unpack8(q0, qf); unpack8(q1, qf + 8);
                float qn = 0.f;
#pragma unroll
                for (int i = 0; i < 16; ++i) qn += qf[i] * FL[FN + 16 * part + i];
                const float bl = GB[row]; const float mrow = bl + fmaxf(GB[192 + row], m); const float sc = exp_f(bl + m - mrow);
                float tot = sp + sc * qn;
                tot += __shfl_xor(tot, 1); tot += __shfl_xor(tot, 2); tot += __shfl_xor(tot, 4);
                if (part == 0) FL[FDEN + row] = fmaxf(fabsf(tot), exp_f(-mrow));
            }
            const int eh = wave & 1;
            f32x4 o1[4], o2[4];
#pragma unroll
            for (int ei = 0; ei < 4; ++ei) { const int et = 4 * eh + ei;
                f32x4 a1 = (f32x4){0.f, 0.f, 0.f, 0.f}, a2 = (f32x4){0.f, 0.f, 0.f, 0.f};
#pragma unroll
                for (int ks = 0; ks < 2; ++ks) { const bf16x8 a = *(const LAS bf16x8*)(L + ML_VT + (16 * et + l15) * ML_TSTR + (((4 * ks + g4) ^ ((2 * et + (l15 >> 3)) & 7)) << 4));
                    const bf16x8 bb = *(const LAS bf16x8*)(L + ML_PS + (16 * lt + l15) * ML_TSTR + 64 * ks + 16 * g4);
                    a1 = __builtin_amdgcn_mfma_f32_16x16x32_bf16(a, bb, a1, 0, 0, 0); }
#pragma unroll
                for (int ks = 0; ks < 4; ++ks) { const bf16x8 a = *(const LAS bf16x8*)(L + ML_CT + (16 * et + l15) * ML_QSTR + 64 * ks + 16 * g4);
                    const bf16x8 bb = *(const LAS bf16x8*)(L + ML_QS + (16 * lt + l15) * ML_QSTR + 64 * ks + 16 * g4);
                    a2 = __builtin_amdgcn_mfma_f32_16x16x32_bf16(a, bb, a2, 0, 0, 0); }
                o1[ei] = a1; o2[ei] = a2; }
            __syncthreads();
            {
                const int l = 16 * lt + l15; const float bl = GB[l]; const float mrow = bl + fmaxf(GB[192 + l], m); const float sc = exp_f(bl + m - mrow);
                const float inv = 1.0f / FL[FDEN + l];
#pragma unroll
                for (int ei = 0; ei < 4; ++ei) { const int et = 4 * eh + ei; const f32x4 hv = (o1[ei] + o2[ei] * sc) * inv;
                    *(LAS f32x4*)(L + l * ML_HSTR + (16 * et + 4 * g4) * 4) = hv; }
            }
        }
        {
            bf16x8 af[2];
#pragma unroll
            for (int ks = 0; ks < 2; ++ks) af[ks] = *(const LAS bf16x8*)(L + ML_KWT + (16 * wave + l15) * ML_TSTR + (((4 * ks + g4) ^ ((2 * wave + (l15 >> 3)) & 7)) << 4));
#pragma unroll
            for (int et = 0; et < 8; ++et) { f32x4 d = (f32x4){0.f, 0.f, 0.f, 0.f};
#pragma unroll
                for (int ks = 0; ks < 2; ++ks) { const bf16x8 bb = *(const LAS bf16x8*)(L + ML_VT + (16 * et + l15) * ML_TSTR + (((4 * ks + g4) ^ ((2 * et + (l15 >> 3)) & 7)) << 4));
                    d = __builtin_amdgcn_mfma_f32_16x16x32_bf16(af[ks], bb, d, 0, 0, 0); }
                C[et] = C[et] * so + d * sn; }
            if (tid < 128) { float dn = 0.f;
#pragma unroll
                for (int q = 0; q < 8; ++q) { const v4u w = *(const LAS v4u*)(L + ML_KWT + tid * ML_TSTR + 16 * q); float f[8]; unpack8(w, f); dn += ((f[0] + f[1]) + (f[2] + f[3])) + ((f[4] + f[5]) + (f[6] + f[7])); }
                FL[FN + tid] = so * FL[FN + tid] + sn * dn; }
            m = mn; Gsum += gtot;
            if (PASS == 2) {
#pragma unroll
                for (int et = 0; et < 8; ++et) { v2u w; w.x = pg8::cvt_pk_bf16(C[et][0], C[et][1]); w.y = pg8::cvt_pk_bf16(C[et][2], C[et][3]); *(LAS v2u*)(L + ML_CT + (16 * et + l15) * ML_QSTR + (16 * wave + 4 * g4) * 2) = w; }
            }
        }
        if (PASS == 2) {
            __syncthreads();
            const f32x4 gg0 = *(const f32x4*)(F.mlstm_norm_g + h * 128 + 8 * l15), gg1 = *(const f32x4*)(F.mlstm_norm_g + h * 128 + 8 * l15 + 4);
#pragma unroll
            for (int it = 0; it < 2; ++it) { const int l = 8 * wave + 4 * it + g4;
                const f32x4 h0 = *(const LAS f32x4*)(L + l * ML_HSTR + l15 * 32), h1 = *(const LAS f32x4*)(L + l * ML_HSTR + l15 * 32 + 16);
                float ss = (h0[0] * h0[0] + h0[1] * h0[1]) + (h0[2] * h0[2] + h0[3] * h0[3]) + (h1[0] * h1[0] + h1[1] * h1[1]) + (h1[2] * h1[2] + h1[3] * h1[3]);
                ss += __shfl_xor(ss, 1); ss += __shfl_xor(ss, 2); ss += __shfl_xor(ss, 4); ss += __shfl_xor(ss, 8);
                const float rstd = __builtin_amdgcn_rsqf(ss * (1.f / 128.f) + EPS);
                float mo[8]; unpack8(mo2[it], mo);
                const f32x4 y0 = h0 * gg0 * rstd, y1 = h1 * gg1 * rstd;
                v4u o; o.x = pg8::cvt_pk_bf16(y0[0] * sigmoid_f(mo[0]), y0[1] * sigmoid_f(mo[1])); o.y = pg8::cvt_pk_bf16(y0[2] * sigmoid_f(mo[2]), y0[3] * sigmoid_f(mo[3]));
                o.z = pg8::cvt_pk_bf16(y1[0] * sigmoid_f(mo[4]), y1[1] * sigmoid_f(mo[5])); o.w = pg8::cvt_pk_bf16(y1[2] * sigmoid_f(mo[6]), y1[3] * sigmoid_f(mo[7]));
                *(v4u*)(F.MIX + (t0 + l) * DM + h * 128 + 8 * l15) = o; }
        }
    }
    if (PASS == 1) {
        tid = F.tid; asm volatile("" : "+v"(tid)); lane = tid & 63; l15 = lane & 15; g4 = lane >> 4;
        float* E = F.SEG + (size_t)((b * 4 + h) * 8 + sg) * SEG_STRIDE;
#pragma unroll
        for (int et = 0; et < 8; ++et) ((f32x4*)E)[(et * 8 + wave) * 64 + lane] = C[et];
        if (tid < 128) E[16384 + tid] = FL[FN + tid];
        if (tid == 0) { E[16384 + 128] = m; E[16384 + 129] = Gsum; }
    }
}
template <int PASS> __device__ __forceinline__ void mlstm_phase(Frame& F) {
    for (int it = F.vcu; it < NB * 4 * 8; it += F.G) { const int sg = it & 7, h = (it >> 3) & 3, b = it >> 5;
        if (PASS == 1 && sg == 7) { convert_gu(F, it >> 3, NB * 4); continue; }
        mlstm_item<PASS>(F, b, h, sg); }
}
struct Args { const float* in[15]; float* out; unsigned char* ws; int ph_lo, ph_hi, li, pad; };
__global__ void __launch_bounds__(NWAVES * 64, 2) mk_fwd(Args args) {
    extern __shared__ __attribute__((aligned(16))) unsigned char lds[];
    Frame F;
    F.lds = (LAS unsigned char*)lds;
    F.MISC = (volatile LAS unsigned*)(F.lds + MISC_OFF);
    F.tid = threadIdx.x; F.lane = F.tid & 63; F.wave = __builtin_amdgcn_readfirstlane(F.tid >> 6);
    F.G = gridDim.x; { const int bx = blockIdx.x; F.vcu = (F.G % 8 == 0) ? (bx % 8) * (F.G / 8) + bx / 8 : bx; }
    unsigned char* ws = args.ws;
    F.ctl = (gu32*)(ws + WS_CTL);
    F.x = args.in[0]; F.norm1_g = args.in[1]; F.w_in = args.in[2]; F.conv_w = args.in[3]; F.igate_b = args.in[4]; F.fgate_b = args.in[5]; F.mlstm_norm_g = args.in[6];
    F.q_norm_g = args.in[7]; F.k_norm_g = args.in[8]; F.sinks = args.in[9]; F.w_out = args.in[10]; F.norm2_g = args.in[11]; F.w_gate = args.in[12]; F.w_up = args.in[13]; F.w_down = args.in[14];
    F.out = args.out;
    F.Win_t = (bf16*)(ws + WS_WIN); F.Wout_t = (bf16*)(ws + WS_WOUT); F.Wgu_t = (bf16*)(ws + WS_WGU); F.Wdn_t = (bf16*)(ws + WS_WDN);
    F.XN = (bf16*)(ws + WS_XN); F.MIX = (bf16*)(ws + WS_MIX); F.PROJ = (bf16*)(ws + WS_PROJ);
    F.ROPE = (float2*)(ws + WS_ROPE); F.GATES = (float*)(ws + WS_GATES); F.SSQ = (float*)(ws + WS_SSQ); F.SEG = (float*)(ws + WS_SEG); F.WBG = ws + WS_WBG;
    for (int u = F.tid; u < (LDS_BYTES - LDSCTL_OFF) / 4; u += NWAVES * 64) ((LAS unsigned*)(F.lds + LDSCTL_OFF))[u] = 0u;
    __syncthreads();
    const int lo = args.ph_lo, hi = args.ph_hi;
    XcdBarrier bar; bar.bar = (unsigned*)(F.ctl + CW_BAR) + args.li * XCD_BAR_WORDS; bar.x = 0; bar.st = nullptr;
    if (hi - lo > 1) bar = xcd_barrier_post((unsigned*)(F.ctl + CW_BAR) + args.li * XCD_BAR_WORDS, F.MISC + 8);
#define IN(k) (lo <= (k) && (k) < hi)
#define BOTH(k) (IN(k) && IN((k) + 1))
#define GRID_BAR() xcd_barrier(bar)

#ifndef DOUBLE_PHASE
#define DOUBLE_PHASE -1
#endif
#define RUN_PHASE(k, BODY) if (IN(k)) { { int t_ = threadIdx.x; asm volatile("" : "+v"(t_)); F.tid = t_; F.lane = t_ & 63; }     \
    BODY; if (DOUBLE_PHASE == (k)) { GRID_BAR(); BODY; } if (BOTH(k)) GRID_BAR(); }
#define PH0 p0_prologue(F)
#define PH1 do { pg8::Gemm g{F.XN, F.Win_t, T, NPROJ, DM}; pg8::StaticOrder S; S.init(T, NPROJ, F.G, (int)blockIdx.x); pg8::EpiStoreBf16 E{F.PROJ, NPROJ}; \
        pg8::gemm_phase<pg8::EpiStoreBf16, pg8::StaticOrder, true, true>(F.lds, g, S, E); \
        { const int nwg_ = (T / 256) * (NPROJ / 256), rem_ = nwg_ % F.G;               \
          if (rem_ == 0) p1_side_work(F, (int)blockIdx.x, F.G); else if ((int)blockIdx.x >= rem_) p1_side_work(F, (int)blockIdx.x - rem_, F.G - rem_); } } while (0)
#ifdef H1_BF16
#define PH4 do { pg8::Gemm g{F.MIX, F.Wout_t, T, DM, DM}; pg8::StaticOrder S; S.init(T, DM, F.G, (int)blockIdx.x); pg8::EpiResidNormBS E{F.x, F.XN, F.SSQ}; \
        pg8::gemm_phase<pg8::EpiResidNormBS, pg8::StaticOrder, true, true>(F.lds, g, S, E); } while (0)
#define PH6 do { pg8::Gemm g{F.PROJ, F.Wdn_t, T, DM, DFF}; pg8::StaticOrder S; S.init(T, DM, F.G, (int)blockIdx.x); pg8::EpiResidOutB E{F.XN, F.out}; \
        pg8::gemm_phase<pg8::EpiResidOutB, pg8::StaticOrder, true, true>(F.lds, g, S, E); } while (0)
#else
#define PH4 do { pg8::Gemm g{F.MIX, F.Wout_t, T, DM, DM}; pg8::StaticOrder S; S.init(T, DM, F.G, (int)blockIdx.x); pg8::EpiResidNorm E{F.x, F.out, F.XN, F.SSQ}; \
        pg8::gemm_phase<pg8::EpiResidNorm, pg8::StaticOrder, true, true>(F.lds, g, S, E); } while (0)
#define PH6 do { pg8::Gemm g{F.PROJ, F.Wdn_t, T, DM, DFF}; pg8::StaticOrder S; S.init(T, DM, F.G, (int)blockIdx.x); pg8::EpiResidOut E{F.out, F.out}; \
        pg8::gemm_phase<pg8::EpiResidOut, pg8::StaticOrder, true, true>(F.lds, g, S, E); } while (0)
#endif
#define PH5 do { pg8::Gemm g{F.XN, F.Wgu_t, T, 2 * DFF, DM}; pg8::StaticOrder S; S.init(T, 2 * DFF, F.G, (int)blockIdx.x); pg8::EpiSwiGLU E{F.PROJ, DFF, F.SSQ, EPS}; \
        pg8::gemm_phase<pg8::EpiSwiGLU, pg8::StaticOrder, P5_ALIGN, true>(F.lds, g, S, E); } while (0)
    RUN_PHASE(0, PH0)
    RUN_PHASE(1, PH1)
    RUN_PHASE(2, PHASE2_BODY)
    RUN_PHASE(3, PHASE3_BODY)
    RUN_PHASE(4, PH4)
    RUN_PHASE(5, PH5)
    RUN_PHASE(6, PH6)
#undef IN
#undef BOTH
}
extern "C" void kernel_launch(void* const* d_in, const int* in_sizes, int n_in, void* d_out, int out_size, void* d_ws, size_t ws_size, hipStream_t stream) {
    static int grid = 0;
    if (grid == 0) {
        if (n_in != 15 || in_sizes[0] != T * DM || out_size != T * DM || ws_size < WS_END) { fprintf(stderr, "kernel_launch: unexpected shapes / workspace (n_in %d, ws %zu)\n", n_in, ws_size); grid = -1; return; }
        int dev = 0, cus = 0, per_cu = 0;
        if (hipGetDevice(&dev) != hipSuccess || hipDeviceGetAttribute(&cus, hipDeviceAttributeMultiprocessorCount, dev) != hipSuccess) { grid = -1; return; }
        if (hipFuncSetAttribute((const void*)mk_fwd, hipFuncAttributeMaxDynamicSharedMemorySize, LDS_BYTES) != hipSuccess) { fprintf(stderr, "kernel_launch: hipFuncSetAttribute failed\n"); grid = -1; return; }
        if (hipOccupancyMaxActiveBlocksPerMultiprocessor(&per_cu, (const void*)mk_fwd, NWAVES * 64, LDS_BYTES) != hipSuccess || per_cu < 1) { fprintf(stderr, "kernel_launch: occupancy query says %d blocks per CU\n", per_cu); grid = -1; (void)hipGetLastError(); return; }
        grid = cus;
    }
    if (grid < 0) return;
    (void)hipMemsetAsync((char*)d_ws + WS_CTL, 0, CTL_ZERO_BYTES, stream);
    Args a{};
    for (int i = 0; i < 15; ++i) a.in[i] = (const float*)d_in[i];
    a.out = (float*)d_out; a.ws = (unsigned char*)d_ws;
    LAUNCH_PROGRAM
}
```

```cpp
#define SADDR_SEL 114
#include <hip/hip_runtime.h>
#include <cstdio>
#include <cstdint>
__device__ __forceinline__ int fresh_lane() { return (int)__builtin_amdgcn_mbcnt_hi(~0u, __builtin_amdgcn_mbcnt_lo(~0u, 0u)); }
namespace pg8 {
#define PG8_LAS __attribute__((address_space(3)))
typedef unsigned short bf16_t;
typedef short bf16x8 __attribute__((ext_vector_type(8)));
typedef float f32x4 __attribute__((ext_vector_type(4)));
typedef unsigned u32x4 __attribute__((ext_vector_type(4)));
constexpr int BM = 256, BK = 64, HALF = 128, HTB = HALF * BK * 2  , STAGE_BYTES = 8 * HTB, NXCD = 8, WGM = 8;

__host__ __device__ __forceinline__ int lds_byte(int r, int c) { const int st = (r >> 4) * 2 + (c >> 5), rr = r & 15, cc = c & 31, ob = rr * 64 + cc * 2; return st * 1024 + (ob ^ (((ob >> 9) & 1) << 5)); }
__host__ __device__ __forceinline__ void stage_rc(int b, int& R, int& C) { const int st = b / 1024, sb = b % 1024, swz = sb ^ (((sb >> 9) & 1) << 5); R = (st >> 1) * 16 + swz / 64; C = (st & 1) * 32 + (swz % 64) / 2; }
__host__ __device__ __forceinline__ int perm32(int rho) { const int n = rho >> 4, i = rho & 15; return 8 * (i >> 2) + 4 * n + (i & 3); }

struct Unit { int pm, pn; };
struct Gemm { const bf16_t* A; const bf16_t* Bt; int M, N, K; };

struct StaticOrder {
    int nM, nN, nwg, G, c;
    __host__ __device__ void init(int M, int N, int G_, int c_) { nM = M / BM; nN = N / BM; nwg = nM * nN; G = G_; c = c_; }
    __host__ __device__ bool next(int i, Unit& u) const {
        const long L = (long)i * G + c; if (L >= nwg) return false;
        int wgid = (int)L; { const int q = nwg / NXCD, r = nwg % NXCD, xcd = wgid % NXCD, off = wgid / NXCD; wgid = (xcd < r ? xcd * (q + 1) : r * (q + 1) + (xcd - r) * q) + off; }
        const int nig = WGM * nN, gid = wgid / nig, fm = gid * WGM, gsz = (nM - fm) < WGM ? (nM - fm) : WGM;
        u.pm = fm + ((wgid % nig) % gsz); u.pn = (wgid % nig) / gsz; return true;
    }
    __device__ __forceinline__ void a_ready(const Unit&) const {}
    __device__ __forceinline__ void done(const Unit&) const {}
};

__device__ __forceinline__ unsigned cvt_pk_bf16(float lo, float hi) { unsigned r; asm volatile("v_cvt_pk_bf16_f32 %0, %1, %2" : "=v"(r) : "v"(lo), "v"(hi)); return r; }
typedef float f32x2 __attribute__((ext_vector_type(2)));
#ifndef SADDR_SEL
#define SADDR_SEL 0
#endif
#ifndef PROBE_SEL
#define PROBE_SEL 0
#endif
#ifdef WT_STORES
__device__ __forceinline__ void st16(void* p, u32x4 v) { asm volatile("global_store_dwordx4 %0, %1, off sc1\n\ts_nop 1" :: "v"(p), "v"(v) : "memory"); }
#else
__device__ __forceinline__ void st16(void* p, u32x4 v) { *(u32x4*)p = v; }
#endif
__device__ __forceinline__ float fast_silu(float v) { return v * __builtin_amdgcn_rcpf(1.0f + __builtin_amdgcn_exp2f(v * -1.4426950408889634f)); }
struct EpiStoreBf16 {
    static constexpr bool SADDR = (SADDR_SEL & 2) != 0, PROBE2 = (PROBE_SEL == 1), PERM = true, AFTER_DRAIN = false, STREAM_R = false, STREAM_BF16 = false;
    bf16_t* O; int ldc; int sg0, sg1;
    template <bool SIG> __device__ __forceinline__ void body(const f32x4 (&acc)[2][2][4][2], const Unit& u, int wr, int wc, int fr, int fq) const {
        const int row0 = u.pm * BM + wr * 64 + fr, col0 = u.pn * BM + wc * 32 + 8 * fq;
#pragma unroll
        for (int ai = 0; ai < 2; ++ai)
#pragma unroll
            for (int m = 0; m < 4; ++m) { bf16_t* rowp = O + (size_t)(row0 + ai * HALF + m * 16) * ldc + col0;
#pragma unroll
                for (int bj = 0; bj < 2; ++bj) { f32x4 v0 = acc[ai][bj][m][0], v1 = acc[ai][bj][m][1];
                    if (SIG) {
#pragma unroll
                        for (int j = 0; j < 4; ++j) { v0[j] = __builtin_amdgcn_rcpf(1.0f + __builtin_amdgcn_exp2f(v0[j] * -1.4426950408889634f));
                                                      v1[j] = __builtin_amdgcn_rcpf(1.0f + __builtin_amdgcn_exp2f(v1[j] * -1.4426950408889634f)); } }
                    u32x4 w; w.x = cvt_pk_bf16(v0[0], v0[1]); w.y = cvt_pk_bf16(v0[2], v0[3]); w.z = cvt_pk_bf16(v1[0], v1[1]); w.w = cvt_pk_bf16(v1[2], v1[3]);
                    st16(rowp + bj * HALF, w); } }
    }
    __device__ __forceinline__ void operator()(const f32x4 (&acc)[2][2][4][2], const Unit& u, int wr, int wc, int fr, int fq) const {
        if (u.pn >= sg0 && u.pn < sg1) body<true>(acc, u, wr, wc, fr, fq); else body<false>(acc, u, wr, wc, fr, fq);
    }
};
struct EpiResidNorm {
    static constexpr bool SADDR = false, PROBE2 = false, PERM = true, AFTER_DRAIN = false, STREAM_R = false, STREAM_BF16 = false;
    const float* X; float* H; bf16_t* HB; float* SSQ;
    __device__ __forceinline__ void operator()(const f32x4 (&acc)[2][2][4][2], const Unit& u, int wr, int wc, int fr, int fq) const {
        const int row0 = u.pm * BM + wr * 64 + fr, col0 = u.pn * BM + wc * 32 + 8 * fq;
#pragma unroll
        for (int ai = 0; ai < 2; ++ai)
#pragma unroll
            for (int m = 0; m < 4; ++m) { const int row = row0 + ai * HALF + m * 16; const size_t off = (size_t)row * 1024 + col0; float ss = 0.f;
#pragma unroll
                for (int bj = 0; bj < 2; ++bj) { const f32x4 x0 = *(const f32x4*)(X + off + bj * HALF), x1 = *(const f32x4*)(X + off + bj * HALF + 4);
                    const f32x4 v0 = x0 + acc[ai][bj][m][0], v1 = x1 + acc[ai][bj][m][1];
                    *(f32x4*)(H + off + bj * HALF) = v0; *(f32x4*)(H + off + bj * HALF + 4) = v1;
                    u32x4 w; w.x = cvt_pk_bf16(v0[0], v0[1]); w.y = cvt_pk_bf16(v0[2], v0[3]); w.z = cvt_pk_bf16(v1[0], v1[1]); w.w = cvt_pk_bf16(v1[2], v1[3]);
                    *(u32x4*)(HB + off + bj * HALF) = w;
                    ss += (v0[0] * v0[0] + v0[1] * v0[1]) + (v0[2] * v0[2] + v0[3] * v0[3]) + (v1[0] * v1[0] + v1[1] * v1[1]) + (v1[2] * v1[2] + v1[3] * v1[3]); }
                ss += __shfl_xor(ss, 16); ss += __shfl_xor(ss, 32);
                if (fq == 0) SSQ[(size_t)row * 16 + u.pn * 4 + wc] = ss; }
    }
};
struct EpiSwiGLU {
    static constexpr bool SADDR = (SADDR_SEL & 32) != 0, PROBE2 = (PROBE_SEL == 5), PERM = true, AFTER_DRAIN = false, STREAM_R = false, STREAM_BF16 = false;
    bf16_t* O; int ldc; const float* SSQ; float eps;
    __device__ __forceinline__ void operator()(const f32x4 (&acc)[2][2][4][2], const Unit& u, int wr, int wc, int fr, int fq) const {
        const int row0 = u.pm * BM + wr * 64 + fr, col0 = u.pn * HALF + wc * 32 + 8 * fq;
        float rsv[8];
        { f32x4 sv[8];
#pragma unroll
          for (int grp = 0; grp < 8; ++grp) sv[grp] = *(const f32x4*)(SSQ + (size_t)(row0 + (grp >> 2) * HALF + (grp & 3) * 16) * 16 + 4 * fq);
#pragma unroll
          for (int grp = 0; grp < 8; ++grp) { float t = (sv[grp][0] + sv[grp][1]) + (sv[grp][2] + sv[grp][3]); t += __shfl_xor(t, 16); t += __shfl_xor(t, 32);
              rsv[grp] = __builtin_amdgcn_rsqf(t * (1.0f / 1024.0f) + eps); } }
#pragma unroll
        for (int grp = 0; grp < 8; ++grp) { const int ai = grp >> 2, m = grp & 3; const int row = row0 + ai * HALF + m * 16;
            const float rs = rsv[grp];
            float h[8];
#pragma unroll
            for (int n = 0; n < 2; ++n)
#pragma unroll
                for (int j = 0; j < 4; ++j) { const float g = acc[ai][0][m][n][j] * rs, up = acc[ai][1][m][n][j] * rs; h[n * 4 + j] = fast_silu(g) * up; }
            u32x4 w; w.x = cvt_pk_bf16(h[0], h[1]); w.y = cvt_pk_bf16(h[2], h[3]); w.z = cvt_pk_bf16(h[4], h[5]); w.w = cvt_pk_bf16(h[6], h[7]);
            st16(O + (size_t)row * ldc + col0, w); }
    }
};
struct EpiResidOut {
    static constexpr bool SADDR = false, PROBE2 = false, PERM = true, AFTER_DRAIN = false, STREAM_R = false, STREAM_BF16 = false;
    const float* R; float* OUT;
    __device__ __forceinline__ void operator()(const f32x4 (&acc)[2][2][4][2], const Unit& u, int wr, int wc, int fr, int fq) const {
        const int row0 = u.pm * BM + wr * 64 + fr, col0 = u.pn * BM + wc * 32 + 8 * fq;
#pragma unroll
        for (int ai = 0; ai < 2; ++ai)
#pragma unroll
            for (int m = 0; m < 4; ++m) { const size_t off = (size_t)(row0 + ai * HALF + m * 16) * 1024 + col0;
#pragma unroll
                for (int bj = 0; bj < 2; ++bj) { const f32x4 r0 = *(const f32x4*)(R + off + bj * HALF), r1 = *(const f32x4*)(R + off + bj * HALF + 4);
                    *(f32x4*)(OUT + off + bj * HALF) = r0 + acc[ai][bj][m][0]; *(f32x4*)(OUT + off + bj * HALF + 4) = r1 + acc[ai][bj][m][1]; } }
    }
};
struct EpiResidNormB {
    static constexpr bool SADDR = false, PROBE2 = false, PERM = true, AFTER_DRAIN = false, STREAM_R = false, STREAM_BF16 = false;
    const float* X; bf16_t* HB; float* SSQ;
    __device__ __forceinline__ void operator()(const f32x4 (&acc)[2][2][4][2], const Unit& u, int wr, int wc, int fr, int fq) const {
        const int row0 = u.pm * BM + wr * 64 + fr, col0 = u.pn * BM + wc * 32 + 8 * fq;
#pragma unroll
        for (int ai = 0; ai < 2; ++ai)
#pragma unroll
            for (int m = 0; m < 4; ++m) { const int row = row0 + ai * HALF + m * 16; const size_t off = (size_t)row * 1024 + col0; float ss = 0.f;
#pragma unroll
                for (int bj = 0; bj < 2; ++bj) { const f32x4 x0 = *(const f32x4*)(X + off + bj * HALF), x1 = *(const f32x4*)(X + off + bj * HALF + 4);
                    const f32x4 v0 = x0 + acc[ai][bj][m][0], v1 = x1 + acc[ai][bj][m][1];
                    u32x4 w; w.x = cvt_pk_bf16(v0[0], v0[1]); w.y = cvt_pk_bf16(v0[2], v0[3]); w.z = cvt_pk_bf16(v1[0], v1[1]); w.w = cvt_pk_bf16(v1[2], v1[3]);
                    *(u32x4*)(HB + off + bj * HALF) = w;
                    ss += (v0[0] * v0[0] + v0[1] * v0[1]) + (v0[2] * v0[2] + v0[3] * v0[3]) + (v1[0] * v1[0] + v1[1] * v1[1]) + (v1[2] * v1[2] + v1[3] * v1[3]); }
                ss += __shfl_xor(ss, 16); ss += __shfl_xor(ss, 32);
                if (fq == 0) SSQ[(size_t)row * 16 + u.pn * 4 + wc] = ss; }
    }
};
struct EpiResidOutB {
    static constexpr bool SADDR = (SADDR_SEL & 64) != 0, PROBE2 = (PROBE_SEL == 6), PERM = true, AFTER_DRAIN = false, STREAM_R = false, STREAM_BF16 = false;
    const bf16_t* RB; float* OUT;
    __device__ __forceinline__ void operator()(const f32x4 (&acc)[2][2][4][2], const Unit& u, int wr, int wc, int fr, int fq) const {
        const int row0 = u.pm * BM + wr * 64 + fr, col0 = u.pn * BM + wc * 32 + 8 * fq;
        u32x4 rw[2][4][2];
#pragma unroll
        for (int ai = 0; ai < 2; ++ai)
#pragma unroll
            for (int m = 0; m < 4; ++m) { const size_t off = (size_t)(row0 + ai * HALF + m * 16) * 1024 + col0;
#pragma unroll
                for (int bj = 0; bj < 2; ++bj) rw[ai][m][bj] = *(const u32x4*)(RB + off + bj * HALF); }
        asm volatile("" ::: "memory");
#pragma unroll
        for (int ai = 0; ai < 2; ++ai)
#pragma unroll
            for (int m = 0; m < 4; ++m) { const size_t off = (size_t)(row0 + ai * HALF + m * 16) * 1024 + col0;
#pragma unroll
                for (int bj = 0; bj < 2; ++bj) { const u32x4 w = rw[ai][m][bj];
                    const f32x4 r0 = (f32x4){__builtin_bit_cast(float, w.x << 16), __builtin_bit_cast(float, w.x & 0xffff0000u), __builtin_bit_cast(float, w.y << 16), __builtin_bit_cast(float, w.y & 0xffff0000u)};
                    const f32x4 r1 = (f32x4){__builtin_bit_cast(float, w.z << 16), __builtin_bit_cast(float, w.z & 0xffff0000u), __builtin_bit_cast(float, w.w << 16), __builtin_bit_cast(float, w.w & 0xffff0000u)};
                    *(f32x4*)(OUT + off + bj * HALF) = r0 + acc[ai][bj][m][0]; *(f32x4*)(OUT + off + bj * HALF + 4) = r1 + acc[ai][bj][m][1]; } }
    }
};
struct EpiResidNormBS {
    static constexpr bool SADDR = (SADDR_SEL & 16) != 0, PROBE2 = (PROBE_SEL == 4), PERM = true, AFTER_DRAIN = false, STREAM_R = true, STREAM_BF16 = false;
    const float* RS; bf16_t* HB; float* SSQ;
    __device__ __forceinline__ void operator()(const f32x4 (&acc)[2][2][4][2], const Unit& u, int wr, int wc, int fr, int fq) const {
        const int row0 = u.pm * BM + wr * 64 + fr, col0 = u.pn * BM + wc * 32 + 8 * fq;
#pragma unroll
        for (int ai = 0; ai < 2; ++ai)
#pragma unroll
            for (int m = 0; m < 4; ++m) { const int row = row0 + ai * HALF + m * 16; const size_t off = (size_t)row * 1024 + col0; float ss = 0.f;
#pragma unroll
                for (int bj = 0; bj < 2; ++bj) { const f32x4 v0 = acc[ai][bj][m][0], v1 = acc[ai][bj][m][1];
                    u32x4 w; w.x = cvt_pk_bf16(v0[0], v0[1]); w.y = cvt_pk_bf16(v0[2], v0[3]); w.z = cvt_pk_bf16(v1[0], v1[1]); w.w = cvt_pk_bf16(v1[2], v1[3]);
                    st16(HB + off + bj * HALF, w);
                    ss += (v0[0] * v0[0] + v0[1] * v0[1]) + (v0[2] * v0[2] + v0[3] * v0[3]) + (v1[0] * v1[0] + v1[1] * v1[1]) + (v1[2] * v1[2] + v1[3] * v1[3]); }
                ss += __shfl_xor(ss, 16); ss += __shfl_xor(ss, 32);
                if (fq == 0) SSQ[(size_t)row * 16 + u.pn * 4 + wc] = ss; }
    }
};
struct EpiResidOutBS {
    static constexpr bool SADDR = (SADDR_SEL & 64) != 0, PROBE2 = false, PERM = true, AFTER_DRAIN = false, STREAM_R = true, STREAM_BF16 = true;
    const bf16_t* RS; float* OUT;
    __device__ __forceinline__ void operator()(const f32x4 (&acc)[2][2][4][2], const Unit& u, int wr, int wc, int fr, int fq) const {
        const int row0 = u.pm * BM + wr * 64 + fr, col0 = u.pn * BM + wc * 32 + 8 * fq;
#pragma unroll
        for (int ai = 0; ai < 2; ++ai)
#pragma unroll
            for (int m = 0; m < 4; ++m) { const size_t off = (size_t)(row0 + ai * HALF + m * 16) * 1024 + col0;
#pragma unroll
                for (int bj = 0; bj < 2; ++bj) { *(f32x4*)(OUT + off + bj * HALF) = acc[ai][bj][m][0]; *(f32x4*)(OUT + off + bj * HALF + 4) = acc[ai][bj][m][1]; } }
    }
};
#ifdef PROBE_EPI2
#define PG8_EPI_TWICE if constexpr (Epi::PROBE2) { asm volatile("" ::: "memory"); E(acc, cur, wr, wc, fr, fq); }
#else
#define PG8_EPI_TWICE
#endif
template <class Epi, class Sched, bool ALIGN_EPI = false, bool SP2 = false>
__device__ __forceinline__ void gemm_phase(PG8_LAS unsigned char* lds, const Gemm g, const Sched& S, const Epi& E) {
    const int tid = threadIdx.x, wid = __builtin_amdgcn_readfirstlane(tid >> 6), lane = tid & 63, wr = wid >> 2, wc = wid & 3, fr = lane & 15, fq = lane >> 4;
    const int K = g.K, nt = K / BK;
    unsigned voffA[2], voffB[2];
#pragma unroll
    for (int i = 0; i < 2; ++i) { int R, C; stage_rc(tid * 16 + i * 8192, R, C); const int Rb = Epi::PERM ? ((R & ~31) + perm32(R & 31)) : R;
        voffA[i] = (unsigned)(R * K + C) * 2u; voffB[i] = (unsigned)(Rb * K + C) * 2u; }
    const size_t kstep = (size_t)(BK * 2);
    const size_t hstep = (size_t)HALF * K * 2;
    const size_t tstep = 2 * hstep;
    const unsigned ldsw = (unsigned)wid * 1024u;
    int wrv = wr, wcv = wc; asm volatile("" : "+v"(wrv), "+v"(wcv));
    const int aoff = lds_byte(wrv * 64 + fr, fq * 8), boff = lds_byte(wcv * 32 + fr, fq * 8);
#define PG8_SA(b, h) (((b) * 2 + (h)) * HTB)
#define PG8_SB(b, h) ((4 + (b) * 2 + (h)) * HTB)
#define PG8_STAGE(bufoff, gbase, voff) do { const char* gb_ = (const char*)(gbase); if constexpr (Epi::SADDR) asm volatile("" : "+s"(gb_));     \
        _Pragma("unroll") for (int _i = 0; _i < 2; ++_i) \
        __builtin_amdgcn_global_load_lds((const unsigned*)(gb_ + (voff)[_i]), (PG8_LAS unsigned*)(lds + (bufoff) + ldsw + _i * 8192), 16, 0, 0); } while (0)
#define PG8_PIN() do { if constexpr (Epi::SADDR) asm volatile("" : "+v"(voffA[0]), "+v"(voffA[1]), "+v"(voffB[0]), "+v"(voffB[1]), "+v"(rvo)); } while (0)
#define PG8_LDA(dst, b, h) do { _Pragma("unroll") for (int m = 0; m < 4; ++m) _Pragma("unroll") for (int k = 0; k < 2; ++k) dst[m][k] = *(const PG8_LAS bf16x8*)(lds + PG8_SA(b, h) + aoff + m * 2048 + k * 1024); } while (0)
#define PG8_LDB(dst, b, h) do { _Pragma("unroll") for (int n = 0; n < 2; ++n) _Pragma("unroll") for (int k = 0; k < 2; ++k) dst[n][k] = *(const PG8_LAS bf16x8*)(lds + PG8_SB(b, h) + boff + n * 2048 + k * 1024); } while (0)
#define PG8_MMA(ai, bj, At, Bt) do { __builtin_amdgcn_s_setprio(1); _Pragma("unroll") for (int m = 0; m < 4; ++m) _Pragma("unroll") for (int n = 0; n < 2; ++n) _Pragma("unroll") for (int k = 0; k < 2; ++k) \
        acc[ai][bj][m][n] = __builtin_amdgcn_mfma_f32_16x16x32_bf16(Bt[n][k], At[m][k], acc[ai][bj][m][n], 0, 0, 0); __builtin_amdgcn_s_setprio(0); } while (0)
#define PG8_WAIT_V(n) asm volatile("s_waitcnt vmcnt(" #n ")" ::: "memory")
#define PG8_WAIT_L(n) asm volatile("s_waitcnt lgkmcnt(" #n ")" ::: "memory")
#define PG8_BAR __builtin_amdgcn_s_barrier()
#define PG8_SCHED __builtin_amdgcn_sched_barrier(0)
#define PG8_PIECE_OFF 147456
#define PG8_RLOAD_P(p) do { if constexpr (Epi::STREAM_BF16) { \
            const char* rb_ = rcur + (size_t)((((((p) >> 3) & 1) * HALF + (((p) >> 1) & 3) * 16) * 1024 + ((p) & 1) * HALF) * 2); if constexpr (Epi::SADDR) asm volatile("" : "+s"(rb_)); \
            __builtin_amdgcn_global_load_lds((const unsigned*)(rb_ + rvo), (PG8_LAS unsigned*)(lds + PG8_PIECE_OFF + wid * 2048), 16, 0, 0); \
        } else { \
            const char* rb_ = rcur + (size_t)((((((p) >> 3) & 1) * HALF + (((p) >> 1) & 3) * 16) * 1024 + ((p) & 1) * HALF) * 4); if constexpr (Epi::SADDR) asm volatile("" : "+s"(rb_)); \
            __builtin_amdgcn_global_load_lds((const unsigned*)(rb_ + rvo), (PG8_LAS unsigned*)(lds + PG8_PIECE_OFF + wid * 2048), 16, 0, 0); \
            const char* rc_ = rb_ + 16; if constexpr (Epi::SADDR) asm volatile("" : "+s"(rc_)); \
            __builtin_amdgcn_global_load_lds((const unsigned*)(rc_ + rvo), (PG8_LAS unsigned*)(lds + PG8_PIECE_OFF + wid * 2048 + 1024), 16, 0, 0); } } while (0)
#define PG8_RADD_P(p) do { if constexpr (Epi::STREAM_BF16) { typedef unsigned u32x2_ __attribute__((ext_vector_type(2))); \
            { const u32x2_ w_ = *(const PG8_LAS u32x2_*)(lds + PG8_PIECE_OFF + wid * 2048 + lane * 16); \
              acc[((p) >> 3) & 1][(p) & 1][((p) >> 1) & 3][0] += (f32x4){__builtin_bit_cast(float, w_.x << 16), __builtin_bit_cast(float, w_.x & 0xffff0000u), __builtin_bit_cast(float, w_.y << 16), __builtin_bit_cast(float, w_.y & 0xffff0000u)}; } \
            asm volatile("" ::: "memory"); \
            { const u32x2_ w_ = *(const PG8_LAS u32x2_*)(lds + PG8_PIECE_OFF + wid * 2048 + lane * 16 + 8); \
              acc[((p) >> 3) & 1][(p) & 1][((p) >> 1) & 3][1] += (f32x4){__builtin_bit_cast(float, w_.x << 16), __builtin_bit_cast(float, w_.x & 0xffff0000u), __builtin_bit_cast(float, w_.y << 16), __builtin_bit_cast(float, w_.y & 0xffff0000u)}; } \
        } else { { const f32x4 q0_ = *(const PG8_LAS f32x4*)(lds + PG8_PIECE_OFF + wid * 2048 + lane * 16); acc[((p) >> 3) & 1][(p) & 1][((p) >> 1) & 3][0] += q0_; } asm volatile("" ::: "memory"); \
        { const f32x4 q1_ = *(const PG8_LAS f32x4*)(lds + PG8_PIECE_OFF + wid * 2048 + 1024 + lane * 16); acc[((p) >> 3) & 1][(p) & 1][((p) >> 1) & 3][1] += q1_; } } } while (0)
#define PG8_WAIT_V1P() do { if constexpr (Epi::STREAM_BF16) PG8_WAIT_V(9); else PG8_WAIT_V(10); } while (0)
#define PG8_KPAIR(t, P0_, P1_) do { \
            PG8_PIN(); \
            const bool last = ((t) == nt - 2); \
            const char* a1 = cA + (size_t)((t) + 1) * kstep; \
            const char* a2 = last ? nA : cA + (size_t)((t) + 2) * kstep; const char* b2 = last ? nB : cB + (size_t)((t) + 2) * kstep; \
            const char* a3 = a2 + kstep; const char* b3 = b2 + kstep; \
            if (last && has_next) S.a_ready(nxt); \
            if constexpr ((P0_) >= 0) PG8_RLOAD_P(P0_); \
            PG8_LDB(B0, 0, 0); PG8_LDB(B1, 0, 1); PG8_SCHED; PG8_LDA(At, 0, 0); PG8_STAGE(PG8_SA(1, 1), a1 + hstep, voffA); \
            if constexpr ((P0_) >= 0) PG8_WAIT_V1P(); else PG8_WAIT_V(8); \
            PG8_WAIT_L(0); PG8_BAR; PG8_MMA(0, 0, At, B0); PG8_MMA(0, 1, At, B1); PG8_BAR; PG8_SCHED; \
            PG8_LDA(At, 0, 1); PG8_STAGE(PG8_SB(0, 0), b2, voffB); PG8_STAGE(PG8_SB(0, 1), b2 + hstep, voffB); PG8_STAGE(PG8_SA(0, 0), a2, voffA); \
            PG8_WAIT_V(8); PG8_WAIT_L(0); PG8_BAR; if constexpr ((P0_) >= 0) PG8_RADD_P(P0_); PG8_MMA(1, 0, At, B0); PG8_MMA(1, 1, At, B1); PG8_BAR; PG8_SCHED; \
            if constexpr ((P1_) >= 0) PG8_RLOAD_P(P1_); \
            PG8_LDB(B0, 1, 0); PG8_LDB(B1, 1, 1); PG8_SCHED; PG8_LDA(At, 1, 0); PG8_STAGE(PG8_SA(0, 1), a2 + hstep, voffA); \
            if constexpr ((P1_) >= 0) PG8_WAIT_V1P(); else PG8_WAIT_V(8); \
            PG8_WAIT_L(0); PG8_BAR; PG8_MMA(0, 0, At, B0); PG8_MMA(0, 1, At, B1); PG8_BAR; PG8_SCHED; \
            PG8_LDA(At, 1, 1); PG8_STAGE(PG8_SB(1, 0), b3, voffB); PG8_STAGE(PG8_SB(1, 1), b3 + hstep, voffB); PG8_STAGE(PG8_SA(1, 0), a3, voffA); \
            PG8_WAIT_V(8); PG8_WAIT_L(0); PG8_BAR; if constexpr ((P1_) >= 0) PG8_RADD_P(P1_); PG8_MMA(1, 0, At, B0); PG8_MMA(1, 1, At, B1); PG8_BAR; PG8_SCHED; \
        } while (0)
    Unit cur, nxt; int ui = 0;
    if (!S.next(0, cur)) return;
    f32x4 acc[2][2][4][2];
#pragma unroll
    for (int a = 0; a < 2; ++a)
#pragma unroll
        for (int b = 0; b < 2; ++b)
#pragma unroll
            for (int m = 0; m < 4; ++m)
#pragma unroll
                for (int n = 0; n < 2; ++n) acc[a][b][m][n] = (f32x4){0.f, 0.f, 0.f, 0.f};
    bf16x8 At[4][2], B0[2][2], B1[2][2];
    const char* rcur = nullptr;
    const unsigned rvoff = (unsigned)(((wr * 64 + fr) * 1024 + wc * 32 + 8 * fq) * 4);
    unsigned rvo = Epi::STREAM_BF16 ? (rvoff >> 1) : rvoff;
#define PG8_RCUR(u_) do { if constexpr (Epi::STREAM_R) rcur = (const char*)E.RS + ((size_t)((u_).pm * BM) * 1024 + (u_).pn * BM) * (Epi::STREAM_BF16 ? 2 : 4); } while (0)
    PG8_RCUR(cur);
    const char* cA = (const char*)g.A + (size_t)cur.pm * tstep; const char* cB = (const char*)g.Bt + (size_t)cur.pn * tstep;
    S.a_ready(cur);
    PG8_PIN();
    if constexpr (SP2) {
        PG8_STAGE(PG8_SB(0, 0), cB, voffB); PG8_STAGE(PG8_SB(0, 1), cB + hstep, voffB); PG8_STAGE(PG8_SA(0, 0), cA, voffA); PG8_STAGE(PG8_SA(0, 1), cA + hstep, voffA);
        if (wr == 1) PG8_BAR;
        PG8_PIN();
        PG8_WAIT_V(2); PG8_BAR;
        PG8_STAGE(PG8_SB(1, 0), cB + kstep, voffB); PG8_STAGE(PG8_SA(1, 0), cA + kstep, voffA); PG8_STAGE(PG8_SB(1, 1), cB + hstep + kstep, voffB);
        PG8_WAIT_V(6); PG8_BAR;
    } else {
        PG8_STAGE(PG8_SB(0, 0), cB, voffB); PG8_STAGE(PG8_SA(0, 0), cA, voffA); PG8_STAGE(PG8_SB(0, 1), cB + hstep, voffB); PG8_STAGE(PG8_SA(0, 1), cA + hstep, voffA);
        if (wr == 1) PG8_BAR;
        PG8_PIN();
        PG8_WAIT_V(4); PG8_BAR;
        PG8_STAGE(PG8_SB(1, 0), cB + kstep, voffB); PG8_STAGE(PG8_SA(1, 0), cA + kstep, voffA); PG8_STAGE(PG8_SB(1, 1), cB + hstep + kstep, voffB);
        PG8_WAIT_V(6); PG8_BAR;
    }
    for (;;) {
        const bool has_next = S.next(ui + 1, nxt);
        const char* nA = has_next ? (const char*)g.A + (size_t)nxt.pm * tstep : cA; const char* nB = has_next ? (const char*)g.Bt + (size_t)nxt.pn * tstep : cB;
        if constexpr (SP2 && Epi::STREAM_R) {
            PG8_KPAIR(0, 0, 1); PG8_KPAIR(2, 2, 3); PG8_KPAIR(4, 4, 5); PG8_KPAIR(6, 6, 7); PG8_KPAIR(8, 8, 9); PG8_KPAIR(10, 10, 11); PG8_KPAIR(12, 12, 13); PG8_KPAIR(14, 14, 15);
#pragma unroll 1
            for (int t = 16; t < nt; t += 2) PG8_KPAIR(t, -1, -1);
        } else
        for (int t = 0; t < nt; t += 2) {
            PG8_PIN();
            const bool last = (t == nt - 2);
            const char* a1 = cA + (size_t)(t + 1) * kstep;
            const char* a2 = last ? nA : cA + (size_t)(t + 2) * kstep; const char* b2 = last ? nB : cB + (size_t)(t + 2) * kstep;
            const char* a3 = a2 + kstep; const char* b3 = b2 + kstep;
            if (last && has_next) S.a_ready(nxt);
            if constexpr (SP2) {
            PG8_LDB(B0, 0, 0); PG8_LDB(B1, 0, 1); PG8_SCHED; PG8_LDA(At, 0, 0); PG8_STAGE(PG8_SA(1, 1), a1 + hstep, voffA);
            PG8_WAIT_V(8); PG8_WAIT_L(0); PG8_BAR; PG8_MMA(0, 0, At, B0); PG8_MMA(0, 1, At, B1); PG8_BAR; PG8_SCHED;
            PG8_LDA(At, 0, 1); PG8_STAGE(PG8_SB(0, 0), b2, voffB); PG8_STAGE(PG8_SB(0, 1), b2 + hstep, voffB); PG8_STAGE(PG8_SA(0, 0), a2, voffA);
            PG8_WAIT_V(8); PG8_WAIT_L(0); PG8_BAR; PG8_MMA(1, 0, At, B0); PG8_MMA(1, 1, At, B1); PG8_BAR; PG8_SCHED;
            PG8_LDB(B0, 1, 0); PG8_LDB(B1, 1, 1); PG8_SCHED; PG8_LDA(At, 1, 0); PG8_STAGE(PG8_SA(0, 1), a2 + hstep, voffA);
            PG8_WAIT_V(8); PG8_WAIT_L(0); PG8_BAR; PG8_MMA(0, 0, At, B0); PG8_MMA(0, 1, At, B1); PG8_BAR; PG8_SCHED;
            PG8_LDA(At, 1, 1); PG8_STAGE(PG8_SB(1, 0), b3, voffB); PG8_STAGE(PG8_SB(1, 1), b3 + hstep, voffB); PG8_STAGE(PG8_SA(1, 0), a3, voffA);
            PG8_WAIT_V(8); PG8_WAIT_L(0); PG8_BAR; PG8_MMA(1, 0, At, B0); PG8_MMA(1, 1, At, B1); PG8_BAR; PG8_SCHED;
            } else {
            PG8_LDB(B0, 0, 0); PG8_SCHED; PG8_LDA(At, 0, 0); PG8_STAGE(PG8_SA(1, 1), a1 + hstep, voffA);
            PG8_WAIT_L(8); PG8_BAR; PG8_WAIT_L(0); PG8_MMA(0, 0, At, B0); PG8_BAR; PG8_SCHED;
            PG8_LDB(B1, 0, 1); PG8_STAGE(PG8_SB(0, 0), b2, voffB);
            PG8_BAR; PG8_WAIT_L(0); PG8_MMA(0, 1, At, B1); PG8_BAR;
            PG8_LDA(At, 0, 1); PG8_STAGE(PG8_SA(0, 0), a2, voffA);
            PG8_BAR; PG8_WAIT_L(0); PG8_MMA(1, 0, At, B0); PG8_BAR; PG8_SCHED;
            PG8_STAGE(PG8_SB(0, 1), b2 + hstep, voffB);
            PG8_WAIT_V(6); PG8_BAR; PG8_MMA(1, 1, At, B1); PG8_BAR;
            PG8_LDB(B0, 1, 0); PG8_SCHED; PG8_LDA(At, 1, 0); PG8_STAGE(PG8_SA(0, 1), a2 + hstep, voffA);
            PG8_WAIT_L(8); PG8_BAR; PG8_WAIT_L(0); PG8_MMA(0, 0, At, B0); PG8_BAR; PG8_SCHED;
            PG8_LDB(B1, 1, 1); PG8_STAGE(PG8_SB(1, 0), b3, voffB);
            PG8_BAR; PG8_WAIT_L(0); PG8_MMA(0, 1, At, B1); PG8_BAR;
            PG8_LDA(At, 1, 1); PG8_STAGE(PG8_SA(1, 0), a3, voffA);
            PG8_BAR; PG8_WAIT_L(0); PG8_MMA(1, 0, At, B0); PG8_BAR; PG8_SCHED;
            PG8_STAGE(PG8_SB(1, 1), b3 + hstep, voffB);
            PG8_WAIT_V(6); PG8_BAR; PG8_MMA(1, 1, At, B1); PG8_BAR;
            }
        }
        if constexpr (ALIGN_EPI) { if (wr == 0) PG8_BAR; }
        if constexpr (!Epi::AFTER_DRAIN) { E(acc, cur, wr, wc, fr, fq); PG8_EPI_TWICE S.done(cur); }
        if (!has_next) break;
#pragma unroll
        for (int a = 0; a < 2; ++a)
#pragma unroll
            for (int b = 0; b < 2; ++b)
#pragma unroll
                for (int m = 0; m < 4; ++m)
#pragma unroll
                    for (int n = 0; n < 2; ++n) acc[a][b][m][n] = (f32x4){0.f, 0.f, 0.f, 0.f};
        cur = nxt; cA = nA; cB = nB; ++ui; PG8_RCUR(cur);
        if constexpr (ALIGN_EPI) { if (wr == 1) PG8_BAR; }
    }
    PG8_WAIT_V(0);
    if constexpr (!ALIGN_EPI) { if (wr == 0) PG8_BAR; }
    PG8_BAR;
    if constexpr (Epi::AFTER_DRAIN) { E.fused(acc, cur, wr, wc, fr, fq, lds, wid, lane); S.done(cur); }
#undef PG8_SA
#undef PG8_SB
#undef PG8_STAGE
#undef PG8_LDA
#undef PG8_LDB
#undef PG8_MMA
#undef PG8_WAIT_V
#undef PG8_WAIT_L
#undef PG8_BAR
#undef PG8_SCHED
#undef PG8_PIECE_OFF
#undef PG8_RLOAD_P
#undef PG8_WAIT_V1P
#undef PG8_RADD_P
#undef PG8_KPAIR
#undef PG8_RCUR
}
}
constexpr int NWAVES = 8;
constexpr int NB = 8, SEQ = 4096, T = NB * SEQ, DM = 1024, DIN = 2824, DFF = 2816, NPROJ = 2816;
constexpr int SRC_MI = 2048;
constexpr int PC_MQ = 0, PC_MK = 512, PC_MV = 1024, PC_MO = 1536, PC_AQ = 2048, PC_AK = 2560, PC_AV = 2688;
constexpr float EPS = 1e-6f;
constexpr size_t MiB = 1u << 20;
constexpr size_t WS_CTL = 0, CTL_ZERO_BYTES = 32 * 1024;
constexpr size_t WS_WIN = 1 * MiB;
constexpr size_t WS_WOUT = 7 * MiB;
constexpr size_t WS_WGU = 9 * MiB;
constexpr size_t WS_WDN = 20 * MiB;
constexpr size_t WS_ROPE = 26 * MiB;
constexpr size_t WS_WBG = 26 * MiB + 512 * 1024;
constexpr size_t WS_GATES = 27 * MiB;
constexpr size_t WS_SSQ = 28 * MiB;
constexpr size_t WS_SEG = 30 * MiB;
constexpr size_t WS_XN = 48 * MiB;
constexpr size_t WS_MIX = 112 * MiB;
constexpr size_t WS_PROJ = 176 * MiB;
constexpr size_t WS_END = 352 * MiB;
constexpr int CW_BAR = 4096;
constexpr int RING_BYTES = 131072;
constexpr int LDSCTL_OFF = RING_BYTES, MISC_OFF = LDSCTL_OFF + 320;
constexpr int LDS_BYTES = 163840;

#define GAS __attribute__((address_space(1)))
#define LAS __attribute__((address_space(3)))
typedef unsigned short bf16;
typedef unsigned v4u __attribute__((ext_vector_type(4)));
typedef unsigned v2u __attribute__((ext_vector_type(2)));
typedef float f32x2v __attribute__((ext_vector_type(2)));
typedef float f32x4 __attribute__((ext_vector_type(4)));
typedef short bf16x8 __attribute__((ext_vector_type(8)));
typedef GAS unsigned gu32;
#define RLX_AGENT __ATOMIC_RELAXED, __HIP_MEMORY_SCOPE_AGENT
#define LDS_WAIT() asm volatile("s_waitcnt lgkmcnt(0)" ::: "memory")
#define VM_WAIT() asm volatile("s_waitcnt vmcnt(0)" ::: "memory")
__device__ __forceinline__ unsigned f2bf(float f) { unsigned u = __builtin_bit_cast(unsigned, f); return (u + 0x7fffu + ((u >> 16) & 1u)) >> 16; }
__device__ __forceinline__ unsigned pk2(float lo, float hi) { return f2bf(lo) | (f2bf(hi) << 16); }
__device__ __forceinline__ float bf2f(unsigned short b) { return __builtin_bit_cast(float, (unsigned)b << 16); }
__device__ __forceinline__ float bflo(unsigned w) { return __builtin_bit_cast(float, w << 16); }
__device__ __forceinline__ float bfhi(unsigned w) { return __builtin_bit_cast(float, w & 0xffff0000u); }
__device__ __forceinline__ float wave_sum(float v) {
#pragma unroll
    for (int o = 1; o < 64; o <<= 1) v += __shfl_xor(v, o);
    return v;
}
__device__ __forceinline__ float wave_max(float v) {
#pragma unroll
    for (int o = 1; o < 64; o <<= 1) v = fmaxf(v, __shfl_xor(v, o));
    return v;
}
__device__ __forceinline__ void unpack8(const v4u w, float* o) { o[0] = bflo(w.x); o[1] = bfhi(w.x); o[2] = bflo(w.y); o[3] = bfhi(w.y); o[4] = bflo(w.z); o[5] = bfhi(w.z); o[6] = bflo(w.w); o[7] = bfhi(w.w); }
__device__ __forceinline__ float red16_32_max(float v) {
    auto a = __builtin_amdgcn_permlane16_swap(__float_as_uint(v), __float_as_uint(v), false, false); v = fmaxf(__uint_as_float(a[0]), __uint_as_float(a[1]));
    auto b = __builtin_amdgcn_permlane32_swap(__float_as_uint(v), __float_as_uint(v), false, false); return fmaxf(__uint_as_float(b[0]), __uint_as_float(b[1])); }
__device__ __forceinline__ float red16_32_sum(float v) {
    auto a = __builtin_amdgcn_permlane16_swap(__float_as_uint(v), __float_as_uint(v), false, false); v = __uint_as_float(a[0]) + __uint_as_float(a[1]);
    auto b = __builtin_amdgcn_permlane32_swap(__float_as_uint(v), __float_as_uint(v), false, false); return __uint_as_float(b[0]) + __uint_as_float(b[1]); }
__device__ __forceinline__ float xor16_partner(float v) { const unsigned u = __float_as_uint(v); auto a = __builtin_amdgcn_permlane16_swap(u, u, false, false); return __uint_as_float(a[0] ^ a[1] ^ u); }
#define xor16_max 1
#define XB_TMO      128
#define XB_XCNT(j)  (256  + 64 * (j))
#define XB_XSUB(j)  (1280 + 64 * (j))
#define XB_XGEN(j)  (2304 + 64 * (j))
#define XB_TOP      3328
#define XB_TOPGEN   3392
#define XCD_BAR_WORDS 3456
#define XB_SPIN_CAP (1u << 18)

__device__ __forceinline__ unsigned xb_ld(unsigned* p)              { return __hip_atomic_load(p, __ATOMIC_RELAXED, __HIP_MEMORY_SCOPE_AGENT); }
__device__ __forceinline__ unsigned xb_add(unsigned* p, unsigned v) { return __hip_atomic_fetch_add(p, v, __ATOMIC_RELAXED, __HIP_MEMORY_SCOPE_AGENT); }
__device__ __forceinline__ unsigned xb_xcc_id() { return (unsigned)__builtin_amdgcn_s_getreg((3 << 11) | 20) & 0xFu; }
#define XB_SPIN(cond, bar) do { unsigned _sp = 0; while (cond) { __builtin_amdgcn_s_sleep(1); \
    if ((++_sp & 255u) == 0u) { if (xb_ld(&(bar)[XB_TMO])) break; if (_sp > XB_SPIN_CAP) { atomicAdd(&(bar)[XB_TMO], 1u); break; } } } } while (0)

struct XcdBarrier {
    unsigned* bar; unsigned x;
    volatile LAS unsigned* st;
};

__device__ __forceinline__ XcdBarrier xcd_barrier_post(unsigned* bar, volatile LAS unsigned* st) {
    XcdBarrier b; b.bar = bar; b.x = xb_xcc_id(); b.st = st;
    if (threadIdx.x == 0) (void)xb_add(&bar[XB_XCNT(b.x)], 1u);
    return b;
}
__device__ __forceinline__ void xcd_barrier_complete(unsigned* bar, unsigned x, unsigned& nloc, unsigned& nx) {
    const unsigned G = gridDim.x * gridDim.y * gridDim.z;
    unsigned sum, cnt, mine, sp = 0u;
    for (;;) {
        sum = 0u; cnt = 0u; mine = 0u;
#pragma unroll
        for (unsigned j = 0; j < 16; ++j) { const unsigned c = xb_ld(&bar[XB_XCNT(j)]); sum += c; cnt += (c > 0u) ? 1u : 0u; mine = (j == x) ? c : mine; }
        if (sum == G) break;
        __builtin_amdgcn_s_sleep(1);
        if ((++sp & 255u) == 0u) { if (xb_ld(&bar[XB_TMO])) break; if (sp > XB_SPIN_CAP) { atomicAdd(&bar[XB_TMO], 1u); break; } }
    }
    nloc = mine > 0u ? mine : 1u; nx = cnt > 0u ? cnt : 1u;
}

__device__ __forceinline__ void xcd_barrier(const XcdBarrier& b) {
    asm volatile("s_waitcnt vmcnt(0)" ::: "memory");
    __syncthreads();
    if (threadIdx.x == 0) {
        unsigned* bar = b.bar;
        __builtin_amdgcn_s_waitcnt(0);
        unsigned nloc = b.st[0], nx = b.st[1];
        if (nloc == 0u) { xcd_barrier_complete(bar, b.x, nloc, nx); b.st[0] = nloc; b.st[1] = nx; }
        const unsigned old = xb_add(&bar[XB_XSUB(b.x)], 1u);
        const unsigned gen = old / nloc;
        if (old + 1u == (gen + 1u) * nloc) {
            __builtin_amdgcn_fence(__ATOMIC_RELEASE, "agent");
            asm volatile("s_waitcnt vmcnt(0)" ::: "memory");
            const unsigned og = xb_add(&bar[XB_TOP], 1u);
            const unsigned tg = og / nx;
            if (og + 1u == (tg + 1u) * nx) xb_add(&bar[XB_TOPGEN], 1u);
            else XB_SPIN(xb_ld(&bar[XB_TOPGEN]) == tg, bar);
            __builtin_amdgcn_fence(__ATOMIC_ACQUIRE, "agent");
            xb_add(&bar[XB_XGEN(b.x)], 1u);
            asm volatile("s_waitcnt vmcnt(0)" ::: "memory");
        } else {
            XB_SPIN(xb_ld(&bar[XB_XGEN(b.x)]) == gen, bar);
            __builtin_amdgcn_fence(__ATOMIC_ACQUIRE, "agent");
            asm volatile("s_waitcnt vmcnt(0)" ::: "memory");
        }
    }
    __syncthreads();
}

__device__ __forceinline__ void xcd_barrier_local(const XcdBarrier& b) {
    asm volatile("s_waitcnt vmcnt(0)" ::: "memory");
    __syncthreads();
    if (threadIdx.x == 0) {
        unsigned* bar = b.bar;
        __builtin_amdgcn_s_waitcnt(0);
        unsigned nloc = b.st[0], nx = b.st[1];
        if (nloc == 0u) { xcd_barrier_complete(bar, b.x, nloc, nx); b.st[0] = nloc; b.st[1] = nx; }
        const unsigned old = xb_add(&bar[XB_XSUB(b.x)], 1u);
        const unsigned gen = old / nloc;
        if (old + 1u == (gen + 1u) * nloc) xb_add(&bar[XB_XGEN(b.x)], 1u);
        else XB_SPIN(xb_ld(&bar[XB_XGEN(b.x)]) == gen, bar);
        __builtin_amdgcn_fence(__ATOMIC_ACQUIRE, "agent");
        asm volatile("s_waitcnt vmcnt(0)" ::: "memory");
    }
    __syncthreads();
}
#define H1_BF16 1
#define MERGE23 1
#define P6_STREAM 1
#ifndef P5_ALIGN
#define P5_ALIGN true
#endif
#define PHASE2_BODY do { mlstm_phase<1>(F); swa_phase(F); __syncthreads(); { int t_ = threadIdx.x; asm volatile("" : "+v"(t_)); F.tid = t_; F.lane = t_ & 63; } mlstm_phase<2>(F); } while (0)
#define PHASE3_BODY (void)0
#define LAUNCH_MK(lo_, hi_) do { a.ph_lo = (lo_); a.ph_hi = (hi_); a.li = (lo_); hipLaunchKernelGGL(mk_fwd, dim3(grid), dim3(NWAVES * 64), LDS_BYTES, stream, a); } while (0)
#define LAUNCH_PROGRAM { LAUNCH_MK(0, 7); }
struct Frame {
    LAS unsigned char* lds;
    volatile LAS unsigned* MISC;
    gu32* ctl;
    int tid, lane, wave, vcu, G;
    const float *x, *norm1_g, *w_in, *conv_w, *igate_b, *fgate_b, *mlstm_norm_g, *q_norm_g, *k_norm_g, *sinks, *w_out, *norm2_g, *w_gate, *w_up, *w_down;
    float* out;
    bf16 *Win_t, *Wout_t, *Wgu_t, *Wdn_t, *XN, *MIX, *PROJ;
    float2* ROPE; float* GATES; float* SSQ; float* SEG; unsigned char* WBG;
};

struct P0Item { const float* W; int ldw, src_col0; const float* kscale; bf16* WT; int Kd, dst_row0, kb; };
template <bool SCALE> __device__ __forceinline__ void p0_item_load(const P0Item& I, float (&v)[32], int lane) {
    const int k0 = 64 * I.kb;
#pragma unroll
    for (int i = 0; i < 32; ++i) { const int kk = 2 * i + (lane >> 5); v[i] = I.W[(size_t)(k0 + kk) * I.ldw + I.src_col0 + (lane & 31)]; }
    if (SCALE) {
        float sc[32];
#pragma unroll
        for (int i = 0; i < 32; ++i) sc[i] = I.kscale[k0 + 2 * i + (lane >> 5)];
#pragma unroll
        for (int i = 0; i < 32; ++i) v[i] *= sc[i];
    }
}
__device__ __forceinline__ void p0_item_finish(const P0Item& I, const float (&v)[32], LAS float* scr, int lane) {
    const int k0 = 64 * I.kb;
#pragma unroll
    for (int i = 0; i < 32; ++i) { const int kk = 2 * i + (lane >> 5); scr[kk * 33 + (lane & 31)] = v[i]; }
    LDS_WAIT(); asm volatile("" ::: "memory");
    const int c = lane & 7;
#pragma unroll
    for (int j = 0; j < 4; ++j) { const int n = (lane >> 3) + 8 * j; const LAS float* s = scr + (8 * c) * 33 + n;
        v4u o; o.x = pk2(s[0 * 33], s[1 * 33]); o.y = pk2(s[2 * 33], s[3 * 33]); o.z = pk2(s[4 * 33], s[5 * 33]); o.w = pk2(s[6 * 33], s[7 * 33]);
        *(GAS v4u*)(I.WT + (size_t)(I.dst_row0 + n) * I.Kd + k0 + 8 * c) = o; }
    LDS_WAIT(); asm volatile("" ::: "memory");
}
constexpr int I_IN = 88 * 16, I_OUT = 32 * 16, I_GU = 176 * 16, I_DN = 32 * 44;
__device__ __forceinline__ P0Item p0_item_in(Frame& F, int r) { const int nb = r % 88, kb = r / 88; return P0Item{F.w_in, DIN, nb < 64 ? 32 * nb : 32 * nb + 8, nullptr, F.Win_t, DM, 32 * nb, kb}; }
__device__ __forceinline__ P0Item p0_item_gu(Frame& F, int r) { const int nb = r % 176, kb = r / 176, tile = nb >> 3, wi = nb & 7; const float* W = (wi < 4) ? F.w_gate : F.w_up;
    return P0Item{W, DFF, 128 * tile + 32 * (wi & 3), F.norm2_g, F.Wgu_t, DM, 32 * nb, kb}; }
__device__ __forceinline__ P0Item p0_item_od(Frame& F, int r) {
    if (r < I_OUT) { const int nb = r % 32, kb = r / 32; return P0Item{F.w_out, DM, 32 * nb, nullptr, F.Wout_t, DM, 32 * nb, kb}; } r -= I_OUT;
    { const int nb = r % 32, kb = r / 32; return P0Item{F.w_down, DM, 32 * nb, nullptr, F.Wdn_t, DFF, 32 * nb, kb}; }
}
__device__ __forceinline__ void p0_prologue(Frame& F) {
    LAS float* scr = (LAS float*)(F.lds + F.wave * 8704);
    const int gw = F.vcu * NWAVES + F.wave, NGW = F.G * NWAVES;
    for (int it = gw; it < I_IN; it += NGW) { const P0Item I = p0_item_in(F, it); float v[32]; p0_item_load<false>(I, v, F.lane); p0_item_finish(I, v, scr, F.lane); }
    if (F.vcu < 4) { const int idx = F.vcu * 512 + F.tid; const int ks = idx >> 6, ln = idx & 63, col = ln & 15, gq = ln >> 4;
        v4u o = (v4u){0u, 0u, 0u, 0u};
        if (col < 8) { const float* wp = F.w_in + (size_t)(32 * ks + 8 * gq) * DIN + SRC_MI + col;
            const float w0 = wp[0], w1 = wp[DIN], w2 = wp[2 * DIN], w3 = wp[3 * DIN], w4 = wp[4 * DIN], w5 = wp[5 * DIN], w6 = wp[6 * DIN], w7 = wp[7 * DIN];
            o.x = pk2(w0, w1); o.y = pk2(w2, w3); o.z = pk2(w4, w5); o.w = pk2(w6, w7); }
        ((v4u*)F.WBG)[idx] = o; }
    { const int idx = (F.vcu * NWAVES * 64) + F.tid;
      if (idx < SEQ * 8) { const int pos = idx >> 3, i = idx & 7;
        double f = 1.0; f = (i == 1) ? 0.19392274474868576 : f; f = (i == 2) ? 0.03760603093086393 : f; f = (i == 3) ? 0.007292664737217109 : f; f = (i == 4) ? 0.001414213562373095 : f;
        f = (i == 5) ? 0.0002742481756762073 : f; f = (i == 6) ? 5.318295896944988e-05 : f; f = (i == 7) ? 1.031338537721246e-05 : f;
        const float angf = (float)pos * (float)f; const double rev = (double)angf * 0.15915494309189535; const double fr = rev - __builtin_floor(rev + 0.5);
        const float rr = (float)(fr * 6.283185307179586); F.ROPE[idx] = make_float2(__cosf(rr), __sinf(rr)); } }
    f32x4 g1[4];
#pragma unroll
    for (int j = 0; j < 4; ++j) g1[j] = ((const f32x4*)F.norm1_g)[F.lane + 64 * j];
    f32x4 v[4];
    if (gw < T) {
#pragma unroll
        for (int j = 0; j < 4; ++j) v[j] = ((const GAS f32x4*)(F.x + (size_t)gw * DM))[F.lane + 64 * j];
    }
#pragma unroll 1
    for (int m = gw; m < T; m += NGW) {
        f32x4 c[4]; float s = 0.f;
#pragma unroll
        for (int j = 0; j < 4; ++j) { c[j] = v[j]; s += (c[j].x * c[j].x + c[j].y * c[j].y) + (c[j].z * c[j].z + c[j].w * c[j].w); }
        if (m + NGW < T) {
#pragma unroll
            for (int j = 0; j < 4; ++j) v[j] = ((const GAS f32x4*)(F.x + (size_t)(m + NGW) * DM))[F.lane + 64 * j];
        }
        const float rstd = __builtin_amdgcn_rsqf(wave_sum(s) * (1.f / DM) + EPS);
        GAS v2u* o8 = (GAS v2u*)(F.XN + (size_t)m * DM) + F.lane;
#pragma unroll
        for (int j = 0; j < 4; ++j) { const f32x4 y = c[j] * rstd * g1[j]; v2u w; w.x = pg8::cvt_pk_bf16(y.x, y.y); w.y = pg8::cvt_pk_bf16(y.z, y.w); o8[64 * j] = w; }
    }
}
__device__ __forceinline__ void convert_gu(Frame& F, int ii, int ni) {
    LAS float* scr = (LAS float*)(F.lds + F.wave * 8704);
    __syncthreads();
    const int igw = ii * NWAVES + F.wave, NIW = ni * NWAVES;
#pragma unroll 1
    for (int it = igw; it < I_GU; it += 2 * NIW) {
        const P0Item Ia = p0_item_gu(F, it); const bool two = it + NIW < I_GU; const P0Item Ib = p0_item_gu(F, two ? it + NIW : it);
        float va[32], vb[32]; p0_item_load<true>(Ia, va, F.lane); p0_item_load<true>(Ib, vb, F.lane);
        p0_item_finish(Ia, va, scr, F.lane); if (two) p0_item_finish(Ib, vb, scr, F.lane);
    }
}
__device__ __forceinline__ void convert_od(Frame& F, int ii, int ni) {
    LAS float* scr = (LAS float*)(F.lds + F.wave * 8704);
    const int igw = ii * NWAVES + F.wave, NIW = ni * NWAVES;
#pragma unroll 1
    for (int it = igw; it < I_OUT + I_DN; it += 2 * NIW) {
        const P0Item Ia = p0_item_od(F, it); const bool two = it + NIW < I_OUT + I_DN; const P0Item Ib = p0_item_od(F, two ? it + NIW : it);
        float va[32], vb[32]; p0_item_load<false>(Ia, va, F.lane); p0_item_load<false>(Ib, vb, F.lane);
        p0_item_finish(Ia, va, scr, F.lane); if (two) p0_item_finish(Ib, vb, scr, F.lane);
    }
}
__device__ __forceinline__ void p1_side_work(Frame& F, int ii, int ni) {
    LAS unsigned char* WB = F.lds + 73728;
    for (int idx = F.tid; idx < 2048; idx += NWAVES * 64) *(LAS v4u*)(WB + idx * 16) = ((const v4u*)F.WBG)[idx];
    __syncthreads();
    convert_od(F, ii, ni);
    const int igw = ii * NWAVES + F.wave, NIW = ni * NWAVES;
    const int l15 = F.lane & 15, g = F.lane >> 4;
    for (int blk = igw; blk < T / 16; blk += NIW) {
        const bf16* xp = F.XN + ((size_t)blk * 16 + l15) * DM + 8 * g;
        f32x4 acc = (f32x4){0.f, 0.f, 0.f, 0.f};
        bf16x8 a[32];
#pragma unroll
        for (int q = 0; q < 32; ++q) a[q] = *(const bf16x8*)(xp + 32 * q);
#pragma unroll
        for (int q = 0; q < 32; ++q) acc = __builtin_amdgcn_mfma_f32_16x16x32_bf16(a[q], *(const LAS bf16x8*)(WB + (q * 64 + F.lane) * 16), acc, 0, 0, 0);
        if (l15 < 8) {
#pragma unroll
            for (int r = 0; r < 4; ++r) F.GATES[((size_t)blk * 16 + 4 * g + r) * 8 + l15] = acc[r];
        }
    }
}

constexpr int SWA_KS = 0, SWA_KSTR = 160, SWA_VT = 40960, SWA_VSTR = 528;
typedef short bf16x4 __attribute__((ext_vector_type(4)));
#ifndef SWA_UNROLL
#define SWA_UNROLL 1
#endif
constexpr int SWA_TAB = 74752;
struct SwaKV { v4u k[4], v[4]; float2 cs[8]; };
struct SwaQ { v4u w0, w1; float2 cs[8]; };
__device__ __forceinline__ void swa_load_kv(Frame& F, int tid, int u, SwaKV& R) {
    const int blk = u & 31, kvh = (u >> 5) & 1, b = u >> 6; const int key = tid >> 1, half = tid & 1; const int kt = blk * 128 - 128 + key;
    if (kt >= 0) {
        const bf16* kp = F.PROJ + (size_t)(b * SEQ + kt) * NPROJ + PC_AK + kvh * 64 + 32 * half;
        const bf16* vp = F.PROJ + (size_t)(b * SEQ + kt) * NPROJ + PC_AV + kvh * 64 + 32 * half;
#pragma unroll
        for (int c = 0; c < 4; ++c) { R.k[c] = *(const v4u*)(kp + 8 * c); R.v[c] = *(const v4u*)(vp + 8 * c); }
#pragma unroll
        for (int i = 0; i < 8; ++i) R.cs[i] = F.ROPE[kt * 8 + i];
    } else {
#pragma unroll
        for (int c = 0; c < 4; ++c) { R.k[c] = (v4u){0u, 0u, 0u, 0u}; R.v[c] = (v4u){0u, 0u, 0u, 0u}; }
#pragma unroll
        for (int i = 0; i < 8; ++i) R.cs[i] = make_float2(1.f, 0.f);
    }
}
__device__ __forceinline__ void swa_load_q(Frame& F, int lane, int wave, int u, int rb, SwaQ& R) {
    const int blk = u & 31, kvh = (u >> 5) & 1, b = u >> 6; const int l15 = lane & 15, g = lane >> 4;
    const int hq = kvh * 4 + (wave >> 1), p0 = 64 * (wave & 1) + 16 * rb, tq = blk * 128 + p0 + l15;
    const bf16* qp = F.PROJ + (size_t)(b * SEQ + tq) * NPROJ + PC_AQ + hq * 64 + 8 * g;
    R.w0 = *(const v4u*)qp; R.w1 = *(const v4u*)(qp + 32);
#pragma unroll
    for (int j = 0; j < 8; ++j) R.cs[j] = F.ROPE[tq * 8 + j];
}
__device__ __forceinline__ void swa_phase(Frame& F) {
    LAS unsigned char* KS = F.lds + SWA_KS; LAS unsigned char* VT = F.lds + SWA_VT; LAS float* TAB = (LAS float*)(F.lds + SWA_TAB);
    const int wave = F.wave;
    int u = F.vcu;
    if (u >= NB * 2 * 32) return;
    __syncthreads();
    if (F.tid < 64) TAB[F.tid] = F.q_norm_g[F.tid]; else if (F.tid < 128) TAB[F.tid] = F.k_norm_g[F.tid - 64];
    SwaKV kv; SwaQ qr;
    swa_load_kv(F, F.tid, u, kv);
    swa_load_q(F, F.lane, wave, u, 0, qr);
#pragma unroll 1
    for (; u < NB * 2 * 32; u += F.G) {
        int tid = F.tid; asm volatile("" : "+v"(tid));
        const int lane = tid & 63, l15 = lane & 15, g = lane >> 4;
        const int blk = u & 31, kvh = (u >> 5) & 1, b = u >> 6;
        const int un = u + F.G; const bool has_next = un < NB * 2 * 32;
        __syncthreads();
        {
            const int key = tid >> 1, half = tid & 1;
            float kf[32];
#pragma unroll
            for (int c = 0; c < 4; ++c) unpack8(kv.k[c], kf + 8 * c);
            float ss = 0.f;
#pragma unroll
            for (int c = 0; c < 32; ++c) ss += kf[c] * kf[c];
            ss += __shfl_xor(ss, 1);
            const float rstd = __builtin_amdgcn_rsqf(ss * (1.f / 64.f) + EPS);
#pragma unroll
            for (int c = 0; c < 8; ++c) { const f32x4 gg = *(const LAS f32x4*)(TAB + 64 + 32 * half + 4 * c); kf[4 * c] *= rstd * gg[0]; kf[4 * c + 1] *= rstd * gg[1]; kf[4 * c + 2] *= rstd * gg[2]; kf[4 * c + 3] *= rstd * gg[3]; }
            if (half == 0) {
#pragma unroll
                for (int i = 0; i < 8; ++i) { const float2 cs = kv.cs[i]; const float x1 = kf[i], x2 = kf[8 + i]; kf[i] = x1 * cs.x - x2 * cs.y; kf[8 + i] = x2 * cs.x + x1 * cs.y; }
            }
#pragma unroll
            for (int c = 0; c < 4; ++c) { v4u o; o.x = pg8::cvt_pk_bf16(kf[8 * c], kf[8 * c + 1]); o.y = pg8::cvt_pk_bf16(kf[8 * c + 2], kf[8 * c + 3]); o.z = pg8::cvt_pk_bf16(kf[8 * c + 4], kf[8 * c + 5]); o.w = pg8::cvt_pk_bf16(kf[8 * c + 6], kf[8 * c + 7]);
                *(LAS v4u*)(KS + key * SWA_KSTR + 64 * half + 16 * c) = o; }
#pragma unroll
            for (int c = 0; c < 4; ++c) { const unsigned ww[4] = {kv.v[c].x, kv.v[c].y, kv.v[c].z, kv.v[c].w};
#pragma unroll
                for (int e = 0; e < 4; ++e) { const int d = 32 * half + 8 * c + 2 * e;
                    const unsigned pw = __shfl_xor(ww[e], 2);
                    const unsigned val = (key & 1) ? ((pw >> 16) | (ww[e] & 0xffff0000u)) : ((ww[e] & 0xffffu) | (pw << 16));
                    *(LAS unsigned*)(VT + (d + (key & 1)) * SWA_VSTR + ((((key >> 1) ^ (half << 3))) << 2)) = val; } }
        }
        __syncthreads();
        if (has_next) swa_load_kv(F, tid, un, kv);
        const int hq = kvh * 4 + (wave >> 1);
        const float sink2 = F.sinks[hq] * 1.4426950408889634f;
        const float SC = 0.125f * 1.4426950408889634f;
#pragma unroll 1
        for (int rb = 0; rb < 4; ++rb) {
            const int p0 = 64 * (wave & 1) + 16 * rb, j0 = p0 >> 4;
            const int tq = blk * 128 + p0 + l15;
            bf16x8 qf[2];
            {
                float q0[8], q1[8]; unpack8(qr.w0, q0); unpack8(qr.w1, q1);
                float ss = 0.f;
#pragma unroll
                for (int j = 0; j < 8; ++j) ss += q0[j] * q0[j] + q1[j] * q1[j];
                ss = red16_32_sum(ss);
                const float rstd = __builtin_amdgcn_rsqf(ss * (1.f / 64.f) + EPS);
#pragma unroll
                for (int c = 0; c < 2; ++c) { const f32x4 ga = *(const LAS f32x4*)(TAB + 8 * g + 4 * c), gb = *(const LAS f32x4*)(TAB + 32 + 8 * g + 4 * c);
#pragma unroll
                    for (int e = 0; e < 4; ++e) { q0[4 * c + e] *= rstd * ga[e]; q1[4 * c + e] *= rstd * gb[e]; } }
#pragma unroll
                for (int j = 0; j < 8; ++j) { const float other = xor16_partner(q0[j]); const float2 cs = qr.cs[j];
                    const float r0 = q0[j] * cs.x - other * cs.y, r1 = q0[j] * cs.x + other * cs.y; q0[j] = (g == 0) ? r0 : ((g == 1) ? r1 : q0[j]); }
                v4u a, c2; a.x = pg8::cvt_pk_bf16(q0[0], q0[1]); a.y = pg8::cvt_pk_bf16(q0[2], q0[3]); a.z = pg8::cvt_pk_bf16(q0[4], q0[5]); a.w = pg8::cvt_pk_bf16(q0[6], q0[7]);
                c2.x = pg8::cvt_pk_bf16(q1[0], q1[1]); c2.y = pg8::cvt_pk_bf16(q1[2], q1[3]); c2.z = pg8::cvt_pk_bf16(q1[4], q1[5]); c2.w = pg8::cvt_pk_bf16(q1[6], q1[7]);
                qf[0] = __builtin_bit_cast(bf16x8, a); qf[1] = __builtin_bit_cast(bf16x8, c2);
            }
            if (rb < 3) swa_load_q(F, lane, wave, u, rb + 1, qr); else if (has_next) swa_load_q(F, lane, wave, un, 0, qr);
            f32x4 s[10];
    #pragma unroll
            for (int jj = 0; jj < 9; ++jj) { const int tile = j0 + jj;
                f32x4 acc = (f32x4){0.f, 0.f, 0.f, 0.f};
    #pragma unroll
                for (int ks = 0; ks < 2; ++ks) { const bf16x8 kfr = *(const LAS bf16x8*)(KS + (16 * tile + l15) * SWA_KSTR + 64 * ks + 16 * g);
                    acc = __builtin_amdgcn_mfma_f32_16x16x32_bf16(kfr, qf[ks], acc, 0, 0, 0); }
                s[jj] = acc; }
            s[9] = (f32x4){0.f, 0.f, 0.f, 0.f};
    #pragma unroll
            for (int r = 0; r < 4; ++r) { if (4 * g + r < 1 + l15) s[0][r] = -INFINITY; if (4 * g + r > l15) s[8][r] = -INFINITY; }
            if (blk == 0) {
    #pragma unroll
                for (int jj = 0; jj < 9; ++jj)
    #pragma unroll
                    for (int r = 0; r < 4; ++r) { if (16 * (j0 + jj) + 4 * g + r < 128) s[jj][r] = -INFINITY; }
            }
            float mx = -INFINITY;
    #pragma unroll
            for (int jj = 0; jj < 9; ++jj)
    #pragma unroll
                for (int r = 0; r < 4; ++r) mx = fmaxf(mx, s[jj][r]);
            mx = red16_32_max(mx); mx = fmaxf(mx * SC, sink2);
            float sum = 0.f;
    #pragma unroll
            for (int jj = 0; jj < 9; ++jj)
    #pragma unroll
                for (int r = 0; r < 4; ++r) { const float p = __builtin_amdgcn_exp2f(__builtin_fmaf(s[jj][r], SC, -mx)); s[jj][r] = p; sum += p; }
            sum = red16_32_sum(sum);
            const float inv = 1.0f / (sum + __builtin_amdgcn_exp2f(sink2 - mx));
            f32x4 o[4];
    #pragma unroll
            for (int dt = 0; dt < 4; ++dt) o[dt] = (f32x4){0.f, 0.f, 0.f, 0.f};
    #pragma unroll
            for (int kk = 0; kk < 5; ++kk) {
                const int t0 = (j0 + 2 * kk) > 15 ? 15 : (j0 + 2 * kk), t1 = (j0 + 2 * kk + 1) > 15 ? 15 : (j0 + 2 * kk + 1);
                v4u pw; pw.x = pg8::cvt_pk_bf16(s[2 * kk][0], s[2 * kk][1]); pw.y = pg8::cvt_pk_bf16(s[2 * kk][2], s[2 * kk][3]); pw.z = pg8::cvt_pk_bf16(s[2 * kk + 1][0], s[2 * kk + 1][1]); pw.w = pg8::cvt_pk_bf16(s[2 * kk + 1][2], s[2 * kk + 1][3]);
                const bf16x8 pf = __builtin_bit_cast(bf16x8, pw);
    #pragma unroll
                for (int dt = 0; dt < 4; ++dt) {
                    const v2u a0 = *(const LAS v2u*)(VT + (16 * dt + l15) * SWA_VSTR + (((8 * t0 + 2 * g) ^ ((dt >> 1) << 3)) << 2));
                    const v2u a1 = *(const LAS v2u*)(VT + (16 * dt + l15) * SWA_VSTR + (((8 * t1 + 2 * g) ^ ((dt >> 1) << 3)) << 2));
                    v4u av; av.x = a0.x; av.y = a0.y; av.z = a1.x; av.w = a1.y;
                    o[dt] = __builtin_amdgcn_mfma_f32_16x16x32_bf16(__builtin_bit_cast(bf16x8, av), pf, o[dt], 0, 0, 0); }
            }
            bf16* op = F.MIX + (size_t)(b * SEQ + tq) * DM + 512 + hq * 64 + 4 * g;
    #pragma unroll
            for (int dt = 0; dt < 4; ++dt) { v2u w; w.x = pg8::cvt_pk_bf16(o[dt][0] * inv, o[dt][1] * inv); w.y = pg8::cvt_pk_bf16(o[dt][2] * inv, o[dt][3] * inv); *(v2u*)(op + 16 * dt) = w; }
        }
    }
}
constexpr int ML_QS = 0, ML_KS = 18432, ML_KWT = 36864, ML_VT = 57344, ML_PS = 77824, ML_CT = 88064, ML_F = 122880;
constexpr int ML_QSTR = 288, ML_TSTR = 160, ML_CSTR = 272, ML_HSTR = 528;
constexpr int FDEN = 256, FN = 320;
constexpr int ML_GV = 132096, ML_GS = ML_GV + 8192, ML_CW = ML_GS + 256;
constexpr int SEG_STRIDE = 16640;
constexpr float LOG2E = 1.4426950408889634f;
__device__ __forceinline__ float silu_f(float v) { return v * __builtin_amdgcn_rcpf(1.0f + __builtin_amdgcn_exp2f(v * -LOG2E)); }
__device__ __forceinline__ float sigmoid_f(float v) { return __builtin_amdgcn_rcpf(1.0f + __builtin_amdgcn_exp2f(v * -LOG2E)); }
__device__ __forceinline__ float exp_f(float v) { return __builtin_amdgcn_exp2f(v * LOG2E); }

template <int PASS> __device__ __forceinline__ void mlstm_item(Frame& F, int b, int h, int sg) {
    const int wave = F.wave;
    int tid = F.tid; asm volatile("" : "+v"(tid));
    int lane = tid & 63, l15 = lane & 15, g4 = lane >> 4;
    LAS unsigned char* L = F.lds; LAS float* FL = (LAS float*)(L + ML_F);
    f32x4 C[8];
#pragma unroll
    for (int et = 0; et < 8; ++et) C[et] = (f32x4){0.f, 0.f, 0.f, 0.f};
    float m = -1e30f, Gsum = 0.f;
    LAS float* GV = (LAS float*)(L + ML_GV); LAS float* GS = (LAS float*)(L + ML_GS); LAS float* CW = (LAS float*)(L + ML_CW);
    __syncthreads();
    if (tid < 128) FL[FN + tid] = 0.f;
    for (int i = tid; i < 1024; i += NWAVES * 64) { const int j = i >> 8, ch = i & 255; CW[i] = F.conv_w[j * 1024 + (ch >> 7) * 512 + h * 128 + (ch & 127)]; }
    {
        const size_t tg = (size_t)b * SEQ + (size_t)(sg * 8 + wave) * 64 + lane;
        const float* gr = F.GATES + tg * 8;
        const float ig = gr[h] + F.igate_b[h], fg = gr[4 + h] + F.fgate_b[h];
        const float lf = fminf(fg, 0.f) - log1pf(__expf(-fabsf(fg)));
        float bs = lf;
#pragma unroll
        for (int o = 1; o < 64; o <<= 1) { const float t = __shfl_up(bs, o); if (lane >= o) bs += t; }
        const float gtot = __shfl(bs, 63);
        const float u = ig - bs;
        float pm = u;
#pragma unroll
        for (int o = 1; o < 64; o <<= 1) { const float t = __shfl_up(pm, o); if (lane >= o) pm = fmaxf(pm, t); }
        const float a = gtot + u;
        const float mloc = wave_max(a);
        GV[wave * 256 + lane] = bs; GV[wave * 256 + 64 + lane] = u; GV[wave * 256 + 128 + lane] = exp_f(a - mloc); GV[wave * 256 + 192 + lane] = pm;
        if (lane == 0) { GS[wave * 2] = gtot; GS[wave * 2 + 1] = mloc; }
    }
    if (PASS == 2 && sg > 0) {
#ifdef MERGE23
        if (tid == 0) { unsigned* fl_ = (unsigned*)(F.ctl + (b * 4 + h) * 64); unsigned* bar_ = (unsigned*)(F.ctl + CW_BAR);
            XB_SPIN(xb_ld(fl_) < 7u, bar_);
            __builtin_amdgcn_fence(__ATOMIC_ACQUIRE, "agent"); asm volatile("s_waitcnt vmcnt(0)" ::: "memory"); }
        __syncthreads();
#endif
        const float* E0 = F.SEG + (size_t)((b * 4 + h) * 8) * SEG_STRIDE;
        float lw[7]; float sfx = 0.f, mfin = -1e30f;
#pragma unroll
        for (int j = 6; j >= 0; --j) { const int jc = (j < sg) ? j : 0; const float mE = E0[(size_t)jc * SEG_STRIDE + 16384 + 128], G = E0[(size_t)jc * SEG_STRIDE + 16384 + 129];
            lw[j] = (j < sg) ? (mE + sfx) : -1e30f; sfx += (j < sg) ? G : 0.f; mfin = fmaxf(mfin, lw[j]); }
        float coef[7];
#pragma unroll
        for (int j = 0; j < 7; ++j) coef[j] = (j < sg) ? exp_f(lw[j] - mfin) : 0.f;
#pragma unroll 1
        for (int j = 0; j < sg; ++j) { const float* Ej = E0 + (size_t)j * SEG_STRIDE; float cj = coef[0];
#pragma unroll
            for (int q = 1; q < 7; ++q) cj = (j == q) ? coef[q] : cj;
#pragma unroll
            for (int et = 0; et < 8; ++et) C[et] += ((const f32x4*)Ej)[(unsigned)((et * 8 + wave) * 64 + lane)] * cj;
            if (tid < 128) FL[FN + tid] += cj * Ej[16384 + tid]; }
        m = mfin;
    }
    if (PASS == 2) {
#pragma unroll
        for (int et = 0; et < 8; ++et) { v2u w; w.x = pg8::cvt_pk_bf16(C[et][0], C[et][1]); w.y = pg8::cvt_pk_bf16(C[et][2], C[et][3]); *(LAS v2u*)(L + ML_CT + (16 * et + l15) * ML_CSTR + (16 * wave + 4 * g4) * 2) = w; }
    }
    const float kscale = 0.08838834764831845f;
    v4u xr[7]; v4u vr[4];
#define ML_LOAD(cidx) do { const int c_ = (cidx); const size_t t0_ = (size_t)b * SEQ + (size_t)c_ * 64; \
        const int mat_ = tid >> 8, r8_ = tid & 255, dg_ = r8_ & 15, l0_ = 4 * (r8_ >> 4); \
        if (PASS == 2 || mat_ == 1) { const bf16* src_ = F.PROJ + (mat_ ? PC_MK : PC_MQ) + h * 128 + 8 * dg_; \
            _Pragma("unroll") for (int j = 0; j < 7; ++j) { const int lr = l0_ + j - 3; xr[j] = (c_ == 0 && lr < 0) ? (v4u){0u, 0u, 0u, 0u} : *(const v4u*)(src_ + (t0_ + lr) * NPROJ); } } \
        if (mat_ == 0) { _Pragma("unroll") for (int lp = 0; lp < 4; ++lp) vr[lp] = *(const v4u*)(F.PROJ + (t0_ + l0_ + lp) * NPROJ + PC_MV + h * 128 + 8 * dg_); } } while (0)
    ML_LOAD(sg * 8);
#pragma unroll 1
    for (int cc = 0; cc < 8; ++cc) {
        const int c = sg * 8 + cc; const size_t t0 = (size_t)b * SEQ + (size_t)c * 64;
        tid = F.tid; asm volatile("" : "+v"(tid));
        lane = tid & 63; l15 = lane & 15; g4 = lane >> 4;
        const int mat = tid >> 8, r8 = tid & 255, dg = r8 & 15, rg = r8 >> 4, l0 = 4 * rg;
        const int tsw = (((rg >> 1) ^ ((dg >> 1) & 7)) << 4) + ((rg & 1) << 3);
        LAS float* GB = GV + cc * 256;
        __syncthreads();
        const float gtot = GS[cc * 2], mloc = GS[cc * 2 + 1];
        if (PASS == 2 || mat == 1) {
            const float w0 = GB[128 + l0], w1 = GB[128 + l0 + 1], w2 = GB[128 + l0 + 2], w3 = GB[128 + l0 + 3];
            unsigned ow[4][4];
            const LAS float* cwp = CW + mat * 128 + 8 * dg;
#pragma unroll
            for (int ip = 0; ip < 4; ++ip) {
                const f32x2v c0 = *(const LAS f32x2v*)(cwp + 2 * ip), c1 = *(const LAS f32x2v*)(cwp + 256 + 2 * ip), c2 = *(const LAS f32x2v*)(cwp + 512 + 2 * ip), c3 = *(const LAS f32x2v*)(cwp + 768 + 2 * ip);
                f32x2v x2[7];
#pragma unroll
                for (int j = 0; j < 7; ++j) { const unsigned w = (ip == 0) ? xr[j].x : (ip == 1) ? xr[j].y : (ip == 2) ? xr[j].z : xr[j].w; x2[j] = (f32x2v){bflo(w), bfhi(w)}; }
                f32x2v y2[4];
#pragma unroll
                for (int lp = 0; lp < 4; ++lp) { const f32x2v t = c0 * x2[lp] + c1 * x2[lp + 1] + c2 * x2[lp + 2] + c3 * x2[lp + 3];
                    const f32x2v e = t * (-LOG2E); f32x2v d; d.x = __builtin_amdgcn_exp2f(e.x); d.y = __builtin_amdgcn_exp2f(e.y); d = d + 1.0f;
                    f32x2v r; r.x = __builtin_amdgcn_rcpf(d.x); r.y = __builtin_amdgcn_rcpf(d.y);
                    y2[lp] = t * r * (mat ? kscale : 1.0f);
                    ow[lp][ip] = pg8::cvt_pk_bf16(y2[lp].x, y2[lp].y); }
                if (mat == 1) {
                    const f32x2v s0 = y2[0] * w0, s1 = y2[1] * w1, s2 = y2[2] * w2, s3 = y2[3] * w3;
                    v2u o; o.x = pg8::cvt_pk_bf16(s0.x, s1.x); o.y = pg8::cvt_pk_bf16(s2.x, s3.x); *(LAS v2u*)(L + ML_KWT + (8 * dg + 2 * ip) * ML_TSTR + tsw) = o;
                    o.x = pg8::cvt_pk_bf16(s0.y, s1.y); o.y = pg8::cvt_pk_bf16(s2.y, s3.y); *(LAS v2u*)(L + ML_KWT + (8 * dg + 2 * ip + 1) * ML_TSTR + tsw) = o; }
            }
            if (PASS == 2) {
                LAS unsigned char* dst = L + (mat ? ML_KS : ML_QS) + l0 * ML_QSTR + 16 * dg;
#pragma unroll
                for (int lp = 0; lp < 4; ++lp) { v4u o; o.x = ow[lp][0]; o.y = ow[lp][1]; o.z = ow[lp][2]; o.w = ow[lp][3]; *(LAS v4u*)(dst + lp * ML_QSTR) = o; }
            }
        }
        if (mat == 0) {
            const unsigned ww[4][4] = {{vr[0].x, vr[0].y, vr[0].z, vr[0].w}, {vr[1].x, vr[1].y, vr[1].z, vr[1].w}, {vr[2].x, vr[2].y, vr[2].z, vr[2].w}, {vr[3].x, vr[3].y, vr[3].z, vr[3].w}};
#pragma unroll
            for (int p = 0; p < 4; ++p) {
                v2u lo, hi;
                lo.x = (ww[0][p] & 0xffffu) | (ww[1][p] << 16); lo.y = (ww[2][p] & 0xffffu) | (ww[3][p] << 16);
                hi.x = (ww[0][p] >> 16) | (ww[1][p] & 0xffff0000u); hi.y = (ww[2][p] >> 16) | (ww[3][p] & 0xffff0000u);
                *(LAS v2u*)(L + ML_VT + (8 * dg + 2 * p) * ML_TSTR + tsw) = lo;
                *(LAS v2u*)(L + ML_VT + (8 * dg + 2 * p + 1) * ML_TSTR + tsw) = hi; }
        }
        __syncthreads();
        if (cc < 7) ML_LOAD(c + 1);
        v4u mo2[2];
        if (PASS == 2) {
#pragma unroll
            for (int it = 0; it < 2; ++it) mo2[it] = *(const v4u*)(F.PROJ + (t0 + 8 * wave + 4 * it + g4) * NPROJ + PC_MO + h * 128 + 8 * l15);
        }
        const float mn = fmaxf(gtot + m, mloc), so = exp_f(gtot + m - mn), sn = exp_f(mloc - mn);
        if (PASS == 2) {
            const int lt = wave >> 1;
#pragma unroll
            for (int si = 0; si < 2; ++si) { const int st = 2 * (wave & 1) + si;
                v2u pw = (v2u){0u, 0u};
                if (st <= lt) {
                    f32x4 acc = (f32x4){0.f, 0.f, 0.f, 0.f};
#pragma unroll
                    for (int ks = 0; ks < 4; ++ks) { const bf16x8 a = *(const LAS bf16x8*)(L + ML_KS + (16 * st + l15) * ML_QSTR + 64 * ks + 16 * g4);
                        const bf16x8 bb = *(const LAS bf16x8*)(L + ML_QS + (16 * lt + l15) * ML_QSTR + 64 * ks + 16 * g4);
                        acc = __builtin_amdgcn_mfma_f32_16x16x32_bf16(a, bb, acc, 0, 0, 0); }
                    const int l = 16 * lt + l15, s0 = 16 * st + 4 * g4; const float bl = GB[l]; const float e0 = bl - (bl + fmaxf(GB[192 + l], m));
                    const f32x4 us = *(const LAS f32x4*)(GB + 64 + s0);
                    float p[4];
#pragma unroll
                    for (int r = 0; r < 4; ++r) { const float e = __builtin_amdgcn_exp2f((e0 + us[r]) * LOG2E); p[r] = (s0 + r <= l) ? acc[r] * e : 0.f; }
                    pw.x = pg8::cvt_pk_bf16(p[0], p[1]); pw.y = pg8::cvt_pk_bf16(p[2], p[3]);
                }
                *(LAS v2u*)(L + ML_PS + (16 * lt + l15) * ML_TSTR + (16 * st + 4 * g4) * 2) = pw;
            }
            __syncthreads();
            {
                const int row = 8 * wave + (lane >> 3), part = lane & 7;
                const v4u pw = *(const LAS v4u*)(L + ML_PS + row * ML_TSTR + 16 * part);
                float pf[8]; unpack8(pw, pf);
                float sp = ((pf[0] + pf[1]) + (pf[2] + pf[3])) + ((pf[4] + pf[5]) + (pf[6] + pf[7]));
                const v4u q0 = *(const LAS v4u*)(L + ML_QS + row * ML_QSTR + 32 * part), q1 = *(const LAS v4u*)(L + ML_QS + row * ML_QSTR + 32 * part + 16);
                float qf[16]; unpack8(q0, qf); unpack8(q1, qf + 8);
                float qn = 0.f;
#pragma unroll
                for (int i = 0; i < 16; ++i) qn += qf[i] * FL[FN + 16 * part + i];
                const float bl = GB[row]; const float mrow = bl + fmaxf(GB[192 + row], m); const float sc = exp_f(bl + m - mrow);
                float tot = sp + sc * qn;
                tot += __shfl_xor(tot, 1); tot += __shfl_xor(tot, 2); tot += __shfl_xor(tot, 4);
                if (part == 0) FL[FDEN + row] = fmaxf(fabsf(tot), exp_f(-mrow));
            }
            const int eh = wave & 1;
            f32x4 o1[4], o2[4];
#pragma unroll
            for (int ei = 0; ei < 4; ++ei) { const int et = 4 * eh + ei;
                f32x4 a1 = (f32x4){0.f, 0.f, 0.f, 0.f}, a2 = (f32x4){0.f, 0.f, 0.f, 0.f};
#pragma unroll
                for (int ks = 0; ks < 2; ++ks) { const bf16x8 a = *(const LAS bf16x8*)(L + ML_VT + (16 * et + l15) * ML_TSTR + (((4 * ks + g4) ^ (et & 7)) << 4));
                    const bf16x8 bb = *(const LAS bf16x8*)(L + ML_PS + (16 * lt + l15) * ML_TSTR + 64 * ks + 16 * g4);
                    a1 = __builtin_amdgcn_mfma_f32_16x16x32_bf16(a, bb, a1, 0, 0, 0); }
#pragma unroll
                for (int ks = 0; ks < 4; ++ks) { const bf16x8 a = *(const LAS bf16x8*)(L + ML_CT + (16 * et + l15) * ML_CSTR + 64 * ks + 16 * g4);
                    const bf16x8 bb = *(const LAS bf16x8*)(L + ML_QS + (16 * lt + l15) * ML_QSTR + 64 * ks + 16 * g4);
                    a2 = __builtin_amdgcn_mfma_f32_16x16x32_bf16(a, bb, a2, 0, 0, 0); }
                o1[ei] = a1; o2[ei] = a2; }
            __syncthreads();
            {
                const int l = 16 * lt + l15; const float bl = GB[l]; const float mrow = bl + fmaxf(GB[192 + l], m); const float sc = exp_f(bl + m - mrow);
                const float inv = 1.0f / FL[FDEN + l];
#pragma unroll
                for (int ei = 0; ei < 4; ++ei) { const int et = 4 * eh + ei; const f32x4 hv = (o1[ei] + o2[ei] * sc) * inv;
                    *(LAS f32x4*)(L + l * ML_HSTR + (16 * et + 4 * g4) * 4) = hv; }
            }
        }
        {
            bf16x8 af[2];
#pragma unroll
            for (int ks = 0; ks < 2; ++ks) af[ks] = *(const LAS bf16x8*)(L + ML_KWT + (16 * wave + l15) * ML_TSTR + (((4 * ks + g4) ^ (wave & 7)) << 4));
#pragma unroll
            for (int et = 0; et < 8; ++et) { f32x4 d = (f32x4){0.f, 0.f, 0.f, 0.f};
#pragma unroll
                for (int ks = 0; ks < 2; ++ks) { const bf16x8 bb = *(const LAS bf16x8*)(L + ML_VT + (16 * et + l15) * ML_TSTR + (((4 * ks + g4) ^ (et & 7)) << 4));
                    d = __builtin_amdgcn_mfma_f32_16x16x32_bf16(af[ks], bb, d, 0, 0, 0); }
                C[et] = C[et] * so + d * sn; }
            if (tid < 128) { float dn = 0.f;
#pragma unroll
                for (int q = 0; q < 8; ++q) { const v4u w = *(const LAS v4u*)(L + ML_KWT + tid * ML_TSTR + 16 * q); float f[8]; unpack8(w, f); dn += ((f[0] + f[1]) + (f[2] + f[3])) + ((f[4] + f[5]) + (f[6] + f[7])); }
                FL[FN + tid] = so * FL[FN + tid] + sn * dn; }
            m = mn; Gsum += gtot;
            if (PASS == 2) {
#pragma unroll
                for (int et = 0; et < 8; ++et) { v2u w; w.x = pg8::cvt_pk_bf16(C[et][0], C[et][1]); w.y = pg8::cvt_pk_bf16(C[et][2], C[et][3]); *(LAS v2u*)(L + ML_CT + (16 * et + l15) * ML_CSTR + (16 * wave + 4 * g4) * 2) = w; }
            }
        }
        if (PASS == 2) {
            __syncthreads();
            const f32x4 gg0 = *(const f32x4*)(F.mlstm_norm_g + h * 128 + 8 * l15), gg1 = *(const f32x4*)(F.mlstm_norm_g + h * 128 + 8 * l15 + 4);
#pragma unroll
            for (int it = 0; it < 2; ++it) { const int l = 8 * wave + 4 * it + g4;
                const f32x4 h0 = *(const LAS f32x4*)(L + l * ML_HSTR + l15 * 32), h1 = *(const LAS f32x4*)(L + l * ML_HSTR + l15 * 32 + 16);
                float ss = (h0[0] * h0[0] + h0[1] * h0[1]) + (h0[2] * h0[2] + h0[3] * h0[3]) + (h1[0] * h1[0] + h1[1] * h1[1]) + (h1[2] * h1[2] + h1[3] * h1[3]);
                ss += __shfl_xor(ss, 1); ss += __shfl_xor(ss, 2); ss += __shfl_xor(ss, 4); ss += __shfl_xor(ss, 8);
                const float rstd = __builtin_amdgcn_rsqf(ss * (1.f / 128.f) + EPS);
                float mo[8]; unpack8(mo2[it], mo);
                const f32x4 y0 = h0 * gg0 * rstd, y1 = h1 * gg1 * rstd;
                v4u o; o.x = pg8::cvt_pk_bf16(y0[0] * mo[0], y0[1] * mo[1]); o.y = pg8::cvt_pk_bf16(y0[2] * mo[2], y0[3] * mo[3]);
                o.z = pg8::cvt_pk_bf16(y1[0] * mo[4], y1[1] * mo[5]); o.w = pg8::cvt_pk_bf16(y1[2] * mo[6], y1[3] * mo[7]);
                *(v4u*)(F.MIX + (t0 + l) * DM + h * 128 + 8 * l15) = o; }
        }
    }
    if (PASS == 1) {
        tid = F.tid; asm volatile("" : "+v"(tid)); lane = tid & 63; l15 = lane & 15; g4 = lane >> 4;
        float* E = F.SEG + (size_t)((b * 4 + h) * 8 + sg) * SEG_STRIDE;
#ifdef MERGE23
#pragma unroll
        for (int et = 0; et < 8; ++et) { const f32x4 cv = C[et]; asm volatile("global_store_dwordx4 %0, %1, off sc1\n\ts_nop 1" :: "v"(&((f32x4*)E)[(et * 8 + wave) * 64 + lane]), "v"(cv) : "memory"); }
        if (tid < 128) __hip_atomic_store(E + 16384 + tid, FL[FN + tid], __ATOMIC_RELAXED, __HIP_MEMORY_SCOPE_AGENT);
        if (tid == 0) { __hip_atomic_store(E + 16384 + 128, m, __ATOMIC_RELAXED, __HIP_MEMORY_SCOPE_AGENT); __hip_atomic_store(E + 16384 + 129, Gsum, __ATOMIC_RELAXED, __HIP_MEMORY_SCOPE_AGENT); }
        asm volatile("s_waitcnt vmcnt(0)" ::: "memory");
        __syncthreads();
        if (tid == 0) (void)xb_add((unsigned*)(F.ctl + (b * 4 + h) * 64), 1u);
#else
#pragma unroll
        for (int et = 0; et < 8; ++et) ((f32x4*)E)[(et * 8 + wave) * 64 + lane] = C[et];
        if (tid < 128) E[16384 + tid] = FL[FN + tid];
        if (tid == 0) { E[16384 + 128] = m; E[16384 + 129] = Gsum; }
#endif
    }
}
template <int PASS> __device__ __forceinline__ void mlstm_phase(Frame& F) {
    for (int it = F.vcu; it < NB * 4 * 8; it += F.G) { const int sg = it & 7, h = (it >> 3) & 3, b = it >> 5;
        if (PASS == 1 && sg == 7) { convert_gu(F, it >> 3, NB * 4); continue; }
        mlstm_item<PASS>(F, b, h, sg); }
}
struct Args { const float* in[15]; float* out; unsigned char* ws; int ph_lo, ph_hi, li, pad; };
__global__ void __launch_bounds__(NWAVES * 64, 2) mk_fwd(Args args) {
    extern __shared__ __attribute__((aligned(16))) unsigned char lds[];
    Frame F;
    F.lds = (LAS unsigned char*)lds;
    F.MISC = (volatile LAS unsigned*)(F.lds + MISC_OFF);
    F.tid = threadIdx.x; F.lane = F.tid & 63; F.wave = __builtin_amdgcn_readfirstlane(F.tid >> 6);
    F.G = gridDim.x; { const int bx = blockIdx.x; F.vcu = (F.G % 8 == 0) ? (bx % 8) * (F.G / 8) + bx / 8 : bx; }
    unsigned char* ws = args.ws;
    F.ctl = (gu32*)(ws + WS_CTL);
    F.x = args.in[0]; F.norm1_g = args.in[1]; F.w_in = args.in[2]; F.conv_w = args.in[3]; F.igate_b = args.in[4]; F.fgate_b = args.in[5]; F.mlstm_norm_g = args.in[6];
    F.q_norm_g = args.in[7]; F.k_norm_g = args.in[8]; F.sinks = args.in[9]; F.w_out = args.in[10]; F.norm2_g = args.in[11]; F.w_gate = args.in[12]; F.w_up = args.in[13]; F.w_down = args.in[14];
    F.out = args.out;
    F.Win_t = (bf16*)(ws + WS_WIN); F.Wout_t = (bf16*)(ws + WS_WOUT); F.Wgu_t = (bf16*)(ws + WS_WGU); F.Wdn_t = (bf16*)(ws + WS_WDN);
    F.XN = (bf16*)(ws + WS_XN); F.MIX = (bf16*)(ws + WS_MIX); F.PROJ = (bf16*)(ws + WS_PROJ);
    F.ROPE = (float2*)(ws + WS_ROPE); F.GATES = (float*)(ws + WS_GATES); F.SSQ = (float*)(ws + WS_SSQ); F.SEG = (float*)(ws + WS_SEG); F.WBG = ws + WS_WBG;
    for (int u = F.tid; u < (LDS_BYTES - LDSCTL_OFF) / 4; u += NWAVES * 64) ((LAS unsigned*)(F.lds + LDSCTL_OFF))[u] = 0u;
    __syncthreads();
    const int lo = args.ph_lo, hi = args.ph_hi;
    XcdBarrier bar; bar.bar = (unsigned*)(F.ctl + CW_BAR) + args.li * XCD_BAR_WORDS; bar.x = 0; bar.st = nullptr;
    if (hi - lo > 1) bar = xcd_barrier_post((unsigned*)(F.ctl + CW_BAR) + args.li * XCD_BAR_WORDS, F.MISC + 8);
#define IN(k) (lo <= (k) && (k) < hi)
#define BOTH(k) (IN(k) && IN((k) + 1))
#define GRID_BAR() xcd_barrier(bar)

#ifndef PROBE_LOCALBAR
#define PROBE_LOCALBAR 0
#endif
#ifndef DOUBLE_PHASE
#define DOUBLE_PHASE -1
#endif
#define RUN_PHASE(k, BODY) if (IN(k)) { { int t_ = threadIdx.x; asm volatile("" : "+v"(t_)); F.tid = t_; F.lane = t_ & 63; }     \
    BODY; if (DOUBLE_PHASE == (k)) { GRID_BAR(); BODY; } if (PROBE_LOCALBAR && ((k) == 1 || (k) == 4 || (k) == 5)) xcd_barrier_local(bar); if (BOTH(k)) GRID_BAR(); }
#define PH0 p0_prologue(F)
#define PH1 do { pg8::Gemm g{F.XN, F.Win_t, T, NPROJ, DM}; pg8::StaticOrder S; S.init(T, NPROJ, F.G, (int)blockIdx.x); pg8::EpiStoreBf16 E{F.PROJ, NPROJ, PC_MO / 256, (PC_MO + 512) / 256}; \
        pg8::gemm_phase<pg8::EpiStoreBf16, pg8::StaticOrder, true, true>(F.lds, g, S, E); \
        { const int nwg_ = (T / 256) * (NPROJ / 256), rem_ = nwg_ % F.G;               \
          if (rem_ == 0) p1_side_work(F, (int)blockIdx.x, F.G); else if ((int)blockIdx.x >= rem_) p1_side_work(F, (int)blockIdx.x - rem_, F.G - rem_); } } while (0)
#ifdef H1_BF16
#define PH4 do { pg8::Gemm g{F.MIX, F.Wout_t, T, DM, DM}; pg8::StaticOrder S; S.init(T, DM, F.G, (int)blockIdx.x); pg8::EpiResidNormBS E{F.x, F.XN, F.SSQ}; \
        pg8::gemm_phase<pg8::EpiResidNormBS, pg8::StaticOrder, true, true>(F.lds, g, S, E); } while (0)
#ifdef P6_STREAM
#define PH6 do { pg8::Gemm g{F.PROJ, F.Wdn_t, T, DM, DFF}; pg8::StaticOrder S; S.init(T, DM, F.G, (int)blockIdx.x); pg8::EpiResidOutBS E{F.XN, F.out}; \
        pg8::gemm_phase<pg8::EpiResidOutBS, pg8::StaticOrder, true, true>(F.lds, g, S, E); } while (0)
#else
#define PH6 do { pg8::Gemm g{F.PROJ, F.Wdn_t, T, DM, DFF}; pg8::StaticOrder S; S.init(T, DM, F.G, (int)blockIdx.x); pg8::EpiResidOutB E{F.XN, F.out}; \
        pg8::gemm_phase<pg8::EpiResidOutB, pg8::StaticOrder, true, true>(F.lds, g, S, E); } while (0)
#endif
#else
#define PH4 do { pg8::Gemm g{F.MIX, F.Wout_t, T, DM, DM}; pg8::StaticOrder S; S.init(T, DM, F.G, (int)blockIdx.x); pg8::EpiResidNorm E{F.x, F.out, F.XN, F.SSQ}; \
        pg8::gemm_phase<pg8::EpiResidNorm, pg8::StaticOrder, true, true>(F.lds, g, S, E); } while (0)
#define PH6 do { pg8::Gemm g{F.PROJ, F.Wdn_t, T, DM, DFF}; pg8::StaticOrder S; S.init(T, DM, F.G, (int)blockIdx.x); pg8::EpiResidOut E{F.out, F.out}; \
        pg8::gemm_phase<pg8::EpiResidOut, pg8::StaticOrder, true, true>(F.lds, g, S, E); } while (0)
#endif
#define PH5 do { pg8::Gemm g{F.XN, F.Wgu_t, T, 2 * DFF, DM}; pg8::StaticOrder S; S.init(T, 2 * DFF, F.G, (int)blockIdx.x); pg8::EpiSwiGLU E{F.PROJ, DFF, F.SSQ, EPS}; \
        pg8::gemm_phase<pg8::EpiSwiGLU, pg8::StaticOrder, P5_ALIGN, true>(F.lds, g, S, E); } while (0)
    RUN_PHASE(0, PH0)
    RUN_PHASE(1, PH1)
    RUN_PHASE(2, PHASE2_BODY)
#ifndef MERGE23
    RUN_PHASE(3, PHASE3_BODY)
#endif
    RUN_PHASE(4, PH4)
    RUN_PHASE(5, PH5)
    RUN_PHASE(6, PH6)
#undef IN
#undef BOTH
}
extern "C" void kernel_launch(void* const* d_in, const int* in_sizes, int n_in, void* d_out, int out_size, void* d_ws, size_t ws_size, hipStream_t stream) {
    static int grid = 0;
    if (grid == 0) {
        if (n_in != 15 || in_sizes[0] != T * DM || out_size != T * DM || ws_size < WS_END) { fprintf(stderr, "kernel_launch: unexpected shapes / workspace (n_in %d, ws %zu)\n", n_in, ws_size); grid = -1; return; }
        int dev = 0, cus = 0, per_cu = 0;
        if (hipGetDevice(&dev) != hipSuccess || hipDeviceGetAttribute(&cus, hipDeviceAttributeMultiprocessorCount, dev) != hipSuccess) { grid = -1; return; }
        if (hipFuncSetAttribute((const void*)mk_fwd, hipFuncAttributeMaxDynamicSharedMemorySize, LDS_BYTES) != hipSuccess) { fprintf(stderr, "kernel_launch: hipFuncSetAttribute failed\n"); grid = -1; return; }
        if (hipOccupancyMaxActiveBlocksPerMultiprocessor(&per_cu, (const void*)mk_fwd, NWAVES * 64, LDS_BYTES) != hipSuccess || per_cu < 1) { fprintf(stderr, "kernel_launch: occupancy query says %d blocks per CU\n", per_cu); grid = -1; (void)hipGetLastError(); return; }
        grid = cus;
    }
    if (grid < 0) return;
    (void)hipMemsetAsync((char*)d_ws + WS_CTL, 0, CTL_ZERO_BYTES, stream);
    Args a{};
    for (int i = 0; i < 15; ++i) a.in[i] = (const float*)d_in[i];
    a.out = (float*)d_out; a.ws = (unsigned char*)d_ws;
    LAUNCH_PROGRAM
}
```

```cpp
#define SADDR_SEL 114
#include <hip/hip_runtime.h>
#include <cstdio>
#include <cstdint>
__device__ __forceinline__ int fresh_lane() { return (int)__builtin_amdgcn_mbcnt_hi(~0u, __builtin_amdgcn_mbcnt_lo(~0u, 0u)); }
namespace pg8 {
#define PG8_LAS __attribute__((address_space(3)))
typedef unsigned short bf16_t;
typedef short bf16x8 __attribute__((ext_vector_type(8)));
typedef float f32x4 __attribute__((ext_vector_type(4)));
typedef unsigned u32x4 __attribute__((ext_vector_type(4)));
constexpr int BM = 256, BK = 64, HALF = 128, HTB = HALF * BK * 2  , STAGE_BYTES = 8 * HTB, NXCD = 8, WGM = 8;

__host__ __device__ __forceinline__ int lds_byte(int r, int c) { const int st = (r >> 4) * 2 + (c >> 5), rr = r & 15, cc = c & 31, ob = rr * 64 + cc * 2; return st * 1024 + (ob ^ (((ob >> 9) & 1) << 5)); }
__host__ __device__ __forceinline__ void stage_rc(int b, int& R, int& C) { const int st = b / 1024, sb = b % 1024, swz = sb ^ (((sb >> 9) & 1) << 5); R = (st >> 1) * 16 + swz / 64; C = (st & 1) * 32 + (swz % 64) / 2; }
__host__ __device__ __forceinline__ int perm32(int rho) { const int n = rho >> 4, i = rho & 15; return 8 * (i >> 2) + 4 * n + (i & 3); }

struct Unit { int pm, pn; };
struct Gemm { const bf16_t* A; const bf16_t* Bt; int M, N, K; };

struct StaticOrder {
    int nM, nN, nwg, G, c;
    __host__ __device__ void init(int M, int N, int G_, int c_) { nM = M / BM; nN = N / BM; nwg = nM * nN; G = G_; c = c_; }
    __host__ __device__ bool next(int i, Unit& u) const {
        const long L = (long)i * G + c; if (L >= nwg) return false;
        int wgid = (int)L; { const int q = nwg / NXCD, r = nwg % NXCD, xcd = wgid % NXCD, off = wgid / NXCD; wgid = (xcd < r ? xcd * (q + 1) : r * (q + 1) + (xcd - r) * q) + off; }
        const int nig = WGM * nN, gid = wgid / nig, fm = gid * WGM, gsz = (nM - fm) < WGM ? (nM - fm) : WGM;
        u.pm = fm + ((wgid % nig) % gsz); u.pn = (wgid % nig) / gsz; return true;
    }
    __device__ __forceinline__ void a_ready(const Unit&) const {}
    __device__ __forceinline__ void done(const Unit&) const {}
};

__device__ __forceinline__ unsigned cvt_pk_bf16(float lo, float hi) { unsigned r; asm volatile("v_cvt_pk_bf16_f32 %0, %1, %2" : "=v"(r) : "v"(lo), "v"(hi)); return r; }
typedef float f32x2 __attribute__((ext_vector_type(2)));
#ifndef SADDR_SEL
#define SADDR_SEL 0
#endif
#ifndef PROBE_SEL
#define PROBE_SEL 0
#endif
#ifdef WT_STORES
__device__ __forceinline__ void st16(void* p, u32x4 v) { asm volatile("global_store_dwordx4 %0, %1, off sc1\n\ts_nop 1" :: "v"(p), "v"(v) : "memory"); }
#else
__device__ __forceinline__ void st16(void* p, u32x4 v) { *(u32x4*)p = v; }
#endif
__device__ __forceinline__ void st16_nt(void* p, u32x4 v) { __builtin_nontemporal_store(v, (u32x4*)p); }
__device__ __forceinline__ float fast_silu(float v) { return v * __builtin_amdgcn_rcpf(1.0f + __builtin_amdgcn_exp2f(v * -1.4426950408889634f)); }
struct EpiStoreBf16 {
    static constexpr bool SADDR = (SADDR_SEL & 2) != 0, PROBE2 = (PROBE_SEL == 1), PERM = true, AFTER_DRAIN = false, STREAM_R = false, STREAM_BF16 = false;
    bf16_t* O; int ldc; int sg0, sg1;
    template <bool SIG> __device__ __forceinline__ void body(const f32x4 (&acc)[2][2][4][2], const Unit& u, int wr, int wc, int fr, int fq) const {
        const int row0 = u.pm * BM + wr * 64 + fr, col0 = u.pn * BM + wc * 32 + 8 * fq;
#pragma unroll
        for (int ai = 0; ai < 2; ++ai)
#pragma unroll
            for (int m = 0; m < 4; ++m) { bf16_t* rowp = O + (size_t)(row0 + ai * HALF + m * 16) * ldc + col0;
#pragma unroll
                for (int bj = 0; bj < 2; ++bj) { f32x4 v0 = acc[ai][bj][m][0], v1 = acc[ai][bj][m][1];
                    if (SIG) {
#pragma unroll
                        for (int jp = 0; jp < 2; ++jp) {
                            typedef float f32x2_ __attribute__((ext_vector_type(2)));
                            const f32x2_ c = (f32x2_){-1.4426950408889634f, -1.4426950408889634f}, one = (f32x2_){1.0f, 1.0f};
                            const f32x2_ t0 = (f32x2_){v0[2 * jp], v0[2 * jp + 1]} * c, t1 = (f32x2_){v1[2 * jp], v1[2 * jp + 1]} * c;
                            const f32x2_ d0 = (f32x2_){__builtin_amdgcn_exp2f(t0.x), __builtin_amdgcn_exp2f(t0.y)} + one, d1 = (f32x2_){__builtin_amdgcn_exp2f(t1.x), __builtin_amdgcn_exp2f(t1.y)} + one;
                            v0[2 * jp] = __builtin_amdgcn_rcpf(d0.x); v0[2 * jp + 1] = __builtin_amdgcn_rcpf(d0.y); v1[2 * jp] = __builtin_amdgcn_rcpf(d1.x); v1[2 * jp + 1] = __builtin_amdgcn_rcpf(d1.y); } }
                    u32x4 w; w.x = cvt_pk_bf16(v0[0], v0[1]); w.y = cvt_pk_bf16(v0[2], v0[3]); w.z = cvt_pk_bf16(v1[0], v1[1]); w.w = cvt_pk_bf16(v1[2], v1[3]);
                    st16(rowp + bj * HALF, w); } }
    }
    __device__ __forceinline__ void operator()(const f32x4 (&acc)[2][2][4][2], const Unit& u, int wr, int wc, int fr, int fq) const {
        if (u.pn >= sg0 && u.pn < sg1) body<true>(acc, u, wr, wc, fr, fq); else body<false>(acc, u, wr, wc, fr, fq);
    }
};
struct EpiResidNorm {
    static constexpr bool SADDR = false, PROBE2 = false, PERM = true, AFTER_DRAIN = false, STREAM_R = false, STREAM_BF16 = false;
    const float* X; float* H; bf16_t* HB; float* SSQ;
    __device__ __forceinline__ void operator()(const f32x4 (&acc)[2][2][4][2], const Unit& u, int wr, int wc, int fr, int fq) const {
        const int row0 = u.pm * BM + wr * 64 + fr, col0 = u.pn * BM + wc * 32 + 8 * fq;
#pragma unroll
        for (int ai = 0; ai < 2; ++ai)
#pragma unroll
            for (int m = 0; m < 4; ++m) { const int row = row0 + ai * HALF + m * 16; const size_t off = (size_t)row * 1024 + col0; float ss = 0.f;
#pragma unroll
                for (int bj = 0; bj < 2; ++bj) { const f32x4 x0 = *(const f32x4*)(X + off + bj * HALF), x1 = *(const f32x4*)(X + off + bj * HALF + 4);
                    const f32x4 v0 = x0 + acc[ai][bj][m][0], v1 = x1 + acc[ai][bj][m][1];
                    *(f32x4*)(H + off + bj * HALF) = v0; *(f32x4*)(H + off + bj * HALF + 4) = v1;
                    u32x4 w; w.x = cvt_pk_bf16(v0[0], v0[1]); w.y = cvt_pk_bf16(v0[2], v0[3]); w.z = cvt_pk_bf16(v1[0], v1[1]); w.w = cvt_pk_bf16(v1[2], v1[3]);
                    *(u32x4*)(HB + off + bj * HALF) = w;
                    ss += (v0[0] * v0[0] + v0[1] * v0[1]) + (v0[2] * v0[2] + v0[3] * v0[3]) + (v1[0] * v1[0] + v1[1] * v1[1]) + (v1[2] * v1[2] + v1[3] * v1[3]); }
                ss += __shfl_xor(ss, 16); ss += __shfl_xor(ss, 32);
                if (fq == 0) SSQ[(size_t)row * 16 + u.pn * 4 + wc] = ss; }
    }
};
struct EpiSwiGLU {
    static constexpr bool SADDR = (SADDR_SEL & 32) != 0, PROBE2 = (PROBE_SEL == 5), PERM = true, AFTER_DRAIN = false, STREAM_R = false, STREAM_BF16 = false;
    bf16_t* O; int ldc; const float* SSQ; float eps;
    __device__ __forceinline__ void operator()(const f32x4 (&acc)[2][2][4][2], const Unit& u, int wr, int wc, int fr, int fq) const {
        const int row0 = u.pm * BM + wr * 64 + fr, col0 = u.pn * HALF + wc * 32 + 8 * fq;
        float rsv[8];
        { f32x4 sv[8];
#pragma unroll
          for (int grp = 0; grp < 8; ++grp) sv[grp] = *(const f32x4*)(SSQ + (size_t)(row0 + (grp >> 2) * HALF + (grp & 3) * 16) * 16 + 4 * fq);
#pragma unroll
          for (int grp = 0; grp < 8; ++grp) { float t = (sv[grp][0] + sv[grp][1]) + (sv[grp][2] + sv[grp][3]); t += __shfl_xor(t, 16); t += __shfl_xor(t, 32);
              rsv[grp] = t * (1.0f / 1024.0f) + eps; } }
#pragma unroll
        for (int grp = 0; grp < 8; ++grp) { const int ai = grp >> 2, m = grp & 3; const int row = row0 + ai * HALF + m * 16;
            typedef float f32x2_ __attribute__((ext_vector_type(2)));
            const float iv = rsv[grp]; const float c1s = __builtin_amdgcn_rsqf(iv) * -1.4426950408889634f;
            const f32x2_ c1 = (f32x2_){c1s, c1s}, iv2 = (f32x2_){iv, iv};
            float h[8];
#pragma unroll
            for (int n = 0; n < 2; ++n)
#pragma unroll
                for (int jp = 0; jp < 2; ++jp) { const f32x2_ ag = (f32x2_){acc[ai][0][m][n][2 * jp], acc[ai][0][m][n][2 * jp + 1]}, au = (f32x2_){acc[ai][1][m][n][2 * jp], acc[ai][1][m][n][2 * jp + 1]};
                    const f32x2_ t = ag * c1; const f32x2_ d = __builtin_elementwise_fma((f32x2_){__builtin_amdgcn_exp2f(t.x), __builtin_amdgcn_exp2f(t.y)}, iv2, iv2);
                    const f32x2_ q = (f32x2_){__builtin_amdgcn_rcpf(d.x), __builtin_amdgcn_rcpf(d.y)}; const f32x2_ hh = (ag * au) * q;
                    h[n * 4 + 2 * jp] = hh.x; h[n * 4 + 2 * jp + 1] = hh.y; }
            u32x4 w; w.x = cvt_pk_bf16(h[0], h[1]); w.y = cvt_pk_bf16(h[2], h[3]); w.z = cvt_pk_bf16(h[4], h[5]); w.w = cvt_pk_bf16(h[6], h[7]);
            st16_nt(O + (size_t)row * ldc + col0, w); }
    }
};
struct EpiResidOut {
    static constexpr bool SADDR = false, PROBE2 = false, PERM = true, AFTER_DRAIN = false, STREAM_R = false, STREAM_BF16 = false;
    const float* R; float* OUT;
    __device__ __forceinline__ void operator()(const f32x4 (&acc)[2][2][4][2], const Unit& u, int wr, int wc, int fr, int fq) const {
        const int row0 = u.pm * BM + wr * 64 + fr, col0 = u.pn * BM + wc * 32 + 8 * fq;
#pragma unroll
        for (int ai = 0; ai < 2; ++ai)
#pragma unroll
            for (int m = 0; m < 4; ++m) { const size_t off = (size_t)(row0 + ai * HALF + m * 16) * 1024 + col0;
#pragma unroll
                for (int bj = 0; bj < 2; ++bj) { const f32x4 r0 = *(const f32x4*)(R + off + bj * HALF), r1 = *(const f32x4*)(R + off + bj * HALF + 4);
                    *(f32x4*)(OUT + off + bj * HALF) = r0 + acc[ai][bj][m][0]; *(f32x4*)(OUT + off + bj * HALF + 4) = r1 + acc[ai][bj][m][1]; } }
    }
};
struct EpiResidNormB {
    static constexpr bool SADDR = false, PROBE2 = false, PERM = true, AFTER_DRAIN = false, STREAM_R = false, STREAM_BF16 = false;
    const float* X; bf16_t* HB; float* SSQ;
    __device__ __forceinline__ void operator()(const f32x4 (&acc)[2][2][4][2], const Unit& u, int wr, int wc, int fr, int fq) const {
        const int row0 = u.pm * BM + wr * 64 + fr, col0 = u.pn * BM + wc * 32 + 8 * fq;
#pragma unroll
        for (int ai = 0; ai < 2; ++ai)
#pragma unroll
            for (int m = 0; m < 4; ++m) { const int row = row0 + ai * HALF + m * 16; const size_t off = (size_t)row * 1024 + col0; float ss = 0.f;
#pragma unroll
                for (int bj = 0; bj < 2; ++bj) { const f32x4 x0 = *(const f32x4*)(X + off + bj * HALF), x1 = *(const f32x4*)(X + off + bj * HALF + 4);
                    const f32x4 v0 = x0 + acc[ai][bj][m][0], v1 = x1 + acc[ai][bj][m][1];
                    u32x4 w; w.x = cvt_pk_bf16(v0[0], v0[1]); w.y = cvt_pk_bf16(v0[2], v0[3]); w.z = cvt_pk_bf16(v1[0], v1[1]); w.w = cvt_pk_bf16(v1[2], v1[3]);
                    *(u32x4*)(HB + off + bj * HALF) = w;
                    ss += (v0[0] * v0[0] + v0[1] * v0[1]) + (v0[2] * v0[2] + v0[3] * v0[3]) + (v1[0] * v1[0] + v1[1] * v1[1]) + (v1[2] * v1[2] + v1[3] * v1[3]); }
                ss += __shfl_xor(ss, 16); ss += __shfl_xor(ss, 32);
                if (fq == 0) SSQ[(size_t)row * 16 + u.pn * 4 + wc] = ss; }
    }
};
struct EpiResidOutB {
    static constexpr bool SADDR = (SADDR_SEL & 64) != 0, PROBE2 = (PROBE_SEL == 6), PERM = true, AFTER_DRAIN = false, STREAM_R = false, STREAM_BF16 = false;
    const bf16_t* RB; float* OUT;
    __device__ __forceinline__ void operator()(const f32x4 (&acc)[2][2][4][2], const Unit& u, int wr, int wc, int fr, int fq) const {
        const int row0 = u.pm * BM + wr * 64 + fr, col0 = u.pn * BM + wc * 32 + 8 * fq;
        u32x4 rw[2][4][2];
#pragma unroll
        for (int ai = 0; ai < 2; ++ai)
#pragma unroll
            for (int m = 0; m < 4; ++m) { const size_t off = (size_t)(row0 + ai * HALF + m * 16) * 1024 + col0;
#pragma unroll
                for (int bj = 0; bj < 2; ++bj) rw[ai][m][bj] = *(const u32x4*)(RB + off + bj * HALF); }
        asm volatile("" ::: "memory");
#pragma unroll
        for (int ai = 0; ai < 2; ++ai)
#pragma unroll
            for (int m = 0; m < 4; ++m) { const size_t off = (size_t)(row0 + ai * HALF + m * 16) * 1024 + col0;
#pragma unroll
                for (int bj = 0; bj < 2; ++bj) { const u32x4 w = rw[ai][m][bj];
                    const f32x4 r0 = (f32x4){__builtin_bit_cast(float, w.x << 16), __builtin_bit_cast(float, w.x & 0xffff0000u), __builtin_bit_cast(float, w.y << 16), __builtin_bit_cast(float, w.y & 0xffff0000u)};
                    const f32x4 r1 = (f32x4){__builtin_bit_cast(float, w.z << 16), __builtin_bit_cast(float, w.z & 0xffff0000u), __builtin_bit_cast(float, w.w << 16), __builtin_bit_cast(float, w.w & 0xffff0000u)};
                    *(f32x4*)(OUT + off + bj * HALF) = r0 + acc[ai][bj][m][0]; *(f32x4*)(OUT + off + bj * HALF + 4) = r1 + acc[ai][bj][m][1]; } }
    }
};
struct EpiResidNormBS {
    static constexpr bool SADDR = (SADDR_SEL & 16) != 0, PROBE2 = (PROBE_SEL == 4), PERM = true, AFTER_DRAIN = false, STREAM_R = true, STREAM_BF16 = false;
    const float* RS; bf16_t* HB; float* SSQ;
    __device__ __forceinline__ void operator()(const f32x4 (&acc)[2][2][4][2], const Unit& u, int wr, int wc, int fr, int fq) const {
        const int row0 = u.pm * BM + wr * 64 + fr, col0 = u.pn * BM + wc * 32 + 8 * fq;
#pragma unroll
        for (int ai = 0; ai < 2; ++ai)
#pragma unroll
            for (int m = 0; m < 4; ++m) { const int row = row0 + ai * HALF + m * 16; const size_t off = (size_t)row * 1024 + col0; float ss = 0.f;
#pragma unroll
                for (int bj = 0; bj < 2; ++bj) { const f32x4 v0 = acc[ai][bj][m][0], v1 = acc[ai][bj][m][1];
                    u32x4 w; w.x = cvt_pk_bf16(v0[0], v0[1]); w.y = cvt_pk_bf16(v0[2], v0[3]); w.z = cvt_pk_bf16(v1[0], v1[1]); w.w = cvt_pk_bf16(v1[2], v1[3]);
                    st16(HB + off + bj * HALF, w);
                    ss += (v0[0] * v0[0] + v0[1] * v0[1]) + (v0[2] * v0[2] + v0[3] * v0[3]) + (v1[0] * v1[0] + v1[1] * v1[1]) + (v1[2] * v1[2] + v1[3] * v1[3]); }
                ss += __shfl_xor(ss, 16); ss += __shfl_xor(ss, 32);
                if (fq == 0) SSQ[(size_t)row * 16 + u.pn * 4 + wc] = ss; }
    }
};
struct EpiResidOutBS {
    static constexpr bool SADDR = (SADDR_SEL & 64) != 0, PROBE2 = false, PERM = true, AFTER_DRAIN = false, STREAM_R = true, STREAM_BF16 = true;
    const bf16_t* RS; float* OUT;
    __device__ __forceinline__ void operator()(const f32x4 (&acc)[2][2][4][2], const Unit& u, int wr, int wc, int fr, int fq) const {
        const int row0 = u.pm * BM + wr * 64 + fr, col0 = u.pn * BM + wc * 32 + 8 * fq;
#pragma unroll
        for (int ai = 0; ai < 2; ++ai)
#pragma unroll
            for (int m = 0; m < 4; ++m) { const size_t off = (size_t)(row0 + ai * HALF + m * 16) * 1024 + col0;
#pragma unroll
                for (int bj = 0; bj < 2; ++bj) { *(f32x4*)(OUT + off + bj * HALF) = acc[ai][bj][m][0]; *(f32x4*)(OUT + off + bj * HALF + 4) = acc[ai][bj][m][1]; } }
    }
};
#ifndef PIECE_F32_AUX
#define PIECE_F32_AUX 2
#endif
#ifdef PROBE_EPI2
#define PG8_EPI_TWICE if constexpr (Epi::PROBE2) { asm volatile("" ::: "memory"); E(acc, cur, wr, wc, fr, fq); }
#else
#define PG8_EPI_TWICE
#endif
template <class Epi, class Sched, bool ALIGN_EPI = false, bool SP2 = false>
__device__ __forceinline__ void gemm_phase(PG8_LAS unsigned char* lds, const Gemm g, const Sched& S, const Epi& E) {
    const int tid = threadIdx.x, wid = __builtin_amdgcn_readfirstlane(tid >> 6), lane = tid & 63, wr = wid >> 2, wc = wid & 3, fr = lane & 15, fq = lane >> 4;
    const int K = g.K, nt = K / BK;
    unsigned voffA[2], voffB[2];
#pragma unroll
    for (int i = 0; i < 2; ++i) { int R, C; stage_rc(tid * 16 + i * 8192, R, C); const int Rb = Epi::PERM ? ((R & ~31) + perm32(R & 31)) : R;
        voffA[i] = (unsigned)(R * K + C) * 2u; voffB[i] = (unsigned)(Rb * K + C) * 2u; }
    const size_t kstep = (size_t)(BK * 2);
    const size_t hstep = (size_t)HALF * K * 2;
    const size_t tstep = 2 * hstep;
    const unsigned ldsw = (unsigned)wid * 1024u;
    int wrv = wr, wcv = wc; asm volatile("" : "+v"(wrv), "+v"(wcv));
    const int aoff = lds_byte(wrv * 64 + fr, fq * 8), boff = lds_byte(wcv * 32 + fr, fq * 8);
#define PG8_SA(b, h) (((b) * 2 + (h)) * HTB)
#define PG8_SB(b, h) ((4 + (b) * 2 + (h)) * HTB)
#define PG8_STAGE(bufoff, gbase, voff) do { const char* gb_ = (const char*)(gbase); if constexpr (Epi::SADDR) asm volatile("" : "+s"(gb_));     \
        _Pragma("unroll") for (int _i = 0; _i < 2; ++_i) \
        __builtin_amdgcn_global_load_lds((const unsigned*)(gb_ + (voff)[_i]), (PG8_LAS unsigned*)(lds + (bufoff) + ldsw + _i * 8192), 16, 0, 0); } while (0)
#define PG8_PIN() do { if constexpr (Epi::SADDR) asm volatile("" : "+v"(voffA[0]), "+v"(voffA[1]), "+v"(voffB[0]), "+v"(voffB[1]), "+v"(rvo)); } while (0)
#define PG8_LDA(dst, b, h) do { _Pragma("unroll") for (int m = 0; m < 4; ++m) _Pragma("unroll") for (int k = 0; k < 2; ++k) dst[m][k] = *(const PG8_LAS bf16x8*)(lds + PG8_SA(b, h) + aoff + m * 2048 + k * 1024); } while (0)
#define PG8_LDB(dst, b, h) do { _Pragma("unroll") for (int n = 0; n < 2; ++n) _Pragma("unroll") for (int k = 0; k < 2; ++k) dst[n][k] = *(const PG8_LAS bf16x8*)(lds + PG8_SB(b, h) + boff + n * 2048 + k * 1024); } while (0)
#define PG8_MMA(ai, bj, At, Bt) do { __builtin_amdgcn_s_setprio(1); _Pragma("unroll") for (int m = 0; m < 4; ++m) _Pragma("unroll") for (int n = 0; n < 2; ++n) _Pragma("unroll") for (int k = 0; k < 2; ++k) \
        acc[ai][bj][m][n] = __builtin_amdgcn_mfma_f32_16x16x32_bf16(Bt[n][k], At[m][k], acc[ai][bj][m][n], 0, 0, 0); __builtin_amdgcn_s_setprio(0); } while (0)
#define PG8_WAIT_V(n) asm volatile("s_waitcnt vmcnt(" #n ")" ::: "memory")
#define PG8_WAIT_L(n) asm volatile("s_waitcnt lgkmcnt(" #n ")" ::: "memory")
#define PG8_BAR __builtin_amdgcn_s_barrier()
#define PG8_SCHED __builtin_amdgcn_sched_barrier(0)
#define PG8_PIECE_OFF 147456
#define PG8_RLOAD_P(p) do { if constexpr (Epi::STREAM_BF16) { \
            const char* rb_ = rcur + (size_t)((((((p) >> 3) & 1) * HALF + (((p) >> 1) & 3) * 16) * 1024 + ((p) & 1) * HALF) * 2); if constexpr (Epi::SADDR) asm volatile("" : "+s"(rb_)); \
            __builtin_amdgcn_global_load_lds((const unsigned*)(rb_ + rvo), (PG8_LAS unsigned*)(lds + PG8_PIECE_OFF + wid * 2048), 16, 0, 0); \
        } else { \
            const char* rb_ = rcur + (size_t)((((((p) >> 3) & 1) * HALF + (((p) >> 1) & 3) * 16) * 1024 + ((p) & 1) * HALF) * 4); if constexpr (Epi::SADDR) asm volatile("" : "+s"(rb_)); \
            __builtin_amdgcn_global_load_lds((const unsigned*)(rb_ + rvo), (PG8_LAS unsigned*)(lds + PG8_PIECE_OFF + wid * 2048), 16, 0, PIECE_F32_AUX); \
            const char* rc_ = rb_ + 16; if constexpr (Epi::SADDR) asm volatile("" : "+s"(rc_)); \
            __builtin_amdgcn_global_load_lds((const unsigned*)(rc_ + rvo), (PG8_LAS unsigned*)(lds + PG8_PIECE_OFF + wid * 2048 + 1024), 16, 0, PIECE_F32_AUX); } } while (0)
#define PG8_RADD_P(p) do { if constexpr (Epi::STREAM_BF16) { typedef unsigned u32x2_ __attribute__((ext_vector_type(2))); \
            { const u32x2_ w_ = *(const PG8_LAS u32x2_*)(lds + PG8_PIECE_OFF + wid * 2048 + lane * 16); \
              acc[((p) >> 3) & 1][(p) & 1][((p) >> 1) & 3][0] += (f32x4){__builtin_bit_cast(float, w_.x << 16), __builtin_bit_cast(float, w_.x & 0xffff0000u), __builtin_bit_cast(float, w_.y << 16), __builtin_bit_cast(float, w_.y & 0xffff0000u)}; } \
            asm volatile("" ::: "memory"); \
            { const u32x2_ w_ = *(const PG8_LAS u32x2_*)(lds + PG8_PIECE_OFF + wid * 2048 + lane * 16 + 8); \
              acc[((p) >> 3) & 1][(p) & 1][((p) >> 1) & 3][1] += (f32x4){__builtin_bit_cast(float, w_.x << 16), __builtin_bit_cast(float, w_.x & 0xffff0000u), __builtin_bit_cast(float, w_.y << 16), __builtin_bit_cast(float, w_.y & 0xffff0000u)}; } \
        } else { { const f32x4 q0_ = *(const PG8_LAS f32x4*)(lds + PG8_PIECE_OFF + wid * 2048 + lane * 16); acc[((p) >> 3) & 1][(p) & 1][((p) >> 1) & 3][0] += q0_; } asm volatile("" ::: "memory"); \
        { const f32x4 q1_ = *(const PG8_LAS f32x4*)(lds + PG8_PIECE_OFF + wid * 2048 + 1024 + lane * 16); acc[((p) >> 3) & 1][(p) & 1][((p) >> 1) & 3][1] += q1_; } } } while (0)
#define PG8_WAIT_V1P() do { if constexpr (Epi::STREAM_BF16) PG8_WAIT_V(9); else PG8_WAIT_V(10); } while (0)
#define PG8_KPAIR(t, P0_, P1_) do { \
            PG8_PIN(); \
            const bool last = ((t) == nt - 2); \
            const char* a1 = cA + (size_t)((t) + 1) * kstep; \
            const char* a2 = last ? nA : cA + (size_t)((t) + 2) * kstep; const char* b2 = last ? nB : cB + (size_t)((t) + 2) * kstep; \
            const char* a3 = a2 + kstep; const char* b3 = b2 + kstep; \
            if (last && has_next) S.a_ready(nxt); \
            if constexpr ((P0_) >= 0) PG8_RLOAD_P(P0_); \
            PG8_LDB(B0, 0, 0); PG8_LDB(B1, 0, 1); PG8_SCHED; PG8_LDA(At, 0, 0); PG8_STAGE(PG8_SA(1, 1), a1 + hstep, voffA); \
            if constexpr ((P0_) >= 0) PG8_WAIT_V1P(); else PG8_WAIT_V(8); \
            PG8_WAIT_L(0); PG8_BAR; PG8_MMA(0, 0, At, B0); PG8_MMA(0, 1, At, B1); PG8_BAR; PG8_SCHED; \
            PG8_LDA(At, 0, 1); PG8_STAGE(PG8_SB(0, 0), b2, voffB); PG8_STAGE(PG8_SB(0, 1), b2 + hstep, voffB); PG8_STAGE(PG8_SA(0, 0), a2, voffA); \
            PG8_WAIT_V(8); PG8_WAIT_L(0); PG8_BAR; if constexpr ((P0_) >= 0) PG8_RADD_P(P0_); PG8_MMA(1, 0, At, B0); PG8_MMA(1, 1, At, B1); PG8_BAR; PG8_SCHED; \
            if constexpr ((P1_) >= 0) PG8_RLOAD_P(P1_); \
            PG8_LDB(B0, 1, 0); PG8_LDB(B1, 1, 1); PG8_SCHED; PG8_LDA(At, 1, 0); PG8_STAGE(PG8_SA(0, 1), a2 + hstep, voffA); \
            if constexpr ((P1_) >= 0) PG8_WAIT_V1P(); else PG8_WAIT_V(8); \
            PG8_WAIT_L(0); PG8_BAR; PG8_MMA(0, 0, At, B0); PG8_MMA(0, 1, At, B1); PG8_BAR; PG8_SCHED; \
            PG8_LDA(At, 1, 1); PG8_STAGE(PG8_SB(1, 0), b3, voffB); PG8_STAGE(PG8_SB(1, 1), b3 + hstep, voffB); PG8_STAGE(PG8_SA(1, 0), a3, voffA); \
            PG8_WAIT_V(8); PG8_WAIT_L(0); PG8_BAR; if constexpr ((P1_) >= 0) PG8_RADD_P(P1_); PG8_MMA(1, 0, At, B0); PG8_MMA(1, 1, At, B1); PG8_BAR; PG8_SCHED; \
        } while (0)
    Unit cur, nxt; int ui = 0;
    if (!S.next(0, cur)) return;
    f32x4 acc[2][2][4][2];
#pragma unroll
    for (int a = 0; a < 2; ++a)
#pragma unroll
        for (int b = 0; b < 2; ++b)
#pragma unroll
            for (int m = 0; m < 4; ++m)
#pragma unroll
                for (int n = 0; n < 2; ++n) acc[a][b][m][n] = (f32x4){0.f, 0.f, 0.f, 0.f};
    bf16x8 At[4][2], B0[2][2], B1[2][2];
    const char* rcur = nullptr;
    const unsigned rvoff = (unsigned)(((wr * 64 + fr) * 1024 + wc * 32 + 8 * fq) * 4);
    unsigned rvo = Epi::STREAM_BF16 ? (rvoff >> 1) : rvoff;
#define PG8_RCUR(u_) do { if constexpr (Epi::STREAM_R) rcur = (const char*)E.RS + ((size_t)((u_).pm * BM) * 1024 + (u_).pn * BM) * (Epi::STREAM_BF16 ? 2 : 4); } while (0)
    PG8_RCUR(cur);
    const char* cA = (const char*)g.A + (size_t)cur.pm * tstep; const char* cB = (const char*)g.Bt + (size_t)cur.pn * tstep;
    S.a_ready(cur);
    PG8_PIN();
    if constexpr (SP2) {
        PG8_STAGE(PG8_SB(0, 0), cB, voffB); PG8_STAGE(PG8_SB(0, 1), cB + hstep, voffB); PG8_STAGE(PG8_SA(0, 0), cA, voffA); PG8_STAGE(PG8_SA(0, 1), cA + hstep, voffA);
        if (wr == 1) PG8_BAR;
        PG8_PIN();
        PG8_WAIT_V(2); PG8_BAR;
        PG8_STAGE(PG8_SB(1, 0), cB + kstep, voffB); PG8_STAGE(PG8_SA(1, 0), cA + kstep, voffA); PG8_STAGE(PG8_SB(1, 1), cB + hstep + kstep, voffB);
        PG8_WAIT_V(6); PG8_BAR;
    } else {
        PG8_STAGE(PG8_SB(0, 0), cB, voffB); PG8_STAGE(PG8_SA(0, 0), cA, voffA); PG8_STAGE(PG8_SB(0, 1), cB + hstep, voffB); PG8_STAGE(PG8_SA(0, 1), cA + hstep, voffA);
        if (wr == 1) PG8_BAR;
        PG8_PIN();
        PG8_WAIT_V(4); PG8_BAR;
        PG8_STAGE(PG8_SB(1, 0), cB + kstep, voffB); PG8_STAGE(PG8_SA(1, 0), cA + kstep, voffA); PG8_STAGE(PG8_SB(1, 1), cB + hstep + kstep, voffB);
        PG8_WAIT_V(6); PG8_BAR;
    }
    for (;;) {
        const bool has_next = S.next(ui + 1, nxt);
        const char* nA = has_next ? (const char*)g.A + (size_t)nxt.pm * tstep : cA; const char* nB = has_next ? (const char*)g.Bt + (size_t)nxt.pn * tstep : cB;
        if constexpr (SP2 && Epi::STREAM_R) {
            PG8_KPAIR(0, 0, 1); PG8_KPAIR(2, 2, 3); PG8_KPAIR(4, 4, 5); PG8_KPAIR(6, 6, 7); PG8_KPAIR(8, 8, 9); PG8_KPAIR(10, 10, 11); PG8_KPAIR(12, 12, 13); PG8_KPAIR(14, 14, 15);
#pragma unroll 1
            for (int t = 16; t < nt; t += 2) PG8_KPAIR(t, -1, -1);
        } else
        for (int t = 0; t < nt; t += 2) {
            PG8_PIN();
            const bool last = (t == nt - 2);
            const char* a1 = cA + (size_t)(t + 1) * kstep;
            const char* a2 = last ? nA : cA + (size_t)(t + 2) * kstep; const char* b2 = last ? nB : cB + (size_t)(t + 2) * kstep;
            const char* a3 = a2 + kstep; const char* b3 = b2 + kstep;
            if (last && has_next) S.a_ready(nxt);
            if constexpr (SP2) {
            PG8_LDB(B0, 0, 0); PG8_LDB(B1, 0, 1); PG8_SCHED; PG8_LDA(At, 0, 0); PG8_STAGE(PG8_SA(1, 1), a1 + hstep, voffA);
            PG8_WAIT_V(8); PG8_WAIT_L(0); PG8_BAR; PG8_MMA(0, 0, At, B0); PG8_MMA(0, 1, At, B1); PG8_BAR; PG8_SCHED;
            PG8_LDA(At, 0, 1); PG8_STAGE(PG8_SB(0, 0), b2, voffB); PG8_STAGE(PG8_SB(0, 1), b2 + hstep, voffB); PG8_STAGE(PG8_SA(0, 0), a2, voffA);
            PG8_WAIT_V(8); PG8_WAIT_L(0); PG8_BAR; PG8_MMA(1, 0, At, B0); PG8_MMA(1, 1, At, B1); PG8_BAR; PG8_SCHED;
            PG8_LDB(B0, 1, 0); PG8_LDB(B1, 1, 1); PG8_SCHED; PG8_LDA(At, 1, 0); PG8_STAGE(PG8_SA(0, 1), a2 + hstep, voffA);
            PG8_WAIT_V(8); PG8_WAIT_L(0); PG8_BAR; PG8_MMA(0, 0, At, B0); PG8_MMA(0, 1, At, B1); PG8_BAR; PG8_SCHED;
            PG8_LDA(At, 1, 1); PG8_STAGE(PG8_SB(1, 0), b3, voffB); PG8_STAGE(PG8_SB(1, 1), b3 + hstep, voffB); PG8_STAGE(PG8_SA(1, 0), a3, voffA);
            PG8_WAIT_V(8); PG8_WAIT_L(0); PG8_BAR; PG8_MMA(1, 0, At, B0); PG8_MMA(1, 1, At, B1); PG8_BAR; PG8_SCHED;
            } else {
            PG8_LDB(B0, 0, 0); PG8_SCHED; PG8_LDA(At, 0, 0); PG8_STAGE(PG8_SA(1, 1), a1 + hstep, voffA);
            PG8_WAIT_L(8); PG8_BAR; PG8_WAIT_L(0); PG8_MMA(0, 0, At, B0); PG8_BAR; PG8_SCHED;
            PG8_LDB(B1, 0, 1); PG8_STAGE(PG8_SB(0, 0), b2, voffB);
            PG8_BAR; PG8_WAIT_L(0); PG8_MMA(0, 1, At, B1); PG8_BAR;
            PG8_LDA(At, 0, 1); PG8_STAGE(PG8_SA(0, 0), a2, voffA);
            PG8_BAR; PG8_WAIT_L(0); PG8_MMA(1, 0, At, B0); PG8_BAR; PG8_SCHED;
            PG8_STAGE(PG8_SB(0, 1), b2 + hstep, voffB);
            PG8_WAIT_V(6); PG8_BAR; PG8_MMA(1, 1, At, B1); PG8_BAR;
            PG8_LDB(B0, 1, 0); PG8_SCHED; PG8_LDA(At, 1, 0); PG8_STAGE(PG8_SA(0, 1), a2 + hstep, voffA);
            PG8_WAIT_L(8); PG8_BAR; PG8_WAIT_L(0); PG8_MMA(0, 0, At, B0); PG8_BAR; PG8_SCHED;
            PG8_LDB(B1, 1, 1); PG8_STAGE(PG8_SB(1, 0), b3, voffB);
            PG8_BAR; PG8_WAIT_L(0); PG8_MMA(0, 1, At, B1); PG8_BAR;
            PG8_LDA(At, 1, 1); PG8_STAGE(PG8_SA(1, 0), a3, voffA);
            PG8_BAR; PG8_WAIT_L(0); PG8_MMA(1, 0, At, B0); PG8_BAR; PG8_SCHED;
            PG8_STAGE(PG8_SB(1, 1), b3 + hstep, voffB);
            PG8_WAIT_V(6); PG8_BAR; PG8_MMA(1, 1, At, B1); PG8_BAR;
            }
        }
        if constexpr (ALIGN_EPI) { if (wr == 0) PG8_BAR; }
        if constexpr (!Epi::AFTER_DRAIN) { E(acc, cur, wr, wc, fr, fq); PG8_EPI_TWICE S.done(cur); }
        if (!has_next) break;
#pragma unroll
        for (int a = 0; a < 2; ++a)
#pragma unroll
            for (int b = 0; b < 2; ++b)
#pragma unroll
                for (int m = 0; m < 4; ++m)
#pragma unroll
                    for (int n = 0; n < 2; ++n) acc[a][b][m][n] = (f32x4){0.f, 0.f, 0.f, 0.f};
        cur = nxt; cA = nA; cB = nB; ++ui; PG8_RCUR(cur);
        if constexpr (ALIGN_EPI) { if (wr == 1) PG8_BAR; }
    }
    PG8_WAIT_V(0);
    if constexpr (!ALIGN_EPI) { if (wr == 0) PG8_BAR; }
    PG8_BAR;
    if constexpr (Epi::AFTER_DRAIN) { E.fused(acc, cur, wr, wc, fr, fq, lds, wid, lane); S.done(cur); }
#undef PG8_SA
#undef PG8_SB
#undef PG8_STAGE
#undef PG8_LDA
#undef PG8_LDB
#undef PG8_MMA
#undef PG8_WAIT_V
#undef PG8_WAIT_L
#undef PG8_BAR
#undef PG8_SCHED
#undef PG8_PIECE_OFF
#undef PG8_RLOAD_P
#undef PG8_WAIT_V1P
#undef PG8_RADD_P
#undef PG8_KPAIR
#undef PG8_RCUR
}
}
constexpr int NWAVES = 8;
constexpr int NB = 8, SEQ = 4096, T = NB * SEQ, DM = 1024, DIN = 2824, DFF = 2816, NPROJ = 2816;
constexpr int SRC_MI = 2048;
constexpr int PC_MQ = 0, PC_MK = 512, PC_MV = 1024, PC_MO = 1536, PC_AQ = 2048, PC_AK = 2560, PC_AV = 2688;
constexpr float EPS = 1e-6f;
constexpr size_t MiB = 1u << 20;
constexpr size_t WS_CTL = 0, CTL_ZERO_BYTES = 32 * 1024;
constexpr size_t WS_WIN = 1 * MiB;
constexpr size_t WS_WOUT = 7 * MiB;
constexpr size_t WS_WGU = 9 * MiB;
constexpr size_t WS_WDN = 20 * MiB;
constexpr size_t WS_ROPE = 26 * MiB;
constexpr size_t WS_WBG = 26 * MiB + 512 * 1024;
constexpr size_t WS_GATES = 27 * MiB;
constexpr size_t WS_SSQ = 28 * MiB;
constexpr size_t WS_SEG = 30 * MiB;
constexpr size_t WS_XN_BACK = 64 * MiB;
constexpr size_t WS_MIX_BACK = 304 * MiB;
constexpr size_t WS_PROJ_BACK = 240 * MiB;
constexpr size_t WS_END = 352 * MiB;
constexpr int CW_BAR = 4096;
constexpr int RING_BYTES = 131072;
constexpr int LDSCTL_OFF = RING_BYTES, MISC_OFF = LDSCTL_OFF + 320;
constexpr int LDS_BYTES = 163840;

#define GAS __attribute__((address_space(1)))
#define LAS __attribute__((address_space(3)))
typedef unsigned short bf16;
typedef unsigned v4u __attribute__((ext_vector_type(4)));
typedef unsigned v2u __attribute__((ext_vector_type(2)));
typedef float f32x2v __attribute__((ext_vector_type(2)));
typedef float f32x4 __attribute__((ext_vector_type(4)));
typedef short bf16x8 __attribute__((ext_vector_type(8)));
typedef GAS unsigned gu32;
#define RLX_AGENT __ATOMIC_RELAXED, __HIP_MEMORY_SCOPE_AGENT
#define LDS_WAIT() asm volatile("s_waitcnt lgkmcnt(0)" ::: "memory")
#define VM_WAIT() asm volatile("s_waitcnt vmcnt(0)" ::: "memory")
__device__ __forceinline__ unsigned f2bf(float f) { unsigned u = __builtin_bit_cast(unsigned, f); return (u + 0x7fffu + ((u >> 16) & 1u)) >> 16; }
__device__ __forceinline__ unsigned pk2(float lo, float hi) { return f2bf(lo) | (f2bf(hi) << 16); }
__device__ __forceinline__ float bf2f(unsigned short b) { return __builtin_bit_cast(float, (unsigned)b << 16); }
__device__ __forceinline__ float bflo(unsigned w) { return __builtin_bit_cast(float, w << 16); }
__device__ __forceinline__ float bfhi(unsigned w) { return __builtin_bit_cast(float, w & 0xffff0000u); }
__device__ __forceinline__ void unpack8(const v4u w, float* o) { o[0] = bflo(w.x); o[1] = bfhi(w.x); o[2] = bflo(w.y); o[3] = bfhi(w.y); o[4] = bflo(w.z); o[5] = bfhi(w.z); o[6] = bflo(w.w); o[7] = bfhi(w.w); }
__device__ __forceinline__ float red16_32_max(float v) {
    auto a = __builtin_amdgcn_permlane16_swap(__float_as_uint(v), __float_as_uint(v), false, false); v = fmaxf(__uint_as_float(a[0]), __uint_as_float(a[1]));
    auto b = __builtin_amdgcn_permlane32_swap(__float_as_uint(v), __float_as_uint(v), false, false); return fmaxf(__uint_as_float(b[0]), __uint_as_float(b[1])); }
__device__ __forceinline__ float red16_32_sum(float v) {
    auto a = __builtin_amdgcn_permlane16_swap(__float_as_uint(v), __float_as_uint(v), false, false); v = __uint_as_float(a[0]) + __uint_as_float(a[1]);
    auto b = __builtin_amdgcn_permlane32_swap(__float_as_uint(v), __float_as_uint(v), false, false); return __uint_as_float(b[0]) + __uint_as_float(b[1]); }
__device__ __forceinline__ float xor16_partner(float v) { const unsigned u = __float_as_uint(v); auto a = __builtin_amdgcn_permlane16_swap(u, u, false, false); return __uint_as_float(a[0] ^ a[1] ^ u); }
template <int CTRL> __device__ __forceinline__ float dppf(float v) { return __builtin_bit_cast(float, __builtin_amdgcn_update_dpp(0, __builtin_bit_cast(int, v), CTRL, 0xf, 0xf, true)); }
template <int CTRL> __device__ __forceinline__ unsigned dppu(unsigned v) { return (unsigned)__builtin_amdgcn_update_dpp(0, (int)v, CTRL, 0xf, 0xf, true); }
__device__ __forceinline__ float sum8(float v)  { v += dppf<0xB1>(v); v += dppf<0x4E>(v); v += dppf<0x141>(v); return v; }
__device__ __forceinline__ float sum16(float v) { v = sum8(v); v += dppf<0x140>(v); return v; }
__device__ __forceinline__ float max16(float v) { v = fmaxf(v, dppf<0xB1>(v)); v = fmaxf(v, dppf<0x4E>(v)); v = fmaxf(v, dppf<0x141>(v)); v = fmaxf(v, dppf<0x140>(v)); return v; }
__device__ __forceinline__ float wave_sum(float v) { return red16_32_sum(sum16(v)); }
__device__ __forceinline__ float wave_max(float v) { return red16_32_max(max16(v)); }
#define xor16_max 1
#define XB_TMO      128
#define XB_XCNT(j)  (256  + 64 * (j))
#define XB_XSUB(j)  (1280 + 64 * (j))
#define XB_XGEN(j)  (2304 + 64 * (j))
#define XB_TOP      3328
#define XB_TOPGEN   3392
#define XCD_BAR_WORDS 3456
#define XB_SPIN_CAP (1u << 18)

__device__ __forceinline__ unsigned xb_ld(unsigned* p)              { return __hip_atomic_load(p, __ATOMIC_RELAXED, __HIP_MEMORY_SCOPE_AGENT); }
__device__ __forceinline__ unsigned xb_add(unsigned* p, unsigned v) { return __hip_atomic_fetch_add(p, v, __ATOMIC_RELAXED, __HIP_MEMORY_SCOPE_AGENT); }
__device__ __forceinline__ unsigned xb_xcc_id() { return (unsigned)__builtin_amdgcn_s_getreg((3 << 11) | 20) & 0xFu; }
#define XB_SPIN(cond, bar) do { unsigned _sp = 0; while (cond) { __builtin_amdgcn_s_sleep(1); \
    if ((++_sp & 255u) == 0u) { if (xb_ld(&(bar)[XB_TMO])) break; if (_sp > XB_SPIN_CAP) { atomicAdd(&(bar)[XB_TMO], 1u); break; } } } } while (0)

struct XcdBarrier {
    unsigned* bar; unsigned x;
    volatile LAS unsigned* st;
};

__device__ __forceinline__ XcdBarrier xcd_barrier_post(unsigned* bar, volatile LAS unsigned* st) {
    XcdBarrier b; b.bar = bar; b.x = xb_xcc_id(); b.st = st;
    if (threadIdx.x == 0) (void)xb_add(&bar[XB_XCNT(b.x)], 1u);
    return b;
}
__device__ __forceinline__ void xcd_barrier_complete(unsigned* bar, unsigned x, unsigned& nloc, unsigned& nx) {
    const unsigned G = gridDim.x * gridDim.y * gridDim.z;
    unsigned sum, cnt, mine, sp = 0u;
    for (;;) {
        sum = 0u; cnt = 0u; mine = 0u;
#pragma unroll
        for (unsigned j = 0; j < 16; ++j) { const unsigned c = xb_ld(&bar[XB_XCNT(j)]); sum += c; cnt += (c > 0u) ? 1u : 0u; mine = (j == x) ? c : mine; }
        if (sum == G) break;
        __builtin_amdgcn_s_sleep(1);
        if ((++sp & 255u) == 0u) { if (xb_ld(&bar[XB_TMO])) break; if (sp > XB_SPIN_CAP) { atomicAdd(&bar[XB_TMO], 1u); break; } }
    }
    nloc = mine > 0u ? mine : 1u; nx = cnt > 0u ? cnt : 1u;
}

__device__ __forceinline__ void xcd_barrier(const XcdBarrier& b) {
    asm volatile("s_waitcnt vmcnt(0)" ::: "memory");
    __syncthreads();
    if (threadIdx.x == 0) {
        unsigned* bar = b.bar;
        __builtin_amdgcn_s_waitcnt(0);
        unsigned nloc = b.st[0], nx = b.st[1];
        if (nloc == 0u) { xcd_barrier_complete(bar, b.x, nloc, nx); b.st[0] = nloc; b.st[1] = nx; }
        const unsigned old = xb_add(&bar[XB_XSUB(b.x)], 1u);
        asm volatile("buffer_inv sc1" ::: "memory");
        const unsigned gen = old / nloc;
        if (old + 1u == (gen + 1u) * nloc) {
            __builtin_amdgcn_fence(__ATOMIC_RELEASE, "agent");
            asm volatile("s_waitcnt vmcnt(0)" ::: "memory");
            const unsigned og = xb_add(&bar[XB_TOP], 1u);
            const unsigned tg = og / nx;
            if (og + 1u == (tg + 1u) * nx) xb_add(&bar[XB_TOPGEN], 1u);
            else XB_SPIN(xb_ld(&bar[XB_TOPGEN]) == tg, bar);
            xb_add(&bar[XB_XGEN(b.x)], 1u);
        } else {
            XB_SPIN(xb_ld(&bar[XB_XGEN(b.x)]) == gen, bar);
        }
        asm volatile("s_waitcnt vmcnt(0)" ::: "memory");
    }
    __syncthreads();
}

__device__ __forceinline__ void xcd_barrier_local(const XcdBarrier& b) {
    asm volatile("s_waitcnt vmcnt(0)" ::: "memory");
    __syncthreads();
    if (threadIdx.x == 0) {
        unsigned* bar = b.bar;
        __builtin_amdgcn_s_waitcnt(0);
        unsigned nloc = b.st[0], nx = b.st[1];
        if (nloc == 0u) { xcd_barrier_complete(bar, b.x, nloc, nx); b.st[0] = nloc; b.st[1] = nx; }
        const unsigned old = xb_add(&bar[XB_XSUB(b.x)], 1u);
        const unsigned gen = old / nloc;
        if (old + 1u == (gen + 1u) * nloc) xb_add(&bar[XB_XGEN(b.x)], 1u);
        else XB_SPIN(xb_ld(&bar[XB_XGEN(b.x)]) == gen, bar);
        __builtin_amdgcn_fence(__ATOMIC_ACQUIRE, "agent");
        asm volatile("s_waitcnt vmcnt(0)" ::: "memory");
    }
    __syncthreads();
}
#define H1_BF16 1
#define MERGE23 1
#define P6_STREAM 1
#ifndef P5_ALIGN
#define P5_ALIGN true
#endif
#define PHASE2_BODY do { mlstm_phase<1>(F); swa_phase(F); __syncthreads(); { int t_ = threadIdx.x; asm volatile("" : "+v"(t_)); F.tid = t_; F.lane = t_ & 63; } mlstm_phase<2>(F); } while (0)
#define PHASE3_BODY (void)0
#define LAUNCH_MK(lo_, hi_) do { a.ph_lo = (lo_); a.ph_hi = (hi_); a.li = (lo_); hipLaunchKernelGGL(mk_fwd, dim3(grid), dim3(NWAVES * 64), LDS_BYTES, stream, a); } while (0)
#define LAUNCH_PROGRAM { LAUNCH_MK(0, 7); }
struct Frame {
    LAS unsigned char* lds;
    volatile LAS unsigned* MISC;
    gu32* ctl;
    int tid, lane, wave, vcu, G;
    const float *x, *norm1_g, *w_in, *conv_w, *igate_b, *fgate_b, *mlstm_norm_g, *q_norm_g, *k_norm_g, *sinks, *w_out, *norm2_g, *w_gate, *w_up, *w_down;
    float* out;
    bf16 *Win_t, *Wout_t, *Wgu_t, *Wdn_t, *XN, *MIX, *PROJ;
    float2* ROPE; float* GATES; float* SSQ; float* SEG; unsigned char* WBG;
};

struct P0Item { const float* W; int ldw, src_col0; const float* kscale; bf16* WT; int Kd, dst_row0, kb; };
template <bool SCALE> __device__ __forceinline__ void p0_item_load(const P0Item& I, float (&v)[32], int lane) {
    const int k0 = 64 * I.kb;
#pragma unroll
    for (int i = 0; i < 32; ++i) { const int kk = 2 * i + (lane >> 5); v[i] = __builtin_nontemporal_load(&I.W[(size_t)(k0 + kk) * I.ldw + I.src_col0 + (lane & 31)]); }
    if (SCALE) {
        float sc[32];
#pragma unroll
        for (int i = 0; i < 32; ++i) sc[i] = I.kscale[k0 + 2 * i + (lane >> 5)];
#pragma unroll
        for (int i = 0; i < 32; ++i) v[i] *= sc[i];
    }
}
__device__ __forceinline__ void p0_item_finish(const P0Item& I, const float (&v)[32], LAS float* scr, int lane) {
    const int k0 = 64 * I.kb;
#pragma unroll
    for (int i = 0; i < 32; ++i) { const int kk = 2 * i + (lane >> 5); scr[kk * 33 + (lane & 31)] = v[i]; }
    LDS_WAIT(); asm volatile("" ::: "memory");
    const int c = lane & 7;
#pragma unroll
    for (int j = 0; j < 4; ++j) { const int n = (lane >> 3) + 8 * j; const LAS float* s = scr + (8 * c) * 33 + n;
        v4u o; o.x = pk2(s[0 * 33], s[1 * 33]); o.y = pk2(s[2 * 33], s[3 * 33]); o.z = pk2(s[4 * 33], s[5 * 33]); o.w = pk2(s[6 * 33], s[7 * 33]);
        *(GAS v4u*)(I.WT + (size_t)(I.dst_row0 + n) * I.Kd + k0 + 8 * c) = o; }
    LDS_WAIT(); asm volatile("" ::: "memory");
}
constexpr int I_IN = 88 * 16, I_OUT = 32 * 16, I_GU = 176 * 16, I_DN = 32 * 44;
__device__ __forceinline__ P0Item p0_item_in(Frame& F, int r) { const int nb = r % 88, kb = r / 88; return P0Item{F.w_in, DIN, nb < 64 ? 32 * nb : 32 * nb + 8, nullptr, F.Win_t, DM, 32 * nb, kb}; }
__device__ __forceinline__ P0Item p0_item_gu(Frame& F, int r) { const int nb = r % 176, kb = r / 176, tile = nb >> 3, wi = nb & 7; const float* W = (wi < 4) ? F.w_gate : F.w_up;
    return P0Item{W, DFF, 128 * tile + 32 * (wi & 3), F.norm2_g, F.Wgu_t, DM, 32 * nb, kb}; }
__device__ __forceinline__ P0Item p0_item_od(Frame& F, int r) {
    if (r < I_OUT) { const int nb = r % 32, kb = r / 32; return P0Item{F.w_out, DM, 32 * nb, nullptr, F.Wout_t, DM, 32 * nb, kb}; } r -= I_OUT;
    { const int nb = r % 32, kb = r / 32; return P0Item{F.w_down, DM, 32 * nb, nullptr, F.Wdn_t, DFF, 32 * nb, kb}; }
}
__device__ __forceinline__ void p0_prologue(Frame& F) {
    LAS float* scr = (LAS float*)(F.lds + F.wave * 8704);
    const int gw = F.vcu * NWAVES + F.wave, NGW = F.G * NWAVES;
    for (int it = gw; it < I_IN; it += NGW) { const P0Item I = p0_item_in(F, it); float v[32]; p0_item_load<false>(I, v, F.lane); p0_item_finish(I, v, scr, F.lane); }
    if (F.vcu < 4) { const int idx = F.vcu * 512 + F.tid; const int ks = idx >> 6, ln = idx & 63, col = ln & 15, gq = ln >> 4;
        v4u o = (v4u){0u, 0u, 0u, 0u};
        if (col < 8) { const float* wp = F.w_in + (size_t)(32 * ks + 8 * gq) * DIN + SRC_MI + col;
            const float w0 = wp[0], w1 = wp[DIN], w2 = wp[2 * DIN], w3 = wp[3 * DIN], w4 = wp[4 * DIN], w5 = wp[5 * DIN], w6 = wp[6 * DIN], w7 = wp[7 * DIN];
            o.x = pk2(w0, w1); o.y = pk2(w2, w3); o.z = pk2(w4, w5); o.w = pk2(w6, w7); }
        ((v4u*)F.WBG)[idx] = o; }
    { const int idx = (F.vcu * NWAVES * 64) + F.tid;
      if (idx < SEQ * 8) { const int pos = idx >> 3, i = idx & 7;
        double f = 1.0; f = (i == 1) ? 0.19392274474868576 : f; f = (i == 2) ? 0.03760603093086393 : f; f = (i == 3) ? 0.007292664737217109 : f; f = (i == 4) ? 0.001414213562373095 : f;
        f = (i == 5) ? 0.0002742481756762073 : f; f = (i == 6) ? 5.318295896944988e-05 : f; f = (i == 7) ? 1.031338537721246e-05 : f;
        const float angf = (float)pos * (float)f; const double rev = (double)angf * 0.15915494309189535; const double fr = rev - __builtin_floor(rev + 0.5);
        const float rr = (float)(fr * 6.283185307179586); F.ROPE[idx] = make_float2(__cosf(rr), __sinf(rr)); } }
    f32x4 g1[4];
#pragma unroll
    for (int j = 0; j < 4; ++j) g1[j] = ((const f32x4*)F.norm1_g)[F.lane + 64 * j];
    f32x4 v[4];
    if (gw < T) {
#pragma unroll
        for (int j = 0; j < 4; ++j) v[j] = __builtin_nontemporal_load(&((const GAS f32x4*)(F.x + (size_t)gw * DM))[F.lane + 64 * j]);
    }
#pragma unroll 1
    for (int m = gw; m < T; m += NGW) {
        f32x4 c[4]; float s = 0.f;
#pragma unroll
        for (int j = 0; j < 4; ++j) { c[j] = v[j]; s += (c[j].x * c[j].x + c[j].y * c[j].y) + (c[j].z * c[j].z + c[j].w * c[j].w); }
        if (m + NGW < T) {
#pragma unroll
            for (int j = 0; j < 4; ++j) v[j] = __builtin_nontemporal_load(&((const GAS f32x4*)(F.x + (size_t)(m + NGW) * DM))[F.lane + 64 * j]);
        }
        const float rstd = __builtin_amdgcn_rsqf(wave_sum(s) * (1.f / DM) + EPS);
        GAS v2u* o8 = (GAS v2u*)(F.XN + (size_t)m * DM) + F.lane;
#pragma unroll
        for (int j = 0; j < 4; ++j) { const f32x4 y = c[j] * rstd * g1[j]; v2u w; w.x = pg8::cvt_pk_bf16(y.x, y.y); w.y = pg8::cvt_pk_bf16(y.z, y.w); o8[64 * j] = w; }
    }
}
__device__ __forceinline__ void convert_gu(Frame& F, int ii, int ni) {
    LAS float* scr = (LAS float*)(F.lds + F.wave * 8704);
    __syncthreads();
    const int igw = ii * NWAVES + F.wave, NIW = ni * NWAVES;
#pragma unroll 1
    for (int it = igw; it < I_GU; it += 2 * NIW) {
        const P0Item Ia = p0_item_gu(F, it); const bool two = it + NIW < I_GU; const P0Item Ib = p0_item_gu(F, two ? it + NIW : it);
        float va[32], vb[32]; p0_item_load<true>(Ia, va, F.lane); p0_item_load<true>(Ib, vb, F.lane);
        p0_item_finish(Ia, va, scr, F.lane); if (two) p0_item_finish(Ib, vb, scr, F.lane);
    }
}
__device__ __forceinline__ void convert_od(Frame& F, int ii, int ni) {
    LAS float* scr = (LAS float*)(F.lds + F.wave * 8704);
    const int igw = ii * NWAVES + F.wave, NIW = ni * NWAVES;
#pragma unroll 1
    for (int it = igw; it < I_OUT + I_DN; it += 2 * NIW) {
        const P0Item Ia = p0_item_od(F, it); const bool two = it + NIW < I_OUT + I_DN; const P0Item Ib = p0_item_od(F, two ? it + NIW : it);
        float va[32], vb[32]; p0_item_load<false>(Ia, va, F.lane); p0_item_load<false>(Ib, vb, F.lane);
        p0_item_finish(Ia, va, scr, F.lane); if (two) p0_item_finish(Ib, vb, scr, F.lane);
    }
}
__device__ __forceinline__ void p1_side_work(Frame& F, int ii, int ni) {
    LAS unsigned char* WB = F.lds + 73728;
    for (int idx = F.tid; idx < 2048; idx += NWAVES * 64) *(LAS v4u*)(WB + idx * 16) = ((const v4u*)F.WBG)[idx];
    __syncthreads();
    convert_od(F, ii, ni);
    const int igw = ii * NWAVES + F.wave, NIW = ni * NWAVES;
    const int l15 = F.lane & 15, g = F.lane >> 4;
    for (int blk = igw; blk < T / 16; blk += NIW) {
        const bf16* xp = F.XN + ((size_t)blk * 16 + l15) * DM + 8 * g;
        f32x4 acc = (f32x4){0.f, 0.f, 0.f, 0.f};
        bf16x8 a[32];
#pragma unroll
        for (int q = 0; q < 32; ++q) a[q] = *(const bf16x8*)(xp + 32 * q);
#pragma unroll
        for (int q = 0; q < 32; ++q) acc = __builtin_amdgcn_mfma_f32_16x16x32_bf16(a[q], *(const LAS bf16x8*)(WB + (q * 64 + F.lane) * 16), acc, 0, 0, 0);
        if (l15 < 8) {
#pragma unroll
            for (int r = 0; r < 4; ++r) F.GATES[((size_t)blk * 16 + 4 * g + r) * 8 + l15] = acc[r];
        }
    }
}

constexpr int SWA_KS = 0, SWA_KSTR = 160, SWA_VT = 40960, SWA_VSTR = 528;
typedef short bf16x4 __attribute__((ext_vector_type(4)));
#ifndef SWA_UNROLL
#define SWA_UNROLL 1
#endif
constexpr int SWA_TAB = 74752;
struct SwaKV { v4u k[4], v[4]; float2 cs[8]; };
struct SwaQ { v4u w0, w1; float2 cs[8]; };
__device__ __forceinline__ void swa_load_kv(Frame& F, int tid, int u, SwaKV& R) {
    const int blk = u & 31, kvh = (u >> 5) & 1, b = u >> 6; const int key = tid >> 1, half = tid & 1; const int kt = blk * 128 - 128 + key;
    if (kt >= 0) {
        const bf16* kp = F.PROJ + (size_t)(b * SEQ + kt) * NPROJ + PC_AK + kvh * 64 + 32 * half;
        const bf16* vp = F.PROJ + (size_t)(b * SEQ + kt) * NPROJ + PC_AV + kvh * 64 + 32 * half;
#pragma unroll
        for (int c = 0; c < 4; ++c) { R.k[c] = *(const v4u*)(kp + 8 * c); R.v[c] = *(const v4u*)(vp + 8 * c); }
#pragma unroll
        for (int i = 0; i < 8; ++i) R.cs[i] = F.ROPE[kt * 8 + i];
    } else {
#pragma unroll
        for (int c = 0; c < 4; ++c) { R.k[c] = (v4u){0u, 0u, 0u, 0u}; R.v[c] = (v4u){0u, 0u, 0u, 0u}; }
#pragma unroll
        for (int i = 0; i < 8; ++i) R.cs[i] = make_float2(1.f, 0.f);
    }
}
__device__ __forceinline__ void swa_load_q(Frame& F, int lane, int wave, int u, int rb, SwaQ& R) {
    const int blk = u & 31, kvh = (u >> 5) & 1, b = u >> 6; const int l15 = lane & 15, g = lane >> 4;
    const int hq = kvh * 4 + (wave >> 1), p0 = 64 * (wave & 1) + 16 * rb, tq = blk * 128 + p0 + l15;
    const bf16* qp = F.PROJ + (size_t)(b * SEQ + tq) * NPROJ + PC_AQ + hq * 64 + 8 * g;
    R.w0 = __builtin_nontemporal_load((const v4u*)qp); R.w1 = __builtin_nontemporal_load((const v4u*)(qp + 32));
#pragma unroll
    for (int j = 0; j < 8; ++j) R.cs[j] = F.ROPE[tq * 8 + j];
}
__device__ __forceinline__ void swa_phase(Frame& F) {
    LAS unsigned char* KS = F.lds + SWA_KS; LAS unsigned char* VT = F.lds + SWA_VT; LAS float* TAB = (LAS float*)(F.lds + SWA_TAB);
    const int wave = F.wave;
    int u = F.vcu;
    if (u >= NB * 2 * 32) return;
    __syncthreads();
    if (F.tid < 64) TAB[F.tid] = F.q_norm_g[F.tid]; else if (F.tid < 128) TAB[F.tid] = F.k_norm_g[F.tid - 64];
    SwaKV kv; SwaQ qr;
    swa_load_kv(F, F.tid, u, kv);
    swa_load_q(F, F.lane, wave, u, 0, qr);
#pragma unroll 1
    for (; u < NB * 2 * 32; u += F.G) {
        int tid = F.tid; asm volatile("" : "+v"(tid));
        const int lane = tid & 63, l15 = lane & 15, g = lane >> 4;
        const int blk = u & 31, kvh = (u >> 5) & 1, b = u >> 6;
        const int un = u + F.G; const bool has_next = un < NB * 2 * 32;
        __syncthreads();
        {
            const int key = tid >> 1, half = tid & 1;
            float kf[32];
#pragma unroll
            for (int c = 0; c < 4; ++c) unpack8(kv.k[c], kf + 8 * c);
            float ss = 0.f;
#pragma unroll
            for (int c = 0; c < 32; ++c) ss += kf[c] * kf[c];
            ss += dppf<0xB1>(ss);
            const float rstd = __builtin_amdgcn_rsqf(ss * (1.f / 64.f) + EPS);
#pragma unroll
            for (int c = 0; c < 8; ++c) { const f32x4 gg = *(const LAS f32x4*)(TAB + 64 + 32 * half + 4 * c); kf[4 * c] *= rstd * gg[0]; kf[4 * c + 1] *= rstd * gg[1]; kf[4 * c + 2] *= rstd * gg[2]; kf[4 * c + 3] *= rstd * gg[3]; }
            if (half == 0) {
#pragma unroll
                for (int i = 0; i < 8; ++i) { const float2 cs = kv.cs[i]; const float x1 = kf[i], x2 = kf[8 + i]; kf[i] = x1 * cs.x - x2 * cs.y; kf[8 + i] = x2 * cs.x + x1 * cs.y; }
            }
#pragma unroll
            for (int c = 0; c < 4; ++c) { v4u o; o.x = pg8::cvt_pk_bf16(kf[8 * c], kf[8 * c + 1]); o.y = pg8::cvt_pk_bf16(kf[8 * c + 2], kf[8 * c + 3]); o.z = pg8::cvt_pk_bf16(kf[8 * c + 4], kf[8 * c + 5]); o.w = pg8::cvt_pk_bf16(kf[8 * c + 6], kf[8 * c + 7]);
                *(LAS v4u*)(KS + key * SWA_KSTR + 64 * half + 16 * c) = o; }
#pragma unroll
            for (int c = 0; c < 4; ++c) { const unsigned ww[4] = {kv.v[c].x, kv.v[c].y, kv.v[c].z, kv.v[c].w};
#pragma unroll
                for (int e = 0; e < 4; ++e) { const int d = 32 * half + 8 * c + 2 * e;
                    const unsigned pw = dppu<0x4E>(ww[e]);
                    const unsigned val = (key & 1) ? ((pw >> 16) | (ww[e] & 0xffff0000u)) : ((ww[e] & 0xffffu) | (pw << 16));
                    *(LAS unsigned*)(VT + (d + (key & 1)) * SWA_VSTR + ((((key >> 1) ^ (half << 3))) << 2)) = val; } }
        }
        __syncthreads();
        if (has_next) swa_load_kv(F, tid, un, kv);
        const int hq = kvh * 4 + (wave >> 1);
        const float sink2 = F.sinks[hq] * 1.4426950408889634f;
        const float SC = 0.125f * 1.4426950408889634f;
#pragma unroll 1
        for (int rb = 0; rb < 4; ++rb) {
            const int p0 = 64 * (wave & 1) + 16 * rb, j0 = p0 >> 4;
            const int tq = blk * 128 + p0 + l15;
            bf16x8 qf[2];
            {
                float q0[8], q1[8]; unpack8(qr.w0, q0); unpack8(qr.w1, q1);
                float ss = 0.f;
#pragma unroll
                for (int j = 0; j < 8; ++j) ss += q0[j] * q0[j] + q1[j] * q1[j];
                ss = red16_32_sum(ss);
                const float rstd = __builtin_amdgcn_rsqf(ss * (1.f / 64.f) + EPS);
#pragma unroll
                for (int c = 0; c < 2; ++c) { const f32x4 ga = *(const LAS f32x4*)(TAB + 8 * g + 4 * c), gb = *(const LAS f32x4*)(TAB + 32 + 8 * g + 4 * c);
#pragma unroll
                    for (int e = 0; e < 4; ++e) { q0[4 * c + e] *= rstd * ga[e]; q1[4 * c + e] *= rstd * gb[e]; } }
#pragma unroll
                for (int j = 0; j < 8; ++j) { const float other = xor16_partner(q0[j]); const float2 cs = qr.cs[j];
                    const float r0 = q0[j] * cs.x - other * cs.y, r1 = q0[j] * cs.x + other * cs.y; q0[j] = (g == 0) ? r0 : ((g == 1) ? r1 : q0[j]); }
                v4u a, c2; a.x = pg8::cvt_pk_bf16(q0[0], q0[1]); a.y = pg8::cvt_pk_bf16(q0[2], q0[3]); a.z = pg8::cvt_pk_bf16(q0[4], q0[5]); a.w = pg8::cvt_pk_bf16(q0[6], q0[7]);
                c2.x = pg8::cvt_pk_bf16(q1[0], q1[1]); c2.y = pg8::cvt_pk_bf16(q1[2], q1[3]); c2.z = pg8::cvt_pk_bf16(q1[4], q1[5]); c2.w = pg8::cvt_pk_bf16(q1[6], q1[7]);
                qf[0] = __builtin_bit_cast(bf16x8, a); qf[1] = __builtin_bit_cast(bf16x8, c2);
            }
            if (rb < 3) swa_load_q(F, lane, wave, u, rb + 1, qr); else if (has_next) swa_load_q(F, lane, wave, un, 0, qr);
            f32x4 s[10];
    #pragma unroll
            for (int jj = 0; jj < 9; ++jj) { const int tile = j0 + jj;
                f32x4 acc = (f32x4){0.f, 0.f, 0.f, 0.f};
    #pragma unroll
                for (int ks = 0; ks < 2; ++ks) { const bf16x8 kfr = *(const LAS bf16x8*)(KS + (16 * tile + l15) * SWA_KSTR + 64 * ks + 16 * g);
                    acc = __builtin_amdgcn_mfma_f32_16x16x32_bf16(kfr, qf[ks], acc, 0, 0, 0); }
                s[jj] = acc; }
            s[9] = (f32x4){0.f, 0.f, 0.f, 0.f};
    #pragma unroll
            for (int r = 0; r < 4; ++r) { if (4 * g + r < 1 + l15) s[0][r] = -INFINITY; if (4 * g + r > l15) s[8][r] = -INFINITY; }
            if (blk == 0) {
    #pragma unroll
                for (int jj = 0; jj < 9; ++jj)
    #pragma unroll
                    for (int r = 0; r < 4; ++r) { if (16 * (j0 + jj) + 4 * g + r < 128) s[jj][r] = -INFINITY; }
            }
            float mx = -INFINITY;
    #pragma unroll
            for (int jj = 0; jj < 9; ++jj)
    #pragma unroll
                for (int r = 0; r < 4; ++r) mx = fmaxf(mx, s[jj][r]);
            mx = red16_32_max(mx); mx = fmaxf(mx * SC, sink2);
            float sum = 0.f;
    #pragma unroll
            for (int jj = 0; jj < 9; ++jj)
    #pragma unroll
                for (int r = 0; r < 4; ++r) { const float p = __builtin_amdgcn_exp2f(__builtin_fmaf(s[jj][r], SC, -mx)); s[jj][r] = p; sum += p; }
            sum = red16_32_sum(sum);
            const float inv = 1.0f / (sum + __builtin_amdgcn_exp2f(sink2 - mx));
            f32x4 o[4];
    #pragma unroll
            for (int dt = 0; dt < 4; ++dt) o[dt] = (f32x4){0.f, 0.f, 0.f, 0.f};
    #pragma unroll
            for (int kk = 0; kk < 5; ++kk) {
                const int t0 = (j0 + 2 * kk) > 15 ? 15 : (j0 + 2 * kk), t1 = (j0 + 2 * kk + 1) > 15 ? 15 : (j0 + 2 * kk + 1);
                v4u pw; pw.x = pg8::cvt_pk_bf16(s[2 * kk][0], s[2 * kk][1]); pw.y = pg8::cvt_pk_bf16(s[2 * kk][2], s[2 * kk][3]); pw.z = pg8::cvt_pk_bf16(s[2 * kk + 1][0], s[2 * kk + 1][1]); pw.w = pg8::cvt_pk_bf16(s[2 * kk + 1][2], s[2 * kk + 1][3]);
                const bf16x8 pf = __builtin_bit_cast(bf16x8, pw);
    #pragma unroll
                for (int dt = 0; dt < 4; ++dt) {
                    const v2u a0 = *(const LAS v2u*)(VT + (16 * dt + l15) * SWA_VSTR + (((8 * t0 + 2 * g) ^ ((dt >> 1) << 3)) << 2));
                    const v2u a1 = *(const LAS v2u*)(VT + (16 * dt + l15) * SWA_VSTR + (((8 * t1 + 2 * g) ^ ((dt >> 1) << 3)) << 2));
                    v4u av; av.x = a0.x; av.y = a0.y; av.z = a1.x; av.w = a1.y;
                    o[dt] = __builtin_amdgcn_mfma_f32_16x16x32_bf16(__builtin_bit_cast(bf16x8, av), pf, o[dt], 0, 0, 0); }
            }
            bf16* op = F.MIX + (size_t)(b * SEQ + tq) * DM + 512 + hq * 64 + 4 * g;
    #pragma unroll
            for (int dt = 0; dt < 4; ++dt) { v2u w; w.x = pg8::cvt_pk_bf16(o[dt][0] * inv, o[dt][1] * inv); w.y = pg8::cvt_pk_bf16(o[dt][2] * inv, o[dt][3] * inv); *(v2u*)(op + 16 * dt) = w; }
        }
    }
}
constexpr int ML_QS = 0, ML_KS = 18432, ML_KWT = 36864, ML_VT = 57344, ML_PS = 77824, ML_CT = 88064, ML_F = 122880;
constexpr int ML_QSTR = 288, ML_TSTR = 160, ML_CSTR = 272, ML_HSTR = 528;
constexpr int FDEN = 256, FN = 320;
constexpr int ML_GV = 132096, ML_GS = ML_GV + 8192, ML_CW = ML_GS + 256;
constexpr int SEG_STRIDE = 16640;
constexpr float LOG2E = 1.4426950408889634f;
__device__ __forceinline__ float silu_f(float v) { return v * __builtin_amdgcn_rcpf(1.0f + __builtin_amdgcn_exp2f(v * -LOG2E)); }
__device__ __forceinline__ float sigmoid_f(float v) { return __builtin_amdgcn_rcpf(1.0f + __builtin_amdgcn_exp2f(v * -LOG2E)); }
__device__ __forceinline__ float exp_f(float v) { return __builtin_amdgcn_exp2f(v * LOG2E); }

template <int PASS> __device__ __forceinline__ void mlstm_item(Frame& F, int b, int h, int sg) {
    const int wave = F.wave;
    int tid = F.tid; asm volatile("" : "+v"(tid));
    int lane = tid & 63, l15 = lane & 15, g4 = lane >> 4;
    LAS unsigned char* L = F.lds; LAS float* FL = (LAS float*)(L + ML_F);
    f32x4 C[8];
#pragma unroll
    for (int et = 0; et < 8; ++et) C[et] = (f32x4){0.f, 0.f, 0.f, 0.f};
    float m = -1e30f, Gsum = 0.f;
    LAS float* GV = (LAS float*)(L + ML_GV); LAS float* GS = (LAS float*)(L + ML_GS); LAS float* CW = (LAS float*)(L + ML_CW);
    __syncthreads();
    if (tid < 128) FL[FN + tid] = 0.f;
    for (int i = tid; i < 1024; i += NWAVES * 64) { const int j = i >> 8, ch = i & 255; CW[i] = F.conv_w[j * 1024 + (ch >> 7) * 512 + h * 128 + (ch & 127)]; }
    {
        const size_t tg = (size_t)b * SEQ + (size_t)(sg * 8 + wave) * 64 + lane;
        const float* gr = F.GATES + tg * 8;
        const float ig = gr[h] + F.igate_b[h], fg = gr[4 + h] + F.fgate_b[h];
        const float lf = fminf(fg, 0.f) - log1pf(__expf(-fabsf(fg)));
        float bs = lf;
#pragma unroll
        for (int o = 1; o < 64; o <<= 1) { const float t = __shfl_up(bs, o); if (lane >= o) bs += t; }
        const float gtot = __shfl(bs, 63);
        const float u = ig - bs;
        float pm = u;
#pragma unroll
        for (int o = 1; o < 64; o <<= 1) { const float t = __shfl_up(pm, o); if (lane >= o) pm = fmaxf(pm, t); }
        const float a = gtot + u;
        const float mloc = wave_max(a);
        GV[wave * 256 + lane] = bs; GV[wave * 256 + 64 + lane] = u; GV[wave * 256 + 128 + lane] = exp_f(a - mloc); GV[wave * 256 + 192 + lane] = pm;
        if (lane == 0) { GS[wave * 2] = gtot; GS[wave * 2 + 1] = mloc; }
    }
    if (PASS == 2 && sg > 0) {
#ifdef MERGE23
        if (tid == 0) { unsigned* fl_ = (unsigned*)(F.ctl + (b * 4 + h) * 64); unsigned* bar_ = (unsigned*)(F.ctl + CW_BAR);
            XB_SPIN(xb_ld(fl_) < 7u, bar_);
            __builtin_amdgcn_fence(__ATOMIC_ACQUIRE, "agent"); asm volatile("s_waitcnt vmcnt(0)" ::: "memory"); }
        __syncthreads();
#endif
        const float* E0 = F.SEG + (size_t)((b * 4 + h) * 8) * SEG_STRIDE;
        float lw[7]; float sfx = 0.f, mfin = -1e30f;
#pragma unroll
        for (int j = 6; j >= 0; --j) { const int jc = (j < sg) ? j : 0; const float mE = E0[(size_t)jc * SEG_STRIDE + 16384 + 128], G = E0[(size_t)jc * SEG_STRIDE + 16384 + 129];
            lw[j] = (j < sg) ? (mE + sfx) : -1e30f; sfx += (j < sg) ? G : 0.f; mfin = fmaxf(mfin, lw[j]); }
        float coef[7];
#pragma unroll
        for (int j = 0; j < 7; ++j) coef[j] = (j < sg) ? exp_f(lw[j] - mfin) : 0.f;
#pragma unroll 1
        for (int j = 0; j < sg; ++j) { const float* Ej = E0 + (size_t)j * SEG_STRIDE; float cj = coef[0];
#pragma unroll
            for (int q = 1; q < 7; ++q) cj = (j == q) ? coef[q] : cj;
#pragma unroll
            for (int et = 0; et < 8; ++et) C[et] += ((const f32x4*)Ej)[(unsigned)((et * 8 + wave) * 64 + lane)] * cj;
            if (tid < 128) FL[FN + tid] += cj * Ej[16384 + tid]; }
        m = mfin;
    }
    if (PASS == 2) {
#pragma unroll
        for (int et = 0; et < 8; ++et) { v2u w; w.x = pg8::cvt_pk_bf16(C[et][0], C[et][1]); w.y = pg8::cvt_pk_bf16(C[et][2], C[et][3]); *(LAS v2u*)(L + ML_CT + (16 * et + l15) * ML_CSTR + (16 * wave + 4 * g4) * 2) = w; }
    }
    const float kscale = 0.08838834764831845f;
    v4u xr[7]; v4u vr[4];
#define ML_LOAD(cidx) do { const int c_ = (cidx); const size_t t0_ = (size_t)b * SEQ + (size_t)c_ * 64; \
        const int mat_ = tid >> 8, r8_ = tid & 255, dg_ = r8_ & 15, l0_ = 4 * (r8_ >> 4); \
        if (PASS == 2 || mat_ == 1) { const bf16* src_ = F.PROJ + (mat_ ? PC_MK : PC_MQ) + h * 128 + 8 * dg_; \
            _Pragma("unroll") for (int j = 0; j < 7; ++j) { const int lr = l0_ + j - 3; xr[j] = (c_ == 0 && lr < 0) ? (v4u){0u, 0u, 0u, 0u} : __builtin_nontemporal_load((const v4u*)(src_ + (t0_ + lr) * NPROJ)); } } \
        if (mat_ == 0) { _Pragma("unroll") for (int lp = 0; lp < 4; ++lp) vr[lp] = __builtin_nontemporal_load((const v4u*)(F.PROJ + (t0_ + l0_ + lp) * NPROJ + PC_MV + h * 128 + 8 * dg_)); } } while (0)
    ML_LOAD(sg * 8);
#pragma unroll 1
    for (int cc = 0; cc < 8; ++cc) {
        const int c = sg * 8 + cc; const size_t t0 = (size_t)b * SEQ + (size_t)c * 64;
        tid = F.tid; asm volatile("" : "+v"(tid));
        lane = tid & 63; l15 = lane & 15; g4 = lane >> 4;
        const int mat = tid >> 8, r8 = tid & 255, dg = r8 & 15, rg = r8 >> 4, l0 = 4 * rg;
        const int tsw = (((rg >> 1) ^ ((dg >> 1) & 7)) << 4) + ((rg & 1) << 3);
        LAS float* GB = GV + cc * 256;
        __syncthreads();
        const float gtot = GS[cc * 2], mloc = GS[cc * 2 + 1];
        if (PASS == 2 || mat == 1) {
            const float w0 = GB[128 + l0], w1 = GB[128 + l0 + 1], w2 = GB[128 + l0 + 2], w3 = GB[128 + l0 + 3];
            unsigned ow[4][4];
            const LAS float* cwp = CW + mat * 128 + 8 * dg;
#pragma unroll
            for (int ip = 0; ip < 4; ++ip) {
                const f32x2v c0 = *(const LAS f32x2v*)(cwp + 2 * ip), c1 = *(const LAS f32x2v*)(cwp + 256 + 2 * ip), c2 = *(const LAS f32x2v*)(cwp + 512 + 2 * ip), c3 = *(const LAS f32x2v*)(cwp + 768 + 2 * ip);
                f32x2v x2[7];
#pragma unroll
                for (int j = 0; j < 7; ++j) { const unsigned w = (ip == 0) ? xr[j].x : (ip == 1) ? xr[j].y : (ip == 2) ? xr[j].z : xr[j].w; x2[j] = (f32x2v){bflo(w), bfhi(w)}; }
                f32x2v y2[4];
#pragma unroll
                for (int lp = 0; lp < 4; ++lp) { const f32x2v t = c0 * x2[lp] + c1 * x2[lp + 1] + c2 * x2[lp + 2] + c3 * x2[lp + 3];
                    const f32x2v e = t * (-LOG2E); f32x2v d; d.x = __builtin_amdgcn_exp2f(e.x); d.y = __builtin_amdgcn_exp2f(e.y); d = d + 1.0f;
                    f32x2v r; r.x = __builtin_amdgcn_rcpf(d.x); r.y = __builtin_amdgcn_rcpf(d.y);
                    y2[lp] = t * r * (mat ? kscale : 1.0f);
                    ow[lp][ip] = pg8::cvt_pk_bf16(y2[lp].x, y2[lp].y); }
                if (mat == 1) {
                    const f32x2v s0 = y2[0] * w0, s1 = y2[1] * w1, s2 = y2[2] * w2, s3 = y2[3] * w3;
                    v2u o; o.x = pg8::cvt_pk_bf16(s0.x, s1.x); o.y = pg8::cvt_pk_bf16(s2.x, s3.x); *(LAS v2u*)(L + ML_KWT + (8 * dg + 2 * ip) * ML_TSTR + tsw) = o;
                    o.x = pg8::cvt_pk_bf16(s0.y, s1.y); o.y = pg8::cvt_pk_bf16(s2.y, s3.y); *(LAS v2u*)(L + ML_KWT + (8 * dg + 2 * ip + 1) * ML_TSTR + tsw) = o; }
            }
            if (PASS == 2) {
                LAS unsigned char* dst = L + (mat ? ML_KS : ML_QS) + l0 * ML_QSTR + 16 * dg;
#pragma unroll
                for (int lp = 0; lp < 4; ++lp) { v4u o; o.x = ow[lp][0]; o.y = ow[lp][1]; o.z = ow[lp][2]; o.w = ow[lp][3]; *(LAS v4u*)(dst + lp * ML_QSTR) = o; }
            }
        }
        if (mat == 0) {
            const unsigned ww[4][4] = {{vr[0].x, vr[0].y, vr[0].z, vr[0].w}, {vr[1].x, vr[1].y, vr[1].z, vr[1].w}, {vr[2].x, vr[2].y, vr[2].z, vr[2].w}, {vr[3].x, vr[3].y, vr[3].z, vr[3].w}};
#pragma unroll
            for (int p = 0; p < 4; ++p) {
                v2u lo, hi;
                lo.x = (ww[0][p] & 0xffffu) | (ww[1][p] << 16); lo.y = (ww[2][p] & 0xffffu) | (ww[3][p] << 16);
                hi.x = (ww[0][p] >> 16) | (ww[1][p] & 0xffff0000u); hi.y = (ww[2][p] >> 16) | (ww[3][p] & 0xffff0000u);
                *(LAS v2u*)(L + ML_VT + (8 * dg + 2 * p) * ML_TSTR + tsw) = lo;
                *(LAS v2u*)(L + ML_VT + (8 * dg + 2 * p + 1) * ML_TSTR + tsw) = hi; }
        }
        __syncthreads();
        if (cc < 7) ML_LOAD(c + 1);
        v4u mo2[2];
        if (PASS == 2) {
#pragma unroll
            for (int it = 0; it < 2; ++it) mo2[it] = __builtin_nontemporal_load((const v4u*)(F.PROJ + (t0 + 8 * wave + 4 * it + g4) * NPROJ + PC_MO + h * 128 + 8 * l15));
        }
        const float mn = fmaxf(gtot + m, mloc), so = exp_f(gtot + m - mn), sn = exp_f(mloc - mn);
        {
            bf16x8 af[2];
#pragma unroll
            for (int ks = 0; ks < 2; ++ks) af[ks] = *(const LAS bf16x8*)(L + ML_KWT + (16 * wave + l15) * ML_TSTR + (((4 * ks + g4) ^ (wave & 7)) << 4));
#pragma unroll
            for (int et = 0; et < 8; ++et) { f32x4 d = (f32x4){0.f, 0.f, 0.f, 0.f};
#pragma unroll
                for (int ks = 0; ks < 2; ++ks) { const bf16x8 bb = *(const LAS bf16x8*)(L + ML_VT + (16 * et + l15) * ML_TSTR + (((4 * ks + g4) ^ (et & 7)) << 4));
                    d = __builtin_amdgcn_mfma_f32_16x16x32_bf16(af[ks], bb, d, 0, 0, 0); }
                C[et] = C[et] * so + d * sn; }
        }
        if (PASS == 2) {
            const int lt = wave >> 1;
#pragma unroll
            for (int si = 0; si < 2; ++si) { const int st = 2 * (wave & 1) + si;
                v2u pw = (v2u){0u, 0u};
                if (st <= lt) {
                    f32x4 acc = (f32x4){0.f, 0.f, 0.f, 0.f};
#pragma unroll
                    for (int ks = 0; ks < 4; ++ks) { const bf16x8 a = *(const LAS bf16x8*)(L + ML_KS + (16 * st + l15) * ML_QSTR + 64 * ks + 16 * g4);
                        const bf16x8 bb = *(const LAS bf16x8*)(L + ML_QS + (16 * lt + l15) * ML_QSTR + 64 * ks + 16 * g4);
                        acc = __builtin_amdgcn_mfma_f32_16x16x32_bf16(a, bb, acc, 0, 0, 0); }
                    const int l = 16 * lt + l15, s0 = 16 * st + 4 * g4; const float bl = GB[l]; const float e0 = bl - (bl + fmaxf(GB[192 + l], m));
                    const f32x4 us = *(const LAS f32x4*)(GB + 64 + s0);
                    float p[4];
#pragma unroll
                    for (int r = 0; r < 4; ++r) { const float e = __builtin_amdgcn_exp2f((e0 + us[r]) * LOG2E); p[r] = (s0 + r <= l) ? acc[r] * e : 0.f; }
                    pw.x = pg8::cvt_pk_bf16(p[0], p[1]); pw.y = pg8::cvt_pk_bf16(p[2], p[3]);
                }
                *(LAS v2u*)(L + ML_PS + (16 * lt + l15) * ML_TSTR + (16 * st + 4 * g4) * 2) = pw;
            }
            __syncthreads();
            {
                const int row = 8 * wave + (lane >> 3), part = lane & 7;
                const v4u pw = *(const LAS v4u*)(L + ML_PS + row * ML_TSTR + 16 * part);
                float pf[8]; unpack8(pw, pf);
                float sp = ((pf[0] + pf[1]) + (pf[2] + pf[3])) + ((pf[4] + pf[5]) + (pf[6] + pf[7]));
                const v4u q0 = *(const LAS v4u*)(L + ML_QS + row * ML_QSTR + 32 * part), q1 = *(const LAS v4u*)(L + ML_QS + row * ML_QSTR + 32 * part + 16);
                float qf[16]; unpack8(q0, qf); unpack8(q1, qf + 8);
                float qn = 0.f;
#pragma unroll
                for (int i = 0; i < 16; ++i) qn += qf[i] * FL[FN + 16 * part + i];
                const float bl = GB[row]; const float mrow = bl + fmaxf(GB[192 + row], m); const float sc = exp_f(bl + m - mrow);
                float tot = sp + sc * qn;
                tot = sum8(tot);
                if (part == 0) FL[FDEN + row] = fmaxf(fabsf(tot), exp_f(-mrow));
            }
            const int eh = wave & 1;
            f32x4 o1[4], o2[4];
#pragma unroll
            for (int ei = 0; ei < 4; ++ei) { const int et = 4 * eh + ei;
                f32x4 a1 = (f32x4){0.f, 0.f, 0.f, 0.f}, a2 = (f32x4){0.f, 0.f, 0.f, 0.f};
#pragma unroll
                for (int ks = 0; ks < 2; ++ks) { const bf16x8 a = *(const LAS bf16x8*)(L + ML_VT + (16 * et + l15) * ML_TSTR + (((4 * ks + g4) ^ (et & 7)) << 4));
                    const bf16x8 bb = *(const LAS bf16x8*)(L + ML_PS + (16 * lt + l15) * ML_TSTR + 64 * ks + 16 * g4);
                    a1 = __builtin_amdgcn_mfma_f32_16x16x32_bf16(a, bb, a1, 0, 0, 0); }
#pragma unroll
                for (int ks = 0; ks < 4; ++ks) { const bf16x8 a = *(const LAS bf16x8*)(L + ML_CT + (16 * et + l15) * ML_CSTR + 64 * ks + 16 * g4);
                    const bf16x8 bb = *(const LAS bf16x8*)(L + ML_QS + (16 * lt + l15) * ML_QSTR + 64 * ks + 16 * g4);
                    a2 = __builtin_amdgcn_mfma_f32_16x16x32_bf16(a, bb, a2, 0, 0, 0); }
                o1[ei] = a1; o2[ei] = a2; }
            __syncthreads();
            {
                const int l = 16 * lt + l15; const float bl = GB[l]; const float mrow = bl + fmaxf(GB[192 + l], m); const float sc = exp_f(bl + m - mrow);
                const float inv = 1.0f / FL[FDEN + l];
#pragma unroll
                for (int ei = 0; ei < 4; ++ei) { const int et = 4 * eh + ei; const f32x4 hv = (o1[ei] + o2[ei] * sc) * inv;
                    *(LAS f32x4*)(L + l * ML_HSTR + (16 * et + 4 * g4) * 4) = hv; }
            }
        }
        {
            { const int d = tid >> 2, qq = tid & 3; float dn = 0.f;
#pragma unroll
                for (int q = 0; q < 2; ++q) { const v4u w = *(const LAS v4u*)(L + ML_KWT + d * ML_TSTR + 16 * (2 * qq + q)); float f[8]; unpack8(w, f); dn += ((f[0] + f[1]) + (f[2] + f[3])) + ((f[4] + f[5]) + (f[6] + f[7])); }
                dn += dppf<0xB1>(dn); dn += dppf<0x4E>(dn);
                if (qq == 0) FL[FN + d] = so * FL[FN + d] + sn * dn; }
            m = mn; Gsum += gtot;
            if (PASS == 2) {
#pragma unroll
                for (int et = 0; et < 8; ++et) { v2u w; w.x = pg8::cvt_pk_bf16(C[et][0], C[et][1]); w.y = pg8::cvt_pk_bf16(C[et][2], C[et][3]); *(LAS v2u*)(L + ML_CT + (16 * et + l15) * ML_CSTR + (16 * wave + 4 * g4) * 2) = w; }
            }
        }
        if (PASS == 2) {
            __syncthreads();
            const f32x4 gg0 = *(const f32x4*)(F.mlstm_norm_g + h * 128 + 8 * l15), gg1 = *(const f32x4*)(F.mlstm_norm_g + h * 128 + 8 * l15 + 4);
#pragma unroll
            for (int it = 0; it < 2; ++it) { const int l = 8 * wave + 4 * it + g4;
                const f32x4 h0 = *(const LAS f32x4*)(L + l * ML_HSTR + l15 * 32), h1 = *(const LAS f32x4*)(L + l * ML_HSTR + l15 * 32 + 16);
                float ss = (h0[0] * h0[0] + h0[1] * h0[1]) + (h0[2] * h0[2] + h0[3] * h0[3]) + (h1[0] * h1[0] + h1[1] * h1[1]) + (h1[2] * h1[2] + h1[3] * h1[3]);
                ss = sum16(ss);
                const float rstd = __builtin_amdgcn_rsqf(ss * (1.f / 128.f) + EPS);
                float mo[8]; unpack8(mo2[it], mo);
                const f32x4 y0 = h0 * gg0 * rstd, y1 = h1 * gg1 * rstd;
                v4u o; o.x = pg8::cvt_pk_bf16(y0[0] * mo[0], y0[1] * mo[1]); o.y = pg8::cvt_pk_bf16(y0[2] * mo[2], y0[3] * mo[3]);
                o.z = pg8::cvt_pk_bf16(y1[0] * mo[4], y1[1] * mo[5]); o.w = pg8::cvt_pk_bf16(y1[2] * mo[6], y1[3] * mo[7]);
                *(v4u*)(F.MIX + (t0 + l) * DM + h * 128 + 8 * l15) = o; }
        }
    }
    if (PASS == 1) {
        tid = F.tid; asm volatile("" : "+v"(tid)); lane = tid & 63; l15 = lane & 15; g4 = lane >> 4;
        float* E = F.SEG + (size_t)((b * 4 + h) * 8 + sg) * SEG_STRIDE;
#ifdef MERGE23
#pragma unroll
        for (int et = 0; et < 8; ++et) { const f32x4 cv = C[et]; asm volatile("global_store_dwordx4 %0, %1, off sc1\n\ts_nop 1" :: "v"(&((f32x4*)E)[(et * 8 + wave) * 64 + lane]), "v"(cv) : "memory"); }
        if (tid < 128) __hip_atomic_store(E + 16384 + tid, FL[FN + tid], __ATOMIC_RELAXED, __HIP_MEMORY_SCOPE_AGENT);
        if (tid == 0) { __hip_atomic_store(E + 16384 + 128, m, __ATOMIC_RELAXED, __HIP_MEMORY_SCOPE_AGENT); __hip_atomic_store(E + 16384 + 129, Gsum, __ATOMIC_RELAXED, __HIP_MEMORY_SCOPE_AGENT); }
        asm volatile("s_waitcnt vmcnt(0)" ::: "memory");
        __syncthreads();
        if (tid == 0) (void)xb_add((unsigned*)(F.ctl + (b * 4 + h) * 64), 1u);
#else
#pragma unroll
        for (int et = 0; et < 8; ++et) ((f32x4*)E)[(et * 8 + wave) * 64 + lane] = C[et];
        if (tid < 128) E[16384 + tid] = FL[FN + tid];
        if (tid == 0) { E[16384 + 128] = m; E[16384 + 129] = Gsum; }
#endif
    }
}
template <int PASS> __device__ __forceinline__ void mlstm_phase(Frame& F) {
    for (int it = F.vcu; it < NB * 4 * 8; it += F.G) { const int sg = it & 7, h = (it >> 3) & 3, b = it >> 5;
        if (PASS == 1 && sg == 7) { convert_gu(F, it >> 3, NB * 4); continue; }
        mlstm_item<PASS>(F, b, h, sg); }
}
struct Args { const float* in[15]; float* out; unsigned char* ws; int ph_lo, ph_hi, li, pad; };
__global__ void __launch_bounds__(NWAVES * 64, 2) mk_fwd(Args args) {
    extern __shared__ __attribute__((aligned(16))) unsigned char lds[];
    Frame F;
    F.lds = (LAS unsigned char*)lds;
    F.MISC = (volatile LAS unsigned*)(F.lds + MISC_OFF);
    F.tid = threadIdx.x; F.lane = F.tid & 63; F.wave = __builtin_amdgcn_readfirstlane(F.tid >> 6);
    F.G = gridDim.x; { const int bx = blockIdx.x; F.vcu = (F.G % 8 == 0) ? (bx % 8) * (F.G / 8) + bx / 8 : bx; }
    unsigned char* ws = args.ws;
    F.ctl = (gu32*)(ws + WS_CTL);
    F.x = args.in[0]; F.norm1_g = args.in[1]; F.w_in = args.in[2]; F.conv_w = args.in[3]; F.igate_b = args.in[4]; F.fgate_b = args.in[5]; F.mlstm_norm_g = args.in[6];
    F.q_norm_g = args.in[7]; F.k_norm_g = args.in[8]; F.sinks = args.in[9]; F.w_out = args.in[10]; F.norm2_g = args.in[11]; F.w_gate = args.in[12]; F.w_up = args.in[13]; F.w_down = args.in[14];
    F.out = args.out;
    F.Win_t = (bf16*)(ws + WS_WIN); F.Wout_t = (bf16*)(ws + WS_WOUT); F.Wgu_t = (bf16*)(ws + WS_WGU); F.Wdn_t = (bf16*)(ws + WS_WDN);
    { const size_t hi = (size_t)args.pad * MiB; F.XN = (bf16*)(ws + hi - WS_XN_BACK); F.MIX = (bf16*)(ws + hi - WS_MIX_BACK); F.PROJ = (bf16*)(ws + hi - WS_PROJ_BACK); }
    F.ROPE = (float2*)(ws + WS_ROPE); F.GATES = (float*)(ws + WS_GATES); F.SSQ = (float*)(ws + WS_SSQ); F.SEG = (float*)(ws + WS_SEG); F.WBG = ws + WS_WBG;
    for (int u = F.tid; u < (LDS_BYTES - LDSCTL_OFF) / 4; u += NWAVES * 64) ((LAS unsigned*)(F.lds + LDSCTL_OFF))[u] = 0u;
    __syncthreads();
    const int lo = args.ph_lo, hi = args.ph_hi;
    XcdBarrier bar; bar.bar = (unsigned*)(F.ctl + CW_BAR) + args.li * XCD_BAR_WORDS; bar.x = 0; bar.st = nullptr;
    if (hi - lo > 1) bar = xcd_barrier_post((unsigned*)(F.ctl + CW_BAR) + args.li * XCD_BAR_WORDS, F.MISC + 8);
#define IN(k) (lo <= (k) && (k) < hi)
#define BOTH(k) (IN(k) && IN((k) + 1))
#define GRID_BAR() xcd_barrier(bar)

#ifndef PROBE_LOCALBAR
#define PROBE_LOCALBAR 0
#endif
#ifndef DOUBLE_PHASE
#define DOUBLE_PHASE -1
#endif
#define RUN_PHASE(k, BODY) if (IN(k)) { { int t_ = threadIdx.x; asm volatile("" : "+v"(t_)); F.tid = t_; F.lane = t_ & 63; }     \
    BODY; if (DOUBLE_PHASE == (k)) { GRID_BAR(); BODY; } if (PROBE_LOCALBAR && ((k) == 1 || (k) == 4 || (k) == 5)) xcd_barrier_local(bar); if (BOTH(k)) GRID_BAR(); }
#define PH0 p0_prologue(F)
#define PH1 do { pg8::Gemm g{F.XN, F.Win_t, T, NPROJ, DM}; pg8::StaticOrder S; S.init(T, NPROJ, F.G, (int)blockIdx.x); pg8::EpiStoreBf16 E{F.PROJ, NPROJ, PC_MO / 256, (PC_MO + 512) / 256}; \
        pg8::gemm_phase<pg8::EpiStoreBf16, pg8::StaticOrder, true, true>(F.lds, g, S, E); \
        { const int nwg_ = (T / 256) * (NPROJ / 256), rem_ = nwg_ % F.G;               \
          if (rem_ == 0) p1_side_work(F, (int)blockIdx.x, F.G); else if ((int)blockIdx.x >= rem_) p1_side_work(F, (int)blockIdx.x - rem_, F.G - rem_); } } while (0)
#ifdef H1_BF16
#define PH4 do { pg8::Gemm g{F.MIX, F.Wout_t, T, DM, DM}; pg8::StaticOrder S; S.init(T, DM, F.G, (int)blockIdx.x); pg8::EpiResidNormBS E{F.x, F.XN, F.SSQ}; \
        pg8::gemm_phase<pg8::EpiResidNormBS, pg8::StaticOrder, true, true>(F.lds, g, S, E); } while (0)
#ifdef P6_STREAM
#define PH6 do { pg8::Gemm g{F.PROJ, F.Wdn_t, T, DM, DFF}; pg8::StaticOrder S; S.init(T, DM, F.G, (int)blockIdx.x); pg8::EpiResidOutBS E{F.XN, F.out}; \
        pg8::gemm_phase<pg8::EpiResidOutBS, pg8::StaticOrder, true, true>(F.lds, g, S, E); } while (0)
#else
#define PH6 do { pg8::Gemm g{F.PROJ, F.Wdn_t, T, DM, DFF}; pg8::StaticOrder S; S.init(T, DM, F.G, (int)blockIdx.x); pg8::EpiResidOutB E{F.XN, F.out}; \
        pg8::gemm_phase<pg8::EpiResidOutB, pg8::StaticOrder, true, true>(F.lds, g, S, E); } while (0)
#endif
#else
#define PH4 do { pg8::Gemm g{F.MIX, F.Wout_t, T, DM, DM}; pg8::StaticOrder S; S.init(T, DM, F.G, (int)blockIdx.x); pg8::EpiResidNorm E{F.x, F.out, F.XN, F.SSQ}; \
        pg8::gemm_phase<pg8::EpiResidNorm, pg8::StaticOrder, true, true>(F.lds, g, S, E); } while (0)
#define PH6 do { pg8::Gemm g{F.PROJ, F.Wdn_t, T, DM, DFF}; pg8::StaticOrder S; S.init(T, DM, F.G, (int)blockIdx.x); pg8::EpiResidOut E{F.out, F.out}; \
        pg8::gemm_phase<pg8::EpiResidOut, pg8::StaticOrder, true, true>(F.lds, g, S, E); } while (0)
#endif
#define PH5 do { pg8::Gemm g{F.XN, F.Wgu_t, T, 2 * DFF, DM}; pg8::StaticOrder S; S.init(T, 2 * DFF, F.G, (int)blockIdx.x); pg8::EpiSwiGLU E{F.PROJ, DFF, F.SSQ, EPS}; \
        pg8::gemm_phase<pg8::EpiSwiGLU, pg8::StaticOrder, P5_ALIGN, true>(F.lds, g, S, E); } while (0)
    RUN_PHASE(0, PH0)
    RUN_PHASE(1, PH1)
    RUN_PHASE(2, PHASE2_BODY)
#ifndef MERGE23
    RUN_PHASE(3, PHASE3_BODY)
#endif
    RUN_PHASE(4, PH4)
    RUN_PHASE(5, PH5)
    RUN_PHASE(6, PH6)
#undef IN
#undef BOTH
}
extern "C" void kernel_launch(void* const* d_in, const int* in_sizes, int n_in, void* d_out, int out_size, void* d_ws, size_t ws_size, hipStream_t stream) {
    static int grid = 0;
    if (grid == 0) {
        if (n_in != 15 || in_sizes[0] != T * DM || out_size != T * DM || ws_size < WS_END) { fprintf(stderr, "kernel_launch: unexpected shapes / workspace (n_in %d, ws %zu)\n", n_in, ws_size); grid = -1; return; }
        int dev = 0, cus = 0, per_cu = 0;
        if (hipGetDevice(&dev) != hipSuccess || hipDeviceGetAttribute(&cus, hipDeviceAttributeMultiprocessorCount, dev) != hipSuccess) { grid = -1; return; }
        if (hipFuncSetAttribute((const void*)mk_fwd, hipFuncAttributeMaxDynamicSharedMemorySize, LDS_BYTES) != hipSuccess) { fprintf(stderr, "kernel_launch: hipFuncSetAttribute failed\n"); grid = -1; return; }
        if (hipOccupancyMaxActiveBlocksPerMultiprocessor(&per_cu, (const void*)mk_fwd, NWAVES * 64, LDS_BYTES) != hipSuccess || per_cu < 1) { fprintf(stderr, "kernel_launch: occupancy query says %d blocks per CU\n", per_cu); grid = -1; (void)hipGetLastError(); return; }
        grid = cus;
    }
    if (grid < 0) return;
    (void)hipMemsetAsync((char*)d_ws + WS_CTL, 0, CTL_ZERO_BYTES, stream);
    Args a{};
    for (int i = 0; i < 15; ++i) a.in[i] = (const float*)d_in[i];
    a.out = (float*)d_out; a.ws = (unsigned char*)d_ws; a.pad = (int)(ws_size >> 20);
    LAUNCH_PROGRAM
}
```
